# Optimizing an MI355X kernel written in HIP

```python
import jax, jax.numpy as jnp
from jax import lax
import numpy as np

D_MODEL = 1024
BATCH = 8
SEQ = 2048
DEPTH = 2

GRID_W = 64
CTX_LEN = 256
HEAD_DIM = 64
EPS = 1e-6
A_WIDTH = D_MODEL // 4
A_HEADS = A_WIDTH // HEAD_DIM
A_CHUNK = 128
B_WIDTH = D_MODEL // 2
B_HEADS = B_WIDTH // HEAD_DIM
B_KV_HEADS = 2
B_GROUP = B_HEADS // B_KV_HEADS
B_KV_WIDTH = B_KV_HEADS * HEAD_DIM
Q_BLOCK = 128
ROPE_AXIS_DIM = HEAD_DIM // 2
ROPE_BASE = 10000.0
C_WIDTH = D_MODEL // 4
C_HEADS = C_WIDTH // HEAD_DIM
C_CHUNK = 64
MIX_WIDTH = A_WIDTH + B_WIDTH + C_WIDTH
OFF_B = 2 * A_WIDTH
OFF_KV = OFF_B + B_WIDTH
OFF_C = OFF_KV + 2 * B_KV_WIDTH
OFF_G = OFF_C + 4 * C_WIDTH
IN_WIDTH = OFF_G + C_WIDTH
N_GROUPS = 4
EXPERTS_PER_GROUP = 8
N_EXPERTS = N_GROUPS * EXPERTS_PER_GROUP
TOP_K = 2
D_FF_EXPERT = D_MODEL // 2
MOE_BLOCK = 128

kernel_name = 'hybrid_dit_gmlp_gqa_hgrn2_hmoe'


def _rms(x):
    xf = x.astype(jnp.float32)
    return (xf * lax.rsqrt(jnp.mean(xf * xf, axis=-1, keepdims=True) + EPS)).astype(x.dtype)


def axial_rope_tables(rows):
    row = jnp.repeat(jnp.arange(rows), GRID_W).astype(jnp.float32)
    col = jnp.tile(jnp.arange(GRID_W), rows).astype(jnp.float32)
    inv_freq = 1.0 / (ROPE_BASE ** (jnp.arange(0, ROPE_AXIS_DIM, 2, dtype=jnp.float32) / ROPE_AXIS_DIM))
    ang = jnp.stack([row[:, None] * inv_freq, col[:, None] * inv_freq], axis=1)
    return jnp.cos(ang)[:, None, :, None, :], jnp.sin(ang)[:, None, :, None, :]


def apply_rope(x, cos, sin):
    b, t, h, _ = x.shape
    xr = x.astype(jnp.float32).reshape(b, t, h, 2, 2, ROPE_AXIS_DIM // 2)
    rot = jnp.stack([-xr[..., 1, :], xr[..., 0, :]], axis=-2)
    return (xr * cos + rot * sin).reshape(b, t, h, HEAD_DIM).astype(x.dtype)


def chunk_mlp(z, w_s, b_s):
    b, t, _ = z.shape
    u, v = jnp.split(jax.nn.gelu(z), 2, axis=-1)
    v = _rms(v.reshape(b, t // A_CHUNK, A_CHUNK, A_HEADS, HEAD_DIM))
    mixed = jnp.einsum('hts,bnshd->bnthd', w_s, v) + b_s.T[:, :, None]
    return u * mixed.reshape(b, t, A_WIDTH)


def _gqa(q, k, v):
    s = jnp.einsum('bqkgd,bskd->bkgqs', q, k).astype(jnp.float32) * (HEAD_DIM ** -0.5)
    p = jax.nn.softmax(s, axis=-1).astype(v.dtype)
    return jnp.einsum('bkgqs,bskd->bqkgd', p, v)


def latent_attention(q, k, v, kc, vc):
    b, t, _, _ = q.shape
    keys = jnp.concatenate([k, kc], axis=1)
    vals = jnp.concatenate([v, vc], axis=1)
    qb = q.reshape(b, t // Q_BLOCK, Q_BLOCK, B_KV_HEADS, B_GROUP, HEAD_DIM).transpose(1, 0, 2, 3, 4, 5)
    out = lax.map(lambda qblk: _gqa(qblk, keys, vals), qb)
    return out.transpose(1, 0, 2, 3, 4, 5).reshape(b, t, B_WIDTH)


def forget_gate(zf, lb):
    zf32 = zf.astype(jnp.float32)
    lbh = lb.reshape(C_HEADS, HEAD_DIM)
    pos = lbh > 0.0
    log_lb = jnp.log(jnp.where(pos, lbh, 1.0))
    log_rest = jnp.log1p(-lbh) + jax.nn.log_sigmoid(zf32)
    log_f = jnp.where(pos, jnp.logaddexp(log_lb, log_rest), log_rest)
    k = (1.0 - lbh) * jax.nn.sigmoid(-zf32)
    return k, log_f


def hgrn_inputs(z, lb):
    b, t, _ = z.shape
    q, zf, zb, v = [a.reshape(b, t, C_HEADS, HEAD_DIM) for a in jnp.split(z, 4, axis=-1)]
    kf, logf_f = forget_gate(zf, lb[0])
    kb, logf_b = forget_gate(zb, lb[1])
    return jax.nn.silu(q), v, kf, logf_f, kb, logf_b


def hgrn_scan(q, k, v, log_f, s0, with_output):
    b, t, h, _ = q.shape
    nc = t // C_CHUNK

    def chunks(a):
        return a.astype(jnp.float32).reshape(b, nc, C_CHUNK, h, a.shape[-1]).transpose(1, 0, 3, 2, 4)

    qc, kc, vc = chunks(q), chunks(k), chunks(v)
    bc = jnp.cumsum(chunks(log_f), axis=3)
    tri = jnp.tril(jnp.ones((C_CHUNK, C_CHUNK), bool))[:, :, None]

    def step(s, inp):
        qi, ki, vi, bi = inp
        b_last = bi[:, :, -1:, :]
        s_new = jnp.exp(b_last[:, :, 0, :, None]) * s + jnp.einsum('bhsk,bhsv->bhkv', ki * jnp.exp(b_last - bi), vi)
        if not with_output:
            return s_new, None
        diff = bi[:, :, :, None, :] - bi[:, :, None, :, :]
        decay = jnp.where(tri, jnp.exp(jnp.where(tri, diff, 0.0)), 0.0)
        scores = jnp.einsum('bhtk,bhsk,bhtsk->bhts', qi, ki, decay)
        o = jnp.einsum('bhts,bhsv->bhtv', scores, vi) + jnp.einsum('bhtk,bhkv->bhtv', qi * jnp.exp(bi), s)
        return s_new, o

    s_fin, o = lax.scan(step, s0, (qc, kc, vc, bc))
    if with_output:
        o = o.transpose(1, 0, 3, 2, 4).reshape(b, t, h, v.shape[-1])
    return s_fin, o


def hgrn_bidir(z, zc, lb, ctx_out):
    q, v, kf, lf, kb, lbw = hgrn_inputs(z, lb)
    qc, vc, kfc, lfc, kbc, lbc = hgrn_inputs(zc, lb)
    s0 = jnp.zeros((z.shape[0], C_HEADS, HEAD_DIM, HEAD_DIM), jnp.float32)
    rev = lambda a: a[:, ::-1]
    sf, of_c = hgrn_scan(qc, kfc, vc, lfc, s0, ctx_out)
    _, of = hgrn_scan(q, kf, v, lf, sf, True)
    sb, ob_c = hgrn_scan(rev(qc), rev(kbc), rev(vc), rev(lbc), s0, ctx_out)
    _, ob = hgrn_scan(rev(q), rev(kb), rev(v), rev(lbw), sb, True)
    o = of + rev(ob)
    o_c = of_c + rev(ob_c) if ctx_out else None
    return o, o_c


def hgrn_out(o, g, w):
    b, t = g.shape[:2]
    return (_rms(o) * w).reshape(b, t, C_WIDTH).astype(g.dtype) * jax.nn.silu(g)


def hier_moe(h, w_grp, b_grp, w_exp, b_exp, w1, w3, w2):
    n_tok, d = h.shape
    g_logits = (h @ w_grp + b_grp).astype(jnp.float32)
    grp = jnp.argmax(g_logits, axis=-1)
    p_grp = jnp.take_along_axis(jax.nn.softmax(g_logits, axis=-1), grp[:, None], axis=-1)
    e_logits = (h @ w_exp + b_exp).astype(jnp.float32).reshape(n_tok, N_GROUPS, EXPERTS_PER_GROUP)
    e_in = jnp.take_along_axis(e_logits, grp[:, None, None], axis=1)[:, 0]
    top_val, top_idx = lax.top_k(e_in, TOP_K)
    gate = (jax.nn.softmax(top_val, axis=-1) * p_grp).reshape(-1)
    expert = (grp[:, None] * EXPERTS_PER_GROUP + top_idx).reshape(-1)
    tok = jnp.repeat(jnp.arange(n_tok), TOP_K)
    n_asg = n_tok * TOP_K
    order = jnp.argsort(expert)
    e_sorted, tok_sorted, gate_sorted = expert[order], tok[order], gate[order]
    counts = jax.ops.segment_sum(jnp.ones_like(expert), expert, num_segments=N_EXPERTS)
    padded = (counts + MOE_BLOCK - 1) // MOE_BLOCK * MOE_BLOCK
    starts = jnp.cumsum(counts) - counts
    pad_ends = jnp.cumsum(padded)
    pad_starts = pad_ends - padded
    dest = pad_starts[e_sorted] + jnp.arange(n_asg) - starts[e_sorted]
    n_blocks = -(-n_asg // MOE_BLOCK) + N_EXPERTS
    buf = jnp.zeros((n_blocks * MOE_BLOCK, d), h.dtype).at[dest].set(h[tok_sorted])
    blk_expert = jnp.minimum(jnp.searchsorted(pad_ends, jnp.arange(n_blocks) * MOE_BLOCK, side='right'), N_EXPERTS - 1)

    def expert_block(args):
        xb, e = args
        return (jax.nn.silu(xb @ w1[e]) * (xb @ w3[e])) @ w2[e]

    out = lax.map(expert_block, (buf.reshape(n_blocks, MOE_BLOCK, d), blk_expert)).reshape(-1, d)
    y = jax.ops.segment_sum(out[dest] * gate_sorted[:, None], tok_sorted, num_segments=n_tok)
    return y.astype(h.dtype)


def hybrid_layer(x, xc, c, c_ctx, cos, sin, lb, w_mod, b_mod, norm1_w, w_in, w_s, b_s, q_norm_w, k_norm_w,
                 hgrn_norm_w, w_out, norm2_w, w_grp, b_grp, w_exp, b_exp, w1, w3, w2, ctx_out):
    b, t, d = x.shape
    lc = xc.shape[1]
    sh1, sc1, g1, sh2, sc2, g2 = jnp.split((jax.nn.silu(c) @ w_mod + b_mod)[:, None, :], 6, axis=-1)
    n_mod = 6 if ctx_out else 2
    mod_c = jnp.split(jax.nn.silu(c_ctx) @ w_mod[:, :n_mod * d] + b_mod[:n_mod * d], n_mod)
    h = _rms(x) * norm1_w * (1.0 + sc1) + sh1
    hc = _rms(xc) * norm1_w * (1.0 + mod_c[1]) + mod_c[0]
    p = h @ w_in
    pc = hc @ w_in[:, OFF_KV:OFF_G]
    ya = chunk_mlp(p[..., :OFF_B], w_s, b_s)
    q = apply_rope(_rms(p[..., OFF_B:OFF_KV].reshape(b, t, B_HEADS, HEAD_DIM)) * q_norm_w, cos, sin)
    k, v = jnp.split(p[..., OFF_KV:OFF_C].reshape(b, t, 2 * B_KV_HEADS, HEAD_DIM), 2, axis=2)
    k = apply_rope(_rms(k) * k_norm_w, cos, sin)
    kc, vc = jnp.split(pc[..., :2 * B_KV_WIDTH].reshape(b, lc, 2 * B_KV_HEADS, HEAD_DIM), 2, axis=2)
    kc = _rms(kc) * k_norm_w
    yb = latent_attention(q, k, v, kc, vc)
    o, o_c = hgrn_bidir(p[..., OFF_C:OFF_G], pc[..., 2 * B_KV_WIDTH:], lb, ctx_out)
    yc = hgrn_out(o, p[..., OFF_G:], hgrn_norm_w)
    x = x + g1 * (jnp.concatenate([ya, yb, yc], axis=-1) @ w_out)
    h2 = _rms(x) * norm2_w * (1.0 + sc2) + sh2
    if ctx_out:
        pc_rest = hc @ w_in[:, :OFF_KV]
        pc_g = hc @ w_in[:, OFF_G:]
        ya_c = chunk_mlp(pc_rest[..., :OFF_B], w_s, b_s)
        qc = _rms(pc_rest[..., OFF_B:].reshape(b, lc, B_HEADS, HEAD_DIM)) * q_norm_w
        yb_c = _gqa(qc.reshape(b, lc, B_KV_HEADS, B_GROUP, HEAD_DIM), kc, vc).reshape(b, lc, B_WIDTH)
        yc_c = hgrn_out(o_c, pc_g, hgrn_norm_w)
        xc = xc + mod_c[2] * (jnp.concatenate([ya_c, yb_c, yc_c], axis=-1) @ w_out)
        h2c = _rms(xc) * norm2_w * (1.0 + mod_c[4]) + mod_c[3]
        tokens = jnp.concatenate([h2.reshape(-1, d), h2c.reshape(-1, d)], axis=0)
        m = hier_moe(tokens, w_grp, b_grp, w_exp, b_exp, w1, w3, w2)
        x = x + g2 * m[:b * t].reshape(b, t, d)
        xc = xc + mod_c[5] * m[b * t:].reshape(b, lc, d)
    else:
        x = x + g2 * hier_moe(h2.reshape(-1, d), w_grp, b_grp, w_exp, b_exp, w1, w3, w2).reshape(b, t, d)
    return x, xc


def setup_inputs(seed: int = 0) -> dict:
    key = jax.random.key(seed)
    ks = jax.random.split(key, 24)
    nrm = lambda k, shape, scale: jax.random.normal(k, shape, jnp.float32) * scale
    return {
        'x': nrm(ks[0], (BATCH, SEQ, D_MODEL), 1.0),
        'c': nrm(ks[1], (BATCH, D_MODEL), 1.0),
        'ctx': nrm(ks[2], (BATCH, CTX_LEN, D_MODEL), 1.0),
        'c_ctx': nrm(ks[3], (D_MODEL,), 1.0),
        'w_mod': nrm(ks[4], (DEPTH, D_MODEL, 6 * D_MODEL), 0.5 * D_MODEL ** -0.5),
        'b_mod': nrm(ks[5], (DEPTH, 6 * D_MODEL), 0.02),
        'norm1_w': 1.0 + nrm(ks[6], (DEPTH, D_MODEL), 0.02),
        'w_in': nrm(ks[7], (DEPTH, D_MODEL, IN_WIDTH), D_MODEL ** -0.5),
        'w_s': nrm(ks[8], (DEPTH, A_HEADS, A_CHUNK, A_CHUNK), A_CHUNK ** -0.5),
        'b_s': 1.0 + nrm(ks[9], (DEPTH, A_HEADS, A_CHUNK), 0.02),
        'q_norm_w': 1.0 + nrm(ks[10], (DEPTH, HEAD_DIM), 0.02),
        'k_norm_w': 1.0 + nrm(ks[11], (DEPTH, HEAD_DIM), 0.02),
        'hgrn_lb_logits': nrm(ks[12], (DEPTH, 2, C_WIDTH), 1.0),
        'hgrn_norm_w': 1.0 + nrm(ks[13], (DEPTH, HEAD_DIM), 0.02),
        'w_out': nrm(ks[14], (DEPTH, MIX_WIDTH, D_MODEL), MIX_WIDTH ** -0.5),
        'norm2_w': 1.0 + nrm(ks[15], (DEPTH, D_MODEL), 0.02),
        'w_grp': nrm(ks[16], (DEPTH, D_MODEL, N_GROUPS), D_MODEL ** -0.5),
        'b_grp': nrm(ks[17], (DEPTH, N_GROUPS), 0.01),
        'w_exp': nrm(ks[18], (DEPTH, D_MODEL, N_EXPERTS), D_MODEL ** -0.5),
        'b_exp': nrm(ks[19], (DEPTH, N_EXPERTS), 0.01),
        'w1': nrm(ks[20], (DEPTH, N_EXPERTS, D_MODEL, D_FF_EXPERT), D_MODEL ** -0.5),
        'w3': nrm(ks[21], (DEPTH, N_EXPERTS, D_MODEL, D_FF_EXPERT), D_MODEL ** -0.5),
        'w2': nrm(ks[22], (DEPTH, N_EXPERTS, D_FF_EXPERT, D_MODEL), D_FF_EXPERT ** -0.5),
    }


def reference(x, c, ctx, c_ctx, w_mod, b_mod, norm1_w, w_in, w_s, b_s, q_norm_w, k_norm_w, hgrn_lb_logits,
              hgrn_norm_w, w_out, norm2_w, w_grp, b_grp, w_exp, b_exp, w1, w3, w2):
    ROWS = x.shape[1] // GRID_W
    cos, sin = axial_rope_tables(ROWS)
    lb_sm = jax.nn.softmax(hgrn_lb_logits.astype(jnp.float32), axis=0)
    lb = jnp.cumsum(lb_sm, axis=0) - lb_sm[0]
    xc = ctx
    for l in range(DEPTH):
        x, xc = hybrid_layer(x, xc, c, c_ctx, cos, sin, lb[l], w_mod[l], b_mod[l], norm1_w[l], w_in[l], w_s[l],
                             b_s[l], q_norm_w[l], k_norm_w[l], hgrn_norm_w[l], w_out[l], norm2_w[l], w_grp[l],
                             b_grp[l], w_exp[l], b_exp[l], w1[l], w3[l], w2[l], ctx_out=(l < DEPTH - 1))
    return x
```

```cpp
#include <hip/hip_runtime.h>
#include <hip/hip_cooperative_groups.h>
#include <cstdio>
#include <cstdint>
namespace cg = cooperative_groups;

constexpr int D = 1024, NB = 8, T = 2048, TC = 256;
constexpr int RL = NB * T, RC = NB * TC, R = RL + RC;
constexpr int INW = 2560, LFW = 512;
constexpr int OFF_B = 512, OFF_KV = 1024, OFF_V = 1152, OFF_C = 1280, OFF_ZF = 1536, OFF_ZB = 1792, OFF_HV = 2048, OFF_G = 2304;
constexpr int NEXP = 32, FF = 512;
constexpr float EPS = 1e-6f;
constexpr int NTHREADS = 256;

constexpr size_t MiB = 1ull << 20;
constexpr size_t WS_CTL = 0;
constexpr size_t WS_TAB = 1 * MiB;
constexpr size_t WS_H = 2 * MiB;
constexpr size_t WS_P = WS_H + 36 * MiB;
constexpr size_t WS_LF = WS_P + 90 * MiB;
constexpr size_t WS_Y = WS_LF + 36 * MiB;
constexpr size_t WS_X1 = WS_Y + 36 * MiB;
constexpr size_t WS_X2 = WS_X1 + 72 * MiB;
constexpr size_t WS_OFB = WS_X2 + 72 * MiB;
constexpr size_t WS_RT = WS_OFB + 18 * MiB;
constexpr size_t WS_END = WS_RT + 4 * MiB;
constexpr int TAB_ROPE = 0;
constexpr int TAB_LB = 2048;
constexpr int TAB_MOD = 4096;

typedef unsigned short bf16_t;
typedef short bf16x8 __attribute__((ext_vector_type(8)));
typedef float f32x4 __attribute__((ext_vector_type(4)));
typedef float f32x2 __attribute__((ext_vector_type(2)));
typedef unsigned u32x4 __attribute__((ext_vector_type(4)));
typedef unsigned u32x2 __attribute__((ext_vector_type(2)));
typedef __bf16 bf16x2_t __attribute__((ext_vector_type(2)));

struct Params {
    const float* in[23];
    float* out;
    unsigned char* ws;
    int ph_lo, ph_hi;
};

__device__ __forceinline__ unsigned pk2(float lo, float hi) { f32x2 v = {lo, hi}; bf16x2_t b = __builtin_convertvector(v, bf16x2_t); return __builtin_bit_cast(unsigned, b); }
__device__ __forceinline__ bf16_t f2bf(float f) { return (bf16_t)(pk2(f, 0.f) & 0xffffu); }
__device__ __forceinline__ float bf2f(bf16_t u) { return __uint_as_float(((unsigned)u) << 16); }
__device__ __forceinline__ float bflo(unsigned w) { return __uint_as_float(w << 16); }
__device__ __forceinline__ float bfhi(unsigned w) { return __uint_as_float(w & 0xffff0000u); }
__device__ __forceinline__ float wave_sum(float v) {
#pragma unroll
    for (int o = 1; o < 64; o <<= 1) v += __shfl_xor(v, o);
    return v;
}
__device__ __forceinline__ float sigmoidf_(float x) { return 1.f / (1.f + __expf(-x)); }
__device__ __forceinline__ float siluf_(float x) { return x * sigmoidf_(x); }
__device__ __forceinline__ float gelu_tanh(float x) {
    const float u = 0.7978845608028654f * (x + 0.044715f * x * x * x);
    const float e = __expf(2.f * u);
    const float th = 1.f - 2.f / (e + 1.f);
    return 0.5f * x * (1.f + th);
}
__device__ __forceinline__ int otid() { int t = threadIdx.x; asm volatile("" : "+v"(t)); return t; }
__device__ __forceinline__ int obid() { int t = blockIdx.x; asm volatile("" : "+s"(t)); return t; }
__device__ __forceinline__ int row_modrow(int row) { return row < RL ? (row >> 11) : 8; }

__device__ void phase_init(const Params& p, unsigned char* smem) {
    float* tab = (float*)(p.ws + WS_TAB);
    const float* c = p.in[1];
    const float* c_ctx = p.in[3];
    const float* w_mod = p.in[4];
    const float* b_mod = p.in[5];
    float* sc = (float*)smem;
    const int tid = otid();
    for (int i = tid; i < 9 * 1024; i += NTHREADS) {
        const int b = i >> 10, k = i & 1023;
        const float v = (b < 8) ? c[b * 1024 + k] : c_ctx[k];
        sc[i] = siluf_(v);
    }
    __syncthreads();
    for (int it = obid(); it < 48; it += gridDim.x) {
        const int l = it / 24, j = (it % 24) * 256 + tid;
        const float* w = w_mod + (size_t)l * 1024 * 6144 + j;
        float acc[9];
#pragma unroll
        for (int b = 0; b < 9; ++b) acc[b] = 0.f;
        for (int k = 0; k < 1024; ++k) {
            const float wv = w[(size_t)k * 6144];
#pragma unroll
            for (int b = 0; b < 9; ++b) acc[b] += sc[b * 1024 + k] * wv;
        }
        const float bm = b_mod[l * 6144 + j];
#pragma unroll
        for (int b = 0; b < 9; ++b) tab[TAB_MOD + (l * 9 + b) * 6144 + j] = acc[b] + bm;
    }
    if (obid() == gridDim.x - 1) {
        for (int i = tid; i < 64 * 16; i += NTHREADS) {
            const int pos = i >> 4, f = i & 15;
            const float inv = 1.0f / powf(10000.0f, (float)(2 * f) / 32.0f);
            const float ang = (float)pos * inv;
            tab[TAB_ROPE + i * 2] = cosf(ang);
            tab[TAB_ROPE + i * 2 + 1] = sinf(ang);
        }
        const float* lbl = p.in[12];
        for (int i = tid; i < 512; i += NTHREADS) {
            const float a0 = lbl[i], a1 = lbl[512 + i];
            const float m = fmaxf(a0, a1);
            const float e0 = expf(a0 - m), e1 = expf(a1 - m);
            const float s1 = e1 / (e0 + e1);
            tab[TAB_LB + i] = 0.f;
            tab[TAB_LB + 512 + i] = s1;
        }
    }
}

__device__ void phase_prep(const Params& p, int l) {
    const float* tab = (const float*)(p.ws + WS_TAB);
    bf16_t* H = (bf16_t*)(p.ws + WS_H);
    const int lane = otid() & 63;
    const int gw = obid() * (NTHREADS / 64) + (otid() >> 6), NGW = gridDim.x * (NTHREADS / 64);
    const float* nw = p.in[6] + l * 1024;
    for (int row = gw; row < R; row += NGW) {
        const int mr = row_modrow(row);
        f32x4 v[4];
        if (l == 0) {
            const float* src = row < RL ? p.in[0] + (size_t)row * D : p.in[2] + (size_t)(row - RL) * D;
#pragma unroll
            for (int j = 0; j < 4; ++j) v[j] = *(const f32x4*)(src + 4 * lane + 256 * j);
        } else {
            const float* X1 = (const float*)(p.ws + WS_X1) + (size_t)row * D;
            const int* rt = (const int*)(p.ws + WS_RT);
            const unsigned* ctl = (const unsigned*)(p.ws + WS_CTL);
            const int e0 = rt[row * 2], e1 = rt[row * 2 + 1];
            const int s0 = rt[2 * R + row * 2], s1 = rt[2 * R + row * 2 + 1];
            const float g0 = ((const float*)rt)[4 * R + row * 2], g1 = ((const float*)rt)[4 * R + row * 2 + 1];
            int base0 = 0, base1 = 0;
            for (int e = 0; e < NEXP; ++e) { const int cnt = (int)ctl[(l - 1) * 64 + e]; if (e < e0) base0 += cnt; if (e < e1) base1 += cnt; }
            const bf16_t* O0 = (const bf16_t*)(p.ws + WS_P) + (size_t)(base0 + s0) * D;
            const bf16_t* O1 = (const bf16_t*)(p.ws + WS_P) + (size_t)(base1 + s1) * D;
            const float* g2 = tab + TAB_MOD + ((l - 1) * 9 + mr) * 6144 + 5 * 1024;
            float* X2 = (float*)(p.ws + WS_X2) + (size_t)row * D;
#pragma unroll
            for (int j = 0; j < 4; ++j) {
                const int k = 4 * lane + 256 * j;
                const f32x4 x1 = *(const f32x4*)(X1 + k);
                const u32x2 a = *(const u32x2*)(O0 + k), b = *(const u32x2*)(O1 + k);
                const f32x4 gg = *(const f32x4*)(g2 + k);
                f32x4 m;
                m.x = g0 * bflo(a.x) + g1 * bflo(b.x); m.y = g0 * bfhi(a.x) + g1 * bfhi(b.x);
                m.z = g0 * bflo(a.y) + g1 * bflo(b.y); m.w = g0 * bfhi(a.y) + g1 * bfhi(b.y);
                v[j] = x1 + gg * m;
                *(f32x4*)(X2 + k) = v[j];
            }
        }
        float ss = 0.f;
#pragma unroll
        for (int j = 0; j < 4; ++j) ss += (v[j].x * v[j].x + v[j].y * v[j].y) + (v[j].z * v[j].z + v[j].w * v[j].w);
        ss = wave_sum(ss);
        const float rstd = rsqrtf(ss * (1.f / D) + EPS);
        const float* sh = tab + TAB_MOD + (l * 9 + mr) * 6144;
        const float* scv = sh + 1024;
#pragma unroll
        for (int j = 0; j < 4; ++j) {
            const int k = 4 * lane + 256 * j;
            const f32x4 w = *(const f32x4*)(nw + k), s = *(const f32x4*)(scv + k), h = *(const f32x4*)(sh + k);
            const f32x4 o = v[j] * rstd * w * (1.f + s) + h;
            u32x2 pk; pk.x = pk2(o.x, o.y); pk.y = pk2(o.z, o.w);
            *(u32x2*)(H + (size_t)row * D + k) = pk;
        }
    }
}

__device__ void phase_final(const Params& p, int l) {
    const float* tab = (const float*)(p.ws + WS_TAB);
    const int lane = otid() & 63;
    const int gw = obid() * (NTHREADS / 64) + (otid() >> 6), NGW = gridDim.x * (NTHREADS / 64);
    const int* rt = (const int*)(p.ws + WS_RT);
    const unsigned* ctl = (const unsigned*)(p.ws + WS_CTL);
    for (int row = gw; row < RL; row += NGW) {
        const int mr = row >> 11;
        const float* X1 = (const float*)(p.ws + WS_X1) + (size_t)row * D;
        const int e0 = rt[row * 2], e1 = rt[row * 2 + 1];
        const int s0 = rt[2 * R + row * 2], s1 = rt[2 * R + row * 2 + 1];
        const float g0 = ((const float*)rt)[4 * R + row * 2], g1 = ((const float*)rt)[4 * R + row * 2 + 1];
        int base0 = 0, base1 = 0;
        for (int e = 0; e < NEXP; ++e) { const int cnt = (int)ctl[l * 64 + e]; if (e < e0) base0 += cnt; if (e < e1) base1 += cnt; }
        const bf16_t* O0 = (const bf16_t*)(p.ws + WS_P) + (size_t)(base0 + s0) * D;
        const bf16_t* O1 = (const bf16_t*)(p.ws + WS_P) + (size_t)(base1 + s1) * D;
        const float* g2 = tab + TAB_MOD + (l * 9 + mr) * 6144 + 5 * 1024;
        float* O = p.out + (size_t)row * D;
#pragma unroll
        for (int j = 0; j < 4; ++j) {
            const int k = 4 * lane + 256 * j;
            const f32x4 x1 = *(const f32x4*)(X1 + k);
            const u32x2 a = *(const u32x2*)(O0 + k), b = *(const u32x2*)(O1 + k);
            const f32x4 gg = *(const f32x4*)(g2 + k);
            f32x4 m;
            m.x = g0 * bflo(a.x) + g1 * bflo(b.x); m.y = g0 * bfhi(a.x) + g1 * bfhi(b.x);
            m.z = g0 * bflo(a.y) + g1 * bflo(b.y); m.w = g0 * bfhi(a.y) + g1 * bfhi(b.y);
            *(f32x4*)(O + k) = x1 + gg * m;
        }
    }
}

constexpr int BM = 128, BN = 128, BK = 64, LDT = BK + 8;
constexpr int GEMM_LDS = (BM + BN) * LDT * 2;

template <class AF, class BF>
__device__ __forceinline__ void gemm_tile(const AF& arow, const BF& bptr, int K, unsigned char* smem, f32x4 (&acc)[4][4]) {
    bf16_t* As = (bf16_t*)smem;
    bf16_t* Bs = As + BM * LDT;
    const int tid = otid(), lane = tid & 63, wid = tid >> 6, wr = wid >> 1, wc = wid & 1, fr = lane & 15, fq = lane >> 4;
    const int a_chunk = tid & 7, a_row0 = tid >> 3;
    const bf16_t* ap[4];
#pragma unroll
    for (int i = 0; i < 4; ++i) ap[i] = arow(a_row0 + 32 * i) + a_chunk * 8;
    const int b_nb = tid & 31, b_kb0 = tid >> 5;
    u32x4 ar[4];
    f32x4 br[2][4];
#pragma unroll
    for (int m = 0; m < 4; ++m)
#pragma unroll
        for (int n = 0; n < 4; ++n) acc[m][n] = (f32x4){0.f, 0.f, 0.f, 0.f};
    const int nk = K / BK;
#pragma unroll
    for (int i = 0; i < 4; ++i) ar[i] = *(const u32x4*)(ap[i]);
#pragma unroll
    for (int i = 0; i < 2; ++i)
#pragma unroll
        for (int kk = 0; kk < 4; ++kk) br[i][kk] = *(const f32x4*)bptr(4 * (b_kb0 + 8 * i) + kk, 4 * b_nb);
    for (int kt = 0; kt < nk; ++kt) {
#pragma unroll
        for (int i = 0; i < 4; ++i) *(u32x4*)(As + (a_row0 + 32 * i) * LDT + a_chunk * 8) = ar[i];
#pragma unroll
        for (int i = 0; i < 2; ++i) {
            const int kb = b_kb0 + 8 * i;
#pragma unroll
            for (int jj = 0; jj < 4; ++jj) {
                u32x2 w; w.x = pk2(br[i][0][jj], br[i][1][jj]); w.y = pk2(br[i][2][jj], br[i][3][jj]);
                *(u32x2*)(Bs + (4 * b_nb + jj) * LDT + 4 * kb) = w;
            }
        }
        __syncthreads();
        if (kt + 1 < nk) {
            const int k0 = (kt + 1) * BK;
#pragma unroll
            for (int i = 0; i < 4; ++i) ar[i] = *(const u32x4*)(ap[i] + k0);
#pragma unroll
            for (int i = 0; i < 2; ++i)
#pragma unroll
                for (int kk = 0; kk < 4; ++kk) br[i][kk] = *(const f32x4*)bptr(k0 + 4 * (b_kb0 + 8 * i) + kk, 4 * b_nb);
        }
#pragma unroll
        for (int ks = 0; ks < 2; ++ks) {
            bf16x8 af[4], bfr[4];
#pragma unroll
            for (int m = 0; m < 4; ++m) af[m] = *(const bf16x8*)(As + (wr * 64 + m * 16 + fr) * LDT + ks * 32 + fq * 8);
#pragma unroll
            for (int n = 0; n < 4; ++n) bfr[n] = *(const bf16x8*)(Bs + (wc * 64 + n * 16 + fr) * LDT + ks * 32 + fq * 8);
#pragma unroll
            for (int m = 0; m < 4; ++m)
#pragma unroll
                for (int n = 0; n < 4; ++n) acc[m][n] = __builtin_amdgcn_mfma_f32_16x16x32_bf16(bfr[n], af[m], acc[m][n], 0, 0, 0);
        }
        __syncthreads();
    }
}

__device__ void phase_gemm_in(const Params& p, int l, unsigned char* smem) {
    const float* tab = (const float*)(p.ws + WS_TAB);
    const bf16_t* H = (const bf16_t*)(p.ws + WS_H);
    bf16_t* P = (bf16_t*)(p.ws + WS_P);
    float* LF = (float*)(p.ws + WS_LF);
    const float* W = p.in[7] + (size_t)l * D * INW;
    const float* qw = p.in[10] + l * 64;
    const float* kw = p.in[11] + l * 64;
    const float* lbt = tab + TAB_LB + l * 512;
    const int tid = otid(), lane = tid & 63, wid = tid >> 6, wr = wid >> 1, wc = wid & 1, fr = lane & 15, fq = lane >> 4;
    const int nMT = R / BM, nNT = INW / BN;
    for (int u = obid(); u < nMT * nNT; u += gridDim.x) {
        const int mt = u / nNT, nt = u % nNT;
        const int row0 = mt * BM, col0 = nt * BN;
        f32x4 acc[4][4];
        auto arow = [&](int i) { return H + (size_t)(row0 + i) * D; };
        auto bptr = [&](int k, int n) { return W + (size_t)k * INW + col0 + n; };
        gemm_tile(arow, bptr, D, smem, acc);
        const int cw = col0 + wc * 64;
#pragma unroll
        for (int m = 0; m < 4; ++m) {
            const int row = row0 + wr * 64 + m * 16 + fr;
            float v[4][4];
#pragma unroll
            for (int n = 0; n < 4; ++n)
#pragma unroll
                for (int j = 0; j < 4; ++j) v[n][j] = acc[m][n][j];
            if (cw >= OFF_ZF && cw < OFF_HV) {
                const int dir = (cw >= OFF_ZB) ? 1 : 0;
                const int cb = cw - (dir ? OFF_ZB : OFF_ZF);
#pragma unroll
                for (int n = 0; n < 4; ++n) {
                    f32x4 o;
#pragma unroll
                    for (int j = 0; j < 4; ++j) {
                        const int c = cb + n * 16 + fq * 4 + j;
                        const float lb = lbt[dir * 256 + c];
                        const float z = v[n][j];
                        float lf;
                        if (lb > 0.f) lf = __logf(lb + (1.f - lb) * sigmoidf_(z));
                        else lf = fminf(z, 0.f) - log1pf(__expf(-fabsf(z)));
                        o[j] = lf;
                    }
                    *(f32x4*)(LF + (size_t)row * LFW + dir * 256 + cb + n * 16 + fq * 4) = o;
                }
                continue;
            }
            if (cw < OFF_B) {
#pragma unroll
                for (int n = 0; n < 4; ++n)
#pragma unroll
                    for (int j = 0; j < 4; ++j) v[n][j] = gelu_tanh(v[n][j]);
            }
            if ((cw >= 256 && cw < OFF_V)) {
                float ss = 0.f;
#pragma unroll
                for (int n = 0; n < 4; ++n)
#pragma unroll
                    for (int j = 0; j < 4; ++j) ss += v[n][j] * v[n][j];
                ss += __shfl_xor(ss, 16); ss += __shfl_xor(ss, 32);
                const float rstd = rsqrtf(ss * (1.f / 64.f) + EPS);
                if (cw < OFF_B) {
#pragma unroll
                    for (int n = 0; n < 4; ++n)
#pragma unroll
                        for (int j = 0; j < 4; ++j) v[n][j] *= rstd;
                } else {
                    const float* nwv = (cw < OFF_KV) ? qw : kw;
#pragma unroll
                    for (int n = 0; n < 4; ++n)
#pragma unroll
                        for (int j = 0; j < 4; ++j) v[n][j] *= rstd * nwv[n * 16 + fq * 4 + j];
                    if (row < RL) {
                        const int t = row & (T - 1);
#pragma unroll
                        for (int a = 0; a < 2; ++a) {
                            const int pos = a == 0 ? (t >> 6) : (t & 63);
#pragma unroll
                            for (int j = 0; j < 4; ++j) {
                                const int f = fq * 4 + j;
                                const float cs = tab[TAB_ROPE + (pos * 16 + f) * 2], sn = tab[TAB_ROPE + (pos * 16 + f) * 2 + 1];
                                const float x0 = v[2 * a][j], x1 = v[2 * a + 1][j];
                                v[2 * a][j] = x0 * cs - x1 * sn;
                                v[2 * a + 1][j] = x1 * cs + x0 * sn;
                            }
                        }
                    }
                }
            }
            if ((cw >= OFF_C && cw < OFF_ZF) || cw >= OFF_G) {
#pragma unroll
                for (int n = 0; n < 4; ++n)
#pragma unroll
                    for (int j = 0; j < 4; ++j) v[n][j] = siluf_(v[n][j]);
            }
#pragma unroll
            for (int n = 0; n < 4; ++n) {
                u32x2 pk; pk.x = pk2(v[n][0], v[n][1]); pk.y = pk2(v[n][2], v[n][3]);
                *(u32x2*)(P + (size_t)row * INW + cw + n * 16 + fq * 4) = pk;
            }
        }
    }
}

__device__ void phase_mix(const Params& p, int l) {
    const bf16_t* P = (const bf16_t*)(p.ws + WS_P);
    const float* LF = (const float*)(p.ws + WS_LF);
    bf16_t* Y = (bf16_t*)(p.ws + WS_Y);
    float* OFB = (float*)(p.ws + WS_OFB);
    const int nrows = (l == 0) ? R : RL;
    const int gtid = obid() * NTHREADS + otid(), gsize = gridDim.x * NTHREADS;
    const int lane = otid() & 63;
    {
        const int gw = gtid >> 6, NGW = gsize >> 6;
        const float* hw = p.in[13] + l * 64;
        for (int it = gw; it < NB * 4; it += NGW) {
            const int b = it >> 2, h = it & 3;
            float S[64];
            for (int dir = 0; dir < 2; ++dir) {
#pragma unroll
                for (int k = 0; k < 64; ++k) S[k] = 0.f;
                for (int step = 0; step < TC + T; ++step) {
                    int row;
                    if (dir == 0) row = step < TC ? RL + b * TC + step : b * T + (step - TC);
                    else row = step < TC ? RL + b * TC + (TC - 1 - step) : b * T + (T - 1 - (step - TC));
                    const float lf = LF[(size_t)row * LFW + dir * 256 + h * 64 + lane];
                    const float fk = __expf(lf), kk = 1.f - fk;
                    const float q = bf2f(P[(size_t)row * INW + OFF_C + h * 64 + lane]);
                    const float v = bf2f(P[(size_t)row * INW + OFF_HV + h * 64 + lane]);
                    float o = 0.f;
#pragma unroll
                    for (int k = 0; k < 64; ++k) {
                        const float fkk = __int_as_float(__builtin_amdgcn_readlane(__float_as_int(fk), k));
                        const float kkk = __int_as_float(__builtin_amdgcn_readlane(__float_as_int(kk), k));
                        const float qk = __int_as_float(__builtin_amdgcn_readlane(__float_as_int(q), k));
                        S[k] = fkk * S[k] + kkk * v;
                        o += S[k] * qk;
                    }
                    if (row < nrows) {
                        if (dir == 0) OFB[(size_t)row * 256 + h * 64 + lane] = o;
                        else {
                            const float ot = o + OFB[(size_t)row * 256 + h * 64 + lane];
                            const float ss = wave_sum(ot * ot);
                            const float g = bf2f(P[(size_t)row * INW + OFF_G + h * 64 + lane]);
                            const float y = ot * rsqrtf(ss * (1.f / 64.f) + EPS) * hw[lane] * g;
                            Y[(size_t)row * D + 768 + h * 64 + lane] = f2bf(y);
                        }
                    }
                }
            }
        }
    }
    {
        const float* ws_ = p.in[8] + (size_t)l * 4 * 128 * 128;
        const float* bs_ = p.in[9] + l * 4 * 128;
        for (int idx = gtid; idx < nrows * 256; idx += gsize) {
            const int row = idx >> 8, c = idx & 255, h = c >> 6;
            const int cbase = row & ~127, t = row & 127;
            const float* wrow = ws_ + ((size_t)h * 128 + t) * 128;
            float acc = 0.f;
            for (int s = 0; s < 128; ++s) acc += wrow[s] * bf2f(P[(size_t)(cbase + s) * INW + 256 + c]);
            acc += bs_[h * 128 + t];
            const float uu = bf2f(P[(size_t)row * INW + c]);
            Y[(size_t)row * D + c] = f2bf(uu * acc);
        }
    }
    {
        const long total = (long)nrows * 8 * 4;
        for (long idx = gtid; idx < total; idx += gsize) {
            const int item = (int)(idx >> 2), sub = (int)(idx & 3);
            const int row = item >> 3, hh = item & 7, kv = hh >> 2;
            float q[16], acc[16];
            {
                const u32x4* qp = (const u32x4*)(P + (size_t)row * INW + OFF_B + hh * 64 + sub * 16);
                const u32x4 a = qp[0], bq = qp[1];
                const unsigned w[8] = {a.x, a.y, a.z, a.w, bq.x, bq.y, bq.z, bq.w};
#pragma unroll
                for (int i = 0; i < 8; ++i) { q[2 * i] = bflo(w[i]) * 0.125f; q[2 * i + 1] = bfhi(w[i]) * 0.125f; }
            }
#pragma unroll
            for (int i = 0; i < 16; ++i) acc[i] = 0.f;
            float mx = -1e30f, lsum = 0.f;
            int b, nkeys;
            const bool latent = row < RL;
            if (latent) { b = row >> 11; nkeys = T + TC; } else { b = (row - RL) >> 8; nkeys = TC; }
            for (int s = 0; s < nkeys; ++s) {
                int kr;
                if (latent) kr = s < T ? b * T + s : RL + b * TC + (s - T);
                else kr = RL + b * TC + s;
                const u32x4* kp = (const u32x4*)(P + (size_t)kr * INW + OFF_KV + kv * 64 + sub * 16);
                const u32x4* vp = (const u32x4*)(P + (size_t)kr * INW + OFF_V + kv * 64 + sub * 16);
                const u32x4 k0 = kp[0], k1 = kp[1], v0 = vp[0], v1 = vp[1];
                const unsigned kwd[8] = {k0.x, k0.y, k0.z, k0.w, k1.x, k1.y, k1.z, k1.w};
                const unsigned vwd[8] = {v0.x, v0.y, v0.z, v0.w, v1.x, v1.y, v1.z, v1.w};
                float sdot = 0.f;
#pragma unroll
                for (int i = 0; i < 8; ++i) sdot += q[2 * i] * bflo(kwd[i]) + q[2 * i + 1] * bfhi(kwd[i]);
                sdot += __shfl_xor(sdot, 1); sdot += __shfl_xor(sdot, 2);
                const float mn = fmaxf(mx, sdot);
                const float corr = __expf(mx - mn), pr = __expf(sdot - mn);
                lsum = lsum * corr + pr;
#pragma unroll
                for (int i = 0; i < 8; ++i) {
                    acc[2 * i] = acc[2 * i] * corr + pr * bflo(vwd[i]);
                    acc[2 * i + 1] = acc[2 * i + 1] * corr + pr * bfhi(vwd[i]);
                }
                mx = mn;
            }
            const float inv = 1.f / lsum;
            u32x4 o0, o1;
            o0.x = pk2(acc[0] * inv, acc[1] * inv); o0.y = pk2(acc[2] * inv, acc[3] * inv); o0.z = pk2(acc[4] * inv, acc[5] * inv); o0.w = pk2(acc[6] * inv, acc[7] * inv);
            o1.x = pk2(acc[8] * inv, acc[9] * inv); o1.y = pk2(acc[10] * inv, acc[11] * inv); o1.z = pk2(acc[12] * inv, acc[13] * inv); o1.w = pk2(acc[14] * inv, acc[15] * inv);
            u32x4* op = (u32x4*)(Y + (size_t)row * D + 256 + hh * 64 + sub * 16);
            op[0] = o0; op[1] = o1;
        }
    }
}

__device__ void phase_out(const Params& p, int l, unsigned char* smem) {
    const float* tab = (const float*)(p.ws + WS_TAB);
    const bf16_t* Y = (const bf16_t*)(p.ws + WS_Y);
    float* X1 = (float*)(p.ws + WS_X1);
    const float* X2 = (const float*)(p.ws + WS_X2);
    const float* W = p.in[14] + (size_t)l * D * D;
    const int tid = otid(), lane = tid & 63, wid = tid >> 6, wr = wid >> 1, wc = wid & 1, fr = lane & 15, fq = lane >> 4;
    const int nrows = (l == 0) ? R : RL;
    const int nMT = nrows / BM, nNT = D / BN;
    for (int u = obid(); u < nMT * nNT; u += gridDim.x) {
        const int mt = u / nNT, nt = u % nNT;
        const int row0 = mt * BM, col0 = nt * BN;
        f32x4 acc[4][4];
        auto arow = [&](int i) { return Y + (size_t)(row0 + i) * D; };
        auto bptr = [&](int k, int n) { return W + (size_t)k * D + col0 + n; };
        gemm_tile(arow, bptr, D, smem, acc);
#pragma unroll
        for (int m = 0; m < 4; ++m) {
            const int row = row0 + wr * 64 + m * 16 + fr;
            const int mr = row_modrow(row);
            const float* g1 = tab + TAB_MOD + (l * 9 + mr) * 6144 + 2 * 1024;
            const float* xin = (l == 0) ? (row < RL ? p.in[0] + (size_t)row * D : p.in[2] + (size_t)(row - RL) * D) : X2 + (size_t)row * D;
#pragma unroll
            for (int n = 0; n < 4; ++n) {
                const int col = col0 + wc * 64 + n * 16 + fq * 4;
                const f32x4 xv = *(const f32x4*)(xin + col), gv = *(const f32x4*)(g1 + col);
                *(f32x4*)(X1 + (size_t)row * D + col) = xv + gv * acc[m][n];
            }
        }
    }
}

__device__ void phase_route(const Params& p, int l) {
    const float* tab = (const float*)(p.ws + WS_TAB);
    bf16_t* H = (bf16_t*)(p.ws + WS_H);
    const float* X1 = (const float*)(p.ws + WS_X1);
    int* rt = (int*)(p.ws + WS_RT);
    unsigned* ctl = (unsigned*)(p.ws + WS_CTL);
    const float* nw = p.in[15] + l * 1024;
    const float* wg = p.in[16] + (size_t)l * 1024 * 4;
    const float* bg = p.in[17] + l * 4;
    const float* we = p.in[18] + (size_t)l * 1024 * 32;
    const float* be = p.in[19] + l * 32;
    const int lane = otid() & 63;
    const int gw = obid() * (NTHREADS / 64) + (otid() >> 6), NGW = gridDim.x * (NTHREADS / 64);
    const int nrows = (l == 0) ? R : RL;
    for (int row = gw; row < nrows; row += NGW) {
        const int mr = row_modrow(row);
        const float* sh = tab + TAB_MOD + (l * 9 + mr) * 6144 + 3 * 1024;
        const float* scv = sh + 1024;
        f32x4 v[4];
        float ss = 0.f;
#pragma unroll
        for (int j = 0; j < 4; ++j) { v[j] = *(const f32x4*)(X1 + (size_t)row * D + 4 * lane + 256 * j); ss += (v[j].x * v[j].x + v[j].y * v[j].y) + (v[j].z * v[j].z + v[j].w * v[j].w); }
        ss = wave_sum(ss);
        const float rstd = rsqrtf(ss * (1.f / D) + EPS);
        float lg[36];
#pragma unroll
        for (int i = 0; i < 36; ++i) lg[i] = 0.f;
#pragma unroll
        for (int j = 0; j < 4; ++j) {
            const int k = 4 * lane + 256 * j;
            const f32x4 w = *(const f32x4*)(nw + k), s = *(const f32x4*)(scv + k), h = *(const f32x4*)(sh + k);
            const f32x4 o = v[j] * rstd * w * (1.f + s) + h;
            u32x2 pk; pk.x = pk2(o.x, o.y); pk.y = pk2(o.z, o.w);
            *(u32x2*)(H + (size_t)row * D + k) = pk;
            v[j] = o;
        }
#pragma unroll 1
        for (int je = 0; je < 16; ++je) {
            const int j = je >> 2, e = je & 3;
            const int k = 4 * lane + 256 * j + e;
            float hv = v[0][0];
#pragma unroll
            for (int jj = 0; jj < 4; ++jj)
#pragma unroll
                for (int ee = 0; ee < 4; ++ee) hv = (je == jj * 4 + ee) ? v[jj][ee] : hv;
            const f32x4 g4 = *(const f32x4*)(wg + (size_t)k * 4);
#pragma unroll
            for (int i = 0; i < 4; ++i) lg[i] += hv * g4[i];
#pragma unroll
            for (int c = 0; c < 8; ++c) {
                const f32x4 e4 = *(const f32x4*)(we + (size_t)k * 32 + c * 4);
#pragma unroll
                for (int i = 0; i < 4; ++i) lg[4 + c * 4 + i] += hv * e4[i];
            }
        }
#pragma unroll
        for (int i = 0; i < 36; ++i) lg[i] = wave_sum(lg[i]);
        float gl[4];
#pragma unroll
        for (int i = 0; i < 4; ++i) gl[i] = lg[i] + bg[i];
        int grp = 0; float gm = gl[0];
#pragma unroll
        for (int i = 1; i < 4; ++i) if (gl[i] > gm) { gm = gl[i]; grp = i; }
        float gs = 0.f;
#pragma unroll
        for (int i = 0; i < 4; ++i) gs += expf(gl[i] - gm);
        const float pgrp = 1.f / gs;
        float ev[8];
#pragma unroll
        for (int i = 0; i < 8; ++i) {
            float x = lg[4 + i];
#pragma unroll
            for (int g = 1; g < 4; ++g) x = (grp == g) ? lg[4 + g * 8 + i] : x;
            ev[i] = x;
        }
        {
#pragma unroll
            for (int i = 0; i < 8; ++i) ev[i] += be[grp * 8 + i];
        }
        int i0 = 0; float v0 = ev[0];
#pragma unroll
        for (int i = 1; i < 8; ++i) if (ev[i] > v0) { v0 = ev[i]; i0 = i; }
        int i1 = -1; float v1 = -3.0e38f;
#pragma unroll
        for (int i = 0; i < 8; ++i) if (i != i0 && ev[i] > v1) { v1 = ev[i]; i1 = i; }
        const float e1 = expf(v1 - v0);
        const float ga = pgrp / (1.f + e1), gb = pgrp * e1 / (1.f + e1);
        if (lane == 0) {
            const int ea = grp * 8 + i0, eb = grp * 8 + i1;
            const int sa = (int)atomicAdd(&ctl[l * 64 + ea], 1u);
            const int sb = (int)atomicAdd(&ctl[l * 64 + eb], 1u);
            rt[row * 2] = ea; rt[row * 2 + 1] = eb;
            rt[2 * R + row * 2] = sa; rt[2 * R + row * 2 + 1] = sb;
            ((float*)rt)[4 * R + row * 2] = ga; ((float*)rt)[4 * R + row * 2 + 1] = gb;
            rt[6 * R + ea * R + sa] = row;
            rt[6 * R + eb * R + sb] = row;
        }
    }
}

__device__ __forceinline__ void moe_units(const Params& p, int l, int* s_cnt, int* s_base, int* s_tpre) {
    const unsigned* ctl = (const unsigned*)(p.ws + WS_CTL);
    if (otid() == 0) {
        int base = 0, tp = 0;
        for (int e = 0; e < NEXP; ++e) {
            const int c = (int)ctl[l * 64 + e];
            s_cnt[e] = c; s_base[e] = base; s_tpre[e] = tp;
            base += c; tp += (c + BM - 1) / BM;
        }
        s_tpre[NEXP] = tp;
    }
    __syncthreads();
}

__device__ void phase_moe1(const Params& p, int l, unsigned char* smem) {
    int* s_cnt = (int*)(smem + GEMM_LDS);
    int* s_base = s_cnt + 32;
    int* s_tpre = s_base + 32;
    moe_units(p, l, s_cnt, s_base, s_tpre);
    const bf16_t* H = (const bf16_t*)(p.ws + WS_H);
    bf16_t* HM = (bf16_t*)(p.ws + WS_LF);
    const int* list = (const int*)(p.ws + WS_RT) + 6 * R;
    const float* W1 = p.in[20] + (size_t)l * NEXP * D * FF;
    const float* W3 = p.in[21] + (size_t)l * NEXP * D * FF;
    const int tid = otid(), lane = tid & 63, wid = tid >> 6, wr = wid >> 1, wc = wid & 1, fr = lane & 15, fq = lane >> 4;
    const int ntiles = s_tpre[NEXP];
    constexpr int nNT = FF / 64;
    for (int u = obid(); u < ntiles * nNT; u += gridDim.x) {
        const int tg = u / nNT, nt = u % nNT;
        int e = 0;
        while (s_tpre[e + 1] <= tg) ++e;
        const int mt = tg - s_tpre[e], cnt = s_cnt[e], base = s_base[e];
        const float* w1 = W1 + (size_t)e * D * FF;
        const float* w3 = W3 + (size_t)e * D * FF;
        const int* lst = list + (size_t)e * R;
        f32x4 acc[4][4];
        auto arow = [&](int i) { int s = mt * BM + i; s = s < cnt ? s : cnt - 1; return H + (size_t)lst[s] * D; };
        auto bptr = [&](int k, int rho) {
            const int n = (rho >> 4) & 3;
            const int col = nt * 64 + (rho >> 6) * 32 + (n & 1) * 16 + (rho & 15);
            return ((n >= 2) ? w3 : w1) + (size_t)k * FF + col;
        };
        gemm_tile(arow, bptr, D, smem, acc);
#pragma unroll
        for (int m = 0; m < 4; ++m) {
            const int s = mt * BM + wr * 64 + m * 16 + fr;
            if (s < cnt) {
#pragma unroll
                for (int n = 0; n < 2; ++n) {
                    float hv[4];
#pragma unroll
                    for (int j = 0; j < 4; ++j) hv[j] = siluf_(acc[m][n][j]) * acc[m][n + 2][j];
                    u32x2 pk; pk.x = pk2(hv[0], hv[1]); pk.y = pk2(hv[2], hv[3]);
                    *(u32x2*)(HM + (size_t)(base + s) * FF + nt * 64 + wc * 32 + n * 16 + fq * 4) = pk;
                }
            }
        }
    }
}

__device__ void phase_moe2(const Params& p, int l, unsigned char* smem) {
    int* s_cnt = (int*)(smem + GEMM_LDS);
    int* s_base = s_cnt + 32;
    int* s_tpre = s_base + 32;
    moe_units(p, l, s_cnt, s_base, s_tpre);
    const bf16_t* HM = (const bf16_t*)(p.ws + WS_LF);
    bf16_t* OUTM = (bf16_t*)(p.ws + WS_P);
    const float* W2 = p.in[22] + (size_t)l * NEXP * FF * D;
    const int tid = otid(), lane = tid & 63, wid = tid >> 6, wr = wid >> 1, wc = wid & 1, fr = lane & 15, fq = lane >> 4;
    const int ntiles = s_tpre[NEXP];
    constexpr int nNT = D / BN;
    for (int u = obid(); u < ntiles * nNT; u += gridDim.x) {
        const int tg = u / nNT, nt = u % nNT;
        int e = 0;
        while (s_tpre[e + 1] <= tg) ++e;
        const int mt = tg - s_tpre[e], cnt = s_cnt[e], base = s_base[e];
        const float* w2 = W2 + (size_t)e * FF * D;
        f32x4 acc[4][4];
        auto arow = [&](int i) { int s = mt * BM + i; s = s < cnt ? s : cnt - 1; return HM + (size_t)(base + s) * FF; };
        auto bptr = [&](int k, int n) { return w2 + (size_t)k * D + nt * BN + n; };
        gemm_tile(arow, bptr, FF, smem, acc);
#pragma unroll
        for (int m = 0; m < 4; ++m) {
            const int s = mt * BM + wr * 64 + m * 16 + fr;
            if (s < cnt) {
#pragma unroll
                for (int n = 0; n < 4; ++n) {
                    u32x2 pk; pk.x = pk2(acc[m][n][0], acc[m][n][1]); pk.y = pk2(acc[m][n][2], acc[m][n][3]);
                    *(u32x2*)(OUTM + (size_t)(base + s) * D + nt * BN + wc * 64 + n * 16 + fq * 4) = pk;
                }
            }
        }
    }
}

constexpr int NPHASES = 16;
__global__ void __launch_bounds__(NTHREADS, 2) mega(Params p) {
    __shared__ __attribute__((aligned(16))) unsigned char smem[40960];
    cg::grid_group grid = cg::this_grid();
    for (int ph = p.ph_lo; ph < p.ph_hi; ++ph) {
        if (ph == 0) phase_init(p, smem);
        else if (ph == NPHASES - 1) phase_final(p, 1);
        else {
            const int l = (ph - 1) / 7, s = (ph - 1) % 7;
            switch (s) {
                case 0: phase_prep(p, l); break;
                case 1: phase_gemm_in(p, l, smem); break;
                case 2: phase_mix(p, l); break;
                case 3: phase_out(p, l, smem); break;
                case 4: phase_route(p, l); break;
                case 5: phase_moe1(p, l, smem); break;
                default: phase_moe2(p, l, smem); break;
            }
        }
        if (ph + 1 < p.ph_hi) grid.sync();
    }
}

extern "C" void kernel_launch(void* const* d_in, const int* in_sizes, int n_in, void* d_out, int out_size, void* d_ws, size_t ws_size, hipStream_t stream) {
    static int grid_blocks = 0;
    if (grid_blocks == 0) {
        if (n_in != 23 || out_size != RL * D || ws_size < WS_END) { fprintf(stderr, "kernel_launch: unexpected shapes (n_in %d out %d ws %zu need %zu)\n", n_in, out_size, ws_size, (size_t)WS_END); grid_blocks = -1; return; }
        int dev = 0, cus = 0, per_cu = 0;
        hipGetDevice(&dev);
        hipDeviceGetAttribute(&cus, hipDeviceAttributeMultiprocessorCount, dev);
        hipOccupancyMaxActiveBlocksPerMultiprocessor(&per_cu, mega, NTHREADS, 0);
        if (per_cu > 2) per_cu = 2;
        if (per_cu < 1) per_cu = 1;
        grid_blocks = cus * per_cu;
    }
    if (grid_blocks < 0) return;
    hipMemsetAsync((char*)d_ws + WS_CTL, 0, 1 * MiB, stream);
    Params p{};
    for (int i = 0; i < 23; ++i) p.in[i] = (const float*)d_in[i];
    p.out = (float*)d_out; p.ws = (unsigned char*)d_ws; p.ph_lo = 0; p.ph_hi = NPHASES;
    void* args[] = {&p};
    hipError_t e = hipLaunchCooperativeKernel((void*)mega, dim3(grid_blocks), dim3(NTHREADS), args, 0, stream);
    if (e != hipSuccess) fprintf(stderr, "cooperative launch failed: %s (grid %d)\n", hipGetErrorString(e), grid_blocks);
}
```

```cpp
#include <hip/hip_runtime.h>
#include <hip/hip_cooperative_groups.h>
#include <cstdio>
#include <cstdint>
namespace cg = cooperative_groups;

constexpr int D = 1024, NB = 8, T = 2048, TC = 256;
constexpr int RL = NB * T, RC = NB * TC, R = RL + RC;
constexpr int INW = 2560, LFW = 512;
constexpr int OFF_B = 512, OFF_KV = 1024, OFF_V = 1152, OFF_C = 1280, OFF_ZF = 1536, OFF_ZB = 1792, OFF_HV = 2048, OFF_G = 2304;
constexpr int NEXP = 32, FF = 512;
constexpr float EPS = 1e-6f;
constexpr int NTHREADS = 256;

constexpr size_t MiB = 1ull << 20;
constexpr size_t WS_CTL = 0;
constexpr size_t WS_TAB = 1 * MiB;
constexpr size_t WS_H = 2 * MiB;
constexpr size_t WS_P = WS_H + 36 * MiB;
constexpr size_t WS_LF = WS_P + 90 * MiB;
constexpr size_t WS_Y = WS_LF + 36 * MiB;
constexpr size_t WS_X1 = WS_Y + 36 * MiB;
constexpr size_t WS_X2 = WS_X1 + 72 * MiB;
constexpr size_t WS_OFB = WS_X2 + 72 * MiB;
constexpr size_t WS_RT = WS_OFB + 18 * MiB;
constexpr size_t WS_END = WS_RT + 4 * MiB;
constexpr int TAB_ROPE = 0;
constexpr int TAB_LB = 2048;
constexpr int TAB_MOD = 4096;

typedef unsigned short bf16_t;
typedef short bf16x8 __attribute__((ext_vector_type(8)));
typedef float f32x4 __attribute__((ext_vector_type(4)));
typedef float f32x2 __attribute__((ext_vector_type(2)));
typedef unsigned u32x4 __attribute__((ext_vector_type(4)));
typedef unsigned u32x2 __attribute__((ext_vector_type(2)));
typedef __bf16 bf16x2_t __attribute__((ext_vector_type(2)));

struct Params {
    const float* in[23];
    float* out;
    unsigned char* ws;
    int ph_lo, ph_hi;
};

__device__ __forceinline__ unsigned pk2(float lo, float hi) { f32x2 v = {lo, hi}; bf16x2_t b = __builtin_convertvector(v, bf16x2_t); return __builtin_bit_cast(unsigned, b); }
__device__ __forceinline__ bf16_t f2bf(float f) { return (bf16_t)(pk2(f, 0.f) & 0xffffu); }
__device__ __forceinline__ float bf2f(bf16_t u) { return __uint_as_float(((unsigned)u) << 16); }
__device__ __forceinline__ float bflo(unsigned w) { return __uint_as_float(w << 16); }
__device__ __forceinline__ float bfhi(unsigned w) { return __uint_as_float(w & 0xffff0000u); }
__device__ __forceinline__ float wave_sum(float v) {
#pragma unroll
    for (int o = 1; o < 64; o <<= 1) v += __shfl_xor(v, o);
    return v;
}
__device__ __forceinline__ float sigmoidf_(float x) { return 1.f / (1.f + __expf(-x)); }
__device__ __forceinline__ float siluf_(float x) { return x * sigmoidf_(x); }
__device__ __forceinline__ float gelu_tanh(float x) {
    const float u = 0.7978845608028654f * (x + 0.044715f * x * x * x);
    const float e = __expf(2.f * u);
    const float th = 1.f - 2.f / (e + 1.f);
    return 0.5f * x * (1.f + th);
}
__device__ __forceinline__ int otid() { int t = threadIdx.x; asm volatile("" : "+v"(t)); return t; }
__device__ __forceinline__ int obid() { int t = blockIdx.x; asm volatile("" : "+s"(t)); return t; }
__device__ __forceinline__ int row_modrow(int row) { return row < RL ? (row >> 11) : 8; }

__device__ void phase_init(const Params& p, unsigned char* smem) {
    float* tab = (float*)(p.ws + WS_TAB);
    const float* c = p.in[1];
    const float* c_ctx = p.in[3];
    const float* w_mod = p.in[4];
    const float* b_mod = p.in[5];
    float* sc = (float*)smem;
    const int tid = otid();
    for (int i = tid; i < 9 * 1024; i += NTHREADS) {
        const int b = i >> 10, k = i & 1023;
        const float v = (b < 8) ? c[b * 1024 + k] : c_ctx[k];
        sc[i] = siluf_(v);
    }
    __syncthreads();
    for (int it = obid(); it < 48; it += gridDim.x) {
        const int l = it / 24, j = (it % 24) * 256 + tid;
        const float* w = w_mod + (size_t)l * 1024 * 6144 + j;
        float acc[9];
#pragma unroll
        for (int b = 0; b < 9; ++b) acc[b] = 0.f;
        for (int k = 0; k < 1024; ++k) {
            const float wv = w[(size_t)k * 6144];
#pragma unroll
            for (int b = 0; b < 9; ++b) acc[b] += sc[b * 1024 + k] * wv;
        }
        const float bm = b_mod[l * 6144 + j];
#pragma unroll
        for (int b = 0; b < 9; ++b) tab[TAB_MOD + (l * 9 + b) * 6144 + j] = acc[b] + bm;
    }
    if (obid() == gridDim.x - 1) {
        for (int i = tid; i < 64 * 16; i += NTHREADS) {
            const int pos = i >> 4, f = i & 15;
            const float inv = 1.0f / powf(10000.0f, (float)(2 * f) / 32.0f);
            const float ang = (float)pos * inv;
            tab[TAB_ROPE + i * 2] = cosf(ang);
            tab[TAB_ROPE + i * 2 + 1] = sinf(ang);
        }
        const float* lbl = p.in[12];
        for (int i = tid; i < 512; i += NTHREADS) {
            const float a0 = lbl[i], a1 = lbl[512 + i];
            const float m = fmaxf(a0, a1);
            const float e0 = expf(a0 - m), e1 = expf(a1 - m);
            const float s1 = e1 / (e0 + e1);
            tab[TAB_LB + i] = 0.f;
            tab[TAB_LB + 512 + i] = s1;
        }
    }
}

__device__ void phase_prep(const Params& p, int l) {
    const float* tab = (const float*)(p.ws + WS_TAB);
    bf16_t* H = (bf16_t*)(p.ws + WS_H);
    const int lane = otid() & 63;
    const int gw = obid() * (NTHREADS / 64) + (otid() >> 6), NGW = gridDim.x * (NTHREADS / 64);
    const float* nw = p.in[6] + l * 1024;
    for (int row = gw; row < R; row += NGW) {
        const int mr = row_modrow(row);
        f32x4 v[4];
        if (l == 0) {
            const float* src = row < RL ? p.in[0] + (size_t)row * D : p.in[2] + (size_t)(row - RL) * D;
#pragma unroll
            for (int j = 0; j < 4; ++j) v[j] = *(const f32x4*)(src + 4 * lane + 256 * j);
        } else {
            const float* X1 = (const float*)(p.ws + WS_X1) + (size_t)row * D;
            const int* rt = (const int*)(p.ws + WS_RT);
            const unsigned* ctl = (const unsigned*)(p.ws + WS_CTL);
            const int e0 = rt[row * 2], e1 = rt[row * 2 + 1];
            const int s0 = rt[2 * R + row * 2], s1 = rt[2 * R + row * 2 + 1];
            const float g0 = ((const float*)rt)[4 * R + row * 2], g1 = ((const float*)rt)[4 * R + row * 2 + 1];
            int base0 = 0, base1 = 0;
            for (int e = 0; e < NEXP; ++e) { const int cnt = (int)ctl[(l - 1) * 64 + e]; if (e < e0) base0 += cnt; if (e < e1) base1 += cnt; }
            const bf16_t* O0 = (const bf16_t*)(p.ws + WS_P) + (size_t)(base0 + s0) * D;
            const bf16_t* O1 = (const bf16_t*)(p.ws + WS_P) + (size_t)(base1 + s1) * D;
            const float* g2 = tab + TAB_MOD + ((l - 1) * 9 + mr) * 6144 + 5 * 1024;
            float* X2 = (float*)(p.ws + WS_X2) + (size_t)row * D;
#pragma unroll
            for (int j = 0; j < 4; ++j) {
                const int k = 4 * lane + 256 * j;
                const f32x4 x1 = *(const f32x4*)(X1 + k);
                const u32x2 a = *(const u32x2*)(O0 + k), b = *(const u32x2*)(O1 + k);
                const f32x4 gg = *(const f32x4*)(g2 + k);
                f32x4 m;
                m.x = g0 * bflo(a.x) + g1 * bflo(b.x); m.y = g0 * bfhi(a.x) + g1 * bfhi(b.x);
                m.z = g0 * bflo(a.y) + g1 * bflo(b.y); m.w = g0 * bfhi(a.y) + g1 * bfhi(b.y);
                v[j] = x1 + gg * m;
                *(f32x4*)(X2 + k) = v[j];
            }
        }
        float ss = 0.f;
#pragma unroll
        for (int j = 0; j < 4; ++j) ss += (v[j].x * v[j].x + v[j].y * v[j].y) + (v[j].z * v[j].z + v[j].w * v[j].w);
        ss = wave_sum(ss);
        const float rstd = rsqrtf(ss * (1.f / D) + EPS);
        const float* sh = tab + TAB_MOD + (l * 9 + mr) * 6144;
        const float* scv = sh + 1024;
#pragma unroll
        for (int j = 0; j < 4; ++j) {
            const int k = 4 * lane + 256 * j;
            const f32x4 w = *(const f32x4*)(nw + k), s = *(const f32x4*)(scv + k), h = *(const f32x4*)(sh + k);
            const f32x4 o = v[j] * rstd * w * (1.f + s) + h;
            u32x2 pk; pk.x = pk2(o.x, o.y); pk.y = pk2(o.z, o.w);
            *(u32x2*)(H + (size_t)row * D + k) = pk;
        }
    }
}

__device__ void phase_final(const Params& p, int l) {
    const float* tab = (const float*)(p.ws + WS_TAB);
    const int lane = otid() & 63;
    const int gw = obid() * (NTHREADS / 64) + (otid() >> 6), NGW = gridDim.x * (NTHREADS / 64);
    const int* rt = (const int*)(p.ws + WS_RT);
    const unsigned* ctl = (const unsigned*)(p.ws + WS_CTL);
    for (int row = gw; row < RL; row += NGW) {
        const int mr = row >> 11;
        const float* X1 = (const float*)(p.ws + WS_X1) + (size_t)row * D;
        const int e0 = rt[row * 2], e1 = rt[row * 2 + 1];
        const int s0 = rt[2 * R + row * 2], s1 = rt[2 * R + row * 2 + 1];
        const float g0 = ((const float*)rt)[4 * R + row * 2], g1 = ((const float*)rt)[4 * R + row * 2 + 1];
        int base0 = 0, base1 = 0;
        for (int e = 0; e < NEXP; ++e) { const int cnt = (int)ctl[l * 64 + e]; if (e < e0) base0 += cnt; if (e < e1) base1 += cnt; }
        const bf16_t* O0 = (const bf16_t*)(p.ws + WS_P) + (size_t)(base0 + s0) * D;
        const bf16_t* O1 = (const bf16_t*)(p.ws + WS_P) + (size_t)(base1 + s1) * D;
        const float* g2 = tab + TAB_MOD + (l * 9 + mr) * 6144 + 5 * 1024;
        float* O = p.out + (size_t)row * D;
#pragma unroll
        for (int j = 0; j < 4; ++j) {
            const int k = 4 * lane + 256 * j;
            const f32x4 x1 = *(const f32x4*)(X1 + k);
            const u32x2 a = *(const u32x2*)(O0 + k), b = *(const u32x2*)(O1 + k);
            const f32x4 gg = *(const f32x4*)(g2 + k);
            f32x4 m;
            m.x = g0 * bflo(a.x) + g1 * bflo(b.x); m.y = g0 * bfhi(a.x) + g1 * bfhi(b.x);
            m.z = g0 * bflo(a.y) + g1 * bflo(b.y); m.w = g0 * bfhi(a.y) + g1 * bfhi(b.y);
            *(f32x4*)(O + k) = x1 + gg * m;
        }
    }
}

constexpr int BM = 128, BN = 128, BK = 64, LDT = BK + 8;
constexpr int GEMM_LDS = (BM + BN) * LDT * 2;

template <class AF, class BF>
__device__ __forceinline__ void gemm_tile(const AF& arow, const BF& bptr, int K, unsigned char* smem, f32x4 (&acc)[4][4]) {
    bf16_t* As = (bf16_t*)smem;
    bf16_t* Bs = As + BM * LDT;
    const int tid = otid(), lane = tid & 63, wid = tid >> 6, wr = wid >> 1, wc = wid & 1, fr = lane & 15, fq = lane >> 4;
    const int a_chunk = tid & 7, a_row0 = tid >> 3;
    const bf16_t* ap[4];
#pragma unroll
    for (int i = 0; i < 4; ++i) ap[i] = arow(a_row0 + 32 * i) + a_chunk * 8;
    const int b_nb = tid & 31, b_kb0 = tid >> 5;
    u32x4 ar[4];
    f32x4 br[2][4];
#pragma unroll
    for (int m = 0; m < 4; ++m)
#pragma unroll
        for (int n = 0; n < 4; ++n) acc[m][n] = (f32x4){0.f, 0.f, 0.f, 0.f};
    const int nk = K / BK;
#pragma unroll
    for (int i = 0; i < 4; ++i) ar[i] = *(const u32x4*)(ap[i]);
#pragma unroll
    for (int i = 0; i < 2; ++i)
#pragma unroll
        for (int kk = 0; kk < 4; ++kk) br[i][kk] = *(const f32x4*)bptr(4 * (b_kb0 + 8 * i) + kk, 4 * b_nb);
    for (int kt = 0; kt < nk; ++kt) {
#pragma unroll
        for (int i = 0; i < 4; ++i) *(u32x4*)(As + (a_row0 + 32 * i) * LDT + a_chunk * 8) = ar[i];
#pragma unroll
        for (int i = 0; i < 2; ++i) {
            const int kb = b_kb0 + 8 * i;
#pragma unroll
            for (int jj = 0; jj < 4; ++jj) {
                u32x2 w; w.x = pk2(br[i][0][jj], br[i][1][jj]); w.y = pk2(br[i][2][jj], br[i][3][jj]);
                *(u32x2*)(Bs + (4 * b_nb + jj) * LDT + 4 * kb) = w;
            }
        }
        __syncthreads();
        if (kt + 1 < nk) {
            const int k0 = (kt + 1) * BK;
#pragma unroll
            for (int i = 0; i < 4; ++i) ar[i] = *(const u32x4*)(ap[i] + k0);
#pragma unroll
            for (int i = 0; i < 2; ++i)
#pragma unroll
                for (int kk = 0; kk < 4; ++kk) br[i][kk] = *(const f32x4*)bptr(k0 + 4 * (b_kb0 + 8 * i) + kk, 4 * b_nb);
        }
#pragma unroll
        for (int ks = 0; ks < 2; ++ks) {
            bf16x8 af[4], bfr[4];
#pragma unroll
            for (int m = 0; m < 4; ++m) af[m] = *(const bf16x8*)(As + (wr * 64 + m * 16 + fr) * LDT + ks * 32 + fq * 8);
#pragma unroll
            for (int n = 0; n < 4; ++n) bfr[n] = *(const bf16x8*)(Bs + (wc * 64 + n * 16 + fr) * LDT + ks * 32 + fq * 8);
#pragma unroll
            for (int m = 0; m < 4; ++m)
#pragma unroll
                for (int n = 0; n < 4; ++n) acc[m][n] = __builtin_amdgcn_mfma_f32_16x16x32_bf16(bfr[n], af[m], acc[m][n], 0, 0, 0);
        }
        __syncthreads();
    }
}

__device__ void phase_gemm_in(const Params& p, int l, unsigned char* smem) {
    const float* tab = (const float*)(p.ws + WS_TAB);
    const bf16_t* H = (const bf16_t*)(p.ws + WS_H);
    bf16_t* P = (bf16_t*)(p.ws + WS_P);
    float* LF = (float*)(p.ws + WS_LF);
    const float* W = p.in[7] + (size_t)l * D * INW;
    const float* qw = p.in[10] + l * 64;
    const float* kw = p.in[11] + l * 64;
    const float* lbt = tab + TAB_LB + l * 512;
    const int tid = otid(), lane = tid & 63, wid = tid >> 6, wr = wid >> 1, wc = wid & 1, fr = lane & 15, fq = lane >> 4;
    const int nMT = R / BM, nNT = INW / BN;
    for (int u = obid(); u < nMT * nNT; u += gridDim.x) {
        const int mt = u / nNT, nt = u % nNT;
        const int row0 = mt * BM, col0 = nt * BN;
        f32x4 acc[4][4];
        auto arow = [&](int i) { return H + (size_t)(row0 + i) * D; };
        auto bptr = [&](int k, int n) { return W + (size_t)k * INW + col0 + n; };
        gemm_tile(arow, bptr, D, smem, acc);
        const int cw = col0 + wc * 64;
#pragma unroll
        for (int m = 0; m < 4; ++m) {
            const int row = row0 + wr * 64 + m * 16 + fr;
            float v[4][4];
#pragma unroll
            for (int n = 0; n < 4; ++n)
#pragma unroll
                for (int j = 0; j < 4; ++j) v[n][j] = acc[m][n][j];
            if (cw >= OFF_ZF && cw < OFF_HV) {
                const int dir = (cw >= OFF_ZB) ? 1 : 0;
                const int cb = cw - (dir ? OFF_ZB : OFF_ZF);
#pragma unroll
                for (int n = 0; n < 4; ++n) {
                    f32x4 o;
#pragma unroll
                    for (int j = 0; j < 4; ++j) {
                        const int c = cb + n * 16 + fq * 4 + j;
                        const float lb = lbt[dir * 256 + c];
                        const float z = v[n][j];
                        float lf;
                        if (lb > 0.f) lf = __logf(lb + (1.f - lb) * sigmoidf_(z));
                        else lf = fminf(z, 0.f) - log1pf(__expf(-fabsf(z)));
                        o[j] = lf;
                    }
                    *(f32x4*)(LF + (size_t)row * LFW + dir * 256 + cb + n * 16 + fq * 4) = o;
                }
                continue;
            }
            if (cw < OFF_B) {
#pragma unroll
                for (int n = 0; n < 4; ++n)
#pragma unroll
                    for (int j = 0; j < 4; ++j) v[n][j] = gelu_tanh(v[n][j]);
            }
            if ((cw >= 256 && cw < OFF_V)) {
                float ss = 0.f;
#pragma unroll
                for (int n = 0; n < 4; ++n)
#pragma unroll
                    for (int j = 0; j < 4; ++j) ss += v[n][j] * v[n][j];
                ss += __shfl_xor(ss, 16); ss += __shfl_xor(ss, 32);
                const float rstd = rsqrtf(ss * (1.f / 64.f) + EPS);
                if (cw < OFF_B) {
#pragma unroll
                    for (int n = 0; n < 4; ++n)
#pragma unroll
                        for (int j = 0; j < 4; ++j) v[n][j] *= rstd;
                } else {
                    const float* nwv = (cw < OFF_KV) ? qw : kw;
#pragma unroll
                    for (int n = 0; n < 4; ++n)
#pragma unroll
                        for (int j = 0; j < 4; ++j) v[n][j] *= rstd * nwv[n * 16 + fq * 4 + j];
                    if (row < RL) {
                        const int t = row & (T - 1);
#pragma unroll
                        for (int a = 0; a < 2; ++a) {
                            const int pos = a == 0 ? (t >> 6) : (t & 63);
#pragma unroll
                            for (int j = 0; j < 4; ++j) {
                                const int f = fq * 4 + j;
                                const float cs = tab[TAB_ROPE + (pos * 16 + f) * 2], sn = tab[TAB_ROPE + (pos * 16 + f) * 2 + 1];
                                const float x0 = v[2 * a][j], x1 = v[2 * a + 1][j];
                                v[2 * a][j] = x0 * cs - x1 * sn;
                                v[2 * a + 1][j] = x1 * cs + x0 * sn;
                            }
                        }
                    }
                }
            }
            if ((cw >= OFF_C && cw < OFF_ZF) || cw >= OFF_G) {
#pragma unroll
                for (int n = 0; n < 4; ++n)
#pragma unroll
                    for (int j = 0; j < 4; ++j) v[n][j] = siluf_(v[n][j]);
            }
#pragma unroll
            for (int n = 0; n < 4; ++n) {
                u32x2 pk; pk.x = pk2(v[n][0], v[n][1]); pk.y = pk2(v[n][2], v[n][3]);
                *(u32x2*)(P + (size_t)row * INW + cw + n * 16 + fq * 4) = pk;
            }
        }
    }
}

__device__ __forceinline__ int next_unit(unsigned* ctr, unsigned char* smem) {
    int* slot = (int*)(smem + 73728 + 512);
    __syncthreads();
    if (otid() == 0) *slot = (int)atomicAdd(ctr, 1u);
    __syncthreads();
    return *slot;
}

constexpr float ATT_C = 0.125f * 1.4426950408889634f;
__device__ __forceinline__ void attn_unit(const Params& p, int u, unsigned char* smem) {
    const bf16_t* P = (const bf16_t*)(p.ws + WS_P);
    bf16_t* Y = (bf16_t*)(p.ws + WS_Y);
    bf16_t* Ks = (bf16_t*)smem;
    bf16_t* Vt = Ks + 2 * 64 * LDT;
    const int tid = otid(), lane = tid & 63, wid = tid >> 6, fr = lane & 15, fq = lane >> 4;
    const int k_row = tid >> 3, k_chunk = tid & 7;
    const int v_dg = tid & 15, v_kg = tid >> 4;
    const int v_pos = 32 * (v_kg >> 3) + 8 * (v_kg & 3) + 4 * ((v_kg >> 2) & 1);
    {
        int b, kvh, qrow0, nkt; bool ctxq = u >= 512;
        if (!ctxq) { b = u >> 6; kvh = (u >> 5) & 1; qrow0 = b * T + (u & 31) * 64; nkt = 36; }
        else { const int v = u - 512; b = v >> 3; kvh = (v >> 2) & 1; qrow0 = RL + b * TC + (v & 3) * 64; nkt = 4; }
        const int hh = kvh * 4 + wid;
        bf16_t* Qs = Vt + 2 * 64 * LDT + wid * 64 * LDT;
#pragma unroll
        for (int i = 0; i < 8; ++i) {
            const int r = i * 8 + (lane >> 3), ch = lane & 7;
            *(u32x4*)(Qs + r * LDT + ch * 8) = *(const u32x4*)(P + (size_t)(qrow0 + r) * INW + OFF_B + hh * 64 + ch * 8);
        }
        f32x4 o[4][4];
        float mrow[4], lrow[4];
#pragma unroll
        for (int m = 0; m < 4; ++m) { mrow[m] = -1e30f; lrow[m] = 0.f;
#pragma unroll
            for (int n = 0; n < 4; ++n) o[m][n] = (f32x4){0.f, 0.f, 0.f, 0.f}; }
        auto krow = [&](int kt, int i) { return ctxq ? (RL + b * TC + kt * 64 + i) : (kt < 32 ? (b * T + kt * 64 + i) : (RL + b * TC + (kt - 32) * 64 + i)); };
        u32x4 kreg[2]; u32x2 vreg[4];
        auto gload = [&](int kt) {
#pragma unroll
            for (int i = 0; i < 2; ++i) kreg[i] = *(const u32x4*)(P + (size_t)krow(kt, k_row + 32 * i) * INW + OFF_KV + kvh * 64 + k_chunk * 8);
#pragma unroll
            for (int i = 0; i < 4; ++i) vreg[i] = *(const u32x2*)(P + (size_t)krow(kt, 4 * v_kg + i) * INW + OFF_V + kvh * 64 + 4 * v_dg);
        };
        auto lwrite = [&](int buf) {
            bf16_t* kb = Ks + buf * 64 * LDT; bf16_t* vb = Vt + buf * 64 * LDT;
#pragma unroll
            for (int i = 0; i < 2; ++i) *(u32x4*)(kb + (k_row + 32 * i) * LDT + k_chunk * 8) = kreg[i];
#pragma unroll
            for (int di = 0; di < 4; ++di) {
                const int w = di >> 1;
                u32x2 ov;
                if ((di & 1) == 0) { ov.x = (vreg[0][w] & 0xffffu) | (vreg[1][w] << 16); ov.y = (vreg[2][w] & 0xffffu) | (vreg[3][w] << 16); }
                else { ov.x = (vreg[0][w] >> 16) | (vreg[1][w] & 0xffff0000u); ov.y = (vreg[2][w] >> 16) | (vreg[3][w] & 0xffff0000u); }
                *(u32x2*)(vb + (4 * v_dg + di) * LDT + v_pos) = ov;
            }
        };
        gload(0); lwrite(0); __syncthreads();
        for (int kt = 0; kt < nkt; ++kt) {
            if (kt + 1 < nkt) gload(kt + 1);
            const bf16_t* kb = Ks + (kt & 1) * 64 * LDT; const bf16_t* vb = Vt + (kt & 1) * 64 * LDT;
            bf16x8 kf[4][2], vf[4][2];
#pragma unroll
            for (int n = 0; n < 4; ++n)
#pragma unroll
                for (int ks = 0; ks < 2; ++ks) {
                    kf[n][ks] = *(const bf16x8*)(kb + (n * 16 + fr) * LDT + ks * 32 + fq * 8);
                    vf[n][ks] = *(const bf16x8*)(vb + (n * 16 + fr) * LDT + ks * 32 + fq * 8);
                }
#pragma unroll
            for (int m = 0; m < 4; ++m) {
                f32x4 sc[4];
                bf16x8 qf[2];
#pragma unroll
                for (int ks = 0; ks < 2; ++ks) qf[ks] = *(const bf16x8*)(Qs + (m * 16 + fr) * LDT + ks * 32 + fq * 8);
#pragma unroll
                for (int n = 0; n < 4; ++n) {
                    sc[n] = (f32x4){0.f, 0.f, 0.f, 0.f};
#pragma unroll
                    for (int ks = 0; ks < 2; ++ks) sc[n] = __builtin_amdgcn_mfma_f32_16x16x32_bf16(kf[n][ks], qf[ks], sc[n], 0, 0, 0);
                }
                float mx = sc[0][0];
#pragma unroll
                for (int n = 0; n < 4; ++n)
#pragma unroll
                    for (int j = 0; j < 4; ++j) mx = fmaxf(mx, sc[n][j]);
                mx = fmaxf(mx, __shfl_xor(mx, 16)); mx = fmaxf(mx, __shfl_xor(mx, 32));
                const float mnew = fmaxf(mrow[m], mx);
                const float alpha = __builtin_amdgcn_exp2f((mrow[m] - mnew) * ATT_C);
                mrow[m] = mnew;
                const float mc = mnew * ATT_C;
                float ls = 0.f;
#pragma unroll
                for (int n = 0; n < 4; ++n)
#pragma unroll
                    for (int j = 0; j < 4; ++j) { sc[n][j] = __builtin_amdgcn_exp2f(sc[n][j] * ATT_C - mc); ls += sc[n][j]; }
                lrow[m] = lrow[m] * alpha + ls;
#pragma unroll
                for (int n = 0; n < 4; ++n) o[m][n] = o[m][n] * alpha;
#pragma unroll
                for (int ks = 0; ks < 2; ++ks) {
                    u32x4 pw;
                    pw.x = pk2(sc[2 * ks][0], sc[2 * ks][1]); pw.y = pk2(sc[2 * ks][2], sc[2 * ks][3]);
                    pw.z = pk2(sc[2 * ks + 1][0], sc[2 * ks + 1][1]); pw.w = pk2(sc[2 * ks + 1][2], sc[2 * ks + 1][3]);
                    const bf16x8 pf = __builtin_bit_cast(bf16x8, pw);
#pragma unroll
                    for (int nd = 0; nd < 4; ++nd) o[m][nd] = __builtin_amdgcn_mfma_f32_16x16x32_bf16(vf[nd][ks], pf, o[m][nd], 0, 0, 0);
                }
            }
            if (kt + 1 < nkt) lwrite((kt + 1) & 1);
            __syncthreads();
        }
#pragma unroll
        for (int m = 0; m < 4; ++m) {
            float lt = lrow[m];
            lt += __shfl_xor(lt, 16); lt += __shfl_xor(lt, 32);
            const float inv = 1.f / lt;
            const size_t row = (size_t)(qrow0 + m * 16 + fr);
#pragma unroll
            for (int nd = 0; nd < 4; ++nd) {
                u32x2 pk; pk.x = pk2(o[m][nd][0] * inv, o[m][nd][1] * inv); pk.y = pk2(o[m][nd][2] * inv, o[m][nd][3] * inv);
                *(u32x2*)(Y + row * D + 256 + hh * 64 + nd * 16 + fq * 4) = pk;
            }
        }
    }
}

constexpr int LDA = 128 + 8;
__device__ __forceinline__ void mixa_unit(const Params& p, int l, int u, unsigned char* smem) {
    const bf16_t* P = (const bf16_t*)(p.ws + WS_P);
    bf16_t* Y = (bf16_t*)(p.ws + WS_Y);
    const int n = u >> 2, h = u & 3;
    const float* W = p.in[8] + ((size_t)l * 4 + h) * 128 * 128;
    const float* bs = p.in[9] + (l * 4 + h) * 128;
    bf16_t* Ws = (bf16_t*)smem;
    bf16_t* Vs = Ws + 128 * LDA;
    const int tid = otid(), lane = tid & 63, wid = tid >> 6, fr = lane & 15, fq = lane >> 4;
#pragma unroll
    for (int i = 0; i < 16; ++i) {
        const int pc = tid + 256 * i, t = pc >> 5, s4 = (pc & 31) * 4;
        const f32x4 w = *(const f32x4*)(W + t * 128 + s4);
        u32x2 o; o.x = pk2(w[0], w[1]); o.y = pk2(w[2], w[3]);
        *(u32x2*)(Ws + t * LDA + s4) = o;
    }
#pragma unroll
    for (int i = 0; i < 2; ++i) {
        const int mb = tid + 256 * i, dg = mb & 15, sg = mb >> 4;
        u32x2 vr[4];
#pragma unroll
        for (int r = 0; r < 4; ++r) vr[r] = *(const u32x2*)(P + (size_t)(n * 128 + 4 * sg + r) * INW + 256 + h * 64 + 4 * dg);
#pragma unroll
        for (int di = 0; di < 4; ++di) {
            const int w = di >> 1;
            u32x2 ov;
            if ((di & 1) == 0) { ov.x = (vr[0][w] & 0xffffu) | (vr[1][w] << 16); ov.y = (vr[2][w] & 0xffffu) | (vr[3][w] << 16); }
            else { ov.x = (vr[0][w] >> 16) | (vr[1][w] & 0xffff0000u); ov.y = (vr[2][w] >> 16) | (vr[3][w] & 0xffff0000u); }
            *(u32x2*)(Vs + (4 * dg + di) * LDA + 4 * sg) = ov;
        }
    }
    __syncthreads();
    f32x4 acc[2][4];
#pragma unroll
    for (int m = 0; m < 2; ++m)
#pragma unroll
        for (int nd = 0; nd < 4; ++nd) acc[m][nd] = (f32x4){0.f, 0.f, 0.f, 0.f};
#pragma unroll
    for (int ks = 0; ks < 4; ++ks) {
        bf16x8 wf[2], vf[4];
#pragma unroll
        for (int m = 0; m < 2; ++m) wf[m] = *(const bf16x8*)(Ws + (32 * wid + 16 * m + fr) * LDA + ks * 32 + fq * 8);
#pragma unroll
        for (int nd = 0; nd < 4; ++nd) vf[nd] = *(const bf16x8*)(Vs + (16 * nd + fr) * LDA + ks * 32 + fq * 8);
#pragma unroll
        for (int m = 0; m < 2; ++m)
#pragma unroll
            for (int nd = 0; nd < 4; ++nd) acc[m][nd] = __builtin_amdgcn_mfma_f32_16x16x32_bf16(vf[nd], wf[m], acc[m][nd], 0, 0, 0);
    }
#pragma unroll
    for (int m = 0; m < 2; ++m) {
        const int t = 32 * wid + 16 * m + fr;
        const size_t row = (size_t)n * 128 + t;
        const float bias = bs[t];
#pragma unroll
        for (int nd = 0; nd < 4; ++nd) {
            const int c = h * 64 + 16 * nd + 4 * fq;
            const u32x2 uu = *(const u32x2*)(P + row * INW + c);
            u32x2 pk;
            pk.x = pk2(bflo(uu.x) * (acc[m][nd][0] + bias), bfhi(uu.x) * (acc[m][nd][1] + bias));
            pk.y = pk2(bflo(uu.y) * (acc[m][nd][2] + bias), bfhi(uu.y) * (acc[m][nd][3] + bias));
            *(u32x2*)(Y + row * D + c) = pk;
        }
    }
}

__device__ __forceinline__ int hg_pos(int I, int ii) { return 32 * (I >> 1) + 4 * (I & 1) + 8 * (ii >> 2) + (ii & 3); }
__device__ __forceinline__ void hgrn_state_unit(const Params& p, int l, int u, unsigned char* smem) {
    const bf16_t* P = (const bf16_t*)(p.ws + WS_P);
    const float* LF = (const float*)(p.ws + WS_LF);
    bf16_t* SST = (bf16_t*)(p.ws + WS_OFB);
    const int b = u >> 3, h = (u >> 1) & 3, dir = u & 1;
    const int tid = otid(), lane = tid & 63, wid = tid >> 6, fr = lane & 15, fq = lane >> 4;
    const int k = lane, I = wid;
    bf16_t* KT = (bf16_t*)smem;
    bf16_t* VT = KT + 64 * LDT;
    float* Tsub = (float*)(VT + 64 * LDT);
    float* Etot = Tsub + 256;
    f32x4 sacc[4];
#pragma unroll
    for (int nk = 0; nk < 4; ++nk) sacc[nk] = (f32x4){0.f, 0.f, 0.f, 0.f};
    float lf[16], vv[16];
    auto mcof = [&](int j) { return dir == 0 ? (j < 4 ? 256 + b * 4 + j : b * 32 + (j - 4)) : (j < 4 ? 256 + b * 4 + (3 - j) : b * 32 + (35 - j)); };
    auto gload = [&](int j) {
        const int mc = mcof(j);
#pragma unroll
        for (int ii = 0; ii < 16; ++ii) {
            const int tau = 16 * I + ii;
            const size_t row = (size_t)mc * 64 + (dir ? 63 - tau : tau);
            lf[ii] = LF[row * LFW + dir * 256 + h * 64 + k];
            vv[ii] = bf2f(P[row * INW + OFF_HV + h * 64 + k]);
        }
    };
    gload(0);
    for (int j = 0; j < 36; ++j) {
        float c[16];
        c[0] = lf[0];
#pragma unroll
        for (int ii = 1; ii < 16; ++ii) c[ii] = c[ii - 1] + lf[ii];
        Tsub[I * 64 + k] = c[15];
        __syncthreads();
        float Rs = 0.f;
#pragma unroll
        for (int M = 1; M < 4; ++M) Rs += (M > I) ? Tsub[M * 64 + k] : 0.f;
        if (I == 0) Etot[k] = __expf(c[15] + Rs);
#pragma unroll
        for (int g = 0; g < 4; ++g) {
            float kh[4];
#pragma unroll
            for (int jj = 0; jj < 4; ++jj) { const int ii = 4 * g + jj; kh[jj] = (1.f - __expf(lf[ii])) * __expf(c[15] - c[ii] + Rs); }
            u32x2 kw; kw.x = pk2(kh[0], kh[1]); kw.y = pk2(kh[2], kh[3]);
            u32x2 vw; vw.x = pk2(vv[4 * g], vv[4 * g + 1]); vw.y = pk2(vv[4 * g + 2], vv[4 * g + 3]);
            const int pos = hg_pos(I, 4 * g);
            *(u32x2*)(KT + k * LDT + pos) = kw;
            *(u32x2*)(VT + k * LDT + pos) = vw;
        }
        const int mc = mcof(j);
        {
            bf16_t* dst = SST + ((size_t)(mc * 4 + h) * 2 + dir) * 4096;
#pragma unroll
            for (int nk = 0; nk < 4; ++nk)
#pragma unroll
                for (int r = 0; r < 4; ++r) dst[(16 * wid + 4 * fq + r) * 64 + 16 * nk + fr] = f2bf(sacc[nk][r]);
        }
        if (j + 1 < 36) gload(j + 1);
        __syncthreads();
        bf16x8 vf[2];
#pragma unroll
        for (int ks = 0; ks < 2; ++ks) vf[ks] = *(const bf16x8*)(VT + (16 * wid + fr) * LDT + 32 * ks + 8 * fq);
#pragma unroll
        for (int nk = 0; nk < 4; ++nk) {
            const float e = Etot[16 * nk + fr];
            sacc[nk] = sacc[nk] * e;
#pragma unroll
            for (int ks = 0; ks < 2; ++ks) {
                const bf16x8 kf = *(const bf16x8*)(KT + (16 * nk + fr) * LDT + 32 * ks + 8 * fq);
                sacc[nk] = __builtin_amdgcn_mfma_f32_16x16x32_bf16(vf[ks], kf, sacc[nk], 0, 0, 0);
            }
        }
        __syncthreads();
    }
}

__device__ __forceinline__ void hgrn_out_unit(const Params& p, int l, int u, unsigned char* smem) {
    const bf16_t* P = (const bf16_t*)(p.ws + WS_P);
    const float* LF = (const float*)(p.ws + WS_LF);
    const bf16_t* SST = (const bf16_t*)(p.ws + WS_OFB);
    bf16_t* Y = (bf16_t*)(p.ws + WS_Y);
    const float* hw = p.in[13] + l * 64;
    const int mc = u >> 2, h = u & 3;
    const int tid = otid(), lane = tid & 63, wid = tid >> 6, fr = lane & 15, fq = lane >> 4;
    const int k = lane, I = wid;
    bf16_t* QT0 = (bf16_t*)smem;
    bf16_t* KD = QT0 + 64 * LDT;
    bf16_t* KO = KD + 64 * LDT;
    bf16_t* QS = KO + 64 * LDT;
    bf16_t* QT1 = QS + 64 * LDT;
    bf16_t* QT2 = QT1 + 32 * LDT;
    bf16_t* VT = QT2 + 16 * LDT;
    float* Tsub = (float*)(VT + 64 * LDT);
    float* SSQ = Tsub + 256;
    f32x4 om[4];
#pragma unroll 1
    for (int dd = 0; dd < 2; ++dd) {
        const int dir = 1 - dd;
        float lf[16], c[16];
#pragma unroll
        for (int ii = 0; ii < 16; ++ii) {
            const int tau = 16 * I + ii;
            const size_t row = (size_t)mc * 64 + (dir ? 63 - tau : tau);
            lf[ii] = LF[row * LFW + dir * 256 + h * 64 + k];
        }
        c[0] = lf[0];
#pragma unroll
        for (int ii = 1; ii < 16; ++ii) c[ii] = c[ii - 1] + lf[ii];
        Tsub[I * 64 + k] = c[15];
        __syncthreads();
        const float T0 = Tsub[k], T1 = Tsub[64 + k], T2 = Tsub[128 + k];
        const float pre = (I > 0 ? T0 : 0.f) + (I > 1 ? T1 : 0.f) + (I > 2 ? T2 : 0.f);
        const float epre = __expf(pre);
        const float g1 = __expf(I == 2 ? T1 : T2);
        const float g2 = __expf(T1 + T2);
#pragma unroll
        for (int g = 0; g < 4; ++g) {
            float vq[4];
#pragma unroll
            for (int jj = 0; jj < 4; ++jj) {
                const int ii = 4 * g + jj, tau = 16 * I + ii;
                const size_t row = (size_t)mc * 64 + (dir ? 63 - tau : tau);
                const float q = bf2f(P[row * INW + OFF_C + h * 64 + k]);
                vq[jj] = bf2f(P[row * INW + OFF_HV + h * 64 + k]);
                const float qt = q * __expf(c[ii]);
                const float kk = 1.f - __expf(lf[ii]);
                QT0[tau * LDT + k] = f2bf(qt);
                QS[tau * LDT + k] = f2bf(qt * epre);
                KD[tau * LDT + k] = f2bf(kk * __expf(fminf(-c[ii], 80.f)));
                KO[tau * LDT + k] = f2bf(kk * __expf(c[15] - c[ii]));
                if (I >= 2) QT1[(tau - 32) * LDT + k] = f2bf(qt * g1);
                if (I == 3) QT2[(tau - 48) * LDT + k] = f2bf(qt * g2);
            }
            u32x2 vw; vw.x = pk2(vq[0], vq[1]); vw.y = pk2(vq[2], vq[3]);
            *(u32x2*)(VT + k * LDT + hg_pos(I, 4 * g)) = vw;
        }
        bf16x8 stf[2];
        {
            const bf16_t* src = SST + ((size_t)(mc * 4 + h) * 2 + dir) * 4096 + (16 * wid + fr) * 64 + 8 * fq;
            stf[0] = *(const bf16x8*)(src); stf[1] = *(const bf16x8*)(src + 32);
        }
        __syncthreads();
        bf16x8 vf[2];
#pragma unroll
        for (int ks = 0; ks < 2; ++ks) vf[ks] = *(const bf16x8*)(VT + (16 * wid + fr) * LDT + 32 * ks + 8 * fq);
        f32x4 o[4];
#pragma unroll
        for (int I2 = 0; I2 < 4; ++I2) {
            f32x4 A[4];
#pragma unroll
            for (int J = 0; J < 4; ++J) {
                A[J] = (f32x4){0.f, 0.f, 0.f, 0.f};
                if (J <= I2) {
                    const bf16_t* kbase = (J == I2 ? KD : KO) + (16 * J + fr) * LDT + 8 * fq;
                    const bf16_t* qbase = (I2 - J <= 1) ? (QT0 + (16 * I2 + fr) * LDT) : ((I2 - J == 2) ? (QT1 + (16 * I2 - 32 + fr) * LDT) : (QT2 + fr * LDT));
#pragma unroll
                    for (int ks = 0; ks < 2; ++ks) {
                        const bf16x8 kf = *(const bf16x8*)(kbase + 32 * ks);
                        const bf16x8 qf = *(const bf16x8*)(qbase + 32 * ks + 8 * fq);
                        A[J] = __builtin_amdgcn_mfma_f32_16x16x32_bf16(kf, qf, A[J], 0, 0, 0);
                    }
                    if (J == I2) {
#pragma unroll
                        for (int r = 0; r < 4; ++r) A[J][r] = (4 * fq + r <= fr) ? A[J][r] : 0.f;
                    }
                }
            }
            o[I2] = (f32x4){0.f, 0.f, 0.f, 0.f};
#pragma unroll
            for (int ks = 0; ks < 2; ++ks) {
                if (2 * ks <= I2) {
                    u32x4 pw;
                    pw.x = pk2(A[2 * ks][0], A[2 * ks][1]); pw.y = pk2(A[2 * ks][2], A[2 * ks][3]);
                    pw.z = pk2(A[2 * ks + 1][0], A[2 * ks + 1][1]); pw.w = pk2(A[2 * ks + 1][2], A[2 * ks + 1][3]);
                    o[I2] = __builtin_amdgcn_mfma_f32_16x16x32_bf16(vf[ks], __builtin_bit_cast(bf16x8, pw), o[I2], 0, 0, 0);
                }
                const bf16x8 qsf = *(const bf16x8*)(QS + (16 * I2 + fr) * LDT + 32 * ks + 8 * fq);
                o[I2] = __builtin_amdgcn_mfma_f32_16x16x32_bf16(stf[ks], qsf, o[I2], 0, 0, 0);
            }
        }
        if (dir == 1) {
            const int src = (lane & 48) | (15 - fr);
#pragma unroll
            for (int Im = 0; Im < 4; ++Im)
#pragma unroll
                for (int r = 0; r < 4; ++r) om[Im][r] = __shfl(o[3 - Im][r], src);
        } else {
#pragma unroll
            for (int Im = 0; Im < 4; ++Im) om[Im] = om[Im] + o[Im];
        }
        __syncthreads();
    }
#pragma unroll
    for (int Im = 0; Im < 4; ++Im) {
        float s = om[Im][0] * om[Im][0] + om[Im][1] * om[Im][1] + om[Im][2] * om[Im][2] + om[Im][3] * om[Im][3];
        s += __shfl_xor(s, 16); s += __shfl_xor(s, 32);
        if (fq == 0) SSQ[wid * 64 + 16 * Im + fr] = s;
    }
    __syncthreads();
    const f32x4 wv = *(const f32x4*)(hw + 16 * wid + 4 * fq);
#pragma unroll
    for (int Im = 0; Im < 4; ++Im) {
        const int i = 16 * Im + fr;
        const float tot = SSQ[i] + SSQ[64 + i] + SSQ[128 + i] + SSQ[192 + i];
        const float rstd = rsqrtf(tot * (1.f / 64.f) + EPS);
        const size_t row = (size_t)mc * 64 + i;
        const u32x2 gg = *(const u32x2*)(P + row * INW + OFF_G + h * 64 + 16 * wid + 4 * fq);
        u32x2 pk;
        pk.x = pk2(om[Im][0] * rstd * wv[0] * bflo(gg.x), om[Im][1] * rstd * wv[1] * bfhi(gg.x));
        pk.y = pk2(om[Im][2] * rstd * wv[2] * bflo(gg.y), om[Im][3] * rstd * wv[3] * bfhi(gg.y));
        *(u32x2*)(Y + row * D + 768 + h * 64 + 16 * wid + 4 * fq) = pk;
    }
}

__device__ void phase_mix1(const Params& p, int l, unsigned char* smem) {
    unsigned* ctr = (unsigned*)(p.ws + WS_CTL) + 128 + l * 2;
    const int n_attn = (l == 0) ? 576 : 512, n_mixa = (l == 0) ? 576 : 512;
    const int total = 64 + n_attn + n_mixa;
    for (;;) {
        const int u = next_unit(ctr, smem);
        if (u >= total) break;
        if (u < 64) hgrn_state_unit(p, l, u, smem);
        else if (u < 64 + n_attn) attn_unit(p, u - 64, smem);
        else mixa_unit(p, l, u - 64 - n_attn, smem);
    }
}
__device__ void phase_mix2(const Params& p, int l, unsigned char* smem) {
    unsigned* ctr = (unsigned*)(p.ws + WS_CTL) + 128 + l * 2 + 1;
    const int total = ((l == 0) ? 288 : 256) * 4;
    for (;;) {
        const int u = next_unit(ctr, smem);
        if (u >= total) break;
        hgrn_out_unit(p, l, u, smem);
    }
}

__device__ void phase_out(const Params& p, int l, unsigned char* smem) {
    const float* tab = (const float*)(p.ws + WS_TAB);
    const bf16_t* Y = (const bf16_t*)(p.ws + WS_Y);
    float* X1 = (float*)(p.ws + WS_X1);
    const float* X2 = (const float*)(p.ws + WS_X2);
    const float* W = p.in[14] + (size_t)l * D * D;
    const int tid = otid(), lane = tid & 63, wid = tid >> 6, wr = wid >> 1, wc = wid & 1, fr = lane & 15, fq = lane >> 4;
    const int nrows = (l == 0) ? R : RL;
    const int nMT = nrows / BM, nNT = D / BN;
    for (int u = obid(); u < nMT * nNT; u += gridDim.x) {
        const int mt = u / nNT, nt = u % nNT;
        const int row0 = mt * BM, col0 = nt * BN;
        f32x4 acc[4][4];
        auto arow = [&](int i) { return Y + (size_t)(row0 + i) * D; };
        auto bptr = [&](int k, int n) { return W + (size_t)k * D + col0 + n; };
        gemm_tile(arow, bptr, D, smem, acc);
#pragma unroll
        for (int m = 0; m < 4; ++m) {
            const int row = row0 + wr * 64 + m * 16 + fr;
            const int mr = row_modrow(row);
            const float* g1 = tab + TAB_MOD + (l * 9 + mr) * 6144 + 2 * 1024;
            const float* xin = (l == 0) ? (row < RL ? p.in[0] + (size_t)row * D : p.in[2] + (size_t)(row - RL) * D) : X2 + (size_t)row * D;
#pragma unroll
            for (int n = 0; n < 4; ++n) {
                const int col = col0 + wc * 64 + n * 16 + fq * 4;
                const f32x4 xv = *(const f32x4*)(xin + col), gv = *(const f32x4*)(g1 + col);
                *(f32x4*)(X1 + (size_t)row * D + col) = xv + gv * acc[m][n];
            }
        }
    }
}

__device__ void phase_route(const Params& p, int l) {
    const float* tab = (const float*)(p.ws + WS_TAB);
    bf16_t* H = (bf16_t*)(p.ws + WS_H);
    const float* X1 = (const float*)(p.ws + WS_X1);
    int* rt = (int*)(p.ws + WS_RT);
    unsigned* ctl = (unsigned*)(p.ws + WS_CTL);
    const float* nw = p.in[15] + l * 1024;
    const float* wg = p.in[16] + (size_t)l * 1024 * 4;
    const float* bg = p.in[17] + l * 4;
    const float* we = p.in[18] + (size_t)l * 1024 * 32;
    const float* be = p.in[19] + l * 32;
    const int lane = otid() & 63;
    const int gw = obid() * (NTHREADS / 64) + (otid() >> 6), NGW = gridDim.x * (NTHREADS / 64);
    const int nrows = (l == 0) ? R : RL;
    for (int row = gw; row < nrows; row += NGW) {
        const int mr = row_modrow(row);
        const float* sh = tab + TAB_MOD + (l * 9 + mr) * 6144 + 3 * 1024;
        const float* scv = sh + 1024;
        f32x4 v[4];
        float ss = 0.f;
#pragma unroll
        for (int j = 0; j < 4; ++j) { v[j] = *(const f32x4*)(X1 + (size_t)row * D + 4 * lane + 256 * j); ss += (v[j].x * v[j].x + v[j].y * v[j].y) + (v[j].z * v[j].z + v[j].w * v[j].w); }
        ss = wave_sum(ss);
        const float rstd = rsqrtf(ss * (1.f / D) + EPS);
        float lg[36];
#pragma unroll
        for (int i = 0; i < 36; ++i) lg[i] = 0.f;
#pragma unroll
        for (int j = 0; j < 4; ++j) {
            const int k = 4 * lane + 256 * j;
            const f32x4 w = *(const f32x4*)(nw + k), s = *(const f32x4*)(scv + k), h = *(const f32x4*)(sh + k);
            const f32x4 o = v[j] * rstd * w * (1.f + s) + h;
            u32x2 pk; pk.x = pk2(o.x, o.y); pk.y = pk2(o.z, o.w);
            *(u32x2*)(H + (size_t)row * D + k) = pk;
            v[j] = o;
        }
#pragma unroll 1
        for (int je = 0; je < 16; ++je) {
            const int j = je >> 2, e = je & 3;
            const int k = 4 * lane + 256 * j + e;
            float hv = v[0][0];
#pragma unroll
            for (int jj = 0; jj < 4; ++jj)
#pragma unroll
                for (int ee = 0; ee < 4; ++ee) hv = (je == jj * 4 + ee) ? v[jj][ee] : hv;
            const f32x4 g4 = *(const f32x4*)(wg + (size_t)k * 4);
#pragma unroll
            for (int i = 0; i < 4; ++i) lg[i] += hv * g4[i];
#pragma unroll
            for (int c = 0; c < 8; ++c) {
                const f32x4 e4 = *(const f32x4*)(we + (size_t)k * 32 + c * 4);
#pragma unroll
                for (int i = 0; i < 4; ++i) lg[4 + c * 4 + i] += hv * e4[i];
            }
        }
#pragma unroll
        for (int i = 0; i < 36; ++i) lg[i] = wave_sum(lg[i]);
        float gl[4];
#pragma unroll
        for (int i = 0; i < 4; ++i) gl[i] = lg[i] + bg[i];
        int grp = 0; float gm = gl[0];
#pragma unroll
        for (int i = 1; i < 4; ++i) if (gl[i] > gm) { gm = gl[i]; grp = i; }
        float gs = 0.f;
#pragma unroll
        for (int i = 0; i < 4; ++i) gs += expf(gl[i] - gm);
        const float pgrp = 1.f / gs;
        float ev[8];
#pragma unroll
        for (int i = 0; i < 8; ++i) {
            float x = lg[4 + i];
#pragma unroll
            for (int g = 1; g < 4; ++g) x = (grp == g) ? lg[4 + g * 8 + i] : x;
            ev[i] = x;
        }
        {
#pragma unroll
            for (int i = 0; i < 8; ++i) ev[i] += be[grp * 8 + i];
        }
        int i0 = 0; float v0 = ev[0];
#pragma unroll
        for (int i = 1; i < 8; ++i) if (ev[i] > v0) { v0 = ev[i]; i0 = i; }
        int i1 = -1; float v1 = -3.0e38f;
#pragma unroll
        for (int i = 0; i < 8; ++i) if (i != i0 && ev[i] > v1) { v1 = ev[i]; i1 = i; }
        const float e1 = expf(v1 - v0);
        const float ga = pgrp / (1.f + e1), gb = pgrp * e1 / (1.f + e1);
        if (lane == 0) {
            const int ea = grp * 8 + i0, eb = grp * 8 + i1;
            const int sa = (int)atomicAdd(&ctl[l * 64 + ea], 1u);
            const int sb = (int)atomicAdd(&ctl[l * 64 + eb], 1u);
            rt[row * 2] = ea; rt[row * 2 + 1] = eb;
            rt[2 * R + row * 2] = sa; rt[2 * R + row * 2 + 1] = sb;
            ((float*)rt)[4 * R + row * 2] = ga; ((float*)rt)[4 * R + row * 2 + 1] = gb;
            rt[6 * R + ea * R + sa] = row;
            rt[6 * R + eb * R + sb] = row;
        }
    }
}

__device__ __forceinline__ void moe_units(const Params& p, int l, int* s_cnt, int* s_base, int* s_tpre) {
    const unsigned* ctl = (const unsigned*)(p.ws + WS_CTL);
    if (otid() == 0) {
        int base = 0, tp = 0;
        for (int e = 0; e < NEXP; ++e) {
            const int c = (int)ctl[l * 64 + e];
            s_cnt[e] = c; s_base[e] = base; s_tpre[e] = tp;
            base += c; tp += (c + BM - 1) / BM;
        }
        s_tpre[NEXP] = tp;
    }
    __syncthreads();
}

__device__ void phase_moe1(const Params& p, int l, unsigned char* smem) {
    int* s_cnt = (int*)(smem + 73728);
    int* s_base = s_cnt + 32;
    int* s_tpre = s_base + 32;
    moe_units(p, l, s_cnt, s_base, s_tpre);
    const bf16_t* H = (const bf16_t*)(p.ws + WS_H);
    bf16_t* HM = (bf16_t*)(p.ws + WS_LF);
    const int* list = (const int*)(p.ws + WS_RT) + 6 * R;
    const float* W1 = p.in[20] + (size_t)l * NEXP * D * FF;
    const float* W3 = p.in[21] + (size_t)l * NEXP * D * FF;
    const int tid = otid(), lane = tid & 63, wid = tid >> 6, wr = wid >> 1, wc = wid & 1, fr = lane & 15, fq = lane >> 4;
    const int ntiles = s_tpre[NEXP];
    constexpr int nNT = FF / 64;
    for (int u = obid(); u < ntiles * nNT; u += gridDim.x) {
        const int tg = u / nNT, nt = u % nNT;
        int e = 0;
        while (s_tpre[e + 1] <= tg) ++e;
        const int mt = tg - s_tpre[e], cnt = s_cnt[e], base = s_base[e];
        const float* w1 = W1 + (size_t)e * D * FF;
        const float* w3 = W3 + (size_t)e * D * FF;
        const int* lst = list + (size_t)e * R;
        f32x4 acc[4][4];
        auto arow = [&](int i) { int s = mt * BM + i; s = s < cnt ? s : cnt - 1; return H + (size_t)lst[s] * D; };
        auto bptr = [&](int k, int rho) {
            const int n = (rho >> 4) & 3;
            const int col = nt * 64 + (rho >> 6) * 32 + (n & 1) * 16 + (rho & 15);
            return ((n >= 2) ? w3 : w1) + (size_t)k * FF + col;
        };
        gemm_tile(arow, bptr, D, smem, acc);
#pragma unroll
        for (int m = 0; m < 4; ++m) {
            const int s = mt * BM + wr * 64 + m * 16 + fr;
            if (s < cnt) {
#pragma unroll
                for (int n = 0; n < 2; ++n) {
                    float hv[4];
#pragma unroll
                    for (int j = 0; j < 4; ++j) hv[j] = siluf_(acc[m][n][j]) * acc[m][n + 2][j];
                    u32x2 pk; pk.x = pk2(hv[0], hv[1]); pk.y = pk2(hv[2], hv[3]);
                    *(u32x2*)(HM + (size_t)(base + s) * FF + nt * 64 + wc * 32 + n * 16 + fq * 4) = pk;
                }
            }
        }
    }
}

__device__ void phase_moe2(const Params& p, int l, unsigned char* smem) {
    int* s_cnt = (int*)(smem + 73728);
    int* s_base = s_cnt + 32;
    int* s_tpre = s_base + 32;
    moe_units(p, l, s_cnt, s_base, s_tpre);
    const bf16_t* HM = (const bf16_t*)(p.ws + WS_LF);
    bf16_t* OUTM = (bf16_t*)(p.ws + WS_P);
    const float* W2 = p.in[22] + (size_t)l * NEXP * FF * D;
    const int tid = otid(), lane = tid & 63, wid = tid >> 6, wr = wid >> 1, wc = wid & 1, fr = lane & 15, fq = lane >> 4;
    const int ntiles = s_tpre[NEXP];
    constexpr int nNT = D / BN;
    for (int u = obid(); u < ntiles * nNT; u += gridDim.x) {
        const int tg = u / nNT, nt = u % nNT;
        int e = 0;
        while (s_tpre[e + 1] <= tg) ++e;
        const int mt = tg - s_tpre[e], cnt = s_cnt[e], base = s_base[e];
        const float* w2 = W2 + (size_t)e * FF * D;
        f32x4 acc[4][4];
        auto arow = [&](int i) { int s = mt * BM + i; s = s < cnt ? s : cnt - 1; return HM + (size_t)(base + s) * FF; };
        auto bptr = [&](int k, int n) { return w2 + (size_t)k * D + nt * BN + n; };
        gemm_tile(arow, bptr, FF, smem, acc);
#pragma unroll
        for (int m = 0; m < 4; ++m) {
            const int s = mt * BM + wr * 64 + m * 16 + fr;
            if (s < cnt) {
#pragma unroll
                for (int n = 0; n < 4; ++n) {
                    u32x2 pk; pk.x = pk2(acc[m][n][0], acc[m][n][1]); pk.y = pk2(acc[m][n][2], acc[m][n][3]);
                    *(u32x2*)(OUTM + (size_t)(base + s) * D + nt * BN + wc * 64 + n * 16 + fq * 4) = pk;
                }
            }
        }
    }
}

constexpr int NPHASES = 18;
constexpr int SMEM_BYTES = 4 * 64 * LDT * 2 + 4 * 64 * LDT * 2 + 1024;
__global__ void __launch_bounds__(NTHREADS, 2) mega(Params p) {
    __shared__ __attribute__((aligned(16))) unsigned char smem[SMEM_BYTES];
    cg::grid_group grid = cg::this_grid();
    for (int ph = p.ph_lo; ph < p.ph_hi; ++ph) {
        if (ph == 0) phase_init(p, smem);
        else if (ph == NPHASES - 1) phase_final(p, 1);
        else {
            const int l = (ph - 1) / 8, s = (ph - 1) % 8;
            switch (s) {
                case 0: phase_prep(p, l); break;
                case 1: phase_gemm_in(p, l, smem); break;
                case 2: phase_mix1(p, l, smem); break;
                case 3: phase_mix2(p, l, smem); break;
                case 4: phase_out(p, l, smem); break;
                case 5: phase_route(p, l); break;
                case 6: phase_moe1(p, l, smem); break;
                default: phase_moe2(p, l, smem); break;
            }
        }
        if (ph + 1 < p.ph_hi) grid.sync();
    }
}

extern "C" void kernel_launch(void* const* d_in, const int* in_sizes, int n_in, void* d_out, int out_size, void* d_ws, size_t ws_size, hipStream_t stream) {
    static int grid_blocks = 0;
    if (grid_blocks == 0) {
        if (n_in != 23 || out_size != RL * D || ws_size < WS_END) { fprintf(stderr, "kernel_launch: unexpected shapes (n_in %d out %d ws %zu need %zu)\n", n_in, out_size, ws_size, (size_t)WS_END); grid_blocks = -1; return; }
        int dev = 0, cus = 0, per_cu = 0;
        hipGetDevice(&dev);
        hipDeviceGetAttribute(&cus, hipDeviceAttributeMultiprocessorCount, dev);
        hipOccupancyMaxActiveBlocksPerMultiprocessor(&per_cu, mega, NTHREADS, 0);
        if (per_cu > 2) per_cu = 2;
        if (per_cu < 1) per_cu = 1;
        grid_blocks = cus * per_cu;
    }
    if (grid_blocks < 0) return;
    hipMemsetAsync((char*)d_ws + WS_CTL, 0, 1 * MiB, stream);
    Params p{};
    for (int i = 0; i < 23; ++i) p.in[i] = (const float*)d_in[i];
    p.out = (float*)d_out; p.ws = (unsigned char*)d_ws; p.ph_lo = 0; p.ph_hi = NPHASES;
    void* args[] = {&p};
    hipError_t e = hipLaunchCooperativeKernel((void*)mega, dim3(grid_blocks), dim3(NTHREADS), args, 0, stream);
    if (e != hipSuccess) fprintf(stderr, "cooperative launch failed: %s (grid %d)\n", hipGetErrorString(e), grid_blocks);
}
```

```cpp
#include <hip/hip_runtime.h>
#include <hip/hip_cooperative_groups.h>
#include <cstdio>
#include <cstdint>
namespace cg = cooperative_groups;

constexpr int D = 1024, NB = 8, T = 2048, TC = 256;
constexpr int RL = NB * T, RC = NB * TC, R = RL + RC;
constexpr int INW = 2560, LFW = 512;
constexpr int OFF_B = 512, OFF_KV = 1024, OFF_V = 1152, OFF_C = 1280, OFF_ZF = 1536, OFF_ZB = 1792, OFF_HV = 2048, OFF_G = 2304;
constexpr int NEXP = 32, FF = 512;
constexpr float EPS = 1e-6f;
constexpr int NTHREADS = 256;

constexpr size_t MiB = 1ull << 20;
constexpr size_t WS_CTL = 0;
constexpr size_t WS_TAB = 1 * MiB;
constexpr size_t WS_H = 2 * MiB;
constexpr size_t WS_P = WS_H + 36 * MiB;
constexpr size_t WS_LF = WS_P + 90 * MiB;
constexpr size_t WS_Y = WS_LF + 36 * MiB;
constexpr size_t WS_X1 = WS_Y + 36 * MiB;
constexpr size_t WS_X2 = WS_X1 + 72 * MiB;
constexpr size_t WS_OFB = WS_X2 + 72 * MiB;
constexpr size_t WS_RT = WS_OFB + 18 * MiB;
constexpr size_t WS_END = WS_RT + 4 * MiB;
constexpr int TAB_ROPE = 0;
constexpr int TAB_LB = 2048;
constexpr int TAB_MOD = 4096;

typedef unsigned short bf16_t;
typedef short bf16x8 __attribute__((ext_vector_type(8)));
typedef float f32x4 __attribute__((ext_vector_type(4)));
typedef float f32x2 __attribute__((ext_vector_type(2)));
typedef unsigned u32x4 __attribute__((ext_vector_type(4)));
typedef unsigned u32x2 __attribute__((ext_vector_type(2)));
typedef __bf16 bf16x2_t __attribute__((ext_vector_type(2)));

struct Params {
    const float* in[23];
    float* out;
    unsigned char* ws;
    int ph_lo, ph_hi;
};

__device__ __forceinline__ unsigned pk2(float lo, float hi) { f32x2 v = {lo, hi}; bf16x2_t b = __builtin_convertvector(v, bf16x2_t); return __builtin_bit_cast(unsigned, b); }
__device__ __forceinline__ bf16_t f2bf(float f) { return (bf16_t)(pk2(f, 0.f) & 0xffffu); }
__device__ __forceinline__ float bf2f(bf16_t u) { return __uint_as_float(((unsigned)u) << 16); }
__device__ __forceinline__ float bflo(unsigned w) { return __uint_as_float(w << 16); }
__device__ __forceinline__ float bfhi(unsigned w) { return __uint_as_float(w & 0xffff0000u); }
__device__ __forceinline__ float wave_sum(float v) {
#pragma unroll
    for (int o = 1; o < 64; o <<= 1) v += __shfl_xor(v, o);
    return v;
}
__device__ __forceinline__ float sigmoidf_(float x) { return 1.f / (1.f + __expf(-x)); }
__device__ __forceinline__ float siluf_(float x) { return x * sigmoidf_(x); }
__device__ __forceinline__ float gelu_tanh(float x) {
    const float u = 0.7978845608028654f * (x + 0.044715f * x * x * x);
    const float e = __expf(2.f * u);
    const float th = 1.f - 2.f / (e + 1.f);
    return 0.5f * x * (1.f + th);
}
__device__ __forceinline__ int otid() { int t = threadIdx.x; asm volatile("" : "+v"(t)); return t; }
__device__ __forceinline__ int obid() { int t = blockIdx.x; asm volatile("" : "+s"(t)); return t; }
__device__ __forceinline__ int row_modrow(int row) { return row < RL ? (row >> 11) : 8; }

__device__ void phase_init(const Params& p, unsigned char* smem) {
    float* tab = (float*)(p.ws + WS_TAB);
    const float* c = p.in[1];
    const float* c_ctx = p.in[3];
    const float* w_mod = p.in[4];
    const float* b_mod = p.in[5];
    float* sc = (float*)smem;
    const int tid = otid();
    for (int i = tid; i < 9 * 1024; i += NTHREADS) {
        const int b = i >> 10, k = i & 1023;
        const float v = (b < 8) ? c[b * 1024 + k] : c_ctx[k];
        sc[i] = siluf_(v);
    }
    __syncthreads();
    float* red = (float*)(smem + 36864);
    for (int it = obid(); it < 384; it += gridDim.x) {
        const int l = it / 192, j0 = (it % 192) * 32;
        const int jj = tid & 31, kg = tid >> 5;
        const float* w = w_mod + (size_t)l * 1024 * 6144 + (size_t)(kg * 128) * 6144 + j0 + jj;
        float acc[9];
#pragma unroll
        for (int b = 0; b < 9; ++b) acc[b] = 0.f;
        for (int k0 = 0; k0 < 128; k0 += 8) {
            float wv[8];
#pragma unroll
            for (int i = 0; i < 8; ++i) wv[i] = w[(size_t)(k0 + i) * 6144];
#pragma unroll
            for (int i = 0; i < 8; ++i)
#pragma unroll
                for (int b = 0; b < 9; ++b) acc[b] += sc[b * 1024 + kg * 128 + k0 + i] * wv[i];
        }
#pragma unroll
        for (int b = 0; b < 9; ++b) red[(kg * 9 + b) * 32 + jj] = acc[b];
        __syncthreads();
        for (int o = tid; o < 9 * 32; o += NTHREADS) {
            const int b = o >> 5, j2 = o & 31;
            float sum = 0.f;
#pragma unroll
            for (int g = 0; g < 8; ++g) sum += red[(g * 9 + b) * 32 + j2];
            tab[TAB_MOD + (l * 9 + b) * 6144 + j0 + j2] = sum + b_mod[l * 6144 + j0 + j2];
        }
        __syncthreads();
    }
    if (obid() == gridDim.x - 1) {
        for (int i = tid; i < 64 * 16; i += NTHREADS) {
            const int pos = i >> 4, f = i & 15;
            const float inv = 1.0f / powf(10000.0f, (float)(2 * f) / 32.0f);
            const float ang = (float)pos * inv;
            tab[TAB_ROPE + i * 2] = cosf(ang);
            tab[TAB_ROPE + i * 2 + 1] = sinf(ang);
        }
        const float* lbl = p.in[12];
        for (int i = tid; i < 512; i += NTHREADS) {
            const float a0 = lbl[i], a1 = lbl[512 + i];
            const float m = fmaxf(a0, a1);
            const float e0 = expf(a0 - m), e1 = expf(a1 - m);
            const float s1 = e1 / (e0 + e1);
            tab[TAB_LB + i] = 0.f;
            tab[TAB_LB + 512 + i] = s1;
        }
    }
}

__device__ void phase_prep(const Params& p, int l) {
    const float* tab = (const float*)(p.ws + WS_TAB);
    bf16_t* H = (bf16_t*)(p.ws + WS_H);
    const int lane = otid() & 63;
    const int gw = obid() * (NTHREADS / 64) + (otid() >> 6), NGW = gridDim.x * (NTHREADS / 64);
    const float* nw = p.in[6] + l * 1024;
    for (int row = gw; row < R; row += NGW) {
        const int mr = row_modrow(row);
        f32x4 v[4];
        if (l == 0) {
            const float* src = row < RL ? p.in[0] + (size_t)row * D : p.in[2] + (size_t)(row - RL) * D;
#pragma unroll
            for (int j = 0; j < 4; ++j) v[j] = *(const f32x4*)(src + 4 * lane + 256 * j);
        } else {
            const float* X1 = (const float*)(p.ws + WS_X1) + (size_t)row * D;
            const int* rt = (const int*)(p.ws + WS_RT);
            const unsigned* ctl = (const unsigned*)(p.ws + WS_CTL);
            const int e0 = rt[row * 2], e1 = rt[row * 2 + 1];
            const int s0 = rt[2 * R + row * 2], s1 = rt[2 * R + row * 2 + 1];
            const float g0 = ((const float*)rt)[4 * R + row * 2], g1 = ((const float*)rt)[4 * R + row * 2 + 1];
            int base0 = 0, base1 = 0;
            for (int e = 0; e < NEXP; ++e) { const int cnt = (int)ctl[(l - 1) * 64 + e]; if (e < e0) base0 += cnt; if (e < e1) base1 += cnt; }
            const bf16_t* O0 = (const bf16_t*)(p.ws + WS_P) + (size_t)(base0 + s0) * D;
            const bf16_t* O1 = (const bf16_t*)(p.ws + WS_P) + (size_t)(base1 + s1) * D;
            const float* g2 = tab + TAB_MOD + ((l - 1) * 9 + mr) * 6144 + 5 * 1024;
            float* X2 = (float*)(p.ws + WS_X2) + (size_t)row * D;
#pragma unroll
            for (int j = 0; j < 4; ++j) {
                const int k = 4 * lane + 256 * j;
                const f32x4 x1 = *(const f32x4*)(X1 + k);
                const u32x2 a = *(const u32x2*)(O0 + k), b = *(const u32x2*)(O1 + k);
                const f32x4 gg = *(const f32x4*)(g2 + k);
                f32x4 m;
                m.x = g0 * bflo(a.x) + g1 * bflo(b.x); m.y = g0 * bfhi(a.x) + g1 * bfhi(b.x);
                m.z = g0 * bflo(a.y) + g1 * bflo(b.y); m.w = g0 * bfhi(a.y) + g1 * bfhi(b.y);
                v[j] = x1 + gg * m;
                *(f32x4*)(X2 + k) = v[j];
            }
        }
        float ss = 0.f;
#pragma unroll
        for (int j = 0; j < 4; ++j) ss += (v[j].x * v[j].x + v[j].y * v[j].y) + (v[j].z * v[j].z + v[j].w * v[j].w);
        ss = wave_sum(ss);
        const float rstd = rsqrtf(ss * (1.f / D) + EPS);
        const float* sh = tab + TAB_MOD + (l * 9 + mr) * 6144;
        const float* scv = sh + 1024;
#pragma unroll
        for (int j = 0; j < 4; ++j) {
            const int k = 4 * lane + 256 * j;
            const f32x4 w = *(const f32x4*)(nw + k), s = *(const f32x4*)(scv + k), h = *(const f32x4*)(sh + k);
            const f32x4 o = v[j] * rstd * w * (1.f + s) + h;
            u32x2 pk; pk.x = pk2(o.x, o.y); pk.y = pk2(o.z, o.w);
            *(u32x2*)(H + (size_t)row * D + k) = pk;
        }
    }
}

__device__ void phase_final(const Params& p, int l) {
    const float* tab = (const float*)(p.ws + WS_TAB);
    const int lane = otid() & 63;
    const int gw = obid() * (NTHREADS / 64) + (otid() >> 6), NGW = gridDim.x * (NTHREADS / 64);
    const int* rt = (const int*)(p.ws + WS_RT);
    const unsigned* ctl = (const unsigned*)(p.ws + WS_CTL);
    for (int row = gw; row < RL; row += NGW) {
        const int mr = row >> 11;
        const float* X1 = (const float*)(p.ws + WS_X1) + (size_t)row * D;
        const int e0 = rt[row * 2], e1 = rt[row * 2 + 1];
        const int s0 = rt[2 * R + row * 2], s1 = rt[2 * R + row * 2 + 1];
        const float g0 = ((const float*)rt)[4 * R + row * 2], g1 = ((const float*)rt)[4 * R + row * 2 + 1];
        int base0 = 0, base1 = 0;
        for (int e = 0; e < NEXP; ++e) { const int cnt = (int)ctl[l * 64 + e]; if (e < e0) base0 += cnt; if (e < e1) base1 += cnt; }
        const bf16_t* O0 = (const bf16_t*)(p.ws + WS_P) + (size_t)(base0 + s0) * D;
        const bf16_t* O1 = (const bf16_t*)(p.ws + WS_P) + (size_t)(base1 + s1) * D;
        const float* g2 = tab + TAB_MOD + (l * 9 + mr) * 6144 + 5 * 1024;
        float* O = p.out + (size_t)row * D;
#pragma unroll
        for (int j = 0; j < 4; ++j) {
            const int k = 4 * lane + 256 * j;
            const f32x4 x1 = *(const f32x4*)(X1 + k);
            const u32x2 a = *(const u32x2*)(O0 + k), b = *(const u32x2*)(O1 + k);
            const f32x4 gg = *(const f32x4*)(g2 + k);
            f32x4 m;
            m.x = g0 * bflo(a.x) + g1 * bflo(b.x); m.y = g0 * bfhi(a.x) + g1 * bfhi(b.x);
            m.z = g0 * bflo(a.y) + g1 * bflo(b.y); m.w = g0 * bfhi(a.y) + g1 * bfhi(b.y);
            *(f32x4*)(O + k) = x1 + gg * m;
        }
    }
}

constexpr int BM = 128, BN = 128, BK = 64, LDT = BK + 8;
constexpr int GEMM_LDS = (BM + BN) * LDT * 2;

template <class AF, class BF>
__device__ __forceinline__ void gemm_tile(const AF& arow, const BF& bptr, int K, unsigned char* smem, f32x4 (&acc)[4][4]) {
    bf16_t* As = (bf16_t*)smem;
    bf16_t* Bs = As + BM * LDT;
    const int tid = otid(), lane = tid & 63, wid = tid >> 6, wr = wid >> 1, wc = wid & 1, fr = lane & 15, fq = lane >> 4;
    const int a_chunk = tid & 7, a_row0 = tid >> 3;
    const bf16_t* ap[4];
#pragma unroll
    for (int i = 0; i < 4; ++i) ap[i] = arow(a_row0 + 32 * i) + a_chunk * 8;
    const int b_nb = tid & 31, b_kb0 = tid >> 5;
    u32x4 ar[4];
    f32x4 br[2][4];
#pragma unroll
    for (int m = 0; m < 4; ++m)
#pragma unroll
        for (int n = 0; n < 4; ++n) acc[m][n] = (f32x4){0.f, 0.f, 0.f, 0.f};
    const int nk = K / BK;
#pragma unroll
    for (int i = 0; i < 4; ++i) ar[i] = *(const u32x4*)(ap[i]);
#pragma unroll
    for (int i = 0; i < 2; ++i)
#pragma unroll
        for (int kk = 0; kk < 4; ++kk) br[i][kk] = *(const f32x4*)bptr(4 * (b_kb0 + 8 * i) + kk, 4 * b_nb);
    for (int kt = 0; kt < nk; ++kt) {
#pragma unroll
        for (int i = 0; i < 4; ++i) *(u32x4*)(As + (a_row0 + 32 * i) * LDT + a_chunk * 8) = ar[i];
#pragma unroll
        for (int i = 0; i < 2; ++i) {
            const int kb = b_kb0 + 8 * i;
#pragma unroll
            for (int jj = 0; jj < 4; ++jj) {
                u32x2 w; w.x = pk2(br[i][0][jj], br[i][1][jj]); w.y = pk2(br[i][2][jj], br[i][3][jj]);
                *(u32x2*)(Bs + (4 * b_nb + jj) * LDT + 4 * kb) = w;
            }
        }
        __syncthreads();
        if (kt + 1 < nk) {
            const int k0 = (kt + 1) * BK;
#pragma unroll
            for (int i = 0; i < 4; ++i) ar[i] = *(const u32x4*)(ap[i] + k0);
#pragma unroll
            for (int i = 0; i < 2; ++i)
#pragma unroll
                for (int kk = 0; kk < 4; ++kk) br[i][kk] = *(const f32x4*)bptr(k0 + 4 * (b_kb0 + 8 * i) + kk, 4 * b_nb);
        }
#pragma unroll
        for (int ks = 0; ks < 2; ++ks) {
            bf16x8 af[4], bfr[4];
#pragma unroll
            for (int m = 0; m < 4; ++m) af[m] = *(const bf16x8*)(As + (wr * 64 + m * 16 + fr) * LDT + ks * 32 + fq * 8);
#pragma unroll
            for (int n = 0; n < 4; ++n) bfr[n] = *(const bf16x8*)(Bs + (wc * 64 + n * 16 + fr) * LDT + ks * 32 + fq * 8);
#pragma unroll
            for (int m = 0; m < 4; ++m)
#pragma unroll
                for (int n = 0; n < 4; ++n) acc[m][n] = __builtin_amdgcn_mfma_f32_16x16x32_bf16(bfr[n], af[m], acc[m][n], 0, 0, 0);
        }
        __syncthreads();
    }
}

__device__ void phase_gemm_in(const Params& p, int l, unsigned char* smem) {
    const float* tab = (const float*)(p.ws + WS_TAB);
    const bf16_t* H = (const bf16_t*)(p.ws + WS_H);
    bf16_t* P = (bf16_t*)(p.ws + WS_P);
    float* LF = (float*)(p.ws + WS_LF);
    const float* W = p.in[7] + (size_t)l * D * INW;
    const float* qw = p.in[10] + l * 64;
    const float* kw = p.in[11] + l * 64;
    const float* lbt = tab + TAB_LB + l * 512;
    const int tid = otid(), lane = tid & 63, wid = tid >> 6, wr = wid >> 1, wc = wid & 1, fr = lane & 15, fq = lane >> 4;
    const int nMT = R / BM, nNT = INW / BN;
    for (int u = obid(); u < nMT * nNT; u += gridDim.x) {
        const int mt = u / nNT, nt = u % nNT;
        const int row0 = mt * BM, col0 = nt * BN;
        f32x4 acc[4][4];
        auto arow = [&](int i) { return H + (size_t)(row0 + i) * D; };
        auto bptr = [&](int k, int n) { return W + (size_t)k * INW + col0 + n; };
        gemm_tile(arow, bptr, D, smem, acc);
        const int cw = col0 + wc * 64;
#pragma unroll
        for (int m = 0; m < 4; ++m) {
            const int row = row0 + wr * 64 + m * 16 + fr;
            float v[4][4];
#pragma unroll
            for (int n = 0; n < 4; ++n)
#pragma unroll
                for (int j = 0; j < 4; ++j) v[n][j] = acc[m][n][j];
            if (cw >= OFF_ZF && cw < OFF_HV) {
                const int dir = (cw >= OFF_ZB) ? 1 : 0;
                const int cb = cw - (dir ? OFF_ZB : OFF_ZF);
#pragma unroll
                for (int n = 0; n < 4; ++n) {
                    f32x4 o;
#pragma unroll
                    for (int j = 0; j < 4; ++j) {
                        const int c = cb + n * 16 + fq * 4 + j;
                        const float lb = lbt[dir * 256 + c];
                        const float z = v[n][j];
                        float lf;
                        if (lb > 0.f) lf = __logf(lb + (1.f - lb) * sigmoidf_(z));
                        else lf = fminf(z, 0.f) - log1pf(__expf(-fabsf(z)));
                        o[j] = lf;
                    }
                    *(f32x4*)(LF + (size_t)row * LFW + dir * 256 + cb + n * 16 + fq * 4) = o;
                }
                continue;
            }
            if (cw < OFF_B) {
#pragma unroll
                for (int n = 0; n < 4; ++n)
#pragma unroll
                    for (int j = 0; j < 4; ++j) v[n][j] = gelu_tanh(v[n][j]);
            }
            if ((cw >= 256 && cw < OFF_V)) {
                float ss = 0.f;
#pragma unroll
                for (int n = 0; n < 4; ++n)
#pragma unroll
                    for (int j = 0; j < 4; ++j) ss += v[n][j] * v[n][j];
                ss += __shfl_xor(ss, 16); ss += __shfl_xor(ss, 32);
                const float rstd = rsqrtf(ss * (1.f / 64.f) + EPS);
                if (cw < OFF_B) {
#pragma unroll
                    for (int n = 0; n < 4; ++n)
#pragma unroll
                        for (int j = 0; j < 4; ++j) v[n][j] *= rstd;
                } else {
                    const float* nwv = (cw < OFF_KV) ? qw : kw;
#pragma unroll
                    for (int n = 0; n < 4; ++n)
#pragma unroll
                        for (int j = 0; j < 4; ++j) v[n][j] *= rstd * nwv[n * 16 + fq * 4 + j];
                    if (row < RL) {
                        const int t = row & (T - 1);
#pragma unroll
                        for (int a = 0; a < 2; ++a) {
                            const int pos = a == 0 ? (t >> 6) : (t & 63);
#pragma unroll
                            for (int j = 0; j < 4; ++j) {
                                const int f = fq * 4 + j;
                                const float cs = tab[TAB_ROPE + (pos * 16 + f) * 2], sn = tab[TAB_ROPE + (pos * 16 + f) * 2 + 1];
                                const float x0 = v[2 * a][j], x1 = v[2 * a + 1][j];
                                v[2 * a][j] = x0 * cs - x1 * sn;
                                v[2 * a + 1][j] = x1 * cs + x0 * sn;
                            }
                        }
                    }
                }
            }
            if ((cw >= OFF_C && cw < OFF_ZF) || cw >= OFF_G) {
#pragma unroll
                for (int n = 0; n < 4; ++n)
#pragma unroll
                    for (int j = 0; j < 4; ++j) v[n][j] = siluf_(v[n][j]);
            }
#pragma unroll
            for (int n = 0; n < 4; ++n) {
                u32x2 pk; pk.x = pk2(v[n][0], v[n][1]); pk.y = pk2(v[n][2], v[n][3]);
                *(u32x2*)(P + (size_t)row * INW + cw + n * 16 + fq * 4) = pk;
            }
        }
    }
}

__device__ __forceinline__ int next_unit(unsigned* ctr, unsigned char* smem) {
    int* slot = (int*)(smem + 73728 + 512);
    __syncthreads();
    if (otid() == 0) *slot = (int)atomicAdd(ctr, 1u);
    __syncthreads();
    return *slot;
}

constexpr float ATT_C = 0.125f * 1.4426950408889634f;
__device__ __forceinline__ void attn_unit(const Params& p, int u, unsigned char* smem) {
    const bf16_t* P = (const bf16_t*)(p.ws + WS_P);
    bf16_t* Y = (bf16_t*)(p.ws + WS_Y);
    bf16_t* Ks = (bf16_t*)smem;
    bf16_t* Vt = Ks + 2 * 64 * LDT;
    const int tid = otid(), lane = tid & 63, wid = tid >> 6, fr = lane & 15, fq = lane >> 4;
    const int k_row = tid >> 3, k_chunk = tid & 7;
    const int v_dg = tid & 15, v_kg = tid >> 4;
    const int v_pos = 32 * (v_kg >> 3) + 8 * (v_kg & 3) + 4 * ((v_kg >> 2) & 1);
    {
        int b, kvh, qrow0, nkt; bool ctxq = u >= 512;
        if (!ctxq) { b = u >> 6; kvh = (u >> 5) & 1; qrow0 = b * T + (u & 31) * 64; nkt = 36; }
        else { const int v = u - 512; b = v >> 3; kvh = (v >> 2) & 1; qrow0 = RL + b * TC + (v & 3) * 64; nkt = 4; }
        const int hh = kvh * 4 + wid;
        bf16_t* Qs = Vt + 2 * 64 * LDT + wid * 64 * LDT;
#pragma unroll
        for (int i = 0; i < 8; ++i) {
            const int r = i * 8 + (lane >> 3), ch = lane & 7;
            *(u32x4*)(Qs + r * LDT + ch * 8) = *(const u32x4*)(P + (size_t)(qrow0 + r) * INW + OFF_B + hh * 64 + ch * 8);
        }
        f32x4 o[4][4];
        float mrow[4], lrow[4];
#pragma unroll
        for (int m = 0; m < 4; ++m) { mrow[m] = -1e30f; lrow[m] = 0.f;
#pragma unroll
            for (int n = 0; n < 4; ++n) o[m][n] = (f32x4){0.f, 0.f, 0.f, 0.f}; }
        auto krow = [&](int kt, int i) { return ctxq ? (RL + b * TC + kt * 64 + i) : (kt < 32 ? (b * T + kt * 64 + i) : (RL + b * TC + (kt - 32) * 64 + i)); };
        u32x4 kreg[2]; u32x2 vreg[4];
        auto gload = [&](int kt) {
#pragma unroll
            for (int i = 0; i < 2; ++i) kreg[i] = *(const u32x4*)(P + (size_t)krow(kt, k_row + 32 * i) * INW + OFF_KV + kvh * 64 + k_chunk * 8);
#pragma unroll
            for (int i = 0; i < 4; ++i) vreg[i] = *(const u32x2*)(P + (size_t)krow(kt, 4 * v_kg + i) * INW + OFF_V + kvh * 64 + 4 * v_dg);
        };
        auto lwrite = [&](int buf) {
            bf16_t* kb = Ks + buf * 64 * LDT; bf16_t* vb = Vt + buf * 64 * LDT;
#pragma unroll
            for (int i = 0; i < 2; ++i) *(u32x4*)(kb + (k_row + 32 * i) * LDT + k_chunk * 8) = kreg[i];
#pragma unroll
            for (int di = 0; di < 4; ++di) {
                const int w = di >> 1;
                u32x2 ov;
                if ((di & 1) == 0) { ov.x = (vreg[0][w] & 0xffffu) | (vreg[1][w] << 16); ov.y = (vreg[2][w] & 0xffffu) | (vreg[3][w] << 16); }
                else { ov.x = (vreg[0][w] >> 16) | (vreg[1][w] & 0xffff0000u); ov.y = (vreg[2][w] >> 16) | (vreg[3][w] & 0xffff0000u); }
                *(u32x2*)(vb + (4 * v_dg + di) * LDT + v_pos) = ov;
            }
        };
        gload(0); lwrite(0); __syncthreads();
        for (int kt = 0; kt < nkt; ++kt) {
            if (kt + 1 < nkt) gload(kt + 1);
            const bf16_t* kb = Ks + (kt & 1) * 64 * LDT; const bf16_t* vb = Vt + (kt & 1) * 64 * LDT;
            bf16x8 kf[4][2], vf[4][2];
#pragma unroll
            for (int n = 0; n < 4; ++n)
#pragma unroll
                for (int ks = 0; ks < 2; ++ks) {
                    kf[n][ks] = *(const bf16x8*)(kb + (n * 16 + fr) * LDT + ks * 32 + fq * 8);
                    vf[n][ks] = *(const bf16x8*)(vb + (n * 16 + fr) * LDT + ks * 32 + fq * 8);
                }
#pragma unroll
            for (int m = 0; m < 4; ++m) {
                f32x4 sc[4];
                bf16x8 qf[2];
#pragma unroll
                for (int ks = 0; ks < 2; ++ks) qf[ks] = *(const bf16x8*)(Qs + (m * 16 + fr) * LDT + ks * 32 + fq * 8);
#pragma unroll
                for (int n = 0; n < 4; ++n) {
                    sc[n] = (f32x4){0.f, 0.f, 0.f, 0.f};
#pragma unroll
                    for (int ks = 0; ks < 2; ++ks) sc[n] = __builtin_amdgcn_mfma_f32_16x16x32_bf16(kf[n][ks], qf[ks], sc[n], 0, 0, 0);
                }
                float mx = sc[0][0];
#pragma unroll
                for (int n = 0; n < 4; ++n)
#pragma unroll
                    for (int j = 0; j < 4; ++j) mx = fmaxf(mx, sc[n][j]);
                mx = fmaxf(mx, __shfl_xor(mx, 16)); mx = fmaxf(mx, __shfl_xor(mx, 32));
                const float mnew = fmaxf(mrow[m], mx);
                const float alpha = __builtin_amdgcn_exp2f((mrow[m] - mnew) * ATT_C);
                mrow[m] = mnew;
                const float mc = mnew * ATT_C;
                float ls = 0.f;
#pragma unroll
                for (int n = 0; n < 4; ++n)
#pragma unroll
                    for (int j = 0; j < 4; ++j) { sc[n][j] = __builtin_amdgcn_exp2f(sc[n][j] * ATT_C - mc); ls += sc[n][j]; }
                lrow[m] = lrow[m] * alpha + ls;
#pragma unroll
                for (int n = 0; n < 4; ++n) o[m][n] = o[m][n] * alpha;
#pragma unroll
                for (int ks = 0; ks < 2; ++ks) {
                    u32x4 pw;
                    pw.x = pk2(sc[2 * ks][0], sc[2 * ks][1]); pw.y = pk2(sc[2 * ks][2], sc[2 * ks][3]);
                    pw.z = pk2(sc[2 * ks + 1][0], sc[2 * ks + 1][1]); pw.w = pk2(sc[2 * ks + 1][2], sc[2 * ks + 1][3]);
                    const bf16x8 pf = __builtin_bit_cast(bf16x8, pw);
#pragma unroll
                    for (int nd = 0; nd < 4; ++nd) o[m][nd] = __builtin_amdgcn_mfma_f32_16x16x32_bf16(vf[nd][ks], pf, o[m][nd], 0, 0, 0);
                }
            }
            if (kt + 1 < nkt) lwrite((kt + 1) & 1);
            __syncthreads();
        }
#pragma unroll
        for (int m = 0; m < 4; ++m) {
            float lt = lrow[m];
            lt += __shfl_xor(lt, 16); lt += __shfl_xor(lt, 32);
            const float inv = 1.f / lt;
            const size_t row = (size_t)(qrow0 + m * 16 + fr);
#pragma unroll
            for (int nd = 0; nd < 4; ++nd) {
                u32x2 pk; pk.x = pk2(o[m][nd][0] * inv, o[m][nd][1] * inv); pk.y = pk2(o[m][nd][2] * inv, o[m][nd][3] * inv);
                *(u32x2*)(Y + row * D + 256 + hh * 64 + nd * 16 + fq * 4) = pk;
            }
        }
    }
}

constexpr int LDA = 128 + 8;
__device__ __forceinline__ void mixa_unit(const Params& p, int l, int u, unsigned char* smem) {
    const bf16_t* P = (const bf16_t*)(p.ws + WS_P);
    bf16_t* Y = (bf16_t*)(p.ws + WS_Y);
    const int n = u >> 2, h = u & 3;
    const float* W = p.in[8] + ((size_t)l * 4 + h) * 128 * 128;
    const float* bs = p.in[9] + (l * 4 + h) * 128;
    bf16_t* Ws = (bf16_t*)smem;
    bf16_t* Vs = Ws + 128 * LDA;
    const int tid = otid(), lane = tid & 63, wid = tid >> 6, fr = lane & 15, fq = lane >> 4;
#pragma unroll
    for (int i = 0; i < 16; ++i) {
        const int pc = tid + 256 * i, t = pc >> 5, s4 = (pc & 31) * 4;
        const f32x4 w = *(const f32x4*)(W + t * 128 + s4);
        u32x2 o; o.x = pk2(w[0], w[1]); o.y = pk2(w[2], w[3]);
        *(u32x2*)(Ws + t * LDA + s4) = o;
    }
#pragma unroll
    for (int i = 0; i < 2; ++i) {
        const int mb = tid + 256 * i, dg = mb & 15, sg = mb >> 4;
        u32x2 vr[4];
#pragma unroll
        for (int r = 0; r < 4; ++r) vr[r] = *(const u32x2*)(P + (size_t)(n * 128 + 4 * sg + r) * INW + 256 + h * 64 + 4 * dg);
#pragma unroll
        for (int di = 0; di < 4; ++di) {
            const int w = di >> 1;
            u32x2 ov;
            if ((di & 1) == 0) { ov.x = (vr[0][w] & 0xffffu) | (vr[1][w] << 16); ov.y = (vr[2][w] & 0xffffu) | (vr[3][w] << 16); }
            else { ov.x = (vr[0][w] >> 16) | (vr[1][w] & 0xffff0000u); ov.y = (vr[2][w] >> 16) | (vr[3][w] & 0xffff0000u); }
            *(u32x2*)(Vs + (4 * dg + di) * LDA + 4 * sg) = ov;
        }
    }
    __syncthreads();
    f32x4 acc[2][4];
#pragma unroll
    for (int m = 0; m < 2; ++m)
#pragma unroll
        for (int nd = 0; nd < 4; ++nd) acc[m][nd] = (f32x4){0.f, 0.f, 0.f, 0.f};
#pragma unroll
    for (int ks = 0; ks < 4; ++ks) {
        bf16x8 wf[2], vf[4];
#pragma unroll
        for (int m = 0; m < 2; ++m) wf[m] = *(const bf16x8*)(Ws + (32 * wid + 16 * m + fr) * LDA + ks * 32 + fq * 8);
#pragma unroll
        for (int nd = 0; nd < 4; ++nd) vf[nd] = *(const bf16x8*)(Vs + (16 * nd + fr) * LDA + ks * 32 + fq * 8);
#pragma unroll
        for (int m = 0; m < 2; ++m)
#pragma unroll
            for (int nd = 0; nd < 4; ++nd) acc[m][nd] = __builtin_amdgcn_mfma_f32_16x16x32_bf16(vf[nd], wf[m], acc[m][nd], 0, 0, 0);
    }
#pragma unroll
    for (int m = 0; m < 2; ++m) {
        const int t = 32 * wid + 16 * m + fr;
        const size_t row = (size_t)n * 128 + t;
        const float bias = bs[t];
#pragma unroll
        for (int nd = 0; nd < 4; ++nd) {
            const int c = h * 64 + 16 * nd + 4 * fq;
            const u32x2 uu = *(const u32x2*)(P + row * INW + c);
            u32x2 pk;
            pk.x = pk2(bflo(uu.x) * (acc[m][nd][0] + bias), bfhi(uu.x) * (acc[m][nd][1] + bias));
            pk.y = pk2(bflo(uu.y) * (acc[m][nd][2] + bias), bfhi(uu.y) * (acc[m][nd][3] + bias));
            *(u32x2*)(Y + row * D + c) = pk;
        }
    }
}

__device__ __forceinline__ int hg_pos(int I, int ii) { return 32 * (I >> 1) + 4 * (I & 1) + 8 * (ii >> 2) + (ii & 3); }
__device__ __forceinline__ void hgrn_state_unit(const Params& p, int l, int u, unsigned char* smem) {
    const bf16_t* P = (const bf16_t*)(p.ws + WS_P);
    const float* LF = (const float*)(p.ws + WS_LF);
    bf16_t* SST = (bf16_t*)(p.ws + WS_OFB);
    const int b = u >> 3, h = (u >> 1) & 3, dir = u & 1;
    const int tid = otid(), lane = tid & 63, wid = tid >> 6, fr = lane & 15, fq = lane >> 4;
    const int k = lane, I = wid;
    bf16_t* KT = (bf16_t*)smem;
    bf16_t* VT = KT + 64 * LDT;
    float* Tsub = (float*)(VT + 64 * LDT);
    float* Etot = Tsub + 256;
    f32x4 sacc[4];
#pragma unroll
    for (int nk = 0; nk < 4; ++nk) sacc[nk] = (f32x4){0.f, 0.f, 0.f, 0.f};
    float lf[16], vv[16];
    auto mcof = [&](int j) { return dir == 0 ? (j < 4 ? 256 + b * 4 + j : b * 32 + (j - 4)) : (j < 4 ? 256 + b * 4 + (3 - j) : b * 32 + (35 - j)); };
    auto gload = [&](int j) {
        const int mc = mcof(j);
#pragma unroll
        for (int ii = 0; ii < 16; ++ii) {
            const int tau = 16 * I + ii;
            const size_t row = (size_t)mc * 64 + (dir ? 63 - tau : tau);
            lf[ii] = LF[row * LFW + dir * 256 + h * 64 + k];
            vv[ii] = bf2f(P[row * INW + OFF_HV + h * 64 + k]);
        }
    };
    gload(0);
    for (int j = 0; j < 36; ++j) {
        float c[16];
        c[0] = lf[0];
#pragma unroll
        for (int ii = 1; ii < 16; ++ii) c[ii] = c[ii - 1] + lf[ii];
        Tsub[I * 64 + k] = c[15];
        __syncthreads();
        float Rs = 0.f;
#pragma unroll
        for (int M = 1; M < 4; ++M) Rs += (M > I) ? Tsub[M * 64 + k] : 0.f;
        if (I == 0) Etot[k] = __expf(c[15] + Rs);
#pragma unroll
        for (int g = 0; g < 4; ++g) {
            float kh[4];
#pragma unroll
            for (int jj = 0; jj < 4; ++jj) { const int ii = 4 * g + jj; kh[jj] = (1.f - __expf(lf[ii])) * __expf(c[15] - c[ii] + Rs); }
            u32x2 kw; kw.x = pk2(kh[0], kh[1]); kw.y = pk2(kh[2], kh[3]);
            u32x2 vw; vw.x = pk2(vv[4 * g], vv[4 * g + 1]); vw.y = pk2(vv[4 * g + 2], vv[4 * g + 3]);
            const int pos = hg_pos(I, 4 * g);
            *(u32x2*)(KT + k * LDT + pos) = kw;
            *(u32x2*)(VT + k * LDT + pos) = vw;
        }
        const int mc = mcof(j);
        {
            bf16_t* dst = SST + ((size_t)(mc * 4 + h) * 2 + dir) * 4096;
#pragma unroll
            for (int nk = 0; nk < 4; ++nk)
#pragma unroll
                for (int r = 0; r < 4; ++r) dst[(16 * wid + 4 * fq + r) * 64 + 16 * nk + fr] = f2bf(sacc[nk][r]);
        }
        if (j + 1 < 36) gload(j + 1);
        __syncthreads();
        bf16x8 vf[2];
#pragma unroll
        for (int ks = 0; ks < 2; ++ks) vf[ks] = *(const bf16x8*)(VT + (16 * wid + fr) * LDT + 32 * ks + 8 * fq);
#pragma unroll
        for (int nk = 0; nk < 4; ++nk) {
            const float e = Etot[16 * nk + fr];
            sacc[nk] = sacc[nk] * e;
#pragma unroll
            for (int ks = 0; ks < 2; ++ks) {
                const bf16x8 kf = *(const bf16x8*)(KT + (16 * nk + fr) * LDT + 32 * ks + 8 * fq);
                sacc[nk] = __builtin_amdgcn_mfma_f32_16x16x32_bf16(vf[ks], kf, sacc[nk], 0, 0, 0);
            }
        }
        __syncthreads();
    }
}

__device__ __forceinline__ void hgrn_out_unit(const Params& p, int l, int u, unsigned char* smem) {
    const bf16_t* P = (const bf16_t*)(p.ws + WS_P);
    const float* LF = (const float*)(p.ws + WS_LF);
    const bf16_t* SST = (const bf16_t*)(p.ws + WS_OFB);
    bf16_t* Y = (bf16_t*)(p.ws + WS_Y);
    const float* hw = p.in[13] + l * 64;
    const int mc = u >> 2, h = u & 3;
    const int tid = otid(), lane = tid & 63, wid = tid >> 6, fr = lane & 15, fq = lane >> 4;
    const int k = lane, I = wid;
    bf16_t* QT0 = (bf16_t*)smem;
    bf16_t* KD = QT0 + 64 * LDT;
    bf16_t* KO = KD + 64 * LDT;
    bf16_t* QS = KO + 64 * LDT;
    bf16_t* QT1 = QS + 64 * LDT;
    bf16_t* QT2 = QT1 + 32 * LDT;
    bf16_t* VT = QT2 + 16 * LDT;
    float* Tsub = (float*)(VT + 64 * LDT);
    float* SSQ = Tsub + 256;
    f32x4 om[4];
#pragma unroll 1
    for (int dd = 0; dd < 2; ++dd) {
        const int dir = 1 - dd;
        float lf[16], c[16];
#pragma unroll
        for (int ii = 0; ii < 16; ++ii) {
            const int tau = 16 * I + ii;
            const size_t row = (size_t)mc * 64 + (dir ? 63 - tau : tau);
            lf[ii] = LF[row * LFW + dir * 256 + h * 64 + k];
        }
        c[0] = lf[0];
#pragma unroll
        for (int ii = 1; ii < 16; ++ii) c[ii] = c[ii - 1] + lf[ii];
        Tsub[I * 64 + k] = c[15];
        __syncthreads();
        const float T0 = Tsub[k], T1 = Tsub[64 + k], T2 = Tsub[128 + k];
        const float pre = (I > 0 ? T0 : 0.f) + (I > 1 ? T1 : 0.f) + (I > 2 ? T2 : 0.f);
        const float epre = __expf(pre);
        const float g1 = __expf(I == 2 ? T1 : T2);
        const float g2 = __expf(T1 + T2);
#pragma unroll
        for (int g = 0; g < 4; ++g) {
            float vq[4];
#pragma unroll
            for (int jj = 0; jj < 4; ++jj) {
                const int ii = 4 * g + jj, tau = 16 * I + ii;
                const size_t row = (size_t)mc * 64 + (dir ? 63 - tau : tau);
                const float q = bf2f(P[row * INW + OFF_C + h * 64 + k]);
                vq[jj] = bf2f(P[row * INW + OFF_HV + h * 64 + k]);
                const float qt = q * __expf(c[ii]);
                const float kk = 1.f - __expf(lf[ii]);
                QT0[tau * LDT + k] = f2bf(qt);
                QS[tau * LDT + k] = f2bf(qt * epre);
                KD[tau * LDT + k] = f2bf(kk * __expf(fminf(-c[ii], 80.f)));
                KO[tau * LDT + k] = f2bf(kk * __expf(c[15] - c[ii]));
                if (I >= 2) QT1[(tau - 32) * LDT + k] = f2bf(qt * g1);
                if (I == 3) QT2[(tau - 48) * LDT + k] = f2bf(qt * g2);
            }
            u32x2 vw; vw.x = pk2(vq[0], vq[1]); vw.y = pk2(vq[2], vq[3]);
            *(u32x2*)(VT + k * LDT + hg_pos(I, 4 * g)) = vw;
        }
        bf16x8 stf[2];
        {
            const bf16_t* src = SST + ((size_t)(mc * 4 + h) * 2 + dir) * 4096 + (16 * wid + fr) * 64 + 8 * fq;
            stf[0] = *(const bf16x8*)(src); stf[1] = *(const bf16x8*)(src + 32);
        }
        __syncthreads();
        bf16x8 vf[2];
#pragma unroll
        for (int ks = 0; ks < 2; ++ks) vf[ks] = *(const bf16x8*)(VT + (16 * wid + fr) * LDT + 32 * ks + 8 * fq);
        f32x4 o[4];
#pragma unroll
        for (int I2 = 0; I2 < 4; ++I2) {
            f32x4 A[4];
#pragma unroll
            for (int J = 0; J < 4; ++J) {
                A[J] = (f32x4){0.f, 0.f, 0.f, 0.f};
                if (J <= I2) {
                    const bf16_t* kbase = (J == I2 ? KD : KO) + (16 * J + fr) * LDT + 8 * fq;
                    const bf16_t* qbase = (I2 - J <= 1) ? (QT0 + (16 * I2 + fr) * LDT) : ((I2 - J == 2) ? (QT1 + (16 * I2 - 32 + fr) * LDT) : (QT2 + fr * LDT));
#pragma unroll
                    for (int ks = 0; ks < 2; ++ks) {
                        const bf16x8 kf = *(const bf16x8*)(kbase + 32 * ks);
                        const bf16x8 qf = *(const bf16x8*)(qbase + 32 * ks + 8 * fq);
                        A[J] = __builtin_amdgcn_mfma_f32_16x16x32_bf16(kf, qf, A[J], 0, 0, 0);
                    }
                    if (J == I2) {
#pragma unroll
                        for (int r = 0; r < 4; ++r) A[J][r] = (4 * fq + r <= fr) ? A[J][r] : 0.f;
                    }
                }
            }
            o[I2] = (f32x4){0.f, 0.f, 0.f, 0.f};
#pragma unroll
            for (int ks = 0; ks < 2; ++ks) {
                if (2 * ks <= I2) {
                    u32x4 pw;
                    pw.x = pk2(A[2 * ks][0], A[2 * ks][1]); pw.y = pk2(A[2 * ks][2], A[2 * ks][3]);
                    pw.z = pk2(A[2 * ks + 1][0], A[2 * ks + 1][1]); pw.w = pk2(A[2 * ks + 1][2], A[2 * ks + 1][3]);
                    o[I2] = __builtin_amdgcn_mfma_f32_16x16x32_bf16(vf[ks], __builtin_bit_cast(bf16x8, pw), o[I2], 0, 0, 0);
                }
                const bf16x8 qsf = *(const bf16x8*)(QS + (16 * I2 + fr) * LDT + 32 * ks + 8 * fq);
                o[I2] = __builtin_amdgcn_mfma_f32_16x16x32_bf16(stf[ks], qsf, o[I2], 0, 0, 0);
            }
        }
        if (dir == 1) {
            const int src = (lane & 48) | (15 - fr);
#pragma unroll
            for (int Im = 0; Im < 4; ++Im)
#pragma unroll
                for (int r = 0; r < 4; ++r) om[Im][r] = __shfl(o[3 - Im][r], src);
        } else {
#pragma unroll
            for (int Im = 0; Im < 4; ++Im) om[Im] = om[Im] + o[Im];
        }
        __syncthreads();
    }
#pragma unroll
    for (int Im = 0; Im < 4; ++Im) {
        float s = om[Im][0] * om[Im][0] + om[Im][1] * om[Im][1] + om[Im][2] * om[Im][2] + om[Im][3] * om[Im][3];
        s += __shfl_xor(s, 16); s += __shfl_xor(s, 32);
        if (fq == 0) SSQ[wid * 64 + 16 * Im + fr] = s;
    }
    __syncthreads();
    const f32x4 wv = *(const f32x4*)(hw + 16 * wid + 4 * fq);
#pragma unroll
    for (int Im = 0; Im < 4; ++Im) {
        const int i = 16 * Im + fr;
        const float tot = SSQ[i] + SSQ[64 + i] + SSQ[128 + i] + SSQ[192 + i];
        const float rstd = rsqrtf(tot * (1.f / 64.f) + EPS);
        const size_t row = (size_t)mc * 64 + i;
        const u32x2 gg = *(const u32x2*)(P + row * INW + OFF_G + h * 64 + 16 * wid + 4 * fq);
        u32x2 pk;
        pk.x = pk2(om[Im][0] * rstd * wv[0] * bflo(gg.x), om[Im][1] * rstd * wv[1] * bfhi(gg.x));
        pk.y = pk2(om[Im][2] * rstd * wv[2] * bflo(gg.y), om[Im][3] * rstd * wv[3] * bfhi(gg.y));
        *(u32x2*)(Y + row * D + 768 + h * 64 + 16 * wid + 4 * fq) = pk;
    }
}

__device__ void phase_mix1(const Params& p, int l, unsigned char* smem, int rep) {
    unsigned* ctr = (unsigned*)(p.ws + WS_CTL) + 128 + l * 2 + rep * 4;
    const int n_attn = (l == 0) ? 576 : 512, n_mixa = (l == 0) ? 576 : 512;
    const int total = 64 + n_attn + n_mixa;
    for (;;) {
        const int u = next_unit(ctr, smem);
        if (u >= total) break;
        if (u < 64) hgrn_state_unit(p, l, u, smem);
        else if (u < 64 + n_attn) attn_unit(p, u - 64, smem);
        else mixa_unit(p, l, u - 64 - n_attn, smem);
    }
}
__device__ void phase_mix2(const Params& p, int l, unsigned char* smem, int rep) {
    unsigned* ctr = (unsigned*)(p.ws + WS_CTL) + 128 + l * 2 + 1 + rep * 4;
    const int total = ((l == 0) ? 288 : 256) * 4;
    for (;;) {
        const int u = next_unit(ctr, smem);
        if (u >= total) break;
        hgrn_out_unit(p, l, u, smem);
    }
}

__device__ void phase_out(const Params& p, int l, unsigned char* smem) {
    const float* tab = (const float*)(p.ws + WS_TAB);
    const bf16_t* Y = (const bf16_t*)(p.ws + WS_Y);
    float* X1 = (float*)(p.ws + WS_X1);
    const float* X2 = (const float*)(p.ws + WS_X2);
    const float* W = p.in[14] + (size_t)l * D * D;
    const int tid = otid(), lane = tid & 63, wid = tid >> 6, wr = wid >> 1, wc = wid & 1, fr = lane & 15, fq = lane >> 4;
    const int nrows = (l == 0) ? R : RL;
    const int nMT = nrows / BM, nNT = D / BN;
    for (int u = obid(); u < nMT * nNT; u += gridDim.x) {
        const int mt = u / nNT, nt = u % nNT;
        const int row0 = mt * BM, col0 = nt * BN;
        f32x4 acc[4][4];
        auto arow = [&](int i) { return Y + (size_t)(row0 + i) * D; };
        auto bptr = [&](int k, int n) { return W + (size_t)k * D + col0 + n; };
        gemm_tile(arow, bptr, D, smem, acc);
#pragma unroll
        for (int m = 0; m < 4; ++m) {
            const int row = row0 + wr * 64 + m * 16 + fr;
            const int mr = row_modrow(row);
            const float* g1 = tab + TAB_MOD + (l * 9 + mr) * 6144 + 2 * 1024;
            const float* xin = (l == 0) ? (row < RL ? p.in[0] + (size_t)row * D : p.in[2] + (size_t)(row - RL) * D) : X2 + (size_t)row * D;
#pragma unroll
            for (int n = 0; n < 4; ++n) {
                const int col = col0 + wc * 64 + n * 16 + fq * 4;
                const f32x4 xv = *(const f32x4*)(xin + col), gv = *(const f32x4*)(g1 + col);
                *(f32x4*)(X1 + (size_t)row * D + col) = xv + gv * acc[m][n];
            }
        }
    }
}

__device__ void phase_route(const Params& p, int l, unsigned char* smem) {
    const float* tab = (const float*)(p.ws + WS_TAB);
    bf16_t* H = (bf16_t*)(p.ws + WS_H);
    const float* X1 = (const float*)(p.ws + WS_X1);
    int* rt = (int*)(p.ws + WS_RT);
    unsigned* ctl = (unsigned*)(p.ws + WS_CTL);
    const float* nw = p.in[15] + l * 1024;
    const float* wg = p.in[16] + (size_t)l * 1024 * 4;
    const float* bg = p.in[17] + l * 4;
    const float* we = p.in[18] + (size_t)l * 1024 * 32;
    const float* be = p.in[19] + l * 32;
    const int tid = otid(), lane = tid & 63, wid = tid >> 6, wr = wid >> 1, wc = wid & 1, fr = lane & 15, fq = lane >> 4;
    const int nrows = (l == 0) ? R : RL;
    float* Ls = (float*)smem;
    for (int u = obid(); u < nrows / BM; u += gridDim.x) {
        const int row0 = u * BM;
        for (int rr = 0; rr < 32; ++rr) {
            const int row = row0 + wid * 32 + rr;
            const int mr = row_modrow(row);
            const float* sh = tab + TAB_MOD + (l * 9 + mr) * 6144 + 3 * 1024;
            const float* scv = sh + 1024;
            f32x4 v[4];
            float ss = 0.f;
#pragma unroll
            for (int j = 0; j < 4; ++j) { v[j] = *(const f32x4*)(X1 + (size_t)row * D + 4 * lane + 256 * j); ss += (v[j].x * v[j].x + v[j].y * v[j].y) + (v[j].z * v[j].z + v[j].w * v[j].w); }
            ss = wave_sum(ss);
            const float rstd = rsqrtf(ss * (1.f / D) + EPS);
#pragma unroll
            for (int j = 0; j < 4; ++j) {
                const int k = 4 * lane + 256 * j;
                const f32x4 w = *(const f32x4*)(nw + k), s = *(const f32x4*)(scv + k), h = *(const f32x4*)(sh + k);
                const f32x4 o = v[j] * rstd * w * (1.f + s) + h;
                u32x2 pk; pk.x = pk2(o.x, o.y); pk.y = pk2(o.z, o.w);
                *(u32x2*)(H + (size_t)row * D + k) = pk;
            }
        }
        asm volatile("s_waitcnt vmcnt(0)" ::: "memory");
        __syncthreads();
        f32x4 acc[4][4];
        auto arow = [&](int i) { return H + (size_t)(row0 + i) * D; };
        auto bptr = [&](int k, int n) { return (n < 4) ? (wg + (size_t)k * 4) : ((n < 36) ? (we + (size_t)k * 32 + (n - 4)) : (we + (size_t)k * 32)); };
        gemm_tile(arow, bptr, D, smem, acc);
        if (wc == 0) {
#pragma unroll
            for (int m = 0; m < 4; ++m)
#pragma unroll
                for (int n = 0; n < 3; ++n) {
                    const int col = n * 16 + fq * 4;
                    if (col < 36) *(f32x4*)(Ls + (wr * 64 + m * 16 + fr) * 40 + col) = acc[m][n];
                }
        }
        __syncthreads();
        if (tid < BM) {
            const int row = row0 + tid;
            const float* lg = Ls + tid * 40;
            float gl[4];
#pragma unroll
            for (int i = 0; i < 4; ++i) gl[i] = lg[i] + bg[i];
            int grp = 0; float gm = gl[0];
#pragma unroll
            for (int i = 1; i < 4; ++i) if (gl[i] > gm) { gm = gl[i]; grp = i; }
            float gs = 0.f;
#pragma unroll
            for (int i = 0; i < 4; ++i) gs += expf(gl[i] - gm);
            const float pgrp = 1.f / gs;
            float ev[8];
#pragma unroll
            for (int i = 0; i < 8; ++i) ev[i] = lg[4 + grp * 8 + i] + be[grp * 8 + i];
            int i0 = 0; float v0 = ev[0];
#pragma unroll
            for (int i = 1; i < 8; ++i) if (ev[i] > v0) { v0 = ev[i]; i0 = i; }
            int i1 = -1; float v1 = -3.0e38f;
#pragma unroll
            for (int i = 0; i < 8; ++i) if (i != i0 && ev[i] > v1) { v1 = ev[i]; i1 = i; }
            const float e1 = expf(v1 - v0);
            const float ga = pgrp / (1.f + e1), gb = pgrp * e1 / (1.f + e1);
            const int ea = grp * 8 + i0, eb = grp * 8 + i1;
            const int sa = (int)atomicAdd(&ctl[l * 64 + ea], 1u);
            const int sb = (int)atomicAdd(&ctl[l * 64 + eb], 1u);
            rt[row * 2] = ea; rt[row * 2 + 1] = eb;
            rt[2 * R + row * 2] = sa; rt[2 * R + row * 2 + 1] = sb;
            ((float*)rt)[4 * R + row * 2] = ga; ((float*)rt)[4 * R + row * 2 + 1] = gb;
            rt[6 * R + ea * R + sa] = row;
            rt[6 * R + eb * R + sb] = row;
        }
        __syncthreads();
    }
}

__device__ __forceinline__ void moe_units(const Params& p, int l, int* s_cnt, int* s_base, int* s_tpre) {
    const unsigned* ctl = (const unsigned*)(p.ws + WS_CTL);
    if (otid() == 0) {
        int base = 0, tp = 0;
        for (int e = 0; e < NEXP; ++e) {
            const int c = (int)ctl[l * 64 + e];
            s_cnt[e] = c; s_base[e] = base; s_tpre[e] = tp;
            base += c; tp += (c + BM - 1) / BM;
        }
        s_tpre[NEXP] = tp;
    }
    __syncthreads();
}

__device__ void phase_moe1(const Params& p, int l, unsigned char* smem) {
    int* s_cnt = (int*)(smem + 73728);
    int* s_base = s_cnt + 32;
    int* s_tpre = s_base + 32;
    moe_units(p, l, s_cnt, s_base, s_tpre);
    const bf16_t* H = (const bf16_t*)(p.ws + WS_H);
    bf16_t* HM = (bf16_t*)(p.ws + WS_LF);
    const int* list = (const int*)(p.ws + WS_RT) + 6 * R;
    const float* W1 = p.in[20] + (size_t)l * NEXP * D * FF;
    const float* W3 = p.in[21] + (size_t)l * NEXP * D * FF;
    const int tid = otid(), lane = tid & 63, wid = tid >> 6, wr = wid >> 1, wc = wid & 1, fr = lane & 15, fq = lane >> 4;
    const int ntiles = s_tpre[NEXP];
    constexpr int nNT = FF / 64;
    for (int u = obid(); u < ntiles * nNT; u += gridDim.x) {
        const int tg = u / nNT, nt = u % nNT;
        int e = 0;
        while (s_tpre[e + 1] <= tg) ++e;
        const int mt = tg - s_tpre[e], cnt = s_cnt[e], base = s_base[e];
        const float* w1 = W1 + (size_t)e * D * FF;
        const float* w3 = W3 + (size_t)e * D * FF;
        const int* lst = list + (size_t)e * R;
        f32x4 acc[4][4];
        auto arow = [&](int i) { int s = mt * BM + i; s = s < cnt ? s : cnt - 1; return H + (size_t)lst[s] * D; };
        auto bptr = [&](int k, int rho) {
            const int n = (rho >> 4) & 3;
            const int col = nt * 64 + (rho >> 6) * 32 + (n & 1) * 16 + (rho & 15);
            return ((n >= 2) ? w3 : w1) + (size_t)k * FF + col;
        };
        gemm_tile(arow, bptr, D, smem, acc);
#pragma unroll
        for (int m = 0; m < 4; ++m) {
            const int s = mt * BM + wr * 64 + m * 16 + fr;
            if (s < cnt) {
#pragma unroll
                for (int n = 0; n < 2; ++n) {
                    float hv[4];
#pragma unroll
                    for (int j = 0; j < 4; ++j) hv[j] = siluf_(acc[m][n][j]) * acc[m][n + 2][j];
                    u32x2 pk; pk.x = pk2(hv[0], hv[1]); pk.y = pk2(hv[2], hv[3]);
                    *(u32x2*)(HM + (size_t)(base + s) * FF + nt * 64 + wc * 32 + n * 16 + fq * 4) = pk;
                }
            }
        }
    }
}

__device__ void phase_moe2(const Params& p, int l, unsigned char* smem) {
    int* s_cnt = (int*)(smem + 73728);
    int* s_base = s_cnt + 32;
    int* s_tpre = s_base + 32;
    moe_units(p, l, s_cnt, s_base, s_tpre);
    const bf16_t* HM = (const bf16_t*)(p.ws + WS_LF);
    bf16_t* OUTM = (bf16_t*)(p.ws + WS_P);
    const float* W2 = p.in[22] + (size_t)l * NEXP * FF * D;
    const int tid = otid(), lane = tid & 63, wid = tid >> 6, wr = wid >> 1, wc = wid & 1, fr = lane & 15, fq = lane >> 4;
    const int ntiles = s_tpre[NEXP];
    constexpr int nNT = D / BN;
    for (int u = obid(); u < ntiles * nNT; u += gridDim.x) {
        const int tg = u / nNT, nt = u % nNT;
        int e = 0;
        while (s_tpre[e + 1] <= tg) ++e;
        const int mt = tg - s_tpre[e], cnt = s_cnt[e], base = s_base[e];
        const float* w2 = W2 + (size_t)e * FF * D;
        f32x4 acc[4][4];
        auto arow = [&](int i) { int s = mt * BM + i; s = s < cnt ? s : cnt - 1; return HM + (size_t)(base + s) * FF; };
        auto bptr = [&](int k, int n) { return w2 + (size_t)k * D + nt * BN + n; };
        gemm_tile(arow, bptr, FF, smem, acc);
#pragma unroll
        for (int m = 0; m < 4; ++m) {
            const int s = mt * BM + wr * 64 + m * 16 + fr;
            if (s < cnt) {
#pragma unroll
                for (int n = 0; n < 4; ++n) {
                    u32x2 pk; pk.x = pk2(acc[m][n][0], acc[m][n][1]); pk.y = pk2(acc[m][n][2], acc[m][n][3]);
                    *(u32x2*)(OUTM + (size_t)(base + s) * D + nt * BN + wc * 64 + n * 16 + fq * 4) = pk;
                }
            }
        }
    }
}

#define XB_TMO      128
#define XB_XCNT(j)  (256  + 64 * (j))
#define XB_XSUB(j)  (1280 + 64 * (j))
#define XB_XGEN(j)  (2304 + 64 * (j))
#define XB_TOP      3328
#define XB_TOPGEN   3392
#define XCD_BAR_WORDS 3456
#define XB_SPIN_CAP (1u << 22)
#define LAS __attribute__((address_space(3)))
__device__ __forceinline__ unsigned xb_ld(unsigned* p)              { return __hip_atomic_load(p, __ATOMIC_RELAXED, __HIP_MEMORY_SCOPE_AGENT); }
__device__ __forceinline__ unsigned xb_add(unsigned* p, unsigned v) { return __hip_atomic_fetch_add(p, v, __ATOMIC_RELAXED, __HIP_MEMORY_SCOPE_AGENT); }
__device__ __forceinline__ unsigned xb_xcc_id() { return (unsigned)__builtin_amdgcn_s_getreg((3 << 11) | 20) & 0xFu; }
#define XB_SPIN(cond, bar) do { unsigned _sp = 0; while (cond) { __builtin_amdgcn_s_sleep(1); \
    if ((++_sp & 255u) == 0u) { if (xb_ld(&(bar)[XB_TMO])) break; if (_sp > XB_SPIN_CAP) { atomicAdd(&(bar)[XB_TMO], 1u); break; } } } } while (0)
struct XcdBarrier { unsigned* bar; unsigned x; volatile unsigned* st; };
__device__ __forceinline__ XcdBarrier xcd_barrier_post(unsigned* bar, volatile unsigned* st) {
    XcdBarrier b; b.bar = bar; b.x = xb_xcc_id(); b.st = st;
    if (threadIdx.x == 0) (void)xb_add(&bar[XB_XCNT(b.x)], 1u);
    return b;
}
__device__ __forceinline__ void xcd_barrier_complete(unsigned* bar, unsigned x, unsigned& nloc, unsigned& nx) {
    const unsigned G = gridDim.x * gridDim.y * gridDim.z;
    unsigned sum, cnt, mine, sp = 0u;
    for (;;) {
        sum = 0u; cnt = 0u; mine = 0u;
#pragma unroll
        for (unsigned j = 0; j < 16; ++j) { const unsigned c = xb_ld(&bar[XB_XCNT(j)]); sum += c; cnt += (c > 0u) ? 1u : 0u; mine = (j == x) ? c : mine; }
        if (sum == G) break;
        __builtin_amdgcn_s_sleep(1);
        if ((++sp & 255u) == 0u) { if (xb_ld(&bar[XB_TMO])) break; if (sp > XB_SPIN_CAP) { atomicAdd(&bar[XB_TMO], 1u); break; } }
    }
    nloc = mine > 0u ? mine : 1u; nx = cnt > 0u ? cnt : 1u;
}
__device__ __forceinline__ void xcd_barrier(const XcdBarrier& b) {
    asm volatile("s_waitcnt vmcnt(0)" ::: "memory");
    __syncthreads();
    if (threadIdx.x == 0) {
        unsigned* bar = b.bar;
        __builtin_amdgcn_s_waitcnt(0);
        unsigned nloc = b.st[0], nx = b.st[1];
        if (nloc == 0u) { xcd_barrier_complete(bar, b.x, nloc, nx); b.st[0] = nloc; b.st[1] = nx; }
        const unsigned old = xb_add(&bar[XB_XSUB(b.x)], 1u);
        const unsigned gen = old / nloc;
        if (old + 1u == (gen + 1u) * nloc) {
            __builtin_amdgcn_fence(__ATOMIC_RELEASE, "agent");
            asm volatile("s_waitcnt vmcnt(0)" ::: "memory");
            const unsigned og = xb_add(&bar[XB_TOP], 1u);
            const unsigned tg = og / nx;
            if (og + 1u == (tg + 1u) * nx) xb_add(&bar[XB_TOPGEN], 1u);
            else XB_SPIN(xb_ld(&bar[XB_TOPGEN]) == tg, bar);
            __builtin_amdgcn_fence(__ATOMIC_ACQUIRE, "agent");
            xb_add(&bar[XB_XGEN(b.x)], 1u);
            asm volatile("s_waitcnt vmcnt(0)" ::: "memory");
        } else {
            XB_SPIN(xb_ld(&bar[XB_XGEN(b.x)]) == gen, bar);
            __builtin_amdgcn_fence(__ATOMIC_ACQUIRE, "agent");
            asm volatile("s_waitcnt vmcnt(0)" ::: "memory");
        }
    }
    __syncthreads();
}

constexpr int NPHASES = 18;
#ifndef PROBE_S
#define PROBE_S -1
#define PROBE_REPS 1
#endif
constexpr int SMEM_BYTES = 4 * 64 * LDT * 2 + 4 * 64 * LDT * 2 + 1024;
__global__ void __launch_bounds__(NTHREADS, 2) mega(Params p) {
    __shared__ __attribute__((aligned(16))) unsigned char smem[SMEM_BYTES];
    cg::grid_group grid = cg::this_grid();
    volatile unsigned* st = (volatile unsigned*)(smem + 73728 + 768);
    if (threadIdx.x < 2) st[threadIdx.x] = 0u;
    __syncthreads();
    XcdBarrier bar = xcd_barrier_post((unsigned*)(p.ws + WS_CTL) + 4096, st);
    for (int ph = p.ph_lo; ph < p.ph_hi; ++ph) {
        if (ph == 0) phase_init(p, smem);
        else if (ph == NPHASES - 1) phase_final(p, 1);
        else {
            const int l = (ph - 1) / 8, s = (ph - 1) % 8;
            const int reps = (s == PROBE_S) ? PROBE_REPS : 1;
            for (int rep = 0; rep < reps; ++rep) {
                switch (s) {
                    case 0: phase_prep(p, l); break;
                    case 1: phase_gemm_in(p, l, smem); break;
                    case 2: phase_mix1(p, l, smem, rep); break;
                    case 3: phase_mix2(p, l, smem, rep); break;
                    case 4: phase_out(p, l, smem); break;
                    case 5: phase_route(p, l, smem); break;
                    case 6: phase_moe1(p, l, smem); break;
                    default: phase_moe2(p, l, smem); break;
                }
                if (rep + 1 < reps) xcd_barrier(bar);
            }
        }
        if (ph + 1 < p.ph_hi) { if (ph == 0) grid.sync(); else xcd_barrier(bar); }
    }
}

extern "C" void kernel_launch(void* const* d_in, const int* in_sizes, int n_in, void* d_out, int out_size, void* d_ws, size_t ws_size, hipStream_t stream) {
    static int grid_blocks = 0;
    if (grid_blocks == 0) {
        if (n_in != 23 || out_size != RL * D || ws_size < WS_END) { fprintf(stderr, "kernel_launch: unexpected shapes (n_in %d out %d ws %zu need %zu)\n", n_in, out_size, ws_size, (size_t)WS_END); grid_blocks = -1; return; }
        int dev = 0, cus = 0, per_cu = 0;
        hipGetDevice(&dev);
        hipDeviceGetAttribute(&cus, hipDeviceAttributeMultiprocessorCount, dev);
        hipOccupancyMaxActiveBlocksPerMultiprocessor(&per_cu, mega, NTHREADS, 0);
        if (per_cu > 2) per_cu = 2;
        if (per_cu < 1) per_cu = 1;
        grid_blocks = cus * per_cu;
    }
    if (grid_blocks < 0) return;
    hipMemsetAsync((char*)d_ws + WS_CTL, 0, 1 * MiB, stream);
    Params p{};
    for (int i = 0; i < 23; ++i) p.in[i] = (const float*)d_in[i];
    p.out = (float*)d_out; p.ws = (unsigned char*)d_ws; p.ph_lo = 0; p.ph_hi = NPHASES;
    void* args[] = {&p};
    hipError_t e = hipLaunchCooperativeKernel((void*)mega, dim3(grid_blocks), dim3(NTHREADS), args, 0, stream);
    if (e != hipSuccess) fprintf(stderr, "cooperative launch failed: %s (grid %d)\n", hipGetErrorString(e), grid_blocks);
}
```

```cpp
#include <hip/hip_runtime.h>
#include <hip/hip_cooperative_groups.h>
#include <cstdio>
#include <cstdint>
namespace cg = cooperative_groups;

constexpr int D = 1024, NB = 8, T = 2048, TC = 256;
constexpr int RL = NB * T, RC = NB * TC, R = RL + RC;
constexpr int INW = 2560, LFW = 512;
constexpr int OFF_B = 512, OFF_KV = 1024, OFF_V = 1152, OFF_C = 1280, OFF_ZF = 1536, OFF_ZB = 1792, OFF_HV = 2048, OFF_G = 2304;
constexpr int NEXP = 32, FF = 512;
constexpr float EPS = 1e-6f;
constexpr int NTHREADS = 256;

constexpr size_t MiB = 1ull << 20;
constexpr size_t WS_CTL = 0;
constexpr size_t WS_TAB = 1 * MiB;
constexpr size_t WS_H = 2 * MiB;
constexpr size_t WS_P = WS_H + 36 * MiB;
constexpr size_t WS_LF = WS_P + 90 * MiB;
constexpr size_t WS_Y = WS_LF + 36 * MiB;
constexpr size_t WS_X1 = WS_Y + 36 * MiB;
constexpr size_t WS_X2 = WS_X1 + 72 * MiB;
constexpr size_t WS_OFB = WS_X2 + 72 * MiB;
constexpr size_t WS_RT = WS_OFB + 18 * MiB;
constexpr size_t WS_WIN = WS_RT + 4 * MiB;
constexpr size_t WS_WOUT = WS_WIN + 10 * MiB;
constexpr size_t WS_WR = WS_WOUT + 4 * MiB;
constexpr size_t WS_END = WS_WR + 1 * MiB;
constexpr int TAB_ROPE = 0;
constexpr int TAB_LB = 2048;
constexpr int TAB_MOD = 4096;

typedef unsigned short bf16_t;
typedef short bf16x8 __attribute__((ext_vector_type(8)));
typedef float f32x4 __attribute__((ext_vector_type(4)));
typedef float f32x2 __attribute__((ext_vector_type(2)));
typedef unsigned u32x4 __attribute__((ext_vector_type(4)));
typedef unsigned u32x2 __attribute__((ext_vector_type(2)));
typedef __bf16 bf16x2_t __attribute__((ext_vector_type(2)));

struct Params {
    const float* in[23];
    float* out;
    unsigned char* ws;
    int ph_lo, ph_hi;
};

__device__ __forceinline__ unsigned pk2(float lo, float hi) { f32x2 v = {lo, hi}; bf16x2_t b = __builtin_convertvector(v, bf16x2_t); return __builtin_bit_cast(unsigned, b); }
__device__ __forceinline__ bf16_t f2bf(float f) { return (bf16_t)(pk2(f, 0.f) & 0xffffu); }
__device__ __forceinline__ float bf2f(bf16_t u) { return __uint_as_float(((unsigned)u) << 16); }
__device__ __forceinline__ float bflo(unsigned w) { return __uint_as_float(w << 16); }
__device__ __forceinline__ float bfhi(unsigned w) { return __uint_as_float(w & 0xffff0000u); }
__device__ __forceinline__ float wave_sum(float v) {
#pragma unroll
    for (int o = 1; o < 64; o <<= 1) v += __shfl_xor(v, o);
    return v;
}
__device__ __forceinline__ float sigmoidf_(float x) { return 1.f / (1.f + __expf(-x)); }
__device__ __forceinline__ float siluf_(float x) { return x * sigmoidf_(x); }
__device__ __forceinline__ float gelu_tanh(float x) {
    const float u = 0.7978845608028654f * (x + 0.044715f * x * x * x);
    const float e = __expf(2.f * u);
    const float th = 1.f - 2.f / (e + 1.f);
    return 0.5f * x * (1.f + th);
}
__device__ __forceinline__ int otid() { int t = threadIdx.x; asm volatile("" : "+v"(t)); return t; }
__device__ __forceinline__ int obid() { int t = blockIdx.x; asm volatile("" : "+s"(t)); return t; }
__device__ __forceinline__ int row_modrow(int row) { return row < RL ? (row >> 11) : 8; }

__device__ void phase_init(const Params& p, unsigned char* smem) {
    float* tab = (float*)(p.ws + WS_TAB);
    const float* c = p.in[1];
    const float* c_ctx = p.in[3];
    const float* w_mod = p.in[4];
    const float* b_mod = p.in[5];
    float* sc = (float*)smem;
    const int tid = otid();
    for (int i = tid; i < 9 * 1024; i += NTHREADS) {
        const int b = i >> 10, k = i & 1023;
        const float v = (b < 8) ? c[b * 1024 + k] : c_ctx[k];
        sc[i] = siluf_(v);
    }
    __syncthreads();
    float* red = (float*)(smem + 36864);
    for (int it = obid(); it < 384; it += gridDim.x) {
        const int l = it / 192, j0 = (it % 192) * 32;
        const int jj = tid & 31, kg = tid >> 5;
        const float* w = w_mod + (size_t)l * 1024 * 6144 + (size_t)(kg * 128) * 6144 + j0 + jj;
        float acc[9];
#pragma unroll
        for (int b = 0; b < 9; ++b) acc[b] = 0.f;
        for (int k0 = 0; k0 < 128; k0 += 8) {
            float wv[8];
#pragma unroll
            for (int i = 0; i < 8; ++i) wv[i] = w[(size_t)(k0 + i) * 6144];
#pragma unroll
            for (int i = 0; i < 8; ++i)
#pragma unroll
                for (int b = 0; b < 9; ++b) acc[b] += sc[b * 1024 + kg * 128 + k0 + i] * wv[i];
        }
#pragma unroll
        for (int b = 0; b < 9; ++b) red[(kg * 9 + b) * 32 + jj] = acc[b];
        __syncthreads();
        for (int o = tid; o < 9 * 32; o += NTHREADS) {
            const int b = o >> 5, j2 = o & 31;
            float sum = 0.f;
#pragma unroll
            for (int g = 0; g < 8; ++g) sum += red[(g * 9 + b) * 32 + j2];
            tab[TAB_MOD + (l * 9 + b) * 6144 + j0 + j2] = sum + b_mod[l * 6144 + j0 + j2];
        }
        __syncthreads();
    }
    {
        const int gtid = obid() * NTHREADS + tid, gsize = gridDim.x * NTHREADS;
        const float* w_in = p.in[7]; const float* w_out = p.in[14];
        bf16_t* WIN = (bf16_t*)(p.ws + WS_WIN); bf16_t* WOUT = (bf16_t*)(p.ws + WS_WOUT); bf16_t* WR = (bf16_t*)(p.ws + WS_WR);
        for (int i = gtid; i < 2 * 1024 * INW / 4; i += gsize) { const f32x4 v = *(const f32x4*)(w_in + (size_t)i * 4); u32x2 o; o.x = pk2(v[0], v[1]); o.y = pk2(v[2], v[3]); *(u32x2*)(WIN + (size_t)i * 4) = o; }
        for (int i = gtid; i < 2 * 1024 * D / 4; i += gsize) { const f32x4 v = *(const f32x4*)(w_out + (size_t)i * 4); u32x2 o; o.x = pk2(v[0], v[1]); o.y = pk2(v[2], v[3]); *(u32x2*)(WOUT + (size_t)i * 4) = o; }
        for (int i = gtid; i < 2 * 1024 * 32; i += gsize) {
            const int lk = i >> 5, c4 = (i & 31) * 4;
            f32x4 v = (f32x4){0.f, 0.f, 0.f, 0.f};
            if (c4 == 0) v = *(const f32x4*)(p.in[16] + (size_t)lk * 4);
            else if (c4 < 36) v = *(const f32x4*)(p.in[18] + (size_t)lk * 32 + (c4 - 4));
            u32x2 o; o.x = pk2(v[0], v[1]); o.y = pk2(v[2], v[3]);
            *(u32x2*)(WR + (size_t)lk * 128 + c4) = o;
        }
    }
    if (obid() == gridDim.x - 1) {
        for (int i = tid; i < 64 * 16; i += NTHREADS) {
            const int pos = i >> 4, f = i & 15;
            const float inv = 1.0f / powf(10000.0f, (float)(2 * f) / 32.0f);
            const float ang = (float)pos * inv;
            tab[TAB_ROPE + i * 2] = cosf(ang);
            tab[TAB_ROPE + i * 2 + 1] = sinf(ang);
        }
        const float* lbl = p.in[12];
        for (int i = tid; i < 512; i += NTHREADS) {
            const float a0 = lbl[i], a1 = lbl[512 + i];
            const float m = fmaxf(a0, a1);
            const float e0 = expf(a0 - m), e1 = expf(a1 - m);
            const float s1 = e1 / (e0 + e1);
            tab[TAB_LB + i] = 0.f;
            tab[TAB_LB + 512 + i] = s1;
        }
    }
}

__device__ void phase_prep(const Params& p, int l) {
    const float* tab = (const float*)(p.ws + WS_TAB);
    bf16_t* H = (bf16_t*)(p.ws + WS_H);
    const int lane = otid() & 63;
    const int gw = obid() * (NTHREADS / 64) + (otid() >> 6), NGW = gridDim.x * (NTHREADS / 64);
    const float* nw = p.in[6] + l * 1024;
    for (int row = gw; row < R; row += NGW) {
        const int mr = row_modrow(row);
        f32x4 v[4];
        if (l == 0) {
            const float* src = row < RL ? p.in[0] + (size_t)row * D : p.in[2] + (size_t)(row - RL) * D;
#pragma unroll
            for (int j = 0; j < 4; ++j) v[j] = *(const f32x4*)(src + 4 * lane + 256 * j);
        } else {
            const float* X1 = (const float*)(p.ws + WS_X1) + (size_t)row * D;
            const int* rt = (const int*)(p.ws + WS_RT);
            const unsigned* ctl = (const unsigned*)(p.ws + WS_CTL);
            const int e0 = rt[row * 2], e1 = rt[row * 2 + 1];
            const int s0 = rt[2 * R + row * 2], s1 = rt[2 * R + row * 2 + 1];
            const float g0 = ((const float*)rt)[4 * R + row * 2], g1 = ((const float*)rt)[4 * R + row * 2 + 1];
            int base0 = 0, base1 = 0;
            for (int e = 0; e < NEXP; ++e) { const int cnt = (int)ctl[(l - 1) * 64 + e]; if (e < e0) base0 += cnt; if (e < e1) base1 += cnt; }
            const bf16_t* O0 = (const bf16_t*)(p.ws + WS_P) + (size_t)(base0 + s0) * D;
            const bf16_t* O1 = (const bf16_t*)(p.ws + WS_P) + (size_t)(base1 + s1) * D;
            const float* g2 = tab + TAB_MOD + ((l - 1) * 9 + mr) * 6144 + 5 * 1024;
            float* X2 = (float*)(p.ws + WS_X2) + (size_t)row * D;
#pragma unroll
            for (int j = 0; j < 4; ++j) {
                const int k = 4 * lane + 256 * j;
                const f32x4 x1 = *(const f32x4*)(X1 + k);
                const u32x2 a = *(const u32x2*)(O0 + k), b = *(const u32x2*)(O1 + k);
                const f32x4 gg = *(const f32x4*)(g2 + k);
                f32x4 m;
                m.x = g0 * bflo(a.x) + g1 * bflo(b.x); m.y = g0 * bfhi(a.x) + g1 * bfhi(b.x);
                m.z = g0 * bflo(a.y) + g1 * bflo(b.y); m.w = g0 * bfhi(a.y) + g1 * bfhi(b.y);
                v[j] = x1 + gg * m;
                *(f32x4*)(X2 + k) = v[j];
            }
        }
        float ss = 0.f;
#pragma unroll
        for (int j = 0; j < 4; ++j) ss += (v[j].x * v[j].x + v[j].y * v[j].y) + (v[j].z * v[j].z + v[j].w * v[j].w);
        ss = wave_sum(ss);
        const float rstd = rsqrtf(ss * (1.f / D) + EPS);
        const float* sh = tab + TAB_MOD + (l * 9 + mr) * 6144;
        const float* scv = sh + 1024;
#pragma unroll
        for (int j = 0; j < 4; ++j) {
            const int k = 4 * lane + 256 * j;
            const f32x4 w = *(const f32x4*)(nw + k), s = *(const f32x4*)(scv + k), h = *(const f32x4*)(sh + k);
            const f32x4 o = v[j] * rstd * w * (1.f + s) + h;
            u32x2 pk; pk.x = pk2(o.x, o.y); pk.y = pk2(o.z, o.w);
            *(u32x2*)(H + (size_t)row * D + k) = pk;
        }
    }
}

__device__ void phase_final(const Params& p, int l) {
    const float* tab = (const float*)(p.ws + WS_TAB);
    const int lane = otid() & 63;
    const int gw = obid() * (NTHREADS / 64) + (otid() >> 6), NGW = gridDim.x * (NTHREADS / 64);
    const int* rt = (const int*)(p.ws + WS_RT);
    const unsigned* ctl = (const unsigned*)(p.ws + WS_CTL);
    for (int row = gw; row < RL; row += NGW) {
        const int mr = row >> 11;
        const float* X1 = (const float*)(p.ws + WS_X1) + (size_t)row * D;
        const int e0 = rt[row * 2], e1 = rt[row * 2 + 1];
        const int s0 = rt[2 * R + row * 2], s1 = rt[2 * R + row * 2 + 1];
        const float g0 = ((const float*)rt)[4 * R + row * 2], g1 = ((const float*)rt)[4 * R + row * 2 + 1];
        int base0 = 0, base1 = 0;
        for (int e = 0; e < NEXP; ++e) { const int cnt = (int)ctl[l * 64 + e]; if (e < e0) base0 += cnt; if (e < e1) base1 += cnt; }
        const bf16_t* O0 = (const bf16_t*)(p.ws + WS_P) + (size_t)(base0 + s0) * D;
        const bf16_t* O1 = (const bf16_t*)(p.ws + WS_P) + (size_t)(base1 + s1) * D;
        const float* g2 = tab + TAB_MOD + (l * 9 + mr) * 6144 + 5 * 1024;
        float* O = p.out + (size_t)row * D;
#pragma unroll
        for (int j = 0; j < 4; ++j) {
            const int k = 4 * lane + 256 * j;
            const f32x4 x1 = *(const f32x4*)(X1 + k);
            const u32x2 a = *(const u32x2*)(O0 + k), b = *(const u32x2*)(O1 + k);
            const f32x4 gg = *(const f32x4*)(g2 + k);
            f32x4 m;
            m.x = g0 * bflo(a.x) + g1 * bflo(b.x); m.y = g0 * bfhi(a.x) + g1 * bfhi(b.x);
            m.z = g0 * bflo(a.y) + g1 * bflo(b.y); m.w = g0 * bfhi(a.y) + g1 * bfhi(b.y);
            *(f32x4*)(O + k) = x1 + gg * m;
        }
    }
}

constexpr int BN = 128;
constexpr int LDT = 64 + 8;
constexpr int LDN = BN + 16;
typedef short v4i16_t __attribute__((ext_vector_type(4)));
typedef __attribute__((address_space(3))) v4i16_t* lds_v4i16_ptr;
__device__ __forceinline__ v4i16_t lds_tr16(const bf16_t* p) { return __builtin_amdgcn_ds_read_tr16_b64_v4i16((lds_v4i16_ptr)(p)); }

template <int WM, int KS, class AF, class BF>
__device__ __forceinline__ void gemm_tile(const bf16_t* Abase, const AF& arow, const BF& bptr, int K, unsigned char* smem, f32x4 (&acc)[WM][4]) {
    constexpr int BMt = 32 * WM, BKt = 32 * KS, LDA_ = BKt + 16;
    constexpr int STAGE = BMt * LDA_ * 2 + BKt * LDN * 2;
    static_assert(2 * STAGE <= 73728, "GEMM LDS");
    constexpr int ACH = BKt / 8;
    constexpr int APT = BMt * ACH / NTHREADS;
    constexpr int BPT = BKt * 32 / NTHREADS;
    const int tid = otid(), lane = tid & 63, wid = tid >> 6, wr = wid >> 1, wc = wid & 1, fr = lane & 15, fq = lane >> 4;
    const int a_chunk = tid % ACH, a_row0 = tid / ACH;
    unsigned ap[APT];
#pragma unroll
    for (int i = 0; i < APT; ++i) ap[i] = arow(a_row0 + (NTHREADS / ACH) * i) + a_chunk * 8;
    const int b_n4 = tid & 31, b_k0 = tid >> 5;
    u32x4 ar[APT];
    f32x4 br[BPT];
#pragma unroll
    for (int m = 0; m < WM; ++m)
#pragma unroll
        for (int n = 0; n < 4; ++n) acc[m][n] = (f32x4){0.f, 0.f, 0.f, 0.f};
    const int nk = K / BKt;
    auto gload = [&](int kt) {
        const int k0 = kt * BKt;
#pragma unroll
        for (int i = 0; i < APT; ++i) ar[i] = *(const u32x4*)(Abase + (ap[i] + k0));
#pragma unroll
        for (int i = 0; i < BPT; ++i) br[i] = *(const f32x4*)bptr(k0 + b_k0 + 8 * i, 4 * b_n4);
    };
    auto lwrite = [&](int buf) {
        bf16_t* As = (bf16_t*)(smem + buf * STAGE);
        bf16_t* Bs = As + BMt * LDA_;
#pragma unroll
        for (int i = 0; i < APT; ++i) *(u32x4*)(As + (a_row0 + (NTHREADS / ACH) * i) * LDA_ + a_chunk * 8) = ar[i];
#pragma unroll
        for (int i = 0; i < BPT; ++i) {
            u32x2 w; w.x = pk2(br[i][0], br[i][1]); w.y = pk2(br[i][2], br[i][3]);
            *(u32x2*)(Bs + (b_k0 + 8 * i) * LDN + ((4 * b_n4) ^ ((((b_k0 + 8 * i) >> 3) & 1) << 6))) = w;
        }
    };
    gload(0); lwrite(0); __syncthreads();
    for (int kt = 0; kt < nk; ++kt) {
        if (kt + 1 < nk) gload(kt + 1);
        __builtin_amdgcn_sched_barrier(0);
        const bf16_t* As = (const bf16_t*)(smem + (kt & 1) * STAGE);
        const bf16_t* Bs = As + BMt * LDA_;
#pragma unroll
        for (int ks = 0; ks < KS; ++ks) {
            bf16x8 bfr[4];
#pragma unroll
            for (int n = 0; n < 4; ++n) {
                const bf16_t* bp = Bs + (ks * 32 + fq * 8 + (fr >> 2)) * LDN + ((wc ^ (fq & 1)) * 64) + n * 16 + 4 * (fr & 3);
                const v4i16_t lo = lds_tr16(bp), hi = lds_tr16(bp + 4 * LDN);
                bfr[n] = (bf16x8){lo[0], lo[1], lo[2], lo[3], hi[0], hi[1], hi[2], hi[3]};
            }
#pragma unroll
            for (int mh = 0; mh < WM; mh += WM / 2) {
                bf16x8 af[WM / 2];
#pragma unroll
                for (int m = 0; m < WM / 2; ++m) af[m] = *(const bf16x8*)(As + (wr * (16 * WM) + (mh + m) * 16 + fr) * LDA_ + ks * 32 + fq * 8);
#pragma unroll
                for (int m = 0; m < WM / 2; ++m)
#pragma unroll
                    for (int n = 0; n < 4; ++n) acc[mh + m][n] = __builtin_amdgcn_mfma_f32_16x16x32_bf16(bfr[n], af[m], acc[mh + m][n], 0, 0, 0);
            }
        }
        __builtin_amdgcn_sched_barrier(0);
        if (kt + 1 < nk) lwrite((kt + 1) & 1);
        __syncthreads();
    }
}

template <int WM, int KS, class AF, class BF>
__device__ __forceinline__ void gemm_tile_b16(const bf16_t* Abase, const AF& arow, const BF& bptr, int K, unsigned char* smem, f32x4 (&acc)[WM][4]) {
    constexpr int BMt = 32 * WM, BKt = 32 * KS, LDA_ = BKt + 16;
    constexpr int STAGE = BMt * LDA_ * 2 + BKt * LDN * 2;
    static_assert(2 * STAGE <= 73728, "GEMM LDS");
    constexpr int ACH = BKt / 8;
    constexpr int APT = BMt * ACH / NTHREADS;
    constexpr int BPT = BKt * 16 / NTHREADS;
    const int tid = otid(), lane = tid & 63, wid = tid >> 6, wr = wid >> 1, wc = wid & 1, fr = lane & 15, fq = lane >> 4;
    const int a_chunk = tid % ACH, a_row0 = tid / ACH;
    unsigned ap[APT];
#pragma unroll
    for (int i = 0; i < APT; ++i) ap[i] = arow(a_row0 + (NTHREADS / ACH) * i) + a_chunk * 8;
    const int b_n8 = tid & 15, b_k0 = tid >> 4;
    u32x4 ar0[APT], ar1[APT], br0[BPT], br1[BPT];
#pragma unroll
    for (int m = 0; m < WM; ++m)
#pragma unroll
        for (int n = 0; n < 4; ++n) acc[m][n] = (f32x4){0.f, 0.f, 0.f, 0.f};
    const int nk = K / BKt;
    auto gload = [&](int kt, u32x4 (&ar)[APT], u32x4 (&br)[BPT]) {
        const int k0 = kt * BKt;
#pragma unroll
        for (int i = 0; i < APT; ++i) ar[i] = *(const u32x4*)(Abase + (ap[i] + k0));
#pragma unroll
        for (int i = 0; i < BPT; ++i) br[i] = *(const u32x4*)bptr(k0 + b_k0 + 16 * i, 8 * b_n8);
    };
    auto lwrite = [&](int buf, const u32x4 (&ar)[APT], const u32x4 (&br)[BPT]) {
        bf16_t* As = (bf16_t*)(smem + buf * STAGE);
        bf16_t* Bs = As + BMt * LDA_;
#pragma unroll
        for (int i = 0; i < APT; ++i) *(u32x4*)(As + (a_row0 + (NTHREADS / ACH) * i) * LDA_ + a_chunk * 8) = ar[i];
#pragma unroll
        for (int i = 0; i < BPT; ++i) *(u32x4*)(Bs + (b_k0 + 16 * i) * LDN + ((8 * b_n8) ^ ((((b_k0 + 16 * i) >> 3) & 1) << 6))) = br[i];
    };
    auto compute = [&](int buf) {
        const bf16_t* As = (const bf16_t*)(smem + buf * STAGE);
        const bf16_t* Bs = As + BMt * LDA_;
#pragma unroll
        for (int ks = 0; ks < KS; ++ks) {
            bf16x8 bfr[4];
#pragma unroll
            for (int n = 0; n < 4; ++n) {
                const bf16_t* bp = Bs + (ks * 32 + fq * 8 + (fr >> 2)) * LDN + ((wc ^ (fq & 1)) * 64) + n * 16 + 4 * (fr & 3);
                const v4i16_t lo = lds_tr16(bp), hi = lds_tr16(bp + 4 * LDN);
                bfr[n] = (bf16x8){lo[0], lo[1], lo[2], lo[3], hi[0], hi[1], hi[2], hi[3]};
            }
#pragma unroll
            for (int mh = 0; mh < WM; mh += WM / 2) {
                bf16x8 af[WM / 2];
#pragma unroll
                for (int m = 0; m < WM / 2; ++m) af[m] = *(const bf16x8*)(As + (wr * (16 * WM) + (mh + m) * 16 + fr) * LDA_ + ks * 32 + fq * 8);
#pragma unroll
                for (int m = 0; m < WM / 2; ++m)
#pragma unroll
                    for (int n = 0; n < 4; ++n) acc[mh + m][n] = __builtin_amdgcn_mfma_f32_16x16x32_bf16(bfr[n], af[m], acc[mh + m][n], 0, 0, 0);
            }
        }
    };
    gload(0, ar0, br0); lwrite(0, ar0, br0);
    gload(1, ar1, br1);
    __syncthreads();
    for (int kt = 0; kt < nk; kt += 2) {
        gload(kt + 2 < nk ? kt + 2 : nk - 1, ar0, br0);
        __builtin_amdgcn_sched_barrier(0);
        compute(0);
        __builtin_amdgcn_sched_barrier(0);
        lwrite(1, ar1, br1);
        __syncthreads();
        gload(kt + 3 < nk ? kt + 3 : nk - 1, ar1, br1);
        __builtin_amdgcn_sched_barrier(0);
        compute(1);
        __builtin_amdgcn_sched_barrier(0);
        lwrite(0, ar0, br0);
        __syncthreads();
    }
    asm volatile("s_waitcnt vmcnt(0)" ::: "memory");
}

__device__ __forceinline__ bool xcd_unit(int it, int nMT, int nNT, int& mt, int& nt, const unsigned char* smem) {
    const volatile int* xinfo = (const volatile int*)(smem + 73728 + 800);
    const int G = gridDim.x, b = obid();
    if (xinfo[0]) {
        const int x = xinfo[1], rank = xinfo[2], cntx = xinfo[3];
        const int start = (x * nMT) >> 3, per = (((x + 1) * nMT) >> 3) - start;
        const int q = rank + it * cntx;
        if (q >= per * nNT) return false;
        mt = start + q % per; nt = q / per;
        return true;
    }
    const int u = b + it * G;
    if (u >= nMT * nNT) return false;
    mt = u / nNT; nt = u % nNT;
    return true;
}

__device__ __forceinline__ void epi_in_row(const f32x4 (&a)[4], int row, int cw, int fq, const float* tab, const float* lbt, const float* qw, const float* kw, bf16_t* P, float* LF) {
    float v[4][4];
#pragma unroll
    for (int n = 0; n < 4; ++n)
#pragma unroll
        for (int j = 0; j < 4; ++j) v[n][j] = a[n][j];
    if (cw >= OFF_ZF && cw < OFF_HV) {
        const int dir = (cw >= OFF_ZB) ? 1 : 0;
        const int cb = cw - (dir ? OFF_ZB : OFF_ZF);
#pragma unroll
        for (int n = 0; n < 4; ++n) {
            f32x4 o;
#pragma unroll
            for (int j = 0; j < 4; ++j) {
                const int c = cb + n * 16 + fq * 4 + j;
                const float lb = lbt[dir * 256 + c];
                const float z = v[n][j];
                float lf;
                if (lb > 0.f) lf = __logf(lb + (1.f - lb) * sigmoidf_(z));
                else lf = fminf(z, 0.f) - log1pf(__expf(-fabsf(z)));
                o[j] = lf;
            }
            *(f32x4*)(LF + (size_t)row * LFW + dir * 256 + cb + n * 16 + fq * 4) = o;
        }
        return;
    }
    if (cw < OFF_B) {
#pragma unroll
        for (int n = 0; n < 4; ++n)
#pragma unroll
            for (int j = 0; j < 4; ++j) v[n][j] = gelu_tanh(v[n][j]);
    }
    if ((cw >= 256 && cw < OFF_V)) {
        float ss = 0.f;
#pragma unroll
        for (int n = 0; n < 4; ++n)
#pragma unroll
            for (int j = 0; j < 4; ++j) ss += v[n][j] * v[n][j];
        ss += __shfl_xor(ss, 16); ss += __shfl_xor(ss, 32);
        const float rstd = rsqrtf(ss * (1.f / 64.f) + EPS);
        if (cw < OFF_B) {
#pragma unroll
            for (int n = 0; n < 4; ++n)
#pragma unroll
                for (int j = 0; j < 4; ++j) v[n][j] *= rstd;
        } else {
            const float* nwv = (cw < OFF_KV) ? qw : kw;
#pragma unroll
            for (int n = 0; n < 4; ++n)
#pragma unroll
                for (int j = 0; j < 4; ++j) v[n][j] *= rstd * nwv[n * 16 + fq * 4 + j];
            if (row < RL) {
                const int t = row & (T - 1);
#pragma unroll
                for (int ax = 0; ax < 2; ++ax) {
                    const int pos = ax == 0 ? (t >> 6) : (t & 63);
#pragma unroll
                    for (int j = 0; j < 4; ++j) {
                        const int f = fq * 4 + j;
                        const float cs = tab[TAB_ROPE + (pos * 16 + f) * 2], sn = tab[TAB_ROPE + (pos * 16 + f) * 2 + 1];
                        const float x0 = v[2 * ax][j], x1 = v[2 * ax + 1][j];
                        v[2 * ax][j] = x0 * cs - x1 * sn;
                        v[2 * ax + 1][j] = x1 * cs + x0 * sn;
                    }
                }
            }
        }
    }
    if ((cw >= OFF_C && cw < OFF_ZF) || cw >= OFF_G) {
#pragma unroll
        for (int n = 0; n < 4; ++n)
#pragma unroll
            for (int j = 0; j < 4; ++j) v[n][j] = siluf_(v[n][j]);
    }
#pragma unroll
    for (int n = 0; n < 4; ++n) {
        u32x2 pk; pk.x = pk2(v[n][0], v[n][1]); pk.y = pk2(v[n][2], v[n][3]);
        *(u32x2*)(P + (size_t)row * INW + cw + n * 16 + fq * 4) = pk;
    }
}

__device__ void phase_gemm_in(const Params& p, int l, unsigned char* smem) {
    const float* tab = (const float*)(p.ws + WS_TAB);
    const bf16_t* H = (const bf16_t*)(p.ws + WS_H);
    bf16_t* P = (bf16_t*)(p.ws + WS_P);
    float* LF = (float*)(p.ws + WS_LF);
    const bf16_t* W = (const bf16_t*)(p.ws + WS_WIN) + (size_t)l * D * INW;
    const float* qw = p.in[10] + l * 64;
    const float* kw = p.in[11] + l * 64;
    const float* lbt = tab + TAB_LB + l * 512;
    const int tid = otid(), lane = tid & 63, wid = tid >> 6, wr = wid >> 1, wc = wid & 1, fr = lane & 15, fq = lane >> 4;
    constexpr int WM = 6, BMt = 32 * WM;
    const int nMT = R / BMt, nNT = INW / BN;
    for (int it = 0;; ++it) {
        int mt, nt;
        if (!xcd_unit(it, nMT, nNT, mt, nt, smem)) break;
        const int row0 = mt * BMt, col0 = nt * BN;
        f32x4 acc[WM][4];
        auto arow = [&](int i) { return (unsigned)((row0 + i) * D); };
        auto bptr = [&](int k, int n) { return W + (size_t)k * INW + col0 + n; };
        gemm_tile_b16<WM, 1>(H, arow, bptr, D, smem, acc);
        const int cw = col0 + wc * 64;
        const int rbase = row0 + wr * (16 * WM) + fr;
        epi_in_row(acc[0], rbase, cw, fq, tab, lbt, qw, kw, P, LF);
        epi_in_row(acc[1], rbase + 16, cw, fq, tab, lbt, qw, kw, P, LF);
        epi_in_row(acc[2], rbase + 32, cw, fq, tab, lbt, qw, kw, P, LF);
        epi_in_row(acc[3], rbase + 48, cw, fq, tab, lbt, qw, kw, P, LF);
        epi_in_row(acc[4], rbase + 64, cw, fq, tab, lbt, qw, kw, P, LF);
        epi_in_row(acc[5], rbase + 80, cw, fq, tab, lbt, qw, kw, P, LF);
    }
}

__device__ __forceinline__ int next_unit(unsigned* ctr, unsigned char* smem) {
    int* slot = (int*)(smem + 73728 + 512);
    __syncthreads();
    if (otid() == 0) *slot = (int)atomicAdd(ctr, 1u);
    __syncthreads();
    return *slot;
}

constexpr float ATT_C = 0.125f * 1.4426950408889634f;
__device__ __forceinline__ void attn_unit(const Params& p, int u, unsigned char* smem) {
    const bf16_t* P = (const bf16_t*)(p.ws + WS_P);
    bf16_t* Y = (bf16_t*)(p.ws + WS_Y);
    bf16_t* Ks = (bf16_t*)smem;
    bf16_t* Vt = Ks + 2 * 64 * LDT;
    const int tid = otid(), lane = tid & 63, wid = tid >> 6, fr = lane & 15, fq = lane >> 4;
    const int k_row = tid >> 3, k_chunk = tid & 7;
    const int v_dg = tid & 15, v_kg = tid >> 4;
    const int v_pos = 32 * (v_kg >> 3) + 8 * (v_kg & 3) + 4 * ((v_kg >> 2) & 1);
    {
        int b, kvh, qrow0, nkt; bool ctxq = u >= 512;
        if (!ctxq) { b = u >> 6; kvh = (u >> 5) & 1; qrow0 = b * T + (u & 31) * 64; nkt = 36; }
        else { const int v = u - 512; b = v >> 3; kvh = (v >> 2) & 1; qrow0 = RL + b * TC + (v & 3) * 64; nkt = 4; }
        const int hh = kvh * 4 + wid;
        bf16_t* Qs = Vt + 2 * 64 * LDT + wid * 64 * LDT;
#pragma unroll
        for (int i = 0; i < 8; ++i) {
            const int r = i * 8 + (lane >> 3), ch = lane & 7;
            *(u32x4*)(Qs + r * LDT + ch * 8) = *(const u32x4*)(P + (size_t)(qrow0 + r) * INW + OFF_B + hh * 64 + ch * 8);
        }
        f32x4 o[4][4];
        float mrow[4], lrow[4];
#pragma unroll
        for (int m = 0; m < 4; ++m) { mrow[m] = -1e30f; lrow[m] = 0.f;
#pragma unroll
            for (int n = 0; n < 4; ++n) o[m][n] = (f32x4){0.f, 0.f, 0.f, 0.f}; }
        auto krow = [&](int kt, int i) { return ctxq ? (RL + b * TC + kt * 64 + i) : (kt < 32 ? (b * T + kt * 64 + i) : (RL + b * TC + (kt - 32) * 64 + i)); };
        u32x4 kreg[2]; u32x2 vreg[4];
        auto gload = [&](int kt) {
#pragma unroll
            for (int i = 0; i < 2; ++i) kreg[i] = *(const u32x4*)(P + (size_t)krow(kt, k_row + 32 * i) * INW + OFF_KV + kvh * 64 + k_chunk * 8);
#pragma unroll
            for (int i = 0; i < 4; ++i) vreg[i] = *(const u32x2*)(P + (size_t)krow(kt, 4 * v_kg + i) * INW + OFF_V + kvh * 64 + 4 * v_dg);
        };
        auto lwrite = [&](int buf) {
            bf16_t* kb = Ks + buf * 64 * LDT; bf16_t* vb = Vt + buf * 64 * LDT;
#pragma unroll
            for (int i = 0; i < 2; ++i) *(u32x4*)(kb + (k_row + 32 * i) * LDT + k_chunk * 8) = kreg[i];
#pragma unroll
            for (int di = 0; di < 4; ++di) {
                const int w = di >> 1;
                u32x2 ov;
                if ((di & 1) == 0) { ov.x = (vreg[0][w] & 0xffffu) | (vreg[1][w] << 16); ov.y = (vreg[2][w] & 0xffffu) | (vreg[3][w] << 16); }
                else { ov.x = (vreg[0][w] >> 16) | (vreg[1][w] & 0xffff0000u); ov.y = (vreg[2][w] >> 16) | (vreg[3][w] & 0xffff0000u); }
                *(u32x2*)(vb + (4 * v_dg + di) * LDT + v_pos) = ov;
            }
        };
        gload(0); lwrite(0); __syncthreads();
        for (int kt = 0; kt < nkt; ++kt) {
            if (kt + 1 < nkt) gload(kt + 1);
            __builtin_amdgcn_sched_barrier(0);
            const bf16_t* kb = Ks + (kt & 1) * 64 * LDT; const bf16_t* vb = Vt + (kt & 1) * 64 * LDT;
            bf16x8 kf[4][2], vf[4][2];
#pragma unroll
            for (int n = 0; n < 4; ++n)
#pragma unroll
                for (int ks = 0; ks < 2; ++ks) {
                    kf[n][ks] = *(const bf16x8*)(kb + (n * 16 + fr) * LDT + ks * 32 + fq * 8);
                    vf[n][ks] = *(const bf16x8*)(vb + (n * 16 + fr) * LDT + ks * 32 + fq * 8);
                }
#pragma unroll
            for (int m = 0; m < 4; ++m) {
                f32x4 sc[4];
                bf16x8 qf[2];
#pragma unroll
                for (int ks = 0; ks < 2; ++ks) qf[ks] = *(const bf16x8*)(Qs + (m * 16 + fr) * LDT + ks * 32 + fq * 8);
#pragma unroll
                for (int n = 0; n < 4; ++n) {
                    sc[n] = (f32x4){0.f, 0.f, 0.f, 0.f};
#pragma unroll
                    for (int ks = 0; ks < 2; ++ks) sc[n] = __builtin_amdgcn_mfma_f32_16x16x32_bf16(kf[n][ks], qf[ks], sc[n], 0, 0, 0);
                }
                float mx = sc[0][0];
#pragma unroll
                for (int n = 0; n < 4; ++n)
#pragma unroll
                    for (int j = 0; j < 4; ++j) mx = fmaxf(mx, sc[n][j]);
                mx = fmaxf(mx, __shfl_xor(mx, 16)); mx = fmaxf(mx, __shfl_xor(mx, 32));
                const float mnew = fmaxf(mrow[m], mx);
                const float alpha = __builtin_amdgcn_exp2f((mrow[m] - mnew) * ATT_C);
                mrow[m] = mnew;
                const float mc = mnew * ATT_C;
                float ls = 0.f;
#pragma unroll
                for (int n = 0; n < 4; ++n)
#pragma unroll
                    for (int j = 0; j < 4; ++j) { sc[n][j] = __builtin_amdgcn_exp2f(sc[n][j] * ATT_C - mc); ls += sc[n][j]; }
                lrow[m] = lrow[m] * alpha + ls;
#pragma unroll
                for (int n = 0; n < 4; ++n) o[m][n] = o[m][n] * alpha;
#pragma unroll
                for (int ks = 0; ks < 2; ++ks) {
                    u32x4 pw;
                    pw.x = pk2(sc[2 * ks][0], sc[2 * ks][1]); pw.y = pk2(sc[2 * ks][2], sc[2 * ks][3]);
                    pw.z = pk2(sc[2 * ks + 1][0], sc[2 * ks + 1][1]); pw.w = pk2(sc[2 * ks + 1][2], sc[2 * ks + 1][3]);
                    const bf16x8 pf = __builtin_bit_cast(bf16x8, pw);
#pragma unroll
                    for (int nd = 0; nd < 4; ++nd) o[m][nd] = __builtin_amdgcn_mfma_f32_16x16x32_bf16(vf[nd][ks], pf, o[m][nd], 0, 0, 0);
                }
            }
            __builtin_amdgcn_sched_barrier(0);
            if (kt + 1 < nkt) lwrite((kt + 1) & 1);
            __syncthreads();
        }
#pragma unroll
        for (int m = 0; m < 4; ++m) {
            float lt = lrow[m];
            lt += __shfl_xor(lt, 16); lt += __shfl_xor(lt, 32);
            const float inv = 1.f / lt;
            const size_t row = (size_t)(qrow0 + m * 16 + fr);
#pragma unroll
            for (int nd = 0; nd < 4; ++nd) {
                u32x2 pk; pk.x = pk2(o[m][nd][0] * inv, o[m][nd][1] * inv); pk.y = pk2(o[m][nd][2] * inv, o[m][nd][3] * inv);
                *(u32x2*)(Y + row * D + 256 + hh * 64 + nd * 16 + fq * 4) = pk;
            }
        }
    }
}

constexpr int LDA = 128 + 8;
__device__ __forceinline__ void mixa_unit(const Params& p, int l, int u, unsigned char* smem) {
    const bf16_t* P = (const bf16_t*)(p.ws + WS_P);
    bf16_t* Y = (bf16_t*)(p.ws + WS_Y);
    const int n = u >> 2, h = u & 3;
    const float* W = p.in[8] + ((size_t)l * 4 + h) * 128 * 128;
    const float* bs = p.in[9] + (l * 4 + h) * 128;
    bf16_t* Ws = (bf16_t*)smem;
    bf16_t* Vs = Ws + 128 * LDA;
    const int tid = otid(), lane = tid & 63, wid = tid >> 6, fr = lane & 15, fq = lane >> 4;
#pragma unroll
    for (int i = 0; i < 16; ++i) {
        const int pc = tid + 256 * i, t = pc >> 5, s4 = (pc & 31) * 4;
        const f32x4 w = *(const f32x4*)(W + t * 128 + s4);
        u32x2 o; o.x = pk2(w[0], w[1]); o.y = pk2(w[2], w[3]);
        *(u32x2*)(Ws + t * LDA + s4) = o;
    }
#pragma unroll
    for (int i = 0; i < 2; ++i) {
        const int mb = tid + 256 * i, dg = mb & 15, sg = mb >> 4;
        u32x2 vr[4];
#pragma unroll
        for (int r = 0; r < 4; ++r) vr[r] = *(const u32x2*)(P + (size_t)(n * 128 + 4 * sg + r) * INW + 256 + h * 64 + 4 * dg);
#pragma unroll
        for (int di = 0; di < 4; ++di) {
            const int w = di >> 1;
            u32x2 ov;
            if ((di & 1) == 0) { ov.x = (vr[0][w] & 0xffffu) | (vr[1][w] << 16); ov.y = (vr[2][w] & 0xffffu) | (vr[3][w] << 16); }
            else { ov.x = (vr[0][w] >> 16) | (vr[1][w] & 0xffff0000u); ov.y = (vr[2][w] >> 16) | (vr[3][w] & 0xffff0000u); }
            *(u32x2*)(Vs + (4 * dg + di) * LDA + 4 * sg) = ov;
        }
    }
    __syncthreads();
    f32x4 acc[2][4];
#pragma unroll
    for (int m = 0; m < 2; ++m)
#pragma unroll
        for (int nd = 0; nd < 4; ++nd) acc[m][nd] = (f32x4){0.f, 0.f, 0.f, 0.f};
#pragma unroll
    for (int ks = 0; ks < 4; ++ks) {
        bf16x8 wf[2], vf[4];
#pragma unroll
        for (int m = 0; m < 2; ++m) wf[m] = *(const bf16x8*)(Ws + (32 * wid + 16 * m + fr) * LDA + ks * 32 + fq * 8);
#pragma unroll
        for (int nd = 0; nd < 4; ++nd) vf[nd] = *(const bf16x8*)(Vs + (16 * nd + fr) * LDA + ks * 32 + fq * 8);
#pragma unroll
        for (int m = 0; m < 2; ++m)
#pragma unroll
            for (int nd = 0; nd < 4; ++nd) acc[m][nd] = __builtin_amdgcn_mfma_f32_16x16x32_bf16(vf[nd], wf[m], acc[m][nd], 0, 0, 0);
    }
#pragma unroll
    for (int m = 0; m < 2; ++m) {
        const int t = 32 * wid + 16 * m + fr;
        const size_t row = (size_t)n * 128 + t;
        const float bias = bs[t];
#pragma unroll
        for (int nd = 0; nd < 4; ++nd) {
            const int c = h * 64 + 16 * nd + 4 * fq;
            const u32x2 uu = *(const u32x2*)(P + row * INW + c);
            u32x2 pk;
            pk.x = pk2(bflo(uu.x) * (acc[m][nd][0] + bias), bfhi(uu.x) * (acc[m][nd][1] + bias));
            pk.y = pk2(bflo(uu.y) * (acc[m][nd][2] + bias), bfhi(uu.y) * (acc[m][nd][3] + bias));
            *(u32x2*)(Y + row * D + c) = pk;
        }
    }
}

__device__ __forceinline__ int hg_pos(int I, int ii) { return 32 * (I >> 1) + 4 * (I & 1) + 8 * (ii >> 2) + (ii & 3); }
__device__ __forceinline__ void hgrn_state_unit(const Params& p, int l, int u, unsigned char* smem) {
    const bf16_t* P = (const bf16_t*)(p.ws + WS_P);
    const float* LF = (const float*)(p.ws + WS_LF);
    bf16_t* SST = (bf16_t*)(p.ws + WS_OFB);
    const int b = u >> 3, h = (u >> 1) & 3, dir = u & 1;
    const int tid = otid(), lane = tid & 63, wid = tid >> 6, fr = lane & 15, fq = lane >> 4;
    const int k = lane, I = wid;
    bf16_t* KT = (bf16_t*)smem;
    bf16_t* VT = KT + 64 * LDT;
    float* Tsub = (float*)(VT + 64 * LDT);
    float* Etot = Tsub + 256;
    f32x4 sacc[4];
#pragma unroll
    for (int nk = 0; nk < 4; ++nk) sacc[nk] = (f32x4){0.f, 0.f, 0.f, 0.f};
    float lf[16], vv[16];
    auto mcof = [&](int j) { return dir == 0 ? (j < 4 ? 256 + b * 4 + j : b * 32 + (j - 4)) : (j < 4 ? 256 + b * 4 + (3 - j) : b * 32 + (35 - j)); };
    auto gload = [&](int j) {
        const int mc = mcof(j);
#pragma unroll
        for (int ii = 0; ii < 16; ++ii) {
            const int tau = 16 * I + ii;
            const size_t row = (size_t)mc * 64 + (dir ? 63 - tau : tau);
            lf[ii] = LF[row * LFW + dir * 256 + h * 64 + k];
            vv[ii] = bf2f(P[row * INW + OFF_HV + h * 64 + k]);
        }
    };
    gload(0);
    for (int j = 0; j < 36; ++j) {
        float c[16];
        c[0] = lf[0];
#pragma unroll
        for (int ii = 1; ii < 16; ++ii) c[ii] = c[ii - 1] + lf[ii];
        Tsub[I * 64 + k] = c[15];
        __syncthreads();
        float Rs = 0.f;
#pragma unroll
        for (int M = 1; M < 4; ++M) Rs += (M > I) ? Tsub[M * 64 + k] : 0.f;
        if (I == 0) Etot[k] = __expf(c[15] + Rs);
#pragma unroll
        for (int g = 0; g < 4; ++g) {
            float kh[4];
#pragma unroll
            for (int jj = 0; jj < 4; ++jj) { const int ii = 4 * g + jj; kh[jj] = (1.f - __expf(lf[ii])) * __expf(c[15] - c[ii] + Rs); }
            u32x2 kw; kw.x = pk2(kh[0], kh[1]); kw.y = pk2(kh[2], kh[3]);
            u32x2 vw; vw.x = pk2(vv[4 * g], vv[4 * g + 1]); vw.y = pk2(vv[4 * g + 2], vv[4 * g + 3]);
            const int pos = hg_pos(I, 4 * g);
            *(u32x2*)(KT + k * LDT + pos) = kw;
            *(u32x2*)(VT + k * LDT + pos) = vw;
        }
        const int mc = mcof(j);
        {
            bf16_t* dst = SST + ((size_t)(mc * 4 + h) * 2 + dir) * 4096;
#pragma unroll
            for (int nk = 0; nk < 4; ++nk)
#pragma unroll
                for (int r = 0; r < 4; ++r) dst[(16 * wid + 4 * fq + r) * 64 + 16 * nk + fr] = f2bf(sacc[nk][r]);
        }
        if (j + 1 < 36) gload(j + 1);
        __builtin_amdgcn_sched_barrier(0);
        __syncthreads();
        bf16x8 vf[2];
#pragma unroll
        for (int ks = 0; ks < 2; ++ks) vf[ks] = *(const bf16x8*)(VT + (16 * wid + fr) * LDT + 32 * ks + 8 * fq);
#pragma unroll
        for (int nk = 0; nk < 4; ++nk) {
            const float e = Etot[16 * nk + fr];
            sacc[nk] = sacc[nk] * e;
#pragma unroll
            for (int ks = 0; ks < 2; ++ks) {
                const bf16x8 kf = *(const bf16x8*)(KT + (16 * nk + fr) * LDT + 32 * ks + 8 * fq);
                sacc[nk] = __builtin_amdgcn_mfma_f32_16x16x32_bf16(vf[ks], kf, sacc[nk], 0, 0, 0);
            }
        }
        __syncthreads();
    }
}

__device__ __forceinline__ void hgrn_out_unit(const Params& p, int l, int u, unsigned char* smem) {
    const bf16_t* P = (const bf16_t*)(p.ws + WS_P);
    const float* LF = (const float*)(p.ws + WS_LF);
    const bf16_t* SST = (const bf16_t*)(p.ws + WS_OFB);
    bf16_t* Y = (bf16_t*)(p.ws + WS_Y);
    const float* hw = p.in[13] + l * 64;
    const int mc = u >> 2, h = u & 3;
    const int tid = otid(), lane = tid & 63, wid = tid >> 6, fr = lane & 15, fq = lane >> 4;
    const int k = lane, I = wid;
    bf16_t* QT0 = (bf16_t*)smem;
    bf16_t* KD = QT0 + 64 * LDT;
    bf16_t* KO = KD + 64 * LDT;
    bf16_t* QS = KO + 64 * LDT;
    bf16_t* QT1 = QS + 64 * LDT;
    bf16_t* QT2 = QT1 + 32 * LDT;
    bf16_t* VT = QT2 + 16 * LDT;
    float* Tsub = (float*)(VT + 64 * LDT);
    float* SSQ = Tsub + 256;
    f32x4 om[4];
#pragma unroll 1
    for (int dd = 0; dd < 2; ++dd) {
        const int dir = 1 - dd;
        float lf[16], c[16];
#pragma unroll
        for (int ii = 0; ii < 16; ++ii) {
            const int tau = 16 * I + ii;
            const size_t row = (size_t)mc * 64 + (dir ? 63 - tau : tau);
            lf[ii] = LF[row * LFW + dir * 256 + h * 64 + k];
        }
        c[0] = lf[0];
#pragma unroll
        for (int ii = 1; ii < 16; ++ii) c[ii] = c[ii - 1] + lf[ii];
        Tsub[I * 64 + k] = c[15];
        __syncthreads();
        const float T0 = Tsub[k], T1 = Tsub[64 + k], T2 = Tsub[128 + k];
        const float pre = (I > 0 ? T0 : 0.f) + (I > 1 ? T1 : 0.f) + (I > 2 ? T2 : 0.f);
        const float epre = __expf(pre);
        const float g1 = __expf(I == 2 ? T1 : T2);
        const float g2 = __expf(T1 + T2);
#pragma unroll
        for (int g = 0; g < 4; ++g) {
            float vq[4];
#pragma unroll
            for (int jj = 0; jj < 4; ++jj) {
                const int ii = 4 * g + jj, tau = 16 * I + ii;
                const size_t row = (size_t)mc * 64 + (dir ? 63 - tau : tau);
                const float q = bf2f(P[row * INW + OFF_C + h * 64 + k]);
                vq[jj] = bf2f(P[row * INW + OFF_HV + h * 64 + k]);
                const float qt = q * __expf(c[ii]);
                const float kk = 1.f - __expf(lf[ii]);
                QT0[tau * LDT + k] = f2bf(qt);
                QS[tau * LDT + k] = f2bf(qt * epre);
                KD[tau * LDT + k] = f2bf(kk * __expf(fminf(-c[ii], 80.f)));
                KO[tau * LDT + k] = f2bf(kk * __expf(c[15] - c[ii]));
                if (I >= 2) QT1[(tau - 32) * LDT + k] = f2bf(qt * g1);
                if (I == 3) QT2[(tau - 48) * LDT + k] = f2bf(qt * g2);
            }
            u32x2 vw; vw.x = pk2(vq[0], vq[1]); vw.y = pk2(vq[2], vq[3]);
            *(u32x2*)(VT + k * LDT + hg_pos(I, 4 * g)) = vw;
        }
        bf16x8 stf[2];
        {
            const bf16_t* src = SST + ((size_t)(mc * 4 + h) * 2 + dir) * 4096 + (16 * wid + fr) * 64 + 8 * fq;
            stf[0] = *(const bf16x8*)(src); stf[1] = *(const bf16x8*)(src + 32);
        }
        __syncthreads();
        bf16x8 vf[2];
#pragma unroll
        for (int ks = 0; ks < 2; ++ks) vf[ks] = *(const bf16x8*)(VT + (16 * wid + fr) * LDT + 32 * ks + 8 * fq);
        f32x4 o[4];
#pragma unroll
        for (int I2 = 0; I2 < 4; ++I2) {
            f32x4 A[4];
#pragma unroll
            for (int J = 0; J < 4; ++J) {
                A[J] = (f32x4){0.f, 0.f, 0.f, 0.f};
                if (J <= I2) {
                    const bf16_t* kbase = (J == I2 ? KD : KO) + (16 * J + fr) * LDT + 8 * fq;
                    const bf16_t* qbase = (I2 - J <= 1) ? (QT0 + (16 * I2 + fr) * LDT) : ((I2 - J == 2) ? (QT1 + (16 * I2 - 32 + fr) * LDT) : (QT2 + fr * LDT));
#pragma unroll
                    for (int ks = 0; ks < 2; ++ks) {
                        const bf16x8 kf = *(const bf16x8*)(kbase + 32 * ks);
                        const bf16x8 qf = *(const bf16x8*)(qbase + 32 * ks + 8 * fq);
                        A[J] = __builtin_amdgcn_mfma_f32_16x16x32_bf16(kf, qf, A[J], 0, 0, 0);
                    }
                    if (J == I2) {
#pragma unroll
                        for (int r = 0; r < 4; ++r) A[J][r] = (4 * fq + r <= fr) ? A[J][r] : 0.f;
                    }
                }
            }
            o[I2] = (f32x4){0.f, 0.f, 0.f, 0.f};
#pragma unroll
            for (int ks = 0; ks < 2; ++ks) {
                if (2 * ks <= I2) {
                    u32x4 pw;
                    pw.x = pk2(A[2 * ks][0], A[2 * ks][1]); pw.y = pk2(A[2 * ks][2], A[2 * ks][3]);
                    pw.z = pk2(A[2 * ks + 1][0], A[2 * ks + 1][1]); pw.w = pk2(A[2 * ks + 1][2], A[2 * ks + 1][3]);
                    o[I2] = __builtin_amdgcn_mfma_f32_16x16x32_bf16(vf[ks], __builtin_bit_cast(bf16x8, pw), o[I2], 0, 0, 0);
                }
                const bf16x8 qsf = *(const bf16x8*)(QS + (16 * I2 + fr) * LDT + 32 * ks + 8 * fq);
                o[I2] = __builtin_amdgcn_mfma_f32_16x16x32_bf16(stf[ks], qsf, o[I2], 0, 0, 0);
            }
        }
        if (dir == 1) {
            const int src = (lane & 48) | (15 - fr);
#pragma unroll
            for (int Im = 0; Im < 4; ++Im)
#pragma unroll
                for (int r = 0; r < 4; ++r) om[Im][r] = __shfl(o[3 - Im][r], src);
        } else {
#pragma unroll
            for (int Im = 0; Im < 4; ++Im) om[Im] = om[Im] + o[Im];
        }
        __syncthreads();
    }
#pragma unroll
    for (int Im = 0; Im < 4; ++Im) {
        float s = om[Im][0] * om[Im][0] + om[Im][1] * om[Im][1] + om[Im][2] * om[Im][2] + om[Im][3] * om[Im][3];
        s += __shfl_xor(s, 16); s += __shfl_xor(s, 32);
        if (fq == 0) SSQ[wid * 64 + 16 * Im + fr] = s;
    }
    __syncthreads();
    const f32x4 wv = *(const f32x4*)(hw + 16 * wid + 4 * fq);
#pragma unroll
    for (int Im = 0; Im < 4; ++Im) {
        const int i = 16 * Im + fr;
        const float tot = SSQ[i] + SSQ[64 + i] + SSQ[128 + i] + SSQ[192 + i];
        const float rstd = rsqrtf(tot * (1.f / 64.f) + EPS);
        const size_t row = (size_t)mc * 64 + i;
        const u32x2 gg = *(const u32x2*)(P + row * INW + OFF_G + h * 64 + 16 * wid + 4 * fq);
        u32x2 pk;
        pk.x = pk2(om[Im][0] * rstd * wv[0] * bflo(gg.x), om[Im][1] * rstd * wv[1] * bfhi(gg.x));
        pk.y = pk2(om[Im][2] * rstd * wv[2] * bflo(gg.y), om[Im][3] * rstd * wv[3] * bfhi(gg.y));
        *(u32x2*)(Y + row * D + 768 + h * 64 + 16 * wid + 4 * fq) = pk;
    }
}

__device__ void phase_mix1(const Params& p, int l, unsigned char* smem, int rep) {
    unsigned* ctr = (unsigned*)(p.ws + WS_CTL) + 128 + l * 2 + rep * 4;
    const int n_attn = (l == 0) ? 576 : 512, n_mixa = (l == 0) ? 576 : 512;
    const int total = 64 + n_attn + n_mixa;
    for (;;) {
        const int u = next_unit(ctr, smem);
        if (u >= total) break;
        if (u < 64) hgrn_state_unit(p, l, u, smem);
        else if (u < 64 + n_attn) attn_unit(p, u - 64, smem);
        else mixa_unit(p, l, u - 64 - n_attn, smem);
    }
}
__device__ void phase_mix2(const Params& p, int l, unsigned char* smem, int rep) {
    unsigned* ctr = (unsigned*)(p.ws + WS_CTL) + 128 + l * 2 + 1 + rep * 4;
    const int total = ((l == 0) ? 288 : 256) * 4;
    for (;;) {
        const int u = next_unit(ctr, smem);
        if (u >= total) break;
        hgrn_out_unit(p, l, u, smem);
    }
}

__device__ void phase_out(const Params& p, int l, unsigned char* smem) {
    const float* tab = (const float*)(p.ws + WS_TAB);
    const bf16_t* Y = (const bf16_t*)(p.ws + WS_Y);
    float* X1 = (float*)(p.ws + WS_X1);
    const float* X2 = (const float*)(p.ws + WS_X2);
    const bf16_t* W = (const bf16_t*)(p.ws + WS_WOUT) + (size_t)l * D * D;
    const int tid = otid(), lane = tid & 63, wid = tid >> 6, wr = wid >> 1, wc = wid & 1, fr = lane & 15, fq = lane >> 4;
    const int nrows = (l == 0) ? R : RL;
    constexpr int WM = 6, BMt = 32 * WM;
    const int nMT = (nrows + BMt - 1) / BMt, nNT = D / BN;
    for (int it = 0;; ++it) {
        int mt, nt;
        if (!xcd_unit(it, nMT, nNT, mt, nt, smem)) break;
        const int row0 = mt * BMt, col0 = nt * BN;
        f32x4 acc[WM][4];
        auto arow = [&](int i) { return (unsigned)((row0 + i) * D); };
        auto bptr = [&](int k, int n) { return W + (size_t)k * D + col0 + n; };
        gemm_tile_b16<WM, 1>(Y, arow, bptr, D, smem, acc);
#pragma unroll
        for (int m = 0; m < WM; ++m) {
            const int row = row0 + wr * (16 * WM) + m * 16 + fr;
            const int mr = row_modrow(row);
            const float* g1 = tab + TAB_MOD + (l * 9 + mr) * 6144 + 2 * 1024;
            const float* xin = (l == 0) ? (row < RL ? p.in[0] + (size_t)row * D : p.in[2] + (size_t)(row - RL) * D) : X2 + (size_t)row * D;
#pragma unroll
            for (int n = 0; n < 4; ++n) {
                const int col = col0 + wc * 64 + n * 16 + fq * 4;
                const f32x4 xv = *(const f32x4*)(xin + col), gv = *(const f32x4*)(g1 + col);
                *(f32x4*)(X1 + (size_t)row * D + col) = xv + gv * acc[m][n];
            }
        }
    }
}

__device__ void phase_route(const Params& p, int l, unsigned char* smem) {
    const float* tab = (const float*)(p.ws + WS_TAB);
    bf16_t* H = (bf16_t*)(p.ws + WS_H);
    const float* X1 = (const float*)(p.ws + WS_X1);
    int* rt = (int*)(p.ws + WS_RT);
    unsigned* ctl = (unsigned*)(p.ws + WS_CTL);
    const float* nw = p.in[15] + l * 1024;
    const float* wg = p.in[16] + (size_t)l * 1024 * 4;
    const float* bg = p.in[17] + l * 4;
    const float* we = p.in[18] + (size_t)l * 1024 * 32;
    const float* be = p.in[19] + l * 32;
    const int tid = otid(), lane = tid & 63, wid = tid >> 6, wr = wid >> 1, wc = wid & 1, fr = lane & 15, fq = lane >> 4;
    const int nrows = (l == 0) ? R : RL;
    float* Ls = (float*)smem;
    constexpr int BM = 64;
    for (int u = obid(); u < nrows / BM; u += gridDim.x) {
        const int row0 = u * BM;
        for (int rr = 0; rr < 16; ++rr) {
            const int row = row0 + wid * 16 + rr;
            const int mr = row_modrow(row);
            const float* sh = tab + TAB_MOD + (l * 9 + mr) * 6144 + 3 * 1024;
            const float* scv = sh + 1024;
            f32x4 v[4];
            float ss = 0.f;
#pragma unroll
            for (int j = 0; j < 4; ++j) { v[j] = *(const f32x4*)(X1 + (size_t)row * D + 4 * lane + 256 * j); ss += (v[j].x * v[j].x + v[j].y * v[j].y) + (v[j].z * v[j].z + v[j].w * v[j].w); }
            ss = wave_sum(ss);
            const float rstd = rsqrtf(ss * (1.f / D) + EPS);
#pragma unroll
            for (int j = 0; j < 4; ++j) {
                const int k = 4 * lane + 256 * j;
                const f32x4 w = *(const f32x4*)(nw + k), s = *(const f32x4*)(scv + k), h = *(const f32x4*)(sh + k);
                const f32x4 o = v[j] * rstd * w * (1.f + s) + h;
                u32x2 pk; pk.x = pk2(o.x, o.y); pk.y = pk2(o.z, o.w);
                *(u32x2*)(H + (size_t)row * D + k) = pk;
            }
        }
        asm volatile("s_waitcnt vmcnt(0)" ::: "memory");
        __syncthreads();
        f32x4 acc[2][4];
        auto arow = [&](int i) { return (unsigned)((row0 + i) * D); };
        const bf16_t* WRl = (const bf16_t*)(p.ws + WS_WR) + (size_t)l * 1024 * 128;
        auto bptr = [&](int k, int n) { return WRl + (size_t)k * 128 + n; };
        gemm_tile_b16<2, 1>(H, arow, bptr, D, smem, acc);
        if (wc == 0) {
#pragma unroll
            for (int m = 0; m < 2; ++m)
#pragma unroll
                for (int n = 0; n < 3; ++n) {
                    const int col = n * 16 + fq * 4;
                    if (col < 36) *(f32x4*)(Ls + (wr * 32 + m * 16 + fr) * 40 + col) = acc[m][n];
                }
        }
        __syncthreads();
        if (tid < BM) {
            const int row = row0 + tid;
            const float* lg = Ls + tid * 40;
            float gl[4];
#pragma unroll
            for (int i = 0; i < 4; ++i) gl[i] = lg[i] + bg[i];
            int grp = 0; float gm = gl[0];
#pragma unroll
            for (int i = 1; i < 4; ++i) if (gl[i] > gm) { gm = gl[i]; grp = i; }
            float gs = 0.f;
#pragma unroll
            for (int i = 0; i < 4; ++i) gs += expf(gl[i] - gm);
            const float pgrp = 1.f / gs;
            float ev[8];
#pragma unroll
            for (int i = 0; i < 8; ++i) ev[i] = lg[4 + grp * 8 + i] + be[grp * 8 + i];
            int i0 = 0; float v0 = ev[0];
#pragma unroll
            for (int i = 1; i < 8; ++i) if (ev[i] > v0) { v0 = ev[i]; i0 = i; }
            int i1 = -1; float v1 = -3.0e38f;
#pragma unroll
            for (int i = 0; i < 8; ++i) if (i != i0 && ev[i] > v1) { v1 = ev[i]; i1 = i; }
            const float e1 = expf(v1 - v0);
            const float ga = pgrp / (1.f + e1), gb = pgrp * e1 / (1.f + e1);
            const int ea = grp * 8 + i0, eb = grp * 8 + i1;
            const int sa = (int)atomicAdd(&ctl[l * 64 + ea], 1u);
            const int sb = (int)atomicAdd(&ctl[l * 64 + eb], 1u);
            rt[row * 2] = ea; rt[row * 2 + 1] = eb;
            rt[2 * R + row * 2] = sa; rt[2 * R + row * 2 + 1] = sb;
            ((float*)rt)[4 * R + row * 2] = ga; ((float*)rt)[4 * R + row * 2 + 1] = gb;
            rt[6 * R + ea * R + sa] = row;
            rt[6 * R + eb * R + sb] = row;
        }
        __syncthreads();
    }
}

constexpr int MOE_WM = 6, MOE_BM = 32 * MOE_WM;
__device__ __forceinline__ void moe_units(const Params& p, int l, int* s_cnt, int* s_base, int* s_tpre) {
    const unsigned* ctl = (const unsigned*)(p.ws + WS_CTL);
    if (otid() == 0) {
        int base = 0, tp = 0;
        for (int e = 0; e < NEXP; ++e) {
            const int c = (int)ctl[l * 64 + e];
            s_cnt[e] = c; s_base[e] = base; s_tpre[e] = tp;
            base += c; tp += (c + MOE_BM - 1) / MOE_BM;
        }
        s_tpre[NEXP] = tp;
    }
    __syncthreads();
}

__device__ void phase_moe1(const Params& p, int l, unsigned char* smem) {
    int* s_cnt = (int*)(smem + 73728);
    int* s_base = s_cnt + 32;
    int* s_tpre = s_base + 32;
    moe_units(p, l, s_cnt, s_base, s_tpre);
    const bf16_t* H = (const bf16_t*)(p.ws + WS_H);
    bf16_t* HM = (bf16_t*)(p.ws + WS_LF);
    const int* list = (const int*)(p.ws + WS_RT) + 6 * R;
    const float* W1 = p.in[20] + (size_t)l * NEXP * D * FF;
    const float* W3 = p.in[21] + (size_t)l * NEXP * D * FF;
    const int tid = otid(), lane = tid & 63, wid = tid >> 6, wr = wid >> 1, wc = wid & 1, fr = lane & 15, fq = lane >> 4;
    const int ntiles = s_tpre[NEXP];
    constexpr int nNT = FF / 64;
    for (int it = 0;; ++it) {
        int tg, nt;
        if (!xcd_unit(it, ntiles, nNT, tg, nt, smem)) break;
        int e = 0;
        while (s_tpre[e + 1] <= tg) ++e;
        const int mt = tg - s_tpre[e], cnt = s_cnt[e], base = s_base[e];
        const float* w1 = W1 + (size_t)e * D * FF;
        const float* w3 = W3 + (size_t)e * D * FF;
        const int* lst = list + (size_t)e * R;
        f32x4 acc[MOE_WM][4];
        auto arow = [&](int i) { int s = mt * MOE_BM + i; s = s < cnt ? s : cnt - 1; return (unsigned)(lst[s] * D); };
        auto bptr = [&](int k, int rho) {
            const int n = (rho >> 4) & 3;
            const int col = nt * 64 + (rho >> 6) * 32 + (n & 1) * 16 + (rho & 15);
            return ((n >= 2) ? w3 : w1) + (size_t)k * FF + col;
        };
        gemm_tile<MOE_WM, 1>(H, arow, bptr, D, smem, acc);
#pragma unroll
        for (int m = 0; m < MOE_WM; ++m) {
            const int s = mt * MOE_BM + wr * (16 * MOE_WM) + m * 16 + fr;
            if (s < cnt) {
#pragma unroll
                for (int n = 0; n < 2; ++n) {
                    float hv[4];
#pragma unroll
                    for (int j = 0; j < 4; ++j) hv[j] = siluf_(acc[m][n][j]) * acc[m][n + 2][j];
                    u32x2 pk; pk.x = pk2(hv[0], hv[1]); pk.y = pk2(hv[2], hv[3]);
                    *(u32x2*)(HM + (size_t)(base + s) * FF + nt * 64 + wc * 32 + n * 16 + fq * 4) = pk;
                }
            }
        }
    }
}

__device__ void phase_moe2(const Params& p, int l, unsigned char* smem) {
    int* s_cnt = (int*)(smem + 73728);
    int* s_base = s_cnt + 32;
    int* s_tpre = s_base + 32;
    moe_units(p, l, s_cnt, s_base, s_tpre);
    const bf16_t* HM = (const bf16_t*)(p.ws + WS_LF);
    bf16_t* OUTM = (bf16_t*)(p.ws + WS_P);
    const float* W2 = p.in[22] + (size_t)l * NEXP * FF * D;
    const int tid = otid(), lane = tid & 63, wid = tid >> 6, wr = wid >> 1, wc = wid & 1, fr = lane & 15, fq = lane >> 4;
    const int ntiles = s_tpre[NEXP];
    constexpr int nNT = D / BN;
    for (int it = 0;; ++it) {
        int tg, nt;
        if (!xcd_unit(it, ntiles, nNT, tg, nt, smem)) break;
        int e = 0;
        while (s_tpre[e + 1] <= tg) ++e;
        const int mt = tg - s_tpre[e], cnt = s_cnt[e], base = s_base[e];
        const float* w2 = W2 + (size_t)e * FF * D;
        f32x4 acc[MOE_WM][4];
        auto arow = [&](int i) { int s = mt * MOE_BM + i; s = s < cnt ? s : cnt - 1; return (unsigned)((base + s) * FF); };
        auto bptr = [&](int k, int n) { return w2 + (size_t)k * D + nt * BN + n; };
        gemm_tile<MOE_WM, 1>(HM, arow, bptr, FF, smem, acc);
#pragma unroll
        for (int m = 0; m < MOE_WM; ++m) {
            const int s = mt * MOE_BM + wr * (16 * MOE_WM) + m * 16 + fr;
            if (s < cnt) {
#pragma unroll
                for (int n = 0; n < 4; ++n) {
                    u32x2 pk; pk.x = pk2(acc[m][n][0], acc[m][n][1]); pk.y = pk2(acc[m][n][2], acc[m][n][3]);
                    *(u32x2*)(OUTM + (size_t)(base + s) * D + nt * BN + wc * 64 + n * 16 + fq * 4) = pk;
                }
            }
        }
    }
}

#define XB_TMO      128
#define XB_XCNT(j)  (256  + 64 * (j))
#define XB_XSUB(j)  (1280 + 64 * (j))
#define XB_XGEN(j)  (2304 + 64 * (j))
#define XB_TOP      3328
#define XB_TOPGEN   3392
#define XCD_BAR_WORDS 3456
#define XB_SPIN_CAP (1u << 22)
#define LAS __attribute__((address_space(3)))
__device__ __forceinline__ unsigned xb_ld(unsigned* p)              { return __hip_atomic_load(p, __ATOMIC_RELAXED, __HIP_MEMORY_SCOPE_AGENT); }
__device__ __forceinline__ unsigned xb_add(unsigned* p, unsigned v) { return __hip_atomic_fetch_add(p, v, __ATOMIC_RELAXED, __HIP_MEMORY_SCOPE_AGENT); }
__device__ __forceinline__ unsigned xb_xcc_id() { return (unsigned)__builtin_amdgcn_s_getreg((3 << 11) | 20) & 0xFu; }
#define XB_SPIN(cond, bar) do { unsigned _sp = 0; while (cond) { __builtin_amdgcn_s_sleep(1); \
    if ((++_sp & 255u) == 0u) { if (xb_ld(&(bar)[XB_TMO])) break; if (_sp > XB_SPIN_CAP) { atomicAdd(&(bar)[XB_TMO], 1u); break; } } } } while (0)
struct XcdBarrier { unsigned* bar; unsigned x; volatile unsigned* st; };
__device__ __forceinline__ XcdBarrier xcd_barrier_post(unsigned* bar, volatile unsigned* st, volatile int* xinfo) {
    XcdBarrier b; b.bar = bar; b.x = xb_xcc_id(); b.st = st;
    if (threadIdx.x == 0) { const unsigned r = xb_add(&bar[XB_XCNT(b.x)], 1u); xinfo[0] = 0; xinfo[1] = (int)b.x; xinfo[2] = (int)r; xinfo[3] = 0; }
    return b;
}
__device__ __forceinline__ void xcd_barrier_complete(unsigned* bar, unsigned x, unsigned& nloc, unsigned& nx) {
    const unsigned G = gridDim.x * gridDim.y * gridDim.z;
    unsigned sum, cnt, mine, sp = 0u;
    for (;;) {
        sum = 0u; cnt = 0u; mine = 0u;
#pragma unroll
        for (unsigned j = 0; j < 16; ++j) { const unsigned c = xb_ld(&bar[XB_XCNT(j)]); sum += c; cnt += (c > 0u) ? 1u : 0u; mine = (j == x) ? c : mine; }
        if (sum == G) break;
        __builtin_amdgcn_s_sleep(1);
        if ((++sp & 255u) == 0u) { if (xb_ld(&bar[XB_TMO])) break; if (sp > XB_SPIN_CAP) { atomicAdd(&bar[XB_TMO], 1u); break; } }
    }
    nloc = mine > 0u ? mine : 1u; nx = cnt > 0u ? cnt : 1u;
}
__device__ __forceinline__ void xcd_barrier(const XcdBarrier& b) {
    asm volatile("s_waitcnt vmcnt(0)" ::: "memory");
    __syncthreads();
    if (threadIdx.x == 0) {
        unsigned* bar = b.bar;
        __builtin_amdgcn_s_waitcnt(0);
        unsigned nloc = b.st[0], nx = b.st[1];
        if (nloc == 0u) { xcd_barrier_complete(bar, b.x, nloc, nx); b.st[0] = nloc; b.st[1] = nx; }
        const unsigned old = xb_add(&bar[XB_XSUB(b.x)], 1u);
        const unsigned gen = old / nloc;
        if (old + 1u == (gen + 1u) * nloc) {
            __builtin_amdgcn_fence(__ATOMIC_RELEASE, "agent");
            asm volatile("s_waitcnt vmcnt(0)" ::: "memory");
            const unsigned og = xb_add(&bar[XB_TOP], 1u);
            const unsigned tg = og / nx;
            if (og + 1u == (tg + 1u) * nx) xb_add(&bar[XB_TOPGEN], 1u);
            else XB_SPIN(xb_ld(&bar[XB_TOPGEN]) == tg, bar);
            __builtin_amdgcn_fence(__ATOMIC_ACQUIRE, "agent");
            xb_add(&bar[XB_XGEN(b.x)], 1u);
            asm volatile("s_waitcnt vmcnt(0)" ::: "memory");
        } else {
            XB_SPIN(xb_ld(&bar[XB_XGEN(b.x)]) == gen, bar);
            __builtin_amdgcn_fence(__ATOMIC_ACQUIRE, "agent");
            asm volatile("s_waitcnt vmcnt(0)" ::: "memory");
        }
    }
    __syncthreads();
}

constexpr int NPHASES = 18;
#ifndef PROBE_S
#define PROBE_S -1
#define PROBE_REPS 1
#endif
constexpr int SMEM_BYTES = 4 * 64 * LDT * 2 + 4 * 64 * LDT * 2 + 1024;
__global__ void __launch_bounds__(NTHREADS, 2) mega(Params p) {
    __shared__ __attribute__((aligned(16))) unsigned char smem[SMEM_BYTES];
    cg::grid_group grid = cg::this_grid();
    {
        volatile unsigned* st = (volatile unsigned*)(smem + 73728 + 768);
        if (threadIdx.x < 2) st[threadIdx.x] = 0u;
        __syncthreads();
        volatile int* xinfo = (volatile int*)(smem + 73728 + 800);
        (void)xcd_barrier_post((unsigned*)(p.ws + WS_CTL) + 4096, st, xinfo);
    }
#define GRID_BAR() do { XcdBarrier bar_; bar_.bar = (unsigned*)(p.ws + WS_CTL) + 4096; bar_.x = xb_xcc_id(); bar_.st = (volatile unsigned*)(smem + 73728 + 768); xcd_barrier(bar_); } while (0)
    for (int ph = p.ph_lo; ph < p.ph_hi; ++ph) {
        if (ph == 0) phase_init(p, smem);
        else if (ph == NPHASES - 1) phase_final(p, 1);
        else {
            const int l = (ph - 1) / 8, s = (ph - 1) % 8;
            const int reps = (s == PROBE_S) ? PROBE_REPS : 1;
            for (int rep = 0; rep < reps; ++rep) {
                switch (s) {
                    case 0: phase_prep(p, l); break;
                    case 1: phase_gemm_in(p, l, smem); break;
                    case 2: phase_mix1(p, l, smem, rep); break;
                    case 3: phase_mix2(p, l, smem, rep); break;
                    case 4: phase_out(p, l, smem); break;
                    case 5: phase_route(p, l, smem); break;
                    case 6: phase_moe1(p, l, smem); break;
                    default: phase_moe2(p, l, smem); break;
                }
                if (rep + 1 < reps) GRID_BAR();
            }
        }
        if (ph + 1 < p.ph_hi) {
            if (ph == 0) {
                if (p.ph_hi < 0) grid.sync();
                GRID_BAR();
                if (threadIdx.x == 0) {
                    unsigned* bw = (unsigned*)(p.ws + WS_CTL) + 4096;
                    volatile int* xi = (volatile int*)(smem + 73728 + 800);
                    const unsigned myx = xb_xcc_id();
                    unsigned sum = 0, ok = 1;
                    for (int j = 0; j < 8; ++j) { const unsigned c = xb_ld(&bw[XB_XCNT(j)]); sum += c; ok &= (c > 0u); }
                    xi[3] = (int)xb_ld(&bw[XB_XCNT(myx & 7u)]);
                    xi[0] = (ok && sum == gridDim.x && myx < 8u) ? 1 : 0;
                }
                __syncthreads();
            } else GRID_BAR();
        }
    }
}

extern "C" void kernel_launch(void* const* d_in, const int* in_sizes, int n_in, void* d_out, int out_size, void* d_ws, size_t ws_size, hipStream_t stream) {
    static int grid_blocks = 0;
    if (grid_blocks == 0) {
        if (n_in != 23 || out_size != RL * D || ws_size < WS_END) { fprintf(stderr, "kernel_launch: unexpected shapes (n_in %d out %d ws %zu need %zu)\n", n_in, out_size, ws_size, (size_t)WS_END); grid_blocks = -1; return; }
        int dev = 0, cus = 0, per_cu = 0;
        hipGetDevice(&dev);
        hipDeviceGetAttribute(&cus, hipDeviceAttributeMultiprocessorCount, dev);
        hipOccupancyMaxActiveBlocksPerMultiprocessor(&per_cu, mega, NTHREADS, 0);
        if (per_cu > 2) per_cu = 2;
        if (per_cu < 1) per_cu = 1;
        grid_blocks = cus * per_cu;
    }
    if (grid_blocks < 0) return;
    hipMemsetAsync((char*)d_ws + WS_CTL, 0, 1 * MiB, stream);
    Params p{};
    for (int i = 0; i < 23; ++i) p.in[i] = (const float*)d_in[i];
    p.out = (float*)d_out; p.ws = (unsigned char*)d_ws; p.ph_lo = 0; p.ph_hi = NPHASES;
    void* args[] = {&p};
    hipError_t e = hipLaunchCooperativeKernel((void*)mega, dim3(grid_blocks), dim3(NTHREADS), args, 0, stream);
    if (e != hipSuccess) fprintf(stderr, "cooperative launch failed: %s (grid %d)\n", hipGetErrorString(e), grid_blocks);
}
```

```cpp
#include <hip/hip_runtime.h>
#include <hip/hip_cooperative_groups.h>
#include <cstdio>
#include <cstdint>
namespace cg = cooperative_groups;

constexpr int D = 1024, NB = 8, T = 2048, TC = 256;
constexpr int RL = NB * T, RC = NB * TC, R = RL + RC;
constexpr int INW = 2560, LFW = 512;
constexpr int OFF_B = 512, OFF_KV = 1024, OFF_V = 1152, OFF_C = 1280, OFF_ZF = 1536, OFF_ZB = 1792, OFF_HV = 2048, OFF_G = 2304;
constexpr int NEXP = 32, FF = 512;
constexpr float EPS = 1e-6f;
constexpr int NTHREADS = 256;

constexpr size_t MiB = 1ull << 20;
constexpr size_t WS_CTL = 0;
constexpr size_t WS_TAB = 1 * MiB;
constexpr size_t WS_H = 2 * MiB;
constexpr size_t WS_P = WS_H + 36 * MiB;
constexpr size_t WS_LF = WS_P + 90 * MiB;
constexpr size_t WS_Y = WS_LF + 36 * MiB;
constexpr size_t WS_X1 = WS_Y + 36 * MiB;
constexpr size_t WS_X2 = WS_X1 + 72 * MiB;
constexpr size_t WS_OFB = WS_X2 + 72 * MiB;
constexpr size_t WS_RT = WS_OFB + 18 * MiB;
constexpr size_t WS_WIN = WS_RT + 4 * MiB;
constexpr size_t WS_WOUT = WS_WIN + 10 * MiB;
constexpr size_t WS_WR = WS_WOUT + 4 * MiB;
constexpr size_t WS_END = WS_WR + 1 * MiB;
constexpr int TAB_ROPE = 0;
constexpr int TAB_LB = 2048;
constexpr int TAB_MOD = 4096;

typedef unsigned short bf16_t;
typedef short bf16x8 __attribute__((ext_vector_type(8)));
typedef float f32x4 __attribute__((ext_vector_type(4)));
typedef float f32x2 __attribute__((ext_vector_type(2)));
typedef unsigned u32x4 __attribute__((ext_vector_type(4)));
typedef unsigned u32x2 __attribute__((ext_vector_type(2)));
typedef __bf16 bf16x2_t __attribute__((ext_vector_type(2)));

struct Params {
    const float* in[23];
    float* out;
    unsigned char* ws;
    int ph_lo, ph_hi;
};

__device__ __forceinline__ unsigned pk2(float lo, float hi) { f32x2 v = {lo, hi}; bf16x2_t b = __builtin_convertvector(v, bf16x2_t); return __builtin_bit_cast(unsigned, b); }
__device__ __forceinline__ bf16_t f2bf(float f) { return (bf16_t)(pk2(f, 0.f) & 0xffffu); }
__device__ __forceinline__ float bf2f(bf16_t u) { return __uint_as_float(((unsigned)u) << 16); }
__device__ __forceinline__ float bflo(unsigned w) { return __uint_as_float(w << 16); }
__device__ __forceinline__ float bfhi(unsigned w) { return __uint_as_float(w & 0xffff0000u); }
__device__ __forceinline__ float wave_sum(float v) {
#pragma unroll
    for (int o = 1; o < 64; o <<= 1) v += __shfl_xor(v, o);
    return v;
}
__device__ __forceinline__ float sigmoidf_(float x) { return __builtin_amdgcn_rcpf(1.f + __expf(-x)); }
__device__ __forceinline__ float siluf_(float x) { return x * sigmoidf_(x); }
__device__ __forceinline__ float gelu_tanh(float x) {
    const float u = 0.7978845608028654f * (x + 0.044715f * x * x * x);
    return x * __builtin_amdgcn_rcpf(1.f + __expf(-2.f * u));
}
__device__ __forceinline__ int otid() { int t = threadIdx.x; asm volatile("" : "+v"(t)); return t; }
__device__ __forceinline__ int obid() { int t = blockIdx.x; asm volatile("" : "+s"(t)); return t; }
__device__ __forceinline__ int cur_idx(int l, int e) { return 8192 + (l * 32 + e) * 64; }
__device__ __forceinline__ int row_modrow(int row) { return row < RL ? (row >> 11) : 8; }

__device__ void phase_init(const Params& p, unsigned char* smem) {
    float* tab = (float*)(p.ws + WS_TAB);
    const float* c = p.in[1];
    const float* c_ctx = p.in[3];
    const float* w_mod = p.in[4];
    const float* b_mod = p.in[5];
    float* sc = (float*)smem;
    const int tid = otid();
    for (int i = tid; i < 9 * 1024; i += NTHREADS) {
        const int b = i >> 10, k = i & 1023;
        const float v = (b < 8) ? c[b * 1024 + k] : c_ctx[k];
        sc[i] = siluf_(v);
    }
    __syncthreads();
    float* red = (float*)(smem + 36864);
    for (int it = obid(); it < 384; it += gridDim.x) {
        const int l = it / 192, j0 = (it % 192) * 32;
        const int jj = tid & 31, kg = tid >> 5;
        const float* w = w_mod + (size_t)l * 1024 * 6144 + (size_t)(kg * 128) * 6144 + j0 + jj;
        float acc[9];
#pragma unroll
        for (int b = 0; b < 9; ++b) acc[b] = 0.f;
        for (int k0 = 0; k0 < 128; k0 += 8) {
            float wv[8];
#pragma unroll
            for (int i = 0; i < 8; ++i) wv[i] = w[(size_t)(k0 + i) * 6144];
#pragma unroll
            for (int i = 0; i < 8; ++i)
#pragma unroll
                for (int b = 0; b < 9; ++b) acc[b] += sc[b * 1024 + kg * 128 + k0 + i] * wv[i];
        }
#pragma unroll
        for (int b = 0; b < 9; ++b) red[(kg * 9 + b) * 32 + jj] = acc[b];
        __syncthreads();
        for (int o = tid; o < 9 * 32; o += NTHREADS) {
            const int b = o >> 5, j2 = o & 31;
            float sum = 0.f;
#pragma unroll
            for (int g = 0; g < 8; ++g) sum += red[(g * 9 + b) * 32 + j2];
            tab[TAB_MOD + (l * 9 + b) * 6144 + j0 + j2] = sum + b_mod[l * 6144 + j0 + j2];
        }
        __syncthreads();
    }
    {
        const int gtid = obid() * NTHREADS + tid, gsize = gridDim.x * NTHREADS;
        const float* w_in = p.in[7]; const float* w_out = p.in[14];
        bf16_t* WIN = (bf16_t*)(p.ws + WS_WIN); bf16_t* WOUT = (bf16_t*)(p.ws + WS_WOUT); bf16_t* WR = (bf16_t*)(p.ws + WS_WR);
        for (int i = gtid; i < 2 * 1024 * INW / 4; i += gsize) { const f32x4 v = *(const f32x4*)(w_in + (size_t)i * 4); u32x2 o; o.x = pk2(v[0], v[1]); o.y = pk2(v[2], v[3]); *(u32x2*)(WIN + (size_t)i * 4) = o; }
        for (int i = gtid; i < 2 * 1024 * D / 4; i += gsize) { const f32x4 v = *(const f32x4*)(w_out + (size_t)i * 4); u32x2 o; o.x = pk2(v[0], v[1]); o.y = pk2(v[2], v[3]); *(u32x2*)(WOUT + (size_t)i * 4) = o; }
        for (int i = gtid; i < 2 * 48 * 1024; i += gsize) {
            const int k = i & 1023, n = (i >> 10) % 48, l = i / (48 * 1024);
            float v = 0.f;
            if (n < 4) v = p.in[16][((size_t)l * 1024 + k) * 4 + n];
            else if (n < 36) v = p.in[18][((size_t)l * 1024 + k) * 32 + (n - 4)];
            WR[i] = f2bf(v);
        }
    }
    if (obid() == gridDim.x - 1) {
        for (int i = tid; i < 64 * 16; i += NTHREADS) {
            const int pos = i >> 4, f = i & 15;
            const float inv = 1.0f / powf(10000.0f, (float)(2 * f) / 32.0f);
            const float ang = (float)pos * inv;
            tab[TAB_ROPE + i * 2] = cosf(ang);
            tab[TAB_ROPE + i * 2 + 1] = sinf(ang);
        }
        const float* lbl = p.in[12];
        for (int i = tid; i < 512; i += NTHREADS) {
            const float a0 = lbl[i], a1 = lbl[512 + i];
            const float m = fmaxf(a0, a1);
            const float e0 = expf(a0 - m), e1 = expf(a1 - m);
            const float s1 = e1 / (e0 + e1);
            tab[TAB_LB + i] = 0.f;
            tab[TAB_LB + 512 + i] = s1;
        }
    }
}

__device__ void phase_prep(const Params& p, int l) {
    const float* tab = (const float*)(p.ws + WS_TAB);
    bf16_t* H = (bf16_t*)(p.ws + WS_H);
    const int lane = otid() & 63;
    const int gw = obid() * (NTHREADS / 64) + (otid() >> 6), NGW = gridDim.x * (NTHREADS / 64);
    const float* nw = p.in[6] + l * 1024;
    for (int row = gw; row < R; row += NGW) {
        const int mr = row_modrow(row);
        f32x4 v[4];
        if (l == 0) {
            const float* src = row < RL ? p.in[0] + (size_t)row * D : p.in[2] + (size_t)(row - RL) * D;
#pragma unroll
            for (int j = 0; j < 4; ++j) v[j] = *(const f32x4*)(src + 4 * lane + 256 * j);
        } else {
            const float* X1 = (const float*)(p.ws + WS_X1) + (size_t)row * D;
            const int* rt = (const int*)(p.ws + WS_RT);
            const unsigned* ctl = (const unsigned*)(p.ws + WS_CTL);
            const int e0 = rt[row * 2], e1 = rt[row * 2 + 1];
            const int s0 = rt[2 * R + row * 2], s1 = rt[2 * R + row * 2 + 1];
            const float g0 = ((const float*)rt)[4 * R + row * 2], g1 = ((const float*)rt)[4 * R + row * 2 + 1];
            int base0 = 0, base1 = 0;
            for (int e = 0; e < NEXP; ++e) { const int cnt = (int)ctl[cur_idx(l - 1, e)]; if (e < e0) base0 += cnt; if (e < e1) base1 += cnt; }
            const bf16_t* O0 = (const bf16_t*)(p.ws + WS_P) + (size_t)(base0 + s0) * D;
            const bf16_t* O1 = (const bf16_t*)(p.ws + WS_P) + (size_t)(base1 + s1) * D;
            const float* g2 = tab + TAB_MOD + ((l - 1) * 9 + mr) * 6144 + 5 * 1024;
            float* X2 = (float*)(p.ws + WS_X2) + (size_t)row * D;
#pragma unroll
            for (int j = 0; j < 4; ++j) {
                const int k = 4 * lane + 256 * j;
                const f32x4 x1 = *(const f32x4*)(X1 + k);
                const u32x2 a = *(const u32x2*)(O0 + k), b = *(const u32x2*)(O1 + k);
                const f32x4 gg = *(const f32x4*)(g2 + k);
                f32x4 m;
                m.x = g0 * bflo(a.x) + g1 * bflo(b.x); m.y = g0 * bfhi(a.x) + g1 * bfhi(b.x);
                m.z = g0 * bflo(a.y) + g1 * bflo(b.y); m.w = g0 * bfhi(a.y) + g1 * bfhi(b.y);
                v[j] = x1 + gg * m;
                *(f32x4*)(X2 + k) = v[j];
            }
        }
        float ss = 0.f;
#pragma unroll
        for (int j = 0; j < 4; ++j) ss += (v[j].x * v[j].x + v[j].y * v[j].y) + (v[j].z * v[j].z + v[j].w * v[j].w);
        ss = wave_sum(ss);
        const float rstd = rsqrtf(ss * (1.f / D) + EPS);
        const float* sh = tab + TAB_MOD + (l * 9 + mr) * 6144;
        const float* scv = sh + 1024;
#pragma unroll
        for (int j = 0; j < 4; ++j) {
            const int k = 4 * lane + 256 * j;
            const f32x4 w = *(const f32x4*)(nw + k), s = *(const f32x4*)(scv + k), h = *(const f32x4*)(sh + k);
            const f32x4 o = v[j] * rstd * w * (1.f + s) + h;
            u32x2 pk; pk.x = pk2(o.x, o.y); pk.y = pk2(o.z, o.w);
            *(u32x2*)(H + (size_t)row * D + k) = pk;
        }
    }
}

__device__ void phase_final(const Params& p, int l) {
    const float* tab = (const float*)(p.ws + WS_TAB);
    const int lane = otid() & 63;
    const int gw = obid() * (NTHREADS / 64) + (otid() >> 6), NGW = gridDim.x * (NTHREADS / 64);
    const int* rt = (const int*)(p.ws + WS_RT);
    const unsigned* ctl = (const unsigned*)(p.ws + WS_CTL);
    for (int row = gw; row < RL; row += NGW) {
        const int mr = row >> 11;
        const float* X1 = (const float*)(p.ws + WS_X1) + (size_t)row * D;
        const int e0 = rt[row * 2], e1 = rt[row * 2 + 1];
        const int s0 = rt[2 * R + row * 2], s1 = rt[2 * R + row * 2 + 1];
        const float g0 = ((const float*)rt)[4 * R + row * 2], g1 = ((const float*)rt)[4 * R + row * 2 + 1];
        int base0 = 0, base1 = 0;
        for (int e = 0; e < NEXP; ++e) { const int cnt = (int)ctl[cur_idx(l, e)]; if (e < e0) base0 += cnt; if (e < e1) base1 += cnt; }
        const bf16_t* O0 = (const bf16_t*)(p.ws + WS_P) + (size_t)(base0 + s0) * D;
        const bf16_t* O1 = (const bf16_t*)(p.ws + WS_P) + (size_t)(base1 + s1) * D;
        const float* g2 = tab + TAB_MOD + (l * 9 + mr) * 6144 + 5 * 1024;
        float* O = p.out + (size_t)row * D;
#pragma unroll
        for (int j = 0; j < 4; ++j) {
            const int k = 4 * lane + 256 * j;
            const f32x4 x1 = *(const f32x4*)(X1 + k);
            const u32x2 a = *(const u32x2*)(O0 + k), b = *(const u32x2*)(O1 + k);
            const f32x4 gg = *(const f32x4*)(g2 + k);
            f32x4 m;
            m.x = g0 * bflo(a.x) + g1 * bflo(b.x); m.y = g0 * bfhi(a.x) + g1 * bfhi(b.x);
            m.z = g0 * bflo(a.y) + g1 * bflo(b.y); m.w = g0 * bfhi(a.y) + g1 * bfhi(b.y);
            *(f32x4*)(O + k) = x1 + gg * m;
        }
    }
}

constexpr int BN = 128;
constexpr int LDT = 64 + 8;
constexpr int LDN = BN + 16;
typedef short v4i16_t __attribute__((ext_vector_type(4)));
typedef __attribute__((address_space(3))) v4i16_t* lds_v4i16_ptr;
__device__ __forceinline__ v4i16_t lds_tr16(const bf16_t* p) { return __builtin_amdgcn_ds_read_tr16_b64_v4i16((lds_v4i16_ptr)(p)); }

template <int WM, int KS, class AF, class BF>
__device__ __forceinline__ void gemm_tile(const bf16_t* Abase, const AF& arow, const BF& bptr, int K, unsigned char* smem, f32x4 (&acc)[WM][4]) {
    constexpr int BMt = 32 * WM, BKt = 32 * KS, LDA_ = BKt + 16;
    constexpr int STAGE = BMt * LDA_ * 2 + BKt * LDN * 2;
    static_assert(2 * STAGE <= 73728, "GEMM LDS");
    constexpr int ACH = BKt / 8;
    constexpr int APT = BMt * ACH / NTHREADS;
    constexpr int BPT = BKt * 32 / NTHREADS;
    const int tid = otid(), lane = tid & 63, wid = tid >> 6, wr = wid >> 1, wc = wid & 1, fr = lane & 15, fq = lane >> 4;
    const int a_chunk = tid % ACH, a_row0 = tid / ACH;
    unsigned ap[APT];
#pragma unroll
    for (int i = 0; i < APT; ++i) ap[i] = arow(a_row0 + (NTHREADS / ACH) * i) + a_chunk * 8;
    const int b_n4 = tid & 31, b_k0 = tid >> 5;
    u32x4 ar[APT];
    f32x4 br[BPT];
#pragma unroll
    for (int m = 0; m < WM; ++m)
#pragma unroll
        for (int n = 0; n < 4; ++n) acc[m][n] = (f32x4){0.f, 0.f, 0.f, 0.f};
    const int nk = K / BKt;
    auto gload = [&](int kt) {
        const int k0 = kt * BKt;
#pragma unroll
        for (int i = 0; i < APT; ++i) ar[i] = *(const u32x4*)(Abase + (ap[i] + k0));
#pragma unroll
        for (int i = 0; i < BPT; ++i) br[i] = *(const f32x4*)bptr(k0 + b_k0 + 8 * i, 4 * b_n4);
    };
    auto lwrite = [&](int buf) {
        bf16_t* As = (bf16_t*)(smem + buf * STAGE);
        bf16_t* Bs = As + BMt * LDA_;
#pragma unroll
        for (int i = 0; i < APT; ++i) *(u32x4*)(As + (a_row0 + (NTHREADS / ACH) * i) * LDA_ + a_chunk * 8) = ar[i];
#pragma unroll
        for (int i = 0; i < BPT; ++i) {
            u32x2 w; w.x = pk2(br[i][0], br[i][1]); w.y = pk2(br[i][2], br[i][3]);
            *(u32x2*)(Bs + (b_k0 + 8 * i) * LDN + ((4 * b_n4) ^ ((((b_k0 + 8 * i) >> 3) & 1) << 6))) = w;
        }
    };
    gload(0); lwrite(0); __syncthreads();
    for (int kt = 0; kt < nk; ++kt) {
        if (kt + 1 < nk) gload(kt + 1);
        __builtin_amdgcn_sched_barrier(0);
        const bf16_t* As = (const bf16_t*)(smem + (kt & 1) * STAGE);
        const bf16_t* Bs = As + BMt * LDA_;
#pragma unroll
        for (int ks = 0; ks < KS; ++ks) {
            bf16x8 bfr[4];
#pragma unroll
            for (int n = 0; n < 4; ++n) {
                const bf16_t* bp = Bs + (ks * 32 + fq * 8 + (fr >> 2)) * LDN + ((wc ^ (fq & 1)) * 64) + n * 16 + 4 * (fr & 3);
                const v4i16_t lo = lds_tr16(bp), hi = lds_tr16(bp + 4 * LDN);
                bfr[n] = (bf16x8){lo[0], lo[1], lo[2], lo[3], hi[0], hi[1], hi[2], hi[3]};
            }
#pragma unroll
            for (int mh = 0; mh < WM; mh += WM / 2) {
                bf16x8 af[WM / 2];
#pragma unroll
                for (int m = 0; m < WM / 2; ++m) af[m] = *(const bf16x8*)(As + (wr * (16 * WM) + (mh + m) * 16 + fr) * LDA_ + ks * 32 + fq * 8);
#pragma unroll
                for (int m = 0; m < WM / 2; ++m)
#pragma unroll
                    for (int n = 0; n < 4; ++n) acc[mh + m][n] = __builtin_amdgcn_mfma_f32_16x16x32_bf16(bfr[n], af[m], acc[mh + m][n], 0, 0, 0);
            }
        }
        __builtin_amdgcn_sched_barrier(0);
        if (kt + 1 < nk) lwrite((kt + 1) & 1);
        __syncthreads();
    }
}

template <int WM, int KS, class AF, class BF>
__device__ __forceinline__ void gemm_tile_b16(const bf16_t* Abase, const AF& arow, const BF& bptr, int K, unsigned char* smem, f32x4 (&acc)[WM][4]) {
    constexpr int BMt = 32 * WM, BKt = 32 * KS, LDA_ = BKt + 16;
    constexpr int STAGE = BMt * LDA_ * 2 + BKt * LDN * 2;
    static_assert(2 * STAGE <= 73728, "GEMM LDS");
    constexpr int ACH = BKt / 8;
    constexpr int APT = BMt * ACH / NTHREADS;
    constexpr int BPT = BKt * 16 / NTHREADS;
    const int tid = otid(), lane = tid & 63, wid = tid >> 6, wr = wid >> 1, wc = wid & 1, fr = lane & 15, fq = lane >> 4;
    const int a_chunk = tid % ACH, a_row0 = tid / ACH;
    unsigned ap[APT];
#pragma unroll
    for (int i = 0; i < APT; ++i) ap[i] = arow(a_row0 + (NTHREADS / ACH) * i) + a_chunk * 8;
    const int b_n8 = tid & 15, b_k0 = tid >> 4;
    u32x4 ar0[APT], ar1[APT], br0[BPT], br1[BPT];
#pragma unroll
    for (int m = 0; m < WM; ++m)
#pragma unroll
        for (int n = 0; n < 4; ++n) acc[m][n] = (f32x4){0.f, 0.f, 0.f, 0.f};
    const int nk = K / BKt;
    auto gload = [&](int kt, u32x4 (&ar)[APT], u32x4 (&br)[BPT]) {
        const int k0 = kt * BKt;
#pragma unroll
        for (int i = 0; i < APT; ++i) ar[i] = *(const u32x4*)(Abase + (ap[i] + k0));
#pragma unroll
        for (int i = 0; i < BPT; ++i) br[i] = *(const u32x4*)bptr(k0 + b_k0 + 16 * i, 8 * b_n8);
    };
    auto lwrite = [&](int buf, const u32x4 (&ar)[APT], const u32x4 (&br)[BPT]) {
        bf16_t* As = (bf16_t*)(smem + buf * STAGE);
        bf16_t* Bs = As + BMt * LDA_;
#pragma unroll
        for (int i = 0; i < APT; ++i) *(u32x4*)(As + (a_row0 + (NTHREADS / ACH) * i) * LDA_ + a_chunk * 8) = ar[i];
#pragma unroll
        for (int i = 0; i < BPT; ++i) *(u32x4*)(Bs + (b_k0 + 16 * i) * LDN + ((8 * b_n8) ^ ((((b_k0 + 16 * i) >> 3) & 1) << 6))) = br[i];
    };
    auto compute = [&](int buf) {
        const bf16_t* As = (const bf16_t*)(smem + buf * STAGE);
        const bf16_t* Bs = As + BMt * LDA_;
#pragma unroll
        for (int ks = 0; ks < KS; ++ks) {
            bf16x8 bfr[4];
#pragma unroll
            for (int n = 0; n < 4; ++n) {
                const bf16_t* bp = Bs + (ks * 32 + fq * 8 + (fr >> 2)) * LDN + ((wc ^ (fq & 1)) * 64) + n * 16 + 4 * (fr & 3);
                const v4i16_t lo = lds_tr16(bp), hi = lds_tr16(bp + 4 * LDN);
                bfr[n] = (bf16x8){lo[0], lo[1], lo[2], lo[3], hi[0], hi[1], hi[2], hi[3]};
            }
#pragma unroll
            for (int mh = 0; mh < WM; mh += WM / 2) {
                bf16x8 af[WM / 2];
#pragma unroll
                for (int m = 0; m < WM / 2; ++m) af[m] = *(const bf16x8*)(As + (wr * (16 * WM) + (mh + m) * 16 + fr) * LDA_ + ks * 32 + fq * 8);
#pragma unroll
                for (int m = 0; m < WM / 2; ++m)
#pragma unroll
                    for (int n = 0; n < 4; ++n) acc[mh + m][n] = __builtin_amdgcn_mfma_f32_16x16x32_bf16(bfr[n], af[m], acc[mh + m][n], 0, 0, 0);
            }
        }
    };
    gload(0, ar0, br0); lwrite(0, ar0, br0);
    gload(1, ar1, br1);
    __syncthreads();
    for (int kt = 0; kt < nk; kt += 2) {
        gload(kt + 2 < nk ? kt + 2 : nk - 1, ar0, br0);
        __builtin_amdgcn_sched_barrier(0);
        compute(0);
        __builtin_amdgcn_sched_barrier(0);
        lwrite(1, ar1, br1);
        __syncthreads();
        gload(kt + 3 < nk ? kt + 3 : nk - 1, ar1, br1);
        __builtin_amdgcn_sched_barrier(0);
        compute(1);
        __builtin_amdgcn_sched_barrier(0);
        lwrite(0, ar0, br0);
        __syncthreads();
    }
    asm volatile("s_waitcnt vmcnt(0)" ::: "memory");
}

template <int N> __device__ __forceinline__ void wait_vm() {
    if constexpr (N == 0) asm volatile("s_waitcnt vmcnt(0)" ::: "memory");
    else if constexpr (N == 3) asm volatile("s_waitcnt vmcnt(3)" ::: "memory");
    else if constexpr (N == 4) asm volatile("s_waitcnt vmcnt(4)" ::: "memory");
    else if constexpr (N == 5) asm volatile("s_waitcnt vmcnt(5)" ::: "memory");
    else if constexpr (N == 6) asm volatile("s_waitcnt vmcnt(6)" ::: "memory");
    else static_assert(N < 0, "wait_vm");
}
#define RAW_BARRIER() do { asm volatile("s_waitcnt lgkmcnt(0)" ::: "memory"); __builtin_amdgcn_s_barrier(); } while (0)
__device__ __forceinline__ void glds16(const void* gsrc, unsigned lds_dst) {
    unsigned keep;
    asm volatile("s_mov_b32 %0, m0\n\ts_mov_b32 m0, %2\n\ts_nop 0\n\tglobal_load_lds_dwordx4 %1, off\n\ts_mov_b32 m0, %0" : "=&s"(keep) : "v"(gsrc), "s"(lds_dst) : "memory");
}
template <int WM, class AF>
__device__ __forceinline__ void gemm_tile_dma(const bf16_t* Abase, const AF& arow, const bf16_t* Btile, int ldb, int K, unsigned char* smem, f32x4 (&acc)[WM][4]) {
    constexpr int A_BYTES = 32 * WM * 64, B_BYTES = 8192, STAGE = A_BYTES + B_BYTES;
    constexpr int AI = WM / 2, NI = AI + 2;
    static_assert(WM % 2 == 0 && 3 * STAGE <= 73728, "gemm_tile_dma");
    const int tid = otid(), lane = tid & 63, wid = tid >> 6, wr = wid >> 1, wc = wid & 1, fr = lane & 15, fq = lane >> 4;
    unsigned aoff[AI], boff[2];
#pragma unroll
    for (int i = 0; i < AI; ++i) {
        const int r = 16 * (i * 4 + wid) + (lane >> 2);
        const int c = (lane & 3) ^ (((r >> 3) & 1) << 1);
        aoff[i] = arow(r) + 8 * c;
    }
#pragma unroll
    for (int i = 0; i < 2; ++i) {
        const int kr = 4 * (i * 4 + wid) + (lane >> 4), jp = lane & 15;
        const int g = (jp >> 1) ^ ((kr & 3) | (((kr >> 3) & 1) << 2));
        boff[i] = (unsigned)(kr * ldb + (g * 2 + (jp & 1)) * 8);
    }
#pragma unroll
    for (int m = 0; m < WM; ++m)
#pragma unroll
        for (int n = 0; n < 4; ++n) acc[m][n] = (f32x4){0.f, 0.f, 0.f, 0.f};
    const int nk = K / 32;
    const unsigned lds0 = (unsigned)(uintptr_t)smem;
    const unsigned wbase = (unsigned)__builtin_amdgcn_readfirstlane((int)(lds0 + (unsigned)wid * 1024u));
    auto dma = [&](int kt, int st) {
        const unsigned sa = wbase + (unsigned)(st * STAGE);
#pragma unroll
        for (int i = 0; i < AI; ++i) glds16(Abase + (aoff[i] + kt * 32), (unsigned)__builtin_amdgcn_readfirstlane((int)(sa + i * 4096)));
#pragma unroll
        for (int i = 0; i < 2; ++i) glds16(Btile + (boff[i] + (unsigned)(kt * 32 * ldb)), (unsigned)__builtin_amdgcn_readfirstlane((int)(sa + A_BYTES + i * 4096)));
    };
    const int a_lane = (wr * (16 * WM) + fr) * 64 + 16 * (fq ^ (((fr >> 3) & 1) << 1));
    const int fBl = (fr >> 2) | ((fq & 1) << 2);
    const int b_lane = A_BYTES + (fq * 8 + (fr >> 2)) * 256 + 8 * (fr & 3);
    auto compute = [&](int st) {
        const unsigned char* sb = smem + st * STAGE;
        bf16x8 bfr[4];
#pragma unroll
        for (int n = 0; n < 4; ++n) {
            const bf16_t* bp = (const bf16_t*)(sb + b_lane + 32 * ((wc * 4 + n) ^ fBl));
            const v4i16_t lo = lds_tr16(bp), hi = lds_tr16(bp + 512);
            bfr[n] = (bf16x8){lo[0], lo[1], lo[2], lo[3], hi[0], hi[1], hi[2], hi[3]};
        }
        bf16x8 af[WM];
#pragma unroll
        for (int m = 0; m < WM; ++m) af[m] = *(const bf16x8*)(sb + a_lane + m * 1024);
#pragma unroll
        for (int m = 0; m < WM; ++m)
#pragma unroll
            for (int n = 0; n < 4; ++n) acc[m][n] = __builtin_amdgcn_mfma_f32_16x16x32_bf16(bfr[n], af[m], acc[m][n], 0, 0, 0);
    };
    dma(0, 0); dma(1, 1);
    int st = 0, st2 = 2;
#pragma unroll 1
    for (int kt = 0; kt < nk - 1; ++kt) {
        wait_vm<NI>();
        RAW_BARRIER();
        if (kt + 2 < nk) dma(kt + 2, st2);
        compute(st);
        st = (st == 2) ? 0 : st + 1; st2 = (st2 == 2) ? 0 : st2 + 1;
    }
    wait_vm<0>();
    RAW_BARRIER();
    compute(st);
    RAW_BARRIER();
}

__device__ __forceinline__ bool xcd_unit(int it, int nMT, int nNT, int& mt, int& nt, const unsigned char* smem) {
    const volatile int* xinfo = (const volatile int*)(smem + 73728 + 800);
    const int G = gridDim.x, b = obid();
    if (xinfo[0]) {
        const int x = xinfo[1], rank = xinfo[2], cntx = xinfo[3];
        const int start = (x * nMT) >> 3, per = (((x + 1) * nMT) >> 3) - start;
        const int q = rank + it * cntx;
        if (q >= per * nNT) return false;
        mt = start + q % per; nt = q / per;
        return true;
    }
    const int u = b + it * G;
    if (u >= nMT * nNT) return false;
    mt = u / nNT; nt = u % nNT;
    return true;
}

__device__ __forceinline__ void epi_in_row(const f32x4 (&a)[4], int row, int cw, int fq, const float* tab, const float* lbt, const float* qw, const float* kw, bf16_t* P, float* LF) {
    float v[4][4];
#pragma unroll
    for (int n = 0; n < 4; ++n)
#pragma unroll
        for (int j = 0; j < 4; ++j) v[n][j] = a[n][j];
    if (cw >= OFF_ZF && cw < OFF_HV) {
        const int dir = (cw >= OFF_ZB) ? 1 : 0;
        const int cb = cw - (dir ? OFF_ZB : OFF_ZF);
#pragma unroll
        for (int n = 0; n < 4; ++n) {
            f32x4 o;
#pragma unroll
            for (int j = 0; j < 4; ++j) {
                const int c = cb + n * 16 + fq * 4 + j;
                const float lb = lbt[dir * 256 + c];
                const float z = v[n][j];
                float lf;
                if (lb > 0.f) lf = __logf(lb + (1.f - lb) * sigmoidf_(z));
                else lf = fminf(z, 0.f) - log1pf(__expf(-fabsf(z)));
                o[j] = lf;
            }
            *(f32x4*)(LF + (size_t)row * LFW + dir * 256 + cb + n * 16 + fq * 4) = o;
        }
        return;
    }
    if (cw < OFF_B) {
#pragma unroll
        for (int n = 0; n < 4; ++n)
#pragma unroll
            for (int j = 0; j < 4; ++j) v[n][j] = gelu_tanh(v[n][j]);
    }
    if ((cw >= 256 && cw < OFF_V)) {
        float ss = 0.f;
#pragma unroll
        for (int n = 0; n < 4; ++n)
#pragma unroll
            for (int j = 0; j < 4; ++j) ss += v[n][j] * v[n][j];
        ss += __shfl_xor(ss, 16); ss += __shfl_xor(ss, 32);
        const float rstd = rsqrtf(ss * (1.f / 64.f) + EPS);
        if (cw < OFF_B) {
#pragma unroll
            for (int n = 0; n < 4; ++n)
#pragma unroll
                for (int j = 0; j < 4; ++j) v[n][j] *= rstd;
        } else {
            const float* nwv = (cw < OFF_KV) ? qw : kw;
#pragma unroll
            for (int n = 0; n < 4; ++n)
#pragma unroll
                for (int j = 0; j < 4; ++j) v[n][j] *= rstd * nwv[n * 16 + fq * 4 + j];
            if (row < RL) {
                const int t = row & (T - 1);
#pragma unroll
                for (int ax = 0; ax < 2; ++ax) {
                    const int pos = ax == 0 ? (t >> 6) : (t & 63);
                    const f32x4 cs01 = *(const f32x4*)(tab + TAB_ROPE + (pos * 16 + fq * 4) * 2), cs23 = *(const f32x4*)(tab + TAB_ROPE + (pos * 16 + fq * 4) * 2 + 4);
                    const float csv[4] = {cs01[0], cs01[2], cs23[0], cs23[2]}, snv[4] = {cs01[1], cs01[3], cs23[1], cs23[3]};
#pragma unroll
                    for (int j = 0; j < 4; ++j) {
                        const float cs = csv[j], sn = snv[j];
                        const float x0 = v[2 * ax][j], x1 = v[2 * ax + 1][j];
                        v[2 * ax][j] = x0 * cs - x1 * sn;
                        v[2 * ax + 1][j] = x1 * cs + x0 * sn;
                    }
                }
            }
        }
    }
    if ((cw >= OFF_C && cw < OFF_ZF) || cw >= OFF_G) {
#pragma unroll
        for (int n = 0; n < 4; ++n)
#pragma unroll
            for (int j = 0; j < 4; ++j) v[n][j] = siluf_(v[n][j]);
    }
#pragma unroll
    for (int n = 0; n < 4; ++n) {
        u32x2 pk; pk.x = pk2(v[n][0], v[n][1]); pk.y = pk2(v[n][2], v[n][3]);
        *(u32x2*)(P + (size_t)row * INW + cw + n * 16 + fq * 4) = pk;
    }
}

__device__ void phase_gemm_in(const Params& p, int l, unsigned char* smem) {
    const float* tab = (const float*)(p.ws + WS_TAB);
    const bf16_t* H = (const bf16_t*)(p.ws + WS_H);
    bf16_t* P = (bf16_t*)(p.ws + WS_P);
    float* LF = (float*)(p.ws + WS_LF);
    const bf16_t* W = (const bf16_t*)(p.ws + WS_WIN) + (size_t)l * D * INW;
    const float* qw = p.in[10] + l * 64;
    const float* kw = p.in[11] + l * 64;
    const float* lbt = tab + TAB_LB + l * 512;
    const int tid = otid(), lane = tid & 63, wid = tid >> 6, wr = wid >> 1, wc = wid & 1, fr = lane & 15, fq = lane >> 4;
    constexpr int WM = 6, BMt = 32 * WM;
    const int nMT = R / BMt, nNT = INW / BN;
    for (int it = 0;; ++it) {
        int mt, nt;
        if (!xcd_unit(it, nMT, nNT, mt, nt, smem)) break;
        const int row0 = mt * BMt, col0 = nt * BN;
        f32x4 acc[WM][4];
        auto arow = [&](int i) { return (unsigned)((row0 + i) * D); };
        gemm_tile_dma<WM>(H, arow, W + col0, INW, D, smem, acc);
        const int cw = col0 + wc * 64;
        const int rbase = row0 + wr * (16 * WM) + fr;
        epi_in_row(acc[0], rbase, cw, fq, tab, lbt, qw, kw, P, LF);
        epi_in_row(acc[1], rbase + 16, cw, fq, tab, lbt, qw, kw, P, LF);
        epi_in_row(acc[2], rbase + 32, cw, fq, tab, lbt, qw, kw, P, LF);
        epi_in_row(acc[3], rbase + 48, cw, fq, tab, lbt, qw, kw, P, LF);
        epi_in_row(acc[4], rbase + 64, cw, fq, tab, lbt, qw, kw, P, LF);
        epi_in_row(acc[5], rbase + 80, cw, fq, tab, lbt, qw, kw, P, LF);
    }
}

__device__ __forceinline__ int next_unit(unsigned* ctr, unsigned char* smem) {
    int* slot = (int*)(smem + 73728 + 512);
    __syncthreads();
    if (otid() == 0) *slot = (int)atomicAdd(ctr, 1u);
    __syncthreads();
    return *slot;
}

constexpr float ATT_C = 0.125f * 1.4426950408889634f;
constexpr int ATT_STAGE = 16384;
__device__ __forceinline__ void attn_unit(const Params& p, int u, unsigned char* smem) {
    const bf16_t* P = (const bf16_t*)(p.ws + WS_P);
    bf16_t* Y = (bf16_t*)(p.ws + WS_Y);
    const int tid = otid(), lane = tid & 63, wid = tid >> 6, fr = lane & 15, fq = lane >> 4;
    int b, kvh, qrow0, nkt; const bool ctxq = u >= 1024;
    if (!ctxq) { b = u >> 7; kvh = (u >> 6) & 1; qrow0 = b * T + (u & 63) * 32; nkt = 36; }
    else { const int v = u - 1024; b = v >> 4; kvh = (v >> 3) & 1; qrow0 = RL + b * TC + (v & 7) * 32; nkt = 4; }
    const int hh = kvh * 4 + wid;
    unsigned char* Qs = smem + 3 * ATT_STAGE + wid * 4096;
#pragma unroll
    for (int i = 0; i < 4; ++i) {
        const int pc = i * 64 + lane, r = pc >> 3, c = pc & 7;
        *(u32x4*)(Qs + r * 128 + 16 * (c ^ ((r >> 1) & 7))) = *(const u32x4*)(P + (size_t)(qrow0 + r) * INW + OFF_B + hh * 64 + c * 8);
    }
    f32x4 o[2][4];
    float mrow[2], lrow[2];
#pragma unroll
    for (int m = 0; m < 2; ++m) { mrow[m] = -1e30f; lrow[m] = 0.f;
#pragma unroll
        for (int n = 0; n < 4; ++n) o[m][n] = (f32x4){0.f, 0.f, 0.f, 0.f}; }
    unsigned koff[2], voff[2];
#pragma unroll
    for (int i = 0; i < 2; ++i) {
        const int r = 32 * i + 8 * wid + (lane >> 3), cp = lane & 7;
        koff[i] = (unsigned)(r * INW + OFF_KV + kvh * 64 + (cp ^ ((r >> 1) & 7)) * 8);
        voff[i] = (unsigned)(r * INW + OFF_V + kvh * 64 + ((((cp >> 1) ^ ((r >> 1) & 3)) << 1) | (cp & 1)) * 8);
    }
    const unsigned lds0 = (unsigned)(uintptr_t)smem;
    const unsigned wbase = (unsigned)__builtin_amdgcn_readfirstlane((int)(lds0 + (unsigned)wid * 1024u));
    auto dma = [&](int kt, int st) {
        const int base = ctxq ? (RL + b * TC + kt * 64) : (kt < 32 ? (b * T + kt * 64) : (RL + b * TC + (kt - 32) * 64));
        const bf16_t* src = P + (size_t)base * INW;
        const unsigned sa = wbase + (unsigned)(st * ATT_STAGE);
#pragma unroll
        for (int i = 0; i < 2; ++i) {
            glds16(src + koff[i], (unsigned)__builtin_amdgcn_readfirstlane((int)(sa + i * 4096)));
            glds16(src + voff[i], (unsigned)__builtin_amdgcn_readfirstlane((int)(sa + 8192 + i * 4096)));
        }
    };
    const int kq_lane = fr * 128, kq_sw = (fr >> 1) & 7;
    const int hv = ((fq & 1) << 1) | (fr >> 3);
    const int v_lane = (4 * fq + (fr >> 2)) * 128 + 8 * (fr & 3);
    auto compute = [&](int st) {
        const unsigned char* kb = smem + st * ATT_STAGE;
        const unsigned char* vb = kb + 8192;
        f32x4 sc[2][4];
        {
            bf16x8 kf[4][2], qf[2][2];
#pragma unroll
            for (int n = 0; n < 4; ++n)
#pragma unroll
                for (int ks = 0; ks < 2; ++ks) kf[n][ks] = *(const bf16x8*)(kb + n * 2048 + kq_lane + 16 * ((ks * 4 + fq) ^ kq_sw));
#pragma unroll
            for (int m = 0; m < 2; ++m)
#pragma unroll
                for (int ks = 0; ks < 2; ++ks) qf[m][ks] = *(const bf16x8*)(Qs + m * 2048 + kq_lane + 16 * ((ks * 4 + fq) ^ kq_sw));
#pragma unroll
            for (int m = 0; m < 2; ++m)
#pragma unroll
                for (int n = 0; n < 4; ++n) {
                    sc[m][n] = (f32x4){0.f, 0.f, 0.f, 0.f};
#pragma unroll
                    for (int ks = 0; ks < 2; ++ks) sc[m][n] = __builtin_amdgcn_mfma_f32_16x16x32_bf16(kf[n][ks], qf[m][ks], sc[m][n], 0, 0, 0);
                }
        }
        bf16x8 vf[4][2];
#pragma unroll
        for (int n = 0; n < 4; ++n)
#pragma unroll
            for (int ks = 0; ks < 2; ++ks) {
                const bf16_t* vp = (const bf16_t*)(vb + ks * 4096 + v_lane + 32 * (n ^ hv));
                const v4i16_t lo = lds_tr16(vp), hi = lds_tr16(vp + 1024);
                vf[n][ks] = (bf16x8){lo[0], lo[1], lo[2], lo[3], hi[0], hi[1], hi[2], hi[3]};
            }
        bf16x8 pf[2][2];
#pragma unroll
        for (int m = 0; m < 2; ++m) {
            float mx = sc[m][0][0];
#pragma unroll
            for (int n = 0; n < 4; ++n)
#pragma unroll
                for (int j = 0; j < 4; ++j) mx = fmaxf(mx, sc[m][n][j]);
            mx = fmaxf(mx, __shfl_xor(mx, 16)); mx = fmaxf(mx, __shfl_xor(mx, 32));
            const float mnew = fmaxf(mrow[m], mx);
            const float alpha = __builtin_amdgcn_exp2f((mrow[m] - mnew) * ATT_C);
            mrow[m] = mnew;
            const float mc = mnew * ATT_C;
            float ls = 0.f;
#pragma unroll
            for (int n = 0; n < 4; ++n)
#pragma unroll
                for (int j = 0; j < 4; ++j) { sc[m][n][j] = __builtin_amdgcn_exp2f(sc[m][n][j] * ATT_C - mc); ls += sc[m][n][j]; }
            lrow[m] = lrow[m] * alpha + ls;
#pragma unroll
            for (int n = 0; n < 4; ++n) o[m][n] = o[m][n] * alpha;
#pragma unroll
            for (int ks = 0; ks < 2; ++ks) {
                u32x4 pw;
                pw.x = pk2(sc[m][2 * ks][0], sc[m][2 * ks][1]); pw.y = pk2(sc[m][2 * ks][2], sc[m][2 * ks][3]);
                pw.z = pk2(sc[m][2 * ks + 1][0], sc[m][2 * ks + 1][1]); pw.w = pk2(sc[m][2 * ks + 1][2], sc[m][2 * ks + 1][3]);
                pf[m][ks] = __builtin_bit_cast(bf16x8, pw);
            }
        }
#pragma unroll
        for (int m = 0; m < 2; ++m)
#pragma unroll
            for (int ks = 0; ks < 2; ++ks)
#pragma unroll
                for (int nd = 0; nd < 4; ++nd) o[m][nd] = __builtin_amdgcn_mfma_f32_16x16x32_bf16(vf[nd][ks], pf[m][ks], o[m][nd], 0, 0, 0);
    };
    dma(0, 0); dma(1, 1);
    int st = 0, st2 = 2;
#pragma unroll 1
    for (int kt = 0; kt < nkt - 1; ++kt) {
        wait_vm<4>();
        RAW_BARRIER();
        if (kt + 2 < nkt) dma(kt + 2, st2);
        compute(st);
        st = (st == 2) ? 0 : st + 1; st2 = (st2 == 2) ? 0 : st2 + 1;
    }
    wait_vm<0>();
    RAW_BARRIER();
    compute(st);
#pragma unroll
    for (int m = 0; m < 2; ++m) {
        float lt = lrow[m];
        lt += __shfl_xor(lt, 16); lt += __shfl_xor(lt, 32);
        const float inv = 1.f / lt;
        const size_t row = (size_t)(qrow0 + m * 16 + fr);
#pragma unroll
        for (int nd = 0; nd < 4; ++nd) {
            u32x2 pk; pk.x = pk2(o[m][nd][0] * inv, o[m][nd][1] * inv); pk.y = pk2(o[m][nd][2] * inv, o[m][nd][3] * inv);
            *(u32x2*)(Y + row * D + 256 + hh * 64 + nd * 16 + fq * 4) = pk;
        }
    }
}

constexpr int LDA = 128 + 8;
__device__ __forceinline__ void mixa_unit(const Params& p, int l, int u, unsigned char* smem) {
    const bf16_t* P = (const bf16_t*)(p.ws + WS_P);
    bf16_t* Y = (bf16_t*)(p.ws + WS_Y);
    const int n = u >> 2, h = u & 3;
    const float* W = p.in[8] + ((size_t)l * 4 + h) * 128 * 128;
    const float* bs = p.in[9] + (l * 4 + h) * 128;
    bf16_t* Ws = (bf16_t*)smem;
    bf16_t* Vs = Ws + 128 * LDA;
    const int tid = otid(), lane = tid & 63, wid = tid >> 6, fr = lane & 15, fq = lane >> 4;
#pragma unroll
    for (int i = 0; i < 16; ++i) {
        const int pc = tid + 256 * i, t = pc >> 5, s4 = (pc & 31) * 4;
        const f32x4 w = *(const f32x4*)(W + t * 128 + s4);
        u32x2 o; o.x = pk2(w[0], w[1]); o.y = pk2(w[2], w[3]);
        *(u32x2*)(Ws + t * LDA + s4) = o;
    }
#pragma unroll
    for (int i = 0; i < 2; ++i) {
        const int mb = tid + 256 * i, dg = mb & 15, sg = mb >> 4;
        u32x2 vr[4];
#pragma unroll
        for (int r = 0; r < 4; ++r) vr[r] = *(const u32x2*)(P + (size_t)(n * 128 + 4 * sg + r) * INW + 256 + h * 64 + 4 * dg);
#pragma unroll
        for (int di = 0; di < 4; ++di) {
            const int w = di >> 1;
            u32x2 ov;
            if ((di & 1) == 0) { ov.x = (vr[0][w] & 0xffffu) | (vr[1][w] << 16); ov.y = (vr[2][w] & 0xffffu) | (vr[3][w] << 16); }
            else { ov.x = (vr[0][w] >> 16) | (vr[1][w] & 0xffff0000u); ov.y = (vr[2][w] >> 16) | (vr[3][w] & 0xffff0000u); }
            *(u32x2*)(Vs + (4 * dg + di) * LDA + 4 * sg) = ov;
        }
    }
    __syncthreads();
    f32x4 acc[2][4];
#pragma unroll
    for (int m = 0; m < 2; ++m)
#pragma unroll
        for (int nd = 0; nd < 4; ++nd) acc[m][nd] = (f32x4){0.f, 0.f, 0.f, 0.f};
#pragma unroll
    for (int ks = 0; ks < 4; ++ks) {
        bf16x8 wf[2], vf[4];
#pragma unroll
        for (int m = 0; m < 2; ++m) wf[m] = *(const bf16x8*)(Ws + (32 * wid + 16 * m + fr) * LDA + ks * 32 + fq * 8);
#pragma unroll
        for (int nd = 0; nd < 4; ++nd) vf[nd] = *(const bf16x8*)(Vs + (16 * nd + fr) * LDA + ks * 32 + fq * 8);
#pragma unroll
        for (int m = 0; m < 2; ++m)
#pragma unroll
            for (int nd = 0; nd < 4; ++nd) acc[m][nd] = __builtin_amdgcn_mfma_f32_16x16x32_bf16(vf[nd], wf[m], acc[m][nd], 0, 0, 0);
    }
#pragma unroll
    for (int m = 0; m < 2; ++m) {
        const int t = 32 * wid + 16 * m + fr;
        const size_t row = (size_t)n * 128 + t;
        const float bias = bs[t];
#pragma unroll
        for (int nd = 0; nd < 4; ++nd) {
            const int c = h * 64 + 16 * nd + 4 * fq;
            const u32x2 uu = *(const u32x2*)(P + row * INW + c);
            u32x2 pk;
            pk.x = pk2(bflo(uu.x) * (acc[m][nd][0] + bias), bfhi(uu.x) * (acc[m][nd][1] + bias));
            pk.y = pk2(bflo(uu.y) * (acc[m][nd][2] + bias), bfhi(uu.y) * (acc[m][nd][3] + bias));
            *(u32x2*)(Y + row * D + c) = pk;
        }
    }
}

__device__ __forceinline__ int hg_pos(int I, int ii) { return 32 * (I >> 1) + 4 * (I & 1) + 8 * (ii >> 2) + (ii & 3); }
__device__ __forceinline__ void hgrn_state_unit(const Params& p, int l, int u, unsigned char* smem) {
    const bf16_t* P = (const bf16_t*)(p.ws + WS_P);
    const float* LF = (const float*)(p.ws + WS_LF);
    bf16_t* SST = (bf16_t*)(p.ws + WS_OFB);
    const int b = u >> 3, h = (u >> 1) & 3, dir = u & 1;
    const int tid = otid(), lane = tid & 63, wid = tid >> 6, fr = lane & 15, fq = lane >> 4;
    const int k = lane, I = wid;
    bf16_t* KT = (bf16_t*)smem;
    bf16_t* VT = KT + 64 * LDT;
    float* Tsub = (float*)(VT + 64 * LDT);
    float* Etot = Tsub + 256;
    f32x4 sacc[4];
#pragma unroll
    for (int nk = 0; nk < 4; ++nk) sacc[nk] = (f32x4){0.f, 0.f, 0.f, 0.f};
    float lf[16], vv[16];
    auto mcof = [&](int j) { return dir == 0 ? (j < 4 ? 256 + b * 4 + j : b * 32 + (j - 4)) : (j < 4 ? 256 + b * 4 + (3 - j) : b * 32 + (35 - j)); };
    auto gload = [&](int j) {
        const int mc = mcof(j);
#pragma unroll
        for (int ii = 0; ii < 16; ++ii) {
            const int tau = 16 * I + ii;
            const size_t row = (size_t)mc * 64 + (dir ? 63 - tau : tau);
            lf[ii] = LF[row * LFW + dir * 256 + h * 64 + k];
            vv[ii] = bf2f(P[row * INW + OFF_HV + h * 64 + k]);
        }
    };
    gload(0);
    for (int j = 0; j < 36; ++j) {
        float c[16];
        c[0] = lf[0];
#pragma unroll
        for (int ii = 1; ii < 16; ++ii) c[ii] = c[ii - 1] + lf[ii];
        Tsub[I * 64 + k] = c[15];
        __syncthreads();
        float Rs = 0.f;
#pragma unroll
        for (int M = 1; M < 4; ++M) Rs += (M > I) ? Tsub[M * 64 + k] : 0.f;
        if (I == 0) Etot[k] = __expf(c[15] + Rs);
#pragma unroll
        for (int g = 0; g < 4; ++g) {
            float kh[4];
#pragma unroll
            for (int jj = 0; jj < 4; ++jj) { const int ii = 4 * g + jj; kh[jj] = (1.f - __expf(lf[ii])) * __expf(c[15] - c[ii] + Rs); }
            u32x2 kw; kw.x = pk2(kh[0], kh[1]); kw.y = pk2(kh[2], kh[3]);
            u32x2 vw; vw.x = pk2(vv[4 * g], vv[4 * g + 1]); vw.y = pk2(vv[4 * g + 2], vv[4 * g + 3]);
            const int pos = hg_pos(I, 4 * g);
            *(u32x2*)(KT + k * LDT + pos) = kw;
            *(u32x2*)(VT + k * LDT + pos) = vw;
        }
        const int mc = mcof(j);
        {
            bf16_t* dst = SST + ((size_t)(mc * 4 + h) * 2 + dir) * 4096;
#pragma unroll
            for (int nk = 0; nk < 4; ++nk)
#pragma unroll
                for (int r = 0; r < 4; ++r) dst[(16 * wid + 4 * fq + r) * 64 + 16 * nk + fr] = f2bf(sacc[nk][r]);
        }
        if (j + 1 < 36) gload(j + 1);
        __builtin_amdgcn_sched_barrier(0);
        __syncthreads();
        bf16x8 vf[2];
#pragma unroll
        for (int ks = 0; ks < 2; ++ks) vf[ks] = *(const bf16x8*)(VT + (16 * wid + fr) * LDT + 32 * ks + 8 * fq);
#pragma unroll
        for (int nk = 0; nk < 4; ++nk) {
            const float e = Etot[16 * nk + fr];
            sacc[nk] = sacc[nk] * e;
#pragma unroll
            for (int ks = 0; ks < 2; ++ks) {
                const bf16x8 kf = *(const bf16x8*)(KT + (16 * nk + fr) * LDT + 32 * ks + 8 * fq);
                sacc[nk] = __builtin_amdgcn_mfma_f32_16x16x32_bf16(vf[ks], kf, sacc[nk], 0, 0, 0);
            }
        }
        __syncthreads();
    }
}

__device__ __forceinline__ void hgrn_out_unit(const Params& p, int l, int u, unsigned char* smem) {
    const bf16_t* P = (const bf16_t*)(p.ws + WS_P);
    const float* LF = (const float*)(p.ws + WS_LF);
    const bf16_t* SST = (const bf16_t*)(p.ws + WS_OFB);
    bf16_t* Y = (bf16_t*)(p.ws + WS_Y);
    const float* hw = p.in[13] + l * 64;
    const int mc = u >> 2, h = u & 3;
    const int tid = otid(), lane = tid & 63, wid = tid >> 6, fr = lane & 15, fq = lane >> 4;
    const int k = lane, I = wid;
    bf16_t* QT0 = (bf16_t*)smem;
    bf16_t* KD = QT0 + 64 * LDT;
    bf16_t* KO = KD + 64 * LDT;
    bf16_t* QS = KO + 64 * LDT;
    bf16_t* QT1 = QS + 64 * LDT;
    bf16_t* QT2 = QT1 + 32 * LDT;
    bf16_t* VT = QT2 + 16 * LDT;
    float* Tsub = (float*)(VT + 64 * LDT);
    float* SSQ = Tsub + 256;
    f32x4 om[4];
#pragma unroll 1
    for (int dd = 0; dd < 2; ++dd) {
        const int dir = 1 - dd;
        float lf[16], c[16];
#pragma unroll
        for (int ii = 0; ii < 16; ++ii) {
            const int tau = 16 * I + ii;
            const size_t row = (size_t)mc * 64 + (dir ? 63 - tau : tau);
            lf[ii] = LF[row * LFW + dir * 256 + h * 64 + k];
        }
        c[0] = lf[0];
#pragma unroll
        for (int ii = 1; ii < 16; ++ii) c[ii] = c[ii - 1] + lf[ii];
        Tsub[I * 64 + k] = c[15];
        __syncthreads();
        const float T0 = Tsub[k], T1 = Tsub[64 + k], T2 = Tsub[128 + k];
        const float pre = (I > 0 ? T0 : 0.f) + (I > 1 ? T1 : 0.f) + (I > 2 ? T2 : 0.f);
        const float epre = __expf(pre);
        const float g1 = __expf(I == 2 ? T1 : T2);
        const float g2 = __expf(T1 + T2);
#pragma unroll
        for (int g = 0; g < 4; ++g) {
            float vq[4];
#pragma unroll
            for (int jj = 0; jj < 4; ++jj) {
                const int ii = 4 * g + jj, tau = 16 * I + ii;
                const size_t row = (size_t)mc * 64 + (dir ? 63 - tau : tau);
                const float q = bf2f(P[row * INW + OFF_C + h * 64 + k]);
                vq[jj] = bf2f(P[row * INW + OFF_HV + h * 64 + k]);
                const float qt = q * __expf(c[ii]);
                const float kk = 1.f - __expf(lf[ii]);
                QT0[tau * LDT + k] = f2bf(qt);
                QS[tau * LDT + k] = f2bf(qt * epre);
                KD[tau * LDT + k] = f2bf(kk * __expf(fminf(-c[ii], 80.f)));
                KO[tau * LDT + k] = f2bf(kk * __expf(c[15] - c[ii]));
                if (I >= 2) QT1[(tau - 32) * LDT + k] = f2bf(qt * g1);
                if (I == 3) QT2[(tau - 48) * LDT + k] = f2bf(qt * g2);
            }
            u32x2 vw; vw.x = pk2(vq[0], vq[1]); vw.y = pk2(vq[2], vq[3]);
            *(u32x2*)(VT + k * LDT + hg_pos(I, 4 * g)) = vw;
        }
        bf16x8 stf[2];
        {
            const bf16_t* src = SST + ((size_t)(mc * 4 + h) * 2 + dir) * 4096 + (16 * wid + fr) * 64 + 8 * fq;
            stf[0] = *(const bf16x8*)(src); stf[1] = *(const bf16x8*)(src + 32);
        }
        __syncthreads();
        bf16x8 vf[2];
#pragma unroll
        for (int ks = 0; ks < 2; ++ks) vf[ks] = *(const bf16x8*)(VT + (16 * wid + fr) * LDT + 32 * ks + 8 * fq);
        f32x4 o[4];
#pragma unroll
        for (int I2 = 0; I2 < 4; ++I2) {
            f32x4 A[4];
#pragma unroll
            for (int J = 0; J < 4; ++J) {
                A[J] = (f32x4){0.f, 0.f, 0.f, 0.f};
                if (J <= I2) {
                    const bf16_t* kbase = (J == I2 ? KD : KO) + (16 * J + fr) * LDT + 8 * fq;
                    const bf16_t* qbase = (I2 - J <= 1) ? (QT0 + (16 * I2 + fr) * LDT) : ((I2 - J == 2) ? (QT1 + (16 * I2 - 32 + fr) * LDT) : (QT2 + fr * LDT));
#pragma unroll
                    for (int ks = 0; ks < 2; ++ks) {
                        const bf16x8 kf = *(const bf16x8*)(kbase + 32 * ks);
                        const bf16x8 qf = *(const bf16x8*)(qbase + 32 * ks + 8 * fq);
                        A[J] = __builtin_amdgcn_mfma_f32_16x16x32_bf16(kf, qf, A[J], 0, 0, 0);
                    }
                    if (J == I2) {
#pragma unroll
                        for (int r = 0; r < 4; ++r) A[J][r] = (4 * fq + r <= fr) ? A[J][r] : 0.f;
                    }
                }
            }
            o[I2] = (f32x4){0.f, 0.f, 0.f, 0.f};
#pragma unroll
            for (int ks = 0; ks < 2; ++ks) {
                if (2 * ks <= I2) {
                    u32x4 pw;
                    pw.x = pk2(A[2 * ks][0], A[2 * ks][1]); pw.y = pk2(A[2 * ks][2], A[2 * ks][3]);
                    pw.z = pk2(A[2 * ks + 1][0], A[2 * ks + 1][1]); pw.w = pk2(A[2 * ks + 1][2], A[2 * ks + 1][3]);
                    o[I2] = __builtin_amdgcn_mfma_f32_16x16x32_bf16(vf[ks], __builtin_bit_cast(bf16x8, pw), o[I2], 0, 0, 0);
                }
                const bf16x8 qsf = *(const bf16x8*)(QS + (16 * I2 + fr) * LDT + 32 * ks + 8 * fq);
                o[I2] = __builtin_amdgcn_mfma_f32_16x16x32_bf16(stf[ks], qsf, o[I2], 0, 0, 0);
            }
        }
        if (dir == 1) {
            const int src = (lane & 48) | (15 - fr);
#pragma unroll
            for (int Im = 0; Im < 4; ++Im)
#pragma unroll
                for (int r = 0; r < 4; ++r) om[Im][r] = __shfl(o[3 - Im][r], src);
        } else {
#pragma unroll
            for (int Im = 0; Im < 4; ++Im) om[Im] = om[Im] + o[Im];
        }
        __syncthreads();
    }
#pragma unroll
    for (int Im = 0; Im < 4; ++Im) {
        float s = om[Im][0] * om[Im][0] + om[Im][1] * om[Im][1] + om[Im][2] * om[Im][2] + om[Im][3] * om[Im][3];
        s += __shfl_xor(s, 16); s += __shfl_xor(s, 32);
        if (fq == 0) SSQ[wid * 64 + 16 * Im + fr] = s;
    }
    __syncthreads();
    const f32x4 wv = *(const f32x4*)(hw + 16 * wid + 4 * fq);
#pragma unroll
    for (int Im = 0; Im < 4; ++Im) {
        const int i = 16 * Im + fr;
        const float tot = SSQ[i] + SSQ[64 + i] + SSQ[128 + i] + SSQ[192 + i];
        const float rstd = rsqrtf(tot * (1.f / 64.f) + EPS);
        const size_t row = (size_t)mc * 64 + i;
        const u32x2 gg = *(const u32x2*)(P + row * INW + OFF_G + h * 64 + 16 * wid + 4 * fq);
        u32x2 pk;
        pk.x = pk2(om[Im][0] * rstd * wv[0] * bflo(gg.x), om[Im][1] * rstd * wv[1] * bfhi(gg.x));
        pk.y = pk2(om[Im][2] * rstd * wv[2] * bflo(gg.y), om[Im][3] * rstd * wv[3] * bfhi(gg.y));
        *(u32x2*)(Y + row * D + 768 + h * 64 + 16 * wid + 4 * fq) = pk;
    }
}

__device__ void phase_mix1(const Params& p, int l, unsigned char* smem, int rep) {
    unsigned* ctr = (unsigned*)(p.ws + WS_CTL) + 128 + l * 2 + rep * 4;
    const int n_attn = (l == 0) ? 1152 : 1024, n_mixa = (l == 0) ? 576 : 512;
    const int total = 64 + n_attn + n_mixa;
    for (;;) {
        const int u = next_unit(ctr, smem);
        if (u >= total) break;
        if (u < 64) hgrn_state_unit(p, l, u, smem);
        else if (u < 64 + n_attn) attn_unit(p, u - 64, smem);
        else mixa_unit(p, l, u - 64 - n_attn, smem);
    }
}
__device__ void phase_mix2(const Params& p, int l, unsigned char* smem, int rep) {
    unsigned* ctr = (unsigned*)(p.ws + WS_CTL) + 128 + l * 2 + 1 + rep * 4;
    const int total = ((l == 0) ? 288 : 256) * 4;
    for (;;) {
        const int u = next_unit(ctr, smem);
        if (u >= total) break;
        hgrn_out_unit(p, l, u, smem);
    }
}

__device__ void phase_out(const Params& p, int l, unsigned char* smem) {
    const float* tab = (const float*)(p.ws + WS_TAB);
    const bf16_t* Y = (const bf16_t*)(p.ws + WS_Y);
    float* X1 = (float*)(p.ws + WS_X1);
    const float* X2 = (const float*)(p.ws + WS_X2);
    const bf16_t* W = (const bf16_t*)(p.ws + WS_WOUT) + (size_t)l * D * D;
    const int tid = otid(), lane = tid & 63, wid = tid >> 6, wr = wid >> 1, wc = wid & 1, fr = lane & 15, fq = lane >> 4;
    const int nrows = (l == 0) ? R : RL;
    constexpr int WM = 6, BMt = 32 * WM;
    const int nMT = (nrows + BMt - 1) / BMt, nNT = D / BN;
    for (int it = 0;; ++it) {
        int mt, nt;
        if (!xcd_unit(it, nMT, nNT, mt, nt, smem)) break;
        const int row0 = mt * BMt, col0 = nt * BN;
        f32x4 acc[WM][4];
        auto arow = [&](int i) { return (unsigned)((row0 + i) * D); };
        gemm_tile_dma<WM>(Y, arow, W + col0, D, D, smem, acc);
#pragma unroll
        for (int m = 0; m < WM; ++m) {
            const int row = row0 + wr * (16 * WM) + m * 16 + fr;
            const int mr = row_modrow(row);
            const float* g1 = tab + TAB_MOD + (l * 9 + mr) * 6144 + 2 * 1024;
            const float* xin = (l == 0) ? (row < RL ? p.in[0] + (size_t)row * D : p.in[2] + (size_t)(row - RL) * D) : X2 + (size_t)row * D;
#pragma unroll
            for (int n = 0; n < 4; ++n) {
                const int col = col0 + wc * 64 + n * 16 + fq * 4;
                const f32x4 xv = *(const f32x4*)(xin + col), gv = *(const f32x4*)(g1 + col);
                *(f32x4*)(X1 + (size_t)row * D + col) = xv + gv * acc[m][n];
            }
        }
    }
}

__device__ void phase_route(const Params& p, int l, unsigned char* smem) {
    const float* tab = (const float*)(p.ws + WS_TAB);
    bf16_t* H = (bf16_t*)(p.ws + WS_H);
    const float* X1 = (const float*)(p.ws + WS_X1);
    int* rt = (int*)(p.ws + WS_RT);
    unsigned* ctl = (unsigned*)(p.ws + WS_CTL);
    const float* nw = p.in[15] + l * 1024;
    const float* wg = p.in[16] + (size_t)l * 1024 * 4;
    const float* bg = p.in[17] + l * 4;
    const float* we = p.in[18] + (size_t)l * 1024 * 32;
    const float* be = p.in[19] + l * 32;
    const int tid = otid(), lane = tid & 63, wid = tid >> 6, wr = wid >> 1, wc = wid & 1, fr = lane & 15, fq = lane >> 4;
    const int nrows = (l == 0) ? R : RL;
    float* Ls = (float*)smem;
    constexpr int BM = 64;
    for (int u = obid(); u < nrows / BM; u += gridDim.x) {
        const int row0 = u * BM;
        {
            const int mr = row_modrow(row0);
            const float* sh = tab + TAB_MOD + (l * 9 + mr) * 6144 + 3 * 1024;
            const float* scv = sh + 1024;
            f32x4 ma[4], mb[4];
#pragma unroll
            for (int j = 0; j < 4; ++j) {
                const int k = 4 * lane + 256 * j;
                ma[j] = *(const f32x4*)(nw + k) * (1.f + *(const f32x4*)(scv + k)); mb[j] = *(const f32x4*)(sh + k);
            }
#pragma unroll 1
            for (int rb = 0; rb < 4; ++rb) {
                const int rowb = row0 + wid * 16 + rb * 4;
                f32x4 v[4][4];
#pragma unroll
                for (int q = 0; q < 4; ++q)
#pragma unroll
                    for (int j = 0; j < 4; ++j) v[q][j] = *(const f32x4*)(X1 + (size_t)(rowb + q) * D + 4 * lane + 256 * j);
                float ss[4];
#pragma unroll
                for (int q = 0; q < 4; ++q) {
                    ss[q] = 0.f;
#pragma unroll
                    for (int j = 0; j < 4; ++j) ss[q] += (v[q][j].x * v[q][j].x + v[q][j].y * v[q][j].y) + (v[q][j].z * v[q][j].z + v[q][j].w * v[q][j].w);
                }
#pragma unroll
                for (int o = 1; o < 64; o <<= 1) {
#pragma unroll
                    for (int q = 0; q < 4; ++q) ss[q] += __shfl_xor(ss[q], o);
                }
#pragma unroll
                for (int q = 0; q < 4; ++q) {
                    const float rstd = rsqrtf(ss[q] * (1.f / D) + EPS);
#pragma unroll
                    for (int j = 0; j < 4; ++j) {
                        const f32x4 o = v[q][j] * rstd * ma[j] + mb[j];
                        u32x2 pk; pk.x = pk2(o.x, o.y); pk.y = pk2(o.z, o.w);
                        *(u32x2*)(H + (size_t)(rowb + q) * D + 4 * lane + 256 * j) = pk;
                    }
                }
            }
        }
        asm volatile("s_waitcnt vmcnt(0)" ::: "memory");
        __syncthreads();
        {
            const bf16_t* WRl = (const bf16_t*)(p.ws + WS_WR) + (size_t)l * 48 * 1024;
            f32x4 acc[4][3];
#pragma unroll
            for (int m = 0; m < 4; ++m)
#pragma unroll
                for (int n = 0; n < 3; ++n) acc[m][n] = (f32x4){0.f, 0.f, 0.f, 0.f};
            const bf16_t* ap = H + (size_t)(row0 + fr) * D + wid * 256 + fq * 8;
            const bf16_t* bp = WRl + (size_t)fr * 1024 + wid * 256 + fq * 8;
#pragma unroll
            for (int kh = 0; kh < 2; ++kh) {
                bf16x8 af[4][4], bf[4][3];
#pragma unroll
                for (int ks = 0; ks < 4; ++ks) {
#pragma unroll
                    for (int m = 0; m < 4; ++m) af[ks][m] = *(const bf16x8*)(ap + (size_t)m * 16 * D + (kh * 4 + ks) * 32);
#pragma unroll
                    for (int n = 0; n < 3; ++n) bf[ks][n] = *(const bf16x8*)(bp + (size_t)n * 16 * 1024 + (kh * 4 + ks) * 32);
                }
#pragma unroll
                for (int ks = 0; ks < 4; ++ks)
#pragma unroll
                    for (int m = 0; m < 4; ++m)
#pragma unroll
                        for (int n = 0; n < 3; ++n) acc[m][n] = __builtin_amdgcn_mfma_f32_16x16x32_bf16(bf[ks][n], af[ks][m], acc[m][n], 0, 0, 0);
            }
            float* Lp = (float*)smem + wid * (64 * 48);
#pragma unroll
            for (int m = 0; m < 4; ++m)
#pragma unroll
                for (int n = 0; n < 3; ++n) *(f32x4*)(Lp + (m * 16 + fr) * 48 + n * 16 + fq * 4) = acc[m][n];
        }
        __syncthreads();
        unsigned* lcnt = (unsigned*)(smem + 49152);
        if (tid < 32) lcnt[tid] = 0u;
        int dec_ea = 0, dec_eb = 0, dec_la = 0, dec_lb = 0; float dec_ga = 0.f, dec_gb = 0.f;
        __syncthreads();
        if (tid < BM) {
            const int row = row0 + tid;
            const float* lp = (const float*)smem + tid * 48;
            float lg[36];
#pragma unroll
            for (int i = 0; i < 36; ++i) lg[i] = (lp[i] + lp[64 * 48 + i]) + (lp[2 * 64 * 48 + i] + lp[3 * 64 * 48 + i]);
            float gl[4];
#pragma unroll
            for (int i = 0; i < 4; ++i) gl[i] = lg[i] + bg[i];
            int grp = 0; float gm = gl[0];
#pragma unroll
            for (int i = 1; i < 4; ++i) if (gl[i] > gm) { gm = gl[i]; grp = i; }
            float gs = 0.f;
#pragma unroll
            for (int i = 0; i < 4; ++i) gs += expf(gl[i] - gm);
            const float pgrp = 1.f / gs;
            float ev[8];
#pragma unroll
            for (int i = 0; i < 8; ++i) {
                float x = lg[4 + i];
#pragma unroll
                for (int g = 1; g < 4; ++g) x = (grp == g) ? lg[4 + g * 8 + i] : x;
                ev[i] = x + be[grp * 8 + i];
            }
            int i0 = 0; float v0 = ev[0];
#pragma unroll
            for (int i = 1; i < 8; ++i) if (ev[i] > v0) { v0 = ev[i]; i0 = i; }
            int i1 = -1; float v1 = -3.0e38f;
#pragma unroll
            for (int i = 0; i < 8; ++i) if (i != i0 && ev[i] > v1) { v1 = ev[i]; i1 = i; }
            const float e1 = expf(v1 - v0);
            const float ga = pgrp / (1.f + e1), gb = pgrp * e1 / (1.f + e1);
            const int ea = grp * 8 + i0, eb = grp * 8 + i1;
            dec_ea = ea; dec_eb = eb; dec_ga = ga; dec_gb = gb;
            dec_la = (int)atomicAdd(&lcnt[ea], 1u);
            dec_lb = (int)atomicAdd(&lcnt[eb], 1u);
        }
        __syncthreads();
        if (tid < 32) { const unsigned c = lcnt[tid]; lcnt[32 + tid] = c ? atomicAdd(&ctl[cur_idx(l, tid)], c) : 0u; }
        __syncthreads();
        if (tid < BM) {
            const int row = row0 + tid;
            const int sa = (int)lcnt[32 + dec_ea] + dec_la, sb = (int)lcnt[32 + dec_eb] + dec_lb;
            rt[row * 2] = dec_ea; rt[row * 2 + 1] = dec_eb;
            rt[2 * R + row * 2] = sa; rt[2 * R + row * 2 + 1] = sb;
            ((float*)rt)[4 * R + row * 2] = dec_ga; ((float*)rt)[4 * R + row * 2 + 1] = dec_gb;
            rt[6 * R + dec_ea * R + sa] = row;
            rt[6 * R + dec_eb * R + sb] = row;
        }
        __syncthreads();
    }
}

constexpr int MOE_WM = 6, MOE_BM = 32 * MOE_WM;
__device__ __forceinline__ void moe_units(const Params& p, int l, int* s_cnt, int* s_base, int* s_tpre) {
    const unsigned* ctl = (const unsigned*)(p.ws + WS_CTL);
    if (otid() == 0) {
        int base = 0, tp = 0;
        for (int e = 0; e < NEXP; ++e) {
            const int c = (int)ctl[cur_idx(l, e)];
            s_cnt[e] = c; s_base[e] = base; s_tpre[e] = tp;
            base += c; tp += (c + MOE_BM - 1) / MOE_BM;
        }
        s_tpre[NEXP] = tp;
    }
    __syncthreads();
}

__device__ void phase_moe1(const Params& p, int l, unsigned char* smem) {
    int* s_cnt = (int*)(smem + 73728);
    int* s_base = s_cnt + 32;
    int* s_tpre = s_base + 32;
    moe_units(p, l, s_cnt, s_base, s_tpre);
    const bf16_t* H = (const bf16_t*)(p.ws + WS_H);
    bf16_t* HM = (bf16_t*)(p.ws + WS_LF);
    const int* list = (const int*)(p.ws + WS_RT) + 6 * R;
    const float* W1 = p.in[20] + (size_t)l * NEXP * D * FF;
    const float* W3 = p.in[21] + (size_t)l * NEXP * D * FF;
    const int tid = otid(), lane = tid & 63, wid = tid >> 6, wr = wid >> 1, wc = wid & 1, fr = lane & 15, fq = lane >> 4;
    const int ntiles = s_tpre[NEXP];
    constexpr int nNT = FF / 64;
    for (int it = 0;; ++it) {
        int tg, nt;
        if (!xcd_unit(it, ntiles, nNT, tg, nt, smem)) break;
        int e = 0;
        while (s_tpre[e + 1] <= tg) ++e;
        const int mt = tg - s_tpre[e], cnt = s_cnt[e], base = s_base[e];
        const float* w1 = W1 + (size_t)e * D * FF;
        const float* w3 = W3 + (size_t)e * D * FF;
        const int* lst = list + (size_t)e * R;
        f32x4 acc[MOE_WM][4];
        auto arow = [&](int i) { int s = mt * MOE_BM + i; s = s < cnt ? s : cnt - 1; return (unsigned)(lst[s] * D); };
        auto bptr = [&](int k, int rho) {
            const int n = (rho >> 4) & 3;
            const int col = nt * 64 + (rho >> 6) * 32 + (n & 1) * 16 + (rho & 15);
            return ((n >= 2) ? w3 : w1) + (size_t)k * FF + col;
        };
        gemm_tile<MOE_WM, 1>(H, arow, bptr, D, smem, acc);
#pragma unroll
        for (int m = 0; m < MOE_WM; ++m) {
            const int s = mt * MOE_BM + wr * (16 * MOE_WM) + m * 16 + fr;
            if (s < cnt) {
#pragma unroll
                for (int n = 0; n < 2; ++n) {
                    float hv[4];
#pragma unroll
                    for (int j = 0; j < 4; ++j) hv[j] = siluf_(acc[m][n][j]) * acc[m][n + 2][j];
                    u32x2 pk; pk.x = pk2(hv[0], hv[1]); pk.y = pk2(hv[2], hv[3]);
                    *(u32x2*)(HM + (size_t)(base + s) * FF + nt * 64 + wc * 32 + n * 16 + fq * 4) = pk;
                }
            }
        }
    }
}

__device__ void phase_moe2(const Params& p, int l, unsigned char* smem) {
    int* s_cnt = (int*)(smem + 73728);
    int* s_base = s_cnt + 32;
    int* s_tpre = s_base + 32;
    moe_units(p, l, s_cnt, s_base, s_tpre);
    const bf16_t* HM = (const bf16_t*)(p.ws + WS_LF);
    bf16_t* OUTM = (bf16_t*)(p.ws + WS_P);
    const float* W2 = p.in[22] + (size_t)l * NEXP * FF * D;
    const int tid = otid(), lane = tid & 63, wid = tid >> 6, wr = wid >> 1, wc = wid & 1, fr = lane & 15, fq = lane >> 4;
    const int ntiles = s_tpre[NEXP];
    constexpr int nNT = D / BN;
    for (int it = 0;; ++it) {
        int tg, nt;
        if (!xcd_unit(it, ntiles, nNT, tg, nt, smem)) break;
        int e = 0;
        while (s_tpre[e + 1] <= tg) ++e;
        const int mt = tg - s_tpre[e], cnt = s_cnt[e], base = s_base[e];
        const float* w2 = W2 + (size_t)e * FF * D;
        f32x4 acc[MOE_WM][4];
        auto arow = [&](int i) { int s = mt * MOE_BM + i; s = s < cnt ? s : cnt - 1; return (unsigned)((base + s) * FF); };
        auto bptr = [&](int k, int n) { return w2 + (size_t)k * D + nt * BN + n; };
        gemm_tile<MOE_WM, 1>(HM, arow, bptr, FF, smem, acc);
#pragma unroll
        for (int m = 0; m < MOE_WM; ++m) {
            const int s = mt * MOE_BM + wr * (16 * MOE_WM) + m * 16 + fr;
            if (s < cnt) {
#pragma unroll
                for (int n = 0; n < 4; ++n) {
                    u32x2 pk; pk.x = pk2(acc[m][n][0], acc[m][n][1]); pk.y = pk2(acc[m][n][2], acc[m][n][3]);
                    *(u32x2*)(OUTM + (size_t)(base + s) * D + nt * BN + wc * 64 + n * 16 + fq * 4) = pk;
                }
            }
        }
    }
}

#define XB_TMO      128
#define XB_XCNT(j)  (256  + 64 * (j))
#define XB_XSUB(j)  (1280 + 64 * (j))
#define XB_XGEN(j)  (2304 + 64 * (j))
#define XB_TOP      3328
#define XB_TOPGEN   3392
#define XCD_BAR_WORDS 3456
#define XB_SPIN_CAP (1u << 22)
#define LAS __attribute__((address_space(3)))
__device__ __forceinline__ unsigned xb_ld(unsigned* p)              { return __hip_atomic_load(p, __ATOMIC_RELAXED, __HIP_MEMORY_SCOPE_AGENT); }
__device__ __forceinline__ unsigned xb_add(unsigned* p, unsigned v) { return __hip_atomic_fetch_add(p, v, __ATOMIC_RELAXED, __HIP_MEMORY_SCOPE_AGENT); }
__device__ __forceinline__ unsigned xb_xcc_id() { return (unsigned)__builtin_amdgcn_s_getreg((3 << 11) | 20) & 0xFu; }
#define XB_SPIN(cond, bar) do { unsigned _sp = 0; while (cond) { __builtin_amdgcn_s_sleep(1); \
    if ((++_sp & 255u) == 0u) { if (xb_ld(&(bar)[XB_TMO])) break; if (_sp > XB_SPIN_CAP) { atomicAdd(&(bar)[XB_TMO], 1u); break; } } } } while (0)
struct XcdBarrier { unsigned* bar; unsigned x; volatile unsigned* st; };
__device__ __forceinline__ XcdBarrier xcd_barrier_post(unsigned* bar, volatile unsigned* st, volatile int* xinfo) {
    XcdBarrier b; b.bar = bar; b.x = xb_xcc_id(); b.st = st;
    if (threadIdx.x == 0) { const unsigned r = xb_add(&bar[XB_XCNT(b.x)], 1u); xinfo[0] = 0; xinfo[1] = (int)b.x; xinfo[2] = (int)r; xinfo[3] = 0; }
    return b;
}
__device__ __forceinline__ void xcd_barrier_complete(unsigned* bar, unsigned x, unsigned& nloc, unsigned& nx) {
    const unsigned G = gridDim.x * gridDim.y * gridDim.z;
    unsigned sum, cnt, mine, sp = 0u;
    for (;;) {
        sum = 0u; cnt = 0u; mine = 0u;
#pragma unroll
        for (unsigned j = 0; j < 16; ++j) { const unsigned c = xb_ld(&bar[XB_XCNT(j)]); sum += c; cnt += (c > 0u) ? 1u : 0u; mine = (j == x) ? c : mine; }
        if (sum == G) break;
        __builtin_amdgcn_s_sleep(1);
        if ((++sp & 255u) == 0u) { if (xb_ld(&bar[XB_TMO])) break; if (sp > XB_SPIN_CAP) { atomicAdd(&bar[XB_TMO], 1u); break; } }
    }
    nloc = mine > 0u ? mine : 1u; nx = cnt > 0u ? cnt : 1u;
}
__device__ __forceinline__ void xcd_barrier(const XcdBarrier& b) {
    asm volatile("s_waitcnt vmcnt(0)" ::: "memory");
    __syncthreads();
    if (threadIdx.x == 0) {
        unsigned* bar = b.bar;
        __builtin_amdgcn_s_waitcnt(0);
        unsigned nloc = b.st[0], nx = b.st[1];
        if (nloc == 0u) { xcd_barrier_complete(bar, b.x, nloc, nx); b.st[0] = nloc; b.st[1] = nx; }
        const unsigned old = xb_add(&bar[XB_XSUB(b.x)], 1u);
        const unsigned gen = old / nloc;
        if (old + 1u == (gen + 1u) * nloc) {
            __builtin_amdgcn_fence(__ATOMIC_RELEASE, "agent");
            asm volatile("s_waitcnt vmcnt(0)" ::: "memory");
            const unsigned og = xb_add(&bar[XB_TOP], 1u);
            const unsigned tg = og / nx;
            if (og + 1u == (tg + 1u) * nx) xb_add(&bar[XB_TOPGEN], 1u);
            else XB_SPIN(xb_ld(&bar[XB_TOPGEN]) == tg, bar);
            __builtin_amdgcn_fence(__ATOMIC_ACQUIRE, "agent");
            xb_add(&bar[XB_XGEN(b.x)], 1u);
            asm volatile("s_waitcnt vmcnt(0)" ::: "memory");
        } else {
            XB_SPIN(xb_ld(&bar[XB_XGEN(b.x)]) == gen, bar);
            __builtin_amdgcn_fence(__ATOMIC_ACQUIRE, "agent");
            asm volatile("s_waitcnt vmcnt(0)" ::: "memory");
        }
    }
    __syncthreads();
}

constexpr int NPHASES = 18;
#ifndef PROBE_S
#define PROBE_S -1
#define PROBE_REPS 1
#endif
constexpr int SMEM_BYTES = 4 * 64 * LDT * 2 + 4 * 64 * LDT * 2 + 1024;
__global__ void __launch_bounds__(NTHREADS, 2) mega(Params p) {
    __shared__ __attribute__((aligned(16))) unsigned char smem[SMEM_BYTES];
    cg::grid_group grid = cg::this_grid();
    {
        volatile unsigned* st = (volatile unsigned*)(smem + 73728 + 768);
        if (threadIdx.x < 2) st[threadIdx.x] = 0u;
        __syncthreads();
        volatile int* xinfo = (volatile int*)(smem + 73728 + 800);
        (void)xcd_barrier_post((unsigned*)(p.ws + WS_CTL) + 4096, st, xinfo);
    }
#define GRID_BAR() do { XcdBarrier bar_; bar_.bar = (unsigned*)(p.ws + WS_CTL) + 4096; bar_.x = xb_xcc_id(); bar_.st = (volatile unsigned*)(smem + 73728 + 768); xcd_barrier(bar_); } while (0)
    for (int ph = p.ph_lo; ph < p.ph_hi; ++ph) {
        if (ph == 0) phase_init(p, smem);
        else if (ph == NPHASES - 1) phase_final(p, 1);
        else {
            const int l = (ph - 1) / 8, s = (ph - 1) % 8;
            const int reps = (s == PROBE_S) ? PROBE_REPS : 1;
            for (int rep = 0; rep < reps; ++rep) {
                switch (s) {
                    case 0: phase_prep(p, l); break;
                    case 1: phase_gemm_in(p, l, smem); break;
                    case 2: phase_mix1(p, l, smem, rep); break;
                    case 3: phase_mix2(p, l, smem, rep); break;
                    case 4: phase_out(p, l, smem); break;
                    case 5: phase_route(p, l, smem); break;
                    case 6: phase_moe1(p, l, smem); break;
                    default: phase_moe2(p, l, smem); break;
                }
                if (rep + 1 < reps) GRID_BAR();
            }
        }
        if (ph + 1 < p.ph_hi) {
            if (ph == 0) {
                if (p.ph_hi < 0) grid.sync();
                GRID_BAR();
                if (threadIdx.x == 0) {
                    unsigned* bw = (unsigned*)(p.ws + WS_CTL) + 4096;
                    volatile int* xi = (volatile int*)(smem + 73728 + 800);
                    const unsigned myx = xb_xcc_id();
                    unsigned sum = 0, ok = 1;
                    for (int j = 0; j < 8; ++j) { const unsigned c = xb_ld(&bw[XB_XCNT(j)]); sum += c; ok &= (c > 0u); }
                    xi[3] = (int)xb_ld(&bw[XB_XCNT(myx & 7u)]);
                    xi[0] = (ok && sum == gridDim.x && myx < 8u) ? 1 : 0;
                }
                __syncthreads();
            } else GRID_BAR();
        }
    }
}

extern "C" void kernel_launch(void* const* d_in, const int* in_sizes, int n_in, void* d_out, int out_size, void* d_ws, size_t ws_size, hipStream_t stream) {
    static int grid_blocks = 0;
    if (grid_blocks == 0) {
        if (n_in != 23 || out_size != RL * D || ws_size < WS_END) { fprintf(stderr, "kernel_launch: unexpected shapes (n_in %d out %d ws %zu need %zu)\n", n_in, out_size, ws_size, (size_t)WS_END); grid_blocks = -1; return; }
        int dev = 0, cus = 0, per_cu = 0;
        hipGetDevice(&dev);
        hipDeviceGetAttribute(&cus, hipDeviceAttributeMultiprocessorCount, dev);
        hipOccupancyMaxActiveBlocksPerMultiprocessor(&per_cu, mega, NTHREADS, 0);
        if (per_cu > 2) per_cu = 2;
        if (per_cu < 1) per_cu = 1;
        grid_blocks = cus * per_cu;
    }
    if (grid_blocks < 0) return;
    hipMemsetAsync((char*)d_ws + WS_CTL, 0, 1 * MiB, stream);
    Params p{};
    for (int i = 0; i < 23; ++i) p.in[i] = (const float*)d_in[i];
    p.out = (float*)d_out; p.ws = (unsigned char*)d_ws; p.ph_lo = 0; p.ph_hi = NPHASES;
    void* args[] = {&p};
    hipError_t e = hipLaunchCooperativeKernel((void*)mega, dim3(grid_blocks), dim3(NTHREADS), args, 0, stream);
    if (e != hipSuccess) fprintf(stderr, "cooperative launch failed: %s (grid %d)\n", hipGetErrorString(e), grid_blocks);
}
```

```cpp
#include <hip/hip_runtime.h>
#include <hip/hip_cooperative_groups.h>
#include <cstdio>
#include <cstdint>
namespace cg = cooperative_groups;

constexpr int D = 1024, NB = 8, T = 2048, TC = 256;
constexpr int RL = NB * T, RC = NB * TC, R = RL + RC;
constexpr int INW = 2560, LFW = 512;
constexpr int OFF_B = 512, OFF_KV = 1024, OFF_V = 1152, OFF_C = 1280, OFF_ZF = 1536, OFF_ZB = 1792, OFF_HV = 2048, OFF_G = 2304;
constexpr int NEXP = 32, FF = 512;
constexpr float EPS = 1e-6f;
constexpr int NTHREADS = 256;

constexpr size_t MiB = 1ull << 20;
constexpr size_t WS_CTL = 0;
constexpr size_t WS_TAB = 1 * MiB;
constexpr size_t WS_H = 2 * MiB;
constexpr size_t WS_P = WS_H + 36 * MiB;
constexpr size_t WS_LF = WS_P + 90 * MiB;
constexpr size_t WS_Y = WS_LF + 36 * MiB;
constexpr size_t WS_X1 = WS_Y + 36 * MiB;
constexpr size_t WS_X2 = WS_X1 + 72 * MiB;
constexpr size_t WS_OFB = WS_X2 + 72 * MiB;
constexpr size_t WS_RT = WS_OFB + 18 * MiB;
constexpr size_t WS_WIN = WS_RT + 4 * MiB;
constexpr size_t WS_WOUT = WS_WIN + 10 * MiB;
constexpr size_t WS_WR = WS_WOUT + 4 * MiB;
constexpr size_t WS_END = WS_WR + 1 * MiB;
constexpr int TAB_ROPE = 0;
constexpr int TAB_LB = 2048;
constexpr int TAB_MOD = 4096;

typedef unsigned short bf16_t;
typedef short bf16x8 __attribute__((ext_vector_type(8)));
typedef float f32x4 __attribute__((ext_vector_type(4)));
typedef float f32x2 __attribute__((ext_vector_type(2)));
typedef unsigned u32x4 __attribute__((ext_vector_type(4)));
typedef unsigned u32x2 __attribute__((ext_vector_type(2)));
typedef __bf16 bf16x2_t __attribute__((ext_vector_type(2)));

struct Params {
    const float* in[23];
    float* out;
    unsigned char* ws;
    int ph_lo, ph_hi;
};

__device__ __forceinline__ unsigned pk2(float lo, float hi) { f32x2 v = {lo, hi}; bf16x2_t b = __builtin_convertvector(v, bf16x2_t); return __builtin_bit_cast(unsigned, b); }
__device__ __forceinline__ bf16_t f2bf(float f) { return (bf16_t)(pk2(f, 0.f) & 0xffffu); }
__device__ __forceinline__ float bf2f(bf16_t u) { return __uint_as_float(((unsigned)u) << 16); }
__device__ __forceinline__ float bflo(unsigned w) { return __uint_as_float(w << 16); }
__device__ __forceinline__ float bfhi(unsigned w) { return __uint_as_float(w & 0xffff0000u); }
__device__ __forceinline__ float wave_sum(float v) {
#pragma unroll
    for (int o = 1; o < 64; o <<= 1) v += __shfl_xor(v, o);
    return v;
}
__device__ __forceinline__ float sigmoidf_(float x) { return __builtin_amdgcn_rcpf(1.f + __expf(-x)); }
__device__ __forceinline__ float siluf_(float x) { return x * sigmoidf_(x); }
__device__ __forceinline__ float gelu_tanh(float x) {
    const float u = 0.7978845608028654f * (x + 0.044715f * x * x * x);
    return x * __builtin_amdgcn_rcpf(1.f + __expf(-2.f * u));
}
__device__ __forceinline__ int otid() { int t = threadIdx.x; asm volatile("" : "+v"(t)); return t; }
__device__ __forceinline__ int obid() { int t = blockIdx.x; asm volatile("" : "+s"(t)); return t; }
__device__ __forceinline__ int cur_idx(int l, int e) { return 8192 + (l * 32 + e) * 64; }
__device__ __forceinline__ int row_modrow(int row) { return row < RL ? (row >> 11) : 8; }

__device__ void phase_init(const Params& p, unsigned char* smem) {
    float* tab = (float*)(p.ws + WS_TAB);
    const float* c = p.in[1];
    const float* c_ctx = p.in[3];
    const float* w_mod = p.in[4];
    const float* b_mod = p.in[5];
    float* sc = (float*)smem;
    const int tid = otid();
    for (int i = tid; i < 9 * 1024; i += NTHREADS) {
        const int b = i >> 10, k = i & 1023;
        const float v = (b < 8) ? c[b * 1024 + k] : c_ctx[k];
        sc[i] = siluf_(v);
    }
    __syncthreads();
    float* red = (float*)(smem + 36864);
    for (int it = obid(); it < 384; it += gridDim.x) {
        const int l = it / 192, j0 = (it % 192) * 32;
        const int jj = tid & 31, kg = tid >> 5;
        const float* w = w_mod + (size_t)l * 1024 * 6144 + (size_t)(kg * 128) * 6144 + j0 + jj;
        float acc[9];
#pragma unroll
        for (int b = 0; b < 9; ++b) acc[b] = 0.f;
        for (int k0 = 0; k0 < 128; k0 += 8) {
            float wv[8];
#pragma unroll
            for (int i = 0; i < 8; ++i) wv[i] = w[(size_t)(k0 + i) * 6144];
#pragma unroll
            for (int i = 0; i < 8; ++i)
#pragma unroll
                for (int b = 0; b < 9; ++b) acc[b] += sc[b * 1024 + kg * 128 + k0 + i] * wv[i];
        }
#pragma unroll
        for (int b = 0; b < 9; ++b) red[(kg * 9 + b) * 32 + jj] = acc[b];
        __syncthreads();
        for (int o = tid; o < 9 * 32; o += NTHREADS) {
            const int b = o >> 5, j2 = o & 31;
            float sum = 0.f;
#pragma unroll
            for (int g = 0; g < 8; ++g) sum += red[(g * 9 + b) * 32 + j2];
            tab[TAB_MOD + (l * 9 + b) * 6144 + j0 + j2] = sum + b_mod[l * 6144 + j0 + j2];
        }
        __syncthreads();
    }
    {
        const int gtid = obid() * NTHREADS + tid, gsize = gridDim.x * NTHREADS;
        const float* w_in = p.in[7]; const float* w_out = p.in[14];
        bf16_t* WIN = (bf16_t*)(p.ws + WS_WIN); bf16_t* WOUT = (bf16_t*)(p.ws + WS_WOUT); bf16_t* WR = (bf16_t*)(p.ws + WS_WR);
        for (int i = gtid; i < 2 * 1024 * INW / 4; i += gsize) { const f32x4 v = *(const f32x4*)(w_in + (size_t)i * 4); u32x2 o; o.x = pk2(v[0], v[1]); o.y = pk2(v[2], v[3]); *(u32x2*)(WIN + (size_t)i * 4) = o; }
        for (int i = gtid; i < 2 * 1024 * D / 4; i += gsize) { const f32x4 v = *(const f32x4*)(w_out + (size_t)i * 4); u32x2 o; o.x = pk2(v[0], v[1]); o.y = pk2(v[2], v[3]); *(u32x2*)(WOUT + (size_t)i * 4) = o; }
        for (int i = gtid; i < 2 * 48 * 1024; i += gsize) {
            const int k = i & 1023, n = (i >> 10) % 48, l = i / (48 * 1024);
            float v = 0.f;
            if (n < 4) v = p.in[16][((size_t)l * 1024 + k) * 4 + n];
            else if (n < 36) v = p.in[18][((size_t)l * 1024 + k) * 32 + (n - 4)];
            WR[i] = f2bf(v);
        }
    }
    if (obid() == gridDim.x - 1) {
        for (int i = tid; i < 64 * 16; i += NTHREADS) {
            const int pos = i >> 4, f = i & 15;
            const float inv = 1.0f / powf(10000.0f, (float)(2 * f) / 32.0f);
            const float ang = (float)pos * inv;
            tab[TAB_ROPE + i * 2] = cosf(ang);
            tab[TAB_ROPE + i * 2 + 1] = sinf(ang);
        }
        const float* lbl = p.in[12];
        for (int i = tid; i < 512; i += NTHREADS) {
            const float a0 = lbl[i], a1 = lbl[512 + i];
            const float m = fmaxf(a0, a1);
            const float e0 = expf(a0 - m), e1 = expf(a1 - m);
            const float s1 = e1 / (e0 + e1);
            tab[TAB_LB + i] = 0.f;
            tab[TAB_LB + 512 + i] = s1;
        }
    }
}

__device__ void phase_prep(const Params& p, int l) {
    const float* tab = (const float*)(p.ws + WS_TAB);
    bf16_t* H = (bf16_t*)(p.ws + WS_H);
    const int lane = otid() & 63;
    const int gw = obid() * (NTHREADS / 64) + (otid() >> 6), NGW = gridDim.x * (NTHREADS / 64);
    const float* nw = p.in[6] + l * 1024;
    const int* rt = (const int*)(p.ws + WS_RT);
    int basev = 0;
    if (l > 0) {
        const unsigned* ctl = (const unsigned*)(p.ws + WS_CTL);
        const int cnt = (lane < NEXP) ? (int)ctl[cur_idx(l - 1, lane & 31)] : 0;
        int incl = cnt;
#pragma unroll
        for (int o = 1; o < 32; o <<= 1) { const int t = __shfl_up(incl, o); if (lane >= o) incl += t; }
        basev = incl - cnt;
    }
    auto load_row = [&](int row, f32x4 (&v)[4]) {
        if (l == 0) {
            const float* src = row < RL ? p.in[0] + (size_t)row * D : p.in[2] + (size_t)(row - RL) * D;
#pragma unroll
            for (int j = 0; j < 4; ++j) v[j] = *(const f32x4*)(src + 4 * lane + 256 * j);
        } else {
            const int mr = row_modrow(row);
            const float* X1 = (const float*)(p.ws + WS_X1) + (size_t)row * D;
            const int e0 = rt[row * 2], e1 = rt[row * 2 + 1];
            const int s0 = rt[2 * R + row * 2], s1 = rt[2 * R + row * 2 + 1];
            const float g0 = ((const float*)rt)[4 * R + row * 2], g1 = ((const float*)rt)[4 * R + row * 2 + 1];
            const int base0 = __shfl(basev, e0), base1 = __shfl(basev, e1);
            const bf16_t* O0 = (const bf16_t*)(p.ws + WS_P) + (size_t)(base0 + s0) * D;
            const bf16_t* O1 = (const bf16_t*)(p.ws + WS_P) + (size_t)(base1 + s1) * D;
            const float* g2 = tab + TAB_MOD + ((l - 1) * 9 + mr) * 6144 + 5 * 1024;
            float* X2 = (float*)(p.ws + WS_X2) + (size_t)row * D;
#pragma unroll
            for (int j = 0; j < 4; ++j) {
                const int k = 4 * lane + 256 * j;
                const f32x4 x1 = *(const f32x4*)(X1 + k);
                const u32x2 a = *(const u32x2*)(O0 + k), b = *(const u32x2*)(O1 + k);
                const f32x4 gg = *(const f32x4*)(g2 + k);
                f32x4 m;
                m.x = g0 * bflo(a.x) + g1 * bflo(b.x); m.y = g0 * bfhi(a.x) + g1 * bfhi(b.x);
                m.z = g0 * bflo(a.y) + g1 * bflo(b.y); m.w = g0 * bfhi(a.y) + g1 * bfhi(b.y);
                v[j] = x1 + gg * m;
                *(f32x4*)(X2 + k) = v[j];
            }
        }
    };
    auto store_row = [&](int row, const f32x4 (&v)[4], float ss) {
        const int mr = row_modrow(row);
        const float rstd = rsqrtf(ss * (1.f / D) + EPS);
        const float* sh = tab + TAB_MOD + (l * 9 + mr) * 6144;
        const float* scv = sh + 1024;
#pragma unroll
        for (int j = 0; j < 4; ++j) {
            const int k = 4 * lane + 256 * j;
            const f32x4 w = *(const f32x4*)(nw + k), s = *(const f32x4*)(scv + k), h = *(const f32x4*)(sh + k);
            const f32x4 o = v[j] * rstd * w * (1.f + s) + h;
            u32x2 pk; pk.x = pk2(o.x, o.y); pk.y = pk2(o.z, o.w);
            *(u32x2*)(H + (size_t)row * D + k) = pk;
        }
    };
    for (int row = gw; row < R; row += 3 * NGW) {
        const int r1 = row + NGW, r2 = row + 2 * NGW;
        const bool h1 = r1 < R, h2 = r2 < R;
        f32x4 v0[4], v1[4], v2[4];
        load_row(row, v0);
        if (h1) load_row(r1, v1);
        if (h2) load_row(r2, v2);
        float s0 = 0.f, s1 = 0.f, s2 = 0.f;
#pragma unroll
        for (int j = 0; j < 4; ++j) {
            s0 += (v0[j].x * v0[j].x + v0[j].y * v0[j].y) + (v0[j].z * v0[j].z + v0[j].w * v0[j].w);
            if (h1) s1 += (v1[j].x * v1[j].x + v1[j].y * v1[j].y) + (v1[j].z * v1[j].z + v1[j].w * v1[j].w);
            if (h2) s2 += (v2[j].x * v2[j].x + v2[j].y * v2[j].y) + (v2[j].z * v2[j].z + v2[j].w * v2[j].w);
        }
#pragma unroll
        for (int o = 1; o < 64; o <<= 1) { s0 += __shfl_xor(s0, o); s1 += __shfl_xor(s1, o); s2 += __shfl_xor(s2, o); }
        store_row(row, v0, s0);
        if (h1) store_row(r1, v1, s1);
        if (h2) store_row(r2, v2, s2);
    }
}

__device__ void phase_final(const Params& p, int l) {
    const float* tab = (const float*)(p.ws + WS_TAB);
    const int lane = otid() & 63;
    const int gw = obid() * (NTHREADS / 64) + (otid() >> 6), NGW = gridDim.x * (NTHREADS / 64);
    const int* rt = (const int*)(p.ws + WS_RT);
    const unsigned* ctl = (const unsigned*)(p.ws + WS_CTL);
    int basev;
    {
        const int cnt = (lane < NEXP) ? (int)ctl[cur_idx(l, lane & 31)] : 0;
        int incl = cnt;
#pragma unroll
        for (int o = 1; o < 32; o <<= 1) { const int t = __shfl_up(incl, o); if (lane >= o) incl += t; }
        basev = incl - cnt;
    }
    for (int row0 = gw; row0 < RL; row0 += 2 * NGW) {
        f32x4 x1[2][4], gg[2][4]; u32x2 oa[2][4], ob[2][4]; float g0[2], g1[2];
#pragma unroll
        for (int q = 0; q < 2; ++q) {
            const int row = row0 + q * NGW;
            if (row < RL) {
                const int mr = row >> 11;
                const float* X1 = (const float*)(p.ws + WS_X1) + (size_t)row * D;
                const int e0 = rt[row * 2], e1 = rt[row * 2 + 1];
                const int s0 = rt[2 * R + row * 2], s1 = rt[2 * R + row * 2 + 1];
                g0[q] = ((const float*)rt)[4 * R + row * 2]; g1[q] = ((const float*)rt)[4 * R + row * 2 + 1];
                const int base0 = __shfl(basev, e0), base1 = __shfl(basev, e1);
                const bf16_t* O0 = (const bf16_t*)(p.ws + WS_P) + (size_t)(base0 + s0) * D;
                const bf16_t* O1 = (const bf16_t*)(p.ws + WS_P) + (size_t)(base1 + s1) * D;
                const float* g2 = tab + TAB_MOD + (l * 9 + mr) * 6144 + 5 * 1024;
#pragma unroll
                for (int j = 0; j < 4; ++j) {
                    const int k = 4 * lane + 256 * j;
                    x1[q][j] = *(const f32x4*)(X1 + k); oa[q][j] = *(const u32x2*)(O0 + k); ob[q][j] = *(const u32x2*)(O1 + k); gg[q][j] = *(const f32x4*)(g2 + k);
                }
            }
        }
#pragma unroll
        for (int q = 0; q < 2; ++q) {
            const int row = row0 + q * NGW;
            if (row < RL) {
                float* O = p.out + (size_t)row * D;
#pragma unroll
                for (int j = 0; j < 4; ++j) {
                    const u32x2 a = oa[q][j], b = ob[q][j];
                    f32x4 m;
                    m.x = g0[q] * bflo(a.x) + g1[q] * bflo(b.x); m.y = g0[q] * bfhi(a.x) + g1[q] * bfhi(b.x);
                    m.z = g0[q] * bflo(a.y) + g1[q] * bflo(b.y); m.w = g0[q] * bfhi(a.y) + g1[q] * bfhi(b.y);
                    *(f32x4*)(O + 4 * lane + 256 * j) = x1[q][j] + gg[q][j] * m;
                }
            }
        }
    }
}

constexpr int BN = 128;
constexpr int LDT = 64 + 8;
constexpr int LDN = BN + 16;
typedef short v4i16_t __attribute__((ext_vector_type(4)));
typedef __attribute__((address_space(3))) v4i16_t* lds_v4i16_ptr;
__device__ __forceinline__ v4i16_t lds_tr16(const bf16_t* p) { return __builtin_amdgcn_ds_read_tr16_b64_v4i16((lds_v4i16_ptr)(p)); }

template <int WM, int KS, class AF, class BF>
__device__ __forceinline__ void gemm_tile(const bf16_t* Abase, const AF& arow, const BF& bptr, int K, unsigned char* smem, f32x4 (&acc)[WM][4]) {
    constexpr int BMt = 32 * WM, BKt = 32 * KS, LDA_ = BKt + 16;
    constexpr int STAGE = BMt * LDA_ * 2 + BKt * LDN * 2;
    static_assert(2 * STAGE <= 73728, "GEMM LDS");
    constexpr int ACH = BKt / 8;
    constexpr int APT = BMt * ACH / NTHREADS;
    constexpr int BPT = BKt * 32 / NTHREADS;
    const int tid = otid(), lane = tid & 63, wid = tid >> 6, wr = wid >> 1, wc = wid & 1, fr = lane & 15, fq = lane >> 4;
    const int a_chunk = tid % ACH, a_row0 = tid / ACH;
    unsigned ap[APT];
#pragma unroll
    for (int i = 0; i < APT; ++i) ap[i] = arow(a_row0 + (NTHREADS / ACH) * i) + a_chunk * 8;
    const int b_n4 = tid & 31, b_k0 = tid >> 5;
    u32x4 ar[APT];
    f32x4 br[BPT];
#pragma unroll
    for (int m = 0; m < WM; ++m)
#pragma unroll
        for (int n = 0; n < 4; ++n) acc[m][n] = (f32x4){0.f, 0.f, 0.f, 0.f};
    const int nk = K / BKt;
    auto gload = [&](int kt) {
        const int k0 = kt * BKt;
#pragma unroll
        for (int i = 0; i < APT; ++i) ar[i] = *(const u32x4*)(Abase + (ap[i] + k0));
#pragma unroll
        for (int i = 0; i < BPT; ++i) br[i] = *(const f32x4*)bptr(k0 + b_k0 + 8 * i, 4 * b_n4);
    };
    auto lwrite = [&](int buf) {
        bf16_t* As = (bf16_t*)(smem + buf * STAGE);
        bf16_t* Bs = As + BMt * LDA_;
#pragma unroll
        for (int i = 0; i < APT; ++i) *(u32x4*)(As + (a_row0 + (NTHREADS / ACH) * i) * LDA_ + a_chunk * 8) = ar[i];
#pragma unroll
        for (int i = 0; i < BPT; ++i) {
            u32x2 w; w.x = pk2(br[i][0], br[i][1]); w.y = pk2(br[i][2], br[i][3]);
            *(u32x2*)(Bs + (b_k0 + 8 * i) * LDN + ((4 * b_n4) ^ ((((b_k0 + 8 * i) >> 3) & 1) << 6))) = w;
        }
    };
    gload(0); lwrite(0); __syncthreads();
    for (int kt = 0; kt < nk; ++kt) {
        if (kt + 1 < nk) gload(kt + 1);
        __builtin_amdgcn_sched_barrier(0);
        const bf16_t* As = (const bf16_t*)(smem + (kt & 1) * STAGE);
        const bf16_t* Bs = As + BMt * LDA_;
#pragma unroll
        for (int ks = 0; ks < KS; ++ks) {
            bf16x8 bfr[4];
#pragma unroll
            for (int n = 0; n < 4; ++n) {
                const bf16_t* bp = Bs + (ks * 32 + fq * 8 + (fr >> 2)) * LDN + ((wc ^ (fq & 1)) * 64) + n * 16 + 4 * (fr & 3);
                const v4i16_t lo = lds_tr16(bp), hi = lds_tr16(bp + 4 * LDN);
                bfr[n] = (bf16x8){lo[0], lo[1], lo[2], lo[3], hi[0], hi[1], hi[2], hi[3]};
            }
#pragma unroll
            for (int mh = 0; mh < WM; mh += WM / 2) {
                bf16x8 af[WM / 2];
#pragma unroll
                for (int m = 0; m < WM / 2; ++m) af[m] = *(const bf16x8*)(As + (wr * (16 * WM) + (mh + m) * 16 + fr) * LDA_ + ks * 32 + fq * 8);
#pragma unroll
                for (int m = 0; m < WM / 2; ++m)
#pragma unroll
                    for (int n = 0; n < 4; ++n) acc[mh + m][n] = __builtin_amdgcn_mfma_f32_16x16x32_bf16(bfr[n], af[m], acc[mh + m][n], 0, 0, 0);
            }
        }
        __builtin_amdgcn_sched_barrier(0);
        if (kt + 1 < nk) lwrite((kt + 1) & 1);
        __syncthreads();
    }
}

template <int WM, int KS, class AF, class BF>
__device__ __forceinline__ void gemm_tile_b16(const bf16_t* Abase, const AF& arow, const BF& bptr, int K, unsigned char* smem, f32x4 (&acc)[WM][4]) {
    constexpr int BMt = 32 * WM, BKt = 32 * KS, LDA_ = BKt + 16;
    constexpr int STAGE = BMt * LDA_ * 2 + BKt * LDN * 2;
    static_assert(2 * STAGE <= 73728, "GEMM LDS");
    constexpr int ACH = BKt / 8;
    constexpr int APT = BMt * ACH / NTHREADS;
    constexpr int BPT = BKt * 16 / NTHREADS;
    const int tid = otid(), lane = tid & 63, wid = tid >> 6, wr = wid >> 1, wc = wid & 1, fr = lane & 15, fq = lane >> 4;
    const int a_chunk = tid % ACH, a_row0 = tid / ACH;
    unsigned ap[APT];
#pragma unroll
    for (int i = 0; i < APT; ++i) ap[i] = arow(a_row0 + (NTHREADS / ACH) * i) + a_chunk * 8;
    const int b_n8 = tid & 15, b_k0 = tid >> 4;
    u32x4 ar0[APT], ar1[APT], br0[BPT], br1[BPT];
#pragma unroll
    for (int m = 0; m < WM; ++m)
#pragma unroll
        for (int n = 0; n < 4; ++n) acc[m][n] = (f32x4){0.f, 0.f, 0.f, 0.f};
    const int nk = K / BKt;
    auto gload = [&](int kt, u32x4 (&ar)[APT], u32x4 (&br)[BPT]) {
        const int k0 = kt * BKt;
#pragma unroll
        for (int i = 0; i < APT; ++i) ar[i] = *(const u32x4*)(Abase + (ap[i] + k0));
#pragma unroll
        for (int i = 0; i < BPT; ++i) br[i] = *(const u32x4*)bptr(k0 + b_k0 + 16 * i, 8 * b_n8);
    };
    auto lwrite = [&](int buf, const u32x4 (&ar)[APT], const u32x4 (&br)[BPT]) {
        bf16_t* As = (bf16_t*)(smem + buf * STAGE);
        bf16_t* Bs = As + BMt * LDA_;
#pragma unroll
        for (int i = 0; i < APT; ++i) *(u32x4*)(As + (a_row0 + (NTHREADS / ACH) * i) * LDA_ + a_chunk * 8) = ar[i];
#pragma unroll
        for (int i = 0; i < BPT; ++i) *(u32x4*)(Bs + (b_k0 + 16 * i) * LDN + ((8 * b_n8) ^ ((((b_k0 + 16 * i) >> 3) & 1) << 6))) = br[i];
    };
    auto compute = [&](int buf) {
        const bf16_t* As = (const bf16_t*)(smem + buf * STAGE);
        const bf16_t* Bs = As + BMt * LDA_;
#pragma unroll
        for (int ks = 0; ks < KS; ++ks) {
            bf16x8 bfr[4];
#pragma unroll
            for (int n = 0; n < 4; ++n) {
                const bf16_t* bp = Bs + (ks * 32 + fq * 8 + (fr >> 2)) * LDN + ((wc ^ (fq & 1)) * 64) + n * 16 + 4 * (fr & 3);
                const v4i16_t lo = lds_tr16(bp), hi = lds_tr16(bp + 4 * LDN);
                bfr[n] = (bf16x8){lo[0], lo[1], lo[2], lo[3], hi[0], hi[1], hi[2], hi[3]};
            }
#pragma unroll
            for (int mh = 0; mh < WM; mh += WM / 2) {
                bf16x8 af[WM / 2];
#pragma unroll
                for (int m = 0; m < WM / 2; ++m) af[m] = *(const bf16x8*)(As + (wr * (16 * WM) + (mh + m) * 16 + fr) * LDA_ + ks * 32 + fq * 8);
#pragma unroll
                for (int m = 0; m < WM / 2; ++m)
#pragma unroll
                    for (int n = 0; n < 4; ++n) acc[mh + m][n] = __builtin_amdgcn_mfma_f32_16x16x32_bf16(bfr[n], af[m], acc[mh + m][n], 0, 0, 0);
            }
        }
    };
    gload(0, ar0, br0); lwrite(0, ar0, br0);
    gload(1, ar1, br1);
    __syncthreads();
    for (int kt = 0; kt < nk; kt += 2) {
        gload(kt + 2 < nk ? kt + 2 : nk - 1, ar0, br0);
        __builtin_amdgcn_sched_barrier(0);
        compute(0);
        __builtin_amdgcn_sched_barrier(0);
        lwrite(1, ar1, br1);
        __syncthreads();
        gload(kt + 3 < nk ? kt + 3 : nk - 1, ar1, br1);
        __builtin_amdgcn_sched_barrier(0);
        compute(1);
        __builtin_amdgcn_sched_barrier(0);
        lwrite(0, ar0, br0);
        __syncthreads();
    }
    asm volatile("s_waitcnt vmcnt(0)" ::: "memory");
}

template <int N> __device__ __forceinline__ void wait_vm() {
    if constexpr (N == 0) asm volatile("s_waitcnt vmcnt(0)" ::: "memory");
    else if constexpr (N == 3) asm volatile("s_waitcnt vmcnt(3)" ::: "memory");
    else if constexpr (N == 4) asm volatile("s_waitcnt vmcnt(4)" ::: "memory");
    else if constexpr (N == 5) asm volatile("s_waitcnt vmcnt(5)" ::: "memory");
    else if constexpr (N == 6) asm volatile("s_waitcnt vmcnt(6)" ::: "memory");
    else static_assert(N < 0, "wait_vm");
}
#define RAW_BARRIER() do { asm volatile("s_waitcnt lgkmcnt(0)" ::: "memory"); __builtin_amdgcn_s_barrier(); } while (0)
__device__ __forceinline__ void glds16(const void* gsrc, unsigned lds_dst) {
    unsigned keep;
    asm volatile("s_mov_b32 %0, m0\n\ts_mov_b32 m0, %2\n\ts_nop 0\n\tglobal_load_lds_dwordx4 %1, off\n\ts_mov_b32 m0, %0" : "=&s"(keep) : "v"(gsrc), "s"(lds_dst) : "memory");
}
template <int WM, class AF>
__device__ __forceinline__ void gemm_tile_dma(const bf16_t* Abase, const AF& arow, const bf16_t* Btile, int ldb, int K, unsigned char* smem, f32x4 (&acc)[WM][4]) {
    constexpr int A_BYTES = 32 * WM * 64, B_BYTES = 8192, STAGE = A_BYTES + B_BYTES;
    constexpr int AI = WM / 2, NI = AI + 2;
    static_assert(WM % 2 == 0 && 3 * STAGE <= 73728, "gemm_tile_dma");
    const int tid = otid(), lane = tid & 63, wid = tid >> 6, wr = wid >> 1, wc = wid & 1, fr = lane & 15, fq = lane >> 4;
    unsigned aoff[AI], boff[2];
#pragma unroll
    for (int i = 0; i < AI; ++i) {
        const int r = 16 * (i * 4 + wid) + (lane >> 2);
        const int c = (lane & 3) ^ (((r >> 3) & 1) << 1);
        aoff[i] = arow(r) + 8 * c;
    }
#pragma unroll
    for (int i = 0; i < 2; ++i) {
        const int kr = 4 * (i * 4 + wid) + (lane >> 4), jp = lane & 15;
        const int g = (jp >> 1) ^ ((kr & 3) | (((kr >> 3) & 1) << 2));
        boff[i] = (unsigned)(kr * ldb + (g * 2 + (jp & 1)) * 8);
    }
#pragma unroll
    for (int m = 0; m < WM; ++m)
#pragma unroll
        for (int n = 0; n < 4; ++n) acc[m][n] = (f32x4){0.f, 0.f, 0.f, 0.f};
    const int nk = K / 32;
    const unsigned lds0 = (unsigned)(uintptr_t)smem;
    const unsigned wbase = (unsigned)__builtin_amdgcn_readfirstlane((int)(lds0 + (unsigned)wid * 1024u));
    auto dma = [&](int kt, int st) {
        const unsigned sa = wbase + (unsigned)(st * STAGE);
#pragma unroll
        for (int i = 0; i < AI; ++i) glds16(Abase + (aoff[i] + kt * 32), (unsigned)__builtin_amdgcn_readfirstlane((int)(sa + i * 4096)));
#pragma unroll
        for (int i = 0; i < 2; ++i) glds16(Btile + (boff[i] + (unsigned)(kt * 32 * ldb)), (unsigned)__builtin_amdgcn_readfirstlane((int)(sa + A_BYTES + i * 4096)));
    };
    const int a_lane = (wr * (16 * WM) + fr) * 64 + 16 * (fq ^ (((fr >> 3) & 1) << 1));
    const int fBl = (fr >> 2) | ((fq & 1) << 2);
    const int b_lane = A_BYTES + (fq * 8 + (fr >> 2)) * 256 + 8 * (fr & 3);
    auto compute = [&](int st) {
        const unsigned char* sb = smem + st * STAGE;
        bf16x8 bfr[4];
#pragma unroll
        for (int n = 0; n < 4; ++n) {
            const bf16_t* bp = (const bf16_t*)(sb + b_lane + 32 * ((wc * 4 + n) ^ fBl));
            const v4i16_t lo = lds_tr16(bp), hi = lds_tr16(bp + 512);
            bfr[n] = (bf16x8){lo[0], lo[1], lo[2], lo[3], hi[0], hi[1], hi[2], hi[3]};
        }
        bf16x8 af[WM];
#pragma unroll
        for (int m = 0; m < WM; ++m) af[m] = *(const bf16x8*)(sb + a_lane + m * 1024);
#pragma unroll
        for (int m = 0; m < WM; ++m)
#pragma unroll
            for (int n = 0; n < 4; ++n) acc[m][n] = __builtin_amdgcn_mfma_f32_16x16x32_bf16(bfr[n], af[m], acc[m][n], 0, 0, 0);
    };
    dma(0, 0); dma(1, 1);
    int st = 0, st2 = 2;
#pragma unroll 1
    for (int kt = 0; kt < nk - 1; ++kt) {
        wait_vm<NI>();
        RAW_BARRIER();
        if (kt + 2 < nk) dma(kt + 2, st2);
        compute(st);
        st = (st == 2) ? 0 : st + 1; st2 = (st2 == 2) ? 0 : st2 + 1;
    }
    wait_vm<0>();
    RAW_BARRIER();
    compute(st);
    RAW_BARRIER();
}

__device__ __forceinline__ bool xcd_unit(int it, int nMT, int nNT, int& mt, int& nt, const unsigned char* smem) {
    const volatile int* xinfo = (const volatile int*)(smem + 73728 + 800);
    const int G = gridDim.x, b = obid();
    if (xinfo[0]) {
        const int x = xinfo[1], rank = xinfo[2], cntx = xinfo[3];
        const int start = (x * nMT) >> 3, per = (((x + 1) * nMT) >> 3) - start;
        const int q = rank + it * cntx;
        if (q >= per * nNT) return false;
        mt = start + q % per; nt = q / per;
        return true;
    }
    const int u = b + it * G;
    if (u >= nMT * nNT) return false;
    mt = u / nNT; nt = u % nNT;
    return true;
}

__device__ __forceinline__ void epi_in_row(const f32x4 (&a)[4], int row, int cw, int fq, const float* tab, const float* lbt, const float* qw, const float* kw, bf16_t* P, float* LF) {
    float v[4][4];
#pragma unroll
    for (int n = 0; n < 4; ++n)
#pragma unroll
        for (int j = 0; j < 4; ++j) v[n][j] = a[n][j];
    if (cw >= OFF_ZF && cw < OFF_HV) {
        const int dir = (cw >= OFF_ZB) ? 1 : 0;
        const int cb = cw - (dir ? OFF_ZB : OFF_ZF);
#pragma unroll
        for (int n = 0; n < 4; ++n) {
            f32x4 o;
#pragma unroll
            for (int j = 0; j < 4; ++j) {
                const int c = cb + n * 16 + fq * 4 + j;
                const float lb = lbt[dir * 256 + c];
                const float z = v[n][j];
                float lf;
                if (lb > 0.f) lf = __logf(lb + (1.f - lb) * sigmoidf_(z));
                else lf = fminf(z, 0.f) - log1pf(__expf(-fabsf(z)));
                o[j] = lf;
            }
            *(f32x4*)(LF + (size_t)row * LFW + dir * 256 + cb + n * 16 + fq * 4) = o;
        }
        return;
    }
    if (cw < OFF_B) {
#pragma unroll
        for (int n = 0; n < 4; ++n)
#pragma unroll
            for (int j = 0; j < 4; ++j) v[n][j] = gelu_tanh(v[n][j]);
    }
    if ((cw >= 256 && cw < OFF_V)) {
        float ss = 0.f;
#pragma unroll
        for (int n = 0; n < 4; ++n)
#pragma unroll
            for (int j = 0; j < 4; ++j) ss += v[n][j] * v[n][j];
        ss += __shfl_xor(ss, 16); ss += __shfl_xor(ss, 32);
        const float rstd = rsqrtf(ss * (1.f / 64.f) + EPS);
        if (cw < OFF_B) {
#pragma unroll
            for (int n = 0; n < 4; ++n)
#pragma unroll
                for (int j = 0; j < 4; ++j) v[n][j] *= rstd;
        } else {
            const float* nwv = (cw < OFF_KV) ? qw : kw;
#pragma unroll
            for (int n = 0; n < 4; ++n)
#pragma unroll
                for (int j = 0; j < 4; ++j) v[n][j] *= rstd * nwv[n * 16 + fq * 4 + j];
            if (row < RL) {
                const int t = row & (T - 1);
#pragma unroll
                for (int ax = 0; ax < 2; ++ax) {
                    const int pos = ax == 0 ? (t >> 6) : (t & 63);
                    const f32x4 cs01 = *(const f32x4*)(tab + TAB_ROPE + (pos * 16 + fq * 4) * 2), cs23 = *(const f32x4*)(tab + TAB_ROPE + (pos * 16 + fq * 4) * 2 + 4);
                    const float csv[4] = {cs01[0], cs01[2], cs23[0], cs23[2]}, snv[4] = {cs01[1], cs01[3], cs23[1], cs23[3]};
#pragma unroll
                    for (int j = 0; j < 4; ++j) {
                        const float cs = csv[j], sn = snv[j];
                        const float x0 = v[2 * ax][j], x1 = v[2 * ax + 1][j];
                        v[2 * ax][j] = x0 * cs - x1 * sn;
                        v[2 * ax + 1][j] = x1 * cs + x0 * sn;
                    }
                }
            }
        }
    }
    if ((cw >= OFF_C && cw < OFF_ZF) || cw >= OFF_G) {
#pragma unroll
        for (int n = 0; n < 4; ++n)
#pragma unroll
            for (int j = 0; j < 4; ++j) v[n][j] = siluf_(v[n][j]);
    }
#pragma unroll
    for (int n = 0; n < 4; ++n) {
        u32x2 pk; pk.x = pk2(v[n][0], v[n][1]); pk.y = pk2(v[n][2], v[n][3]);
        *(u32x2*)(P + (size_t)row * INW + cw + n * 16 + fq * 4) = pk;
    }
}

__device__ void phase_gemm_in(const Params& p, int l, unsigned char* smem) {
    const float* tab = (const float*)(p.ws + WS_TAB);
    const bf16_t* H = (const bf16_t*)(p.ws + WS_H);
    bf16_t* P = (bf16_t*)(p.ws + WS_P);
    float* LF = (float*)(p.ws + WS_LF);
    const bf16_t* W = (const bf16_t*)(p.ws + WS_WIN) + (size_t)l * D * INW;
    const float* qw = p.in[10] + l * 64;
    const float* kw = p.in[11] + l * 64;
    const float* lbt = tab + TAB_LB + l * 512;
    const int tid = otid(), lane = tid & 63, wid = tid >> 6, wr = wid >> 1, wc = wid & 1, fr = lane & 15, fq = lane >> 4;
    constexpr int WM = 6, BMt = 32 * WM;
    const int nMT = R / BMt, nNT = INW / BN;
    for (int it = 0;; ++it) {
        int mt, nt;
        if (!xcd_unit(it, nMT, nNT, mt, nt, smem)) break;
        const int row0 = mt * BMt, col0 = nt * BN;
        f32x4 acc[WM][4];
        auto arow = [&](int i) { return (unsigned)((row0 + i) * D); };
        gemm_tile_dma<WM>(H, arow, W + col0, INW, D, smem, acc);
        const int cw = col0 + wc * 64;
        const int rbase = row0 + wr * (16 * WM) + fr;
        epi_in_row(acc[0], rbase, cw, fq, tab, lbt, qw, kw, P, LF);
        epi_in_row(acc[1], rbase + 16, cw, fq, tab, lbt, qw, kw, P, LF);
        epi_in_row(acc[2], rbase + 32, cw, fq, tab, lbt, qw, kw, P, LF);
        epi_in_row(acc[3], rbase + 48, cw, fq, tab, lbt, qw, kw, P, LF);
        epi_in_row(acc[4], rbase + 64, cw, fq, tab, lbt, qw, kw, P, LF);
        epi_in_row(acc[5], rbase + 80, cw, fq, tab, lbt, qw, kw, P, LF);
    }
}

__device__ __forceinline__ int next_unit(unsigned* ctr, unsigned char* smem) {
    int* slot = (int*)(smem + 73728 + 512);
    __syncthreads();
    if (otid() == 0) *slot = (int)atomicAdd(ctr, 1u);
    __syncthreads();
    return *slot;
}

constexpr float ATT_C = 0.125f * 1.4426950408889634f;
constexpr int ATT_STAGE = 16384;
__device__ __forceinline__ void attn_unit(const Params& p, int u, unsigned char* smem) {
    const bf16_t* P = (const bf16_t*)(p.ws + WS_P);
    bf16_t* Y = (bf16_t*)(p.ws + WS_Y);
    const int tid = otid(), lane = tid & 63, wid = tid >> 6, fr = lane & 15, fq = lane >> 4;
    int b, kvh, qrow0, nkt; const bool ctxq = u >= 1024;
    if (!ctxq) { b = u >> 7; kvh = (u >> 6) & 1; qrow0 = b * T + (u & 63) * 32; nkt = 36; }
    else { const int v = u - 1024; b = v >> 4; kvh = (v >> 3) & 1; qrow0 = RL + b * TC + (v & 7) * 32; nkt = 4; }
    const int hh = kvh * 4 + wid;
    unsigned char* Qs = smem + 3 * ATT_STAGE + wid * 4096;
#pragma unroll
    for (int i = 0; i < 4; ++i) {
        const int pc = i * 64 + lane, r = pc >> 3, c = pc & 7;
        *(u32x4*)(Qs + r * 128 + 16 * (c ^ ((r >> 1) & 7))) = *(const u32x4*)(P + (size_t)(qrow0 + r) * INW + OFF_B + hh * 64 + c * 8);
    }
    f32x4 o[2][4];
    float mrow[2], lrow[2];
#pragma unroll
    for (int m = 0; m < 2; ++m) { mrow[m] = -1e30f; lrow[m] = 0.f;
#pragma unroll
        for (int n = 0; n < 4; ++n) o[m][n] = (f32x4){0.f, 0.f, 0.f, 0.f}; }
    unsigned koff[2], voff[2];
#pragma unroll
    for (int i = 0; i < 2; ++i) {
        const int r = 32 * i + 8 * wid + (lane >> 3), cp = lane & 7;
        koff[i] = (unsigned)(r * INW + OFF_KV + kvh * 64 + (cp ^ ((r >> 1) & 7)) * 8);
        voff[i] = (unsigned)(r * INW + OFF_V + kvh * 64 + ((((cp >> 1) ^ ((r >> 1) & 3)) << 1) | (cp & 1)) * 8);
    }
    const unsigned lds0 = (unsigned)(uintptr_t)smem;
    const unsigned wbase = (unsigned)__builtin_amdgcn_readfirstlane((int)(lds0 + (unsigned)wid * 1024u));
    auto dma = [&](int kt, int st) {
        const int base = ctxq ? (RL + b * TC + kt * 64) : (kt < 32 ? (b * T + kt * 64) : (RL + b * TC + (kt - 32) * 64));
        const bf16_t* src = P + (size_t)base * INW;
        const unsigned sa = wbase + (unsigned)(st * ATT_STAGE);
#pragma unroll
        for (int i = 0; i < 2; ++i) {
            glds16(src + koff[i], (unsigned)__builtin_amdgcn_readfirstlane((int)(sa + i * 4096)));
            glds16(src + voff[i], (unsigned)__builtin_amdgcn_readfirstlane((int)(sa + 8192 + i * 4096)));
        }
    };
    const int kq_lane = fr * 128, kq_sw = (fr >> 1) & 7;
    const int hv = ((fq & 1) << 1) | (fr >> 3);
    const int v_lane = (4 * fq + (fr >> 2)) * 128 + 8 * (fr & 3);
    auto compute = [&](int st) {
        const unsigned char* kb = smem + st * ATT_STAGE;
        const unsigned char* vb = kb + 8192;
        f32x4 sc[2][4];
        {
            bf16x8 kf[4][2], qf[2][2];
#pragma unroll
            for (int n = 0; n < 4; ++n)
#pragma unroll
                for (int ks = 0; ks < 2; ++ks) kf[n][ks] = *(const bf16x8*)(kb + n * 2048 + kq_lane + 16 * ((ks * 4 + fq) ^ kq_sw));
#pragma unroll
            for (int m = 0; m < 2; ++m)
#pragma unroll
                for (int ks = 0; ks < 2; ++ks) qf[m][ks] = *(const bf16x8*)(Qs + m * 2048 + kq_lane + 16 * ((ks * 4 + fq) ^ kq_sw));
#pragma unroll
            for (int m = 0; m < 2; ++m)
#pragma unroll
                for (int n = 0; n < 4; ++n) {
                    sc[m][n] = (f32x4){0.f, 0.f, 0.f, 0.f};
#pragma unroll
                    for (int ks = 0; ks < 2; ++ks) sc[m][n] = __builtin_amdgcn_mfma_f32_16x16x32_bf16(kf[n][ks], qf[m][ks], sc[m][n], 0, 0, 0);
                }
        }
        bf16x8 vf[4][2];
#pragma unroll
        for (int n = 0; n < 4; ++n)
#pragma unroll
            for (int ks = 0; ks < 2; ++ks) {
                const bf16_t* vp = (const bf16_t*)(vb + ks * 4096 + v_lane + 32 * (n ^ hv));
                const v4i16_t lo = lds_tr16(vp), hi = lds_tr16(vp + 1024);
                vf[n][ks] = (bf16x8){lo[0], lo[1], lo[2], lo[3], hi[0], hi[1], hi[2], hi[3]};
            }
        bf16x8 pf[2][2];
#pragma unroll
        for (int m = 0; m < 2; ++m) {
            float mx = sc[m][0][0];
#pragma unroll
            for (int n = 0; n < 4; ++n)
#pragma unroll
                for (int j = 0; j < 4; ++j) mx = fmaxf(mx, sc[m][n][j]);
            mx = fmaxf(mx, __shfl_xor(mx, 16)); mx = fmaxf(mx, __shfl_xor(mx, 32));
            const float mnew = fmaxf(mrow[m], mx);
            const float alpha = __builtin_amdgcn_exp2f((mrow[m] - mnew) * ATT_C);
            mrow[m] = mnew;
            const float mc = mnew * ATT_C;
            float ls = 0.f;
#pragma unroll
            for (int n = 0; n < 4; ++n)
#pragma unroll
                for (int j = 0; j < 4; ++j) { sc[m][n][j] = __builtin_amdgcn_exp2f(sc[m][n][j] * ATT_C - mc); ls += sc[m][n][j]; }
            lrow[m] = lrow[m] * alpha + ls;
#pragma unroll
            for (int n = 0; n < 4; ++n) o[m][n] = o[m][n] * alpha;
#pragma unroll
            for (int ks = 0; ks < 2; ++ks) {
                u32x4 pw;
                pw.x = pk2(sc[m][2 * ks][0], sc[m][2 * ks][1]); pw.y = pk2(sc[m][2 * ks][2], sc[m][2 * ks][3]);
                pw.z = pk2(sc[m][2 * ks + 1][0], sc[m][2 * ks + 1][1]); pw.w = pk2(sc[m][2 * ks + 1][2], sc[m][2 * ks + 1][3]);
                pf[m][ks] = __builtin_bit_cast(bf16x8, pw);
            }
        }
#pragma unroll
        for (int m = 0; m < 2; ++m)
#pragma unroll
            for (int ks = 0; ks < 2; ++ks)
#pragma unroll
                for (int nd = 0; nd < 4; ++nd) o[m][nd] = __builtin_amdgcn_mfma_f32_16x16x32_bf16(vf[nd][ks], pf[m][ks], o[m][nd], 0, 0, 0);
    };
    dma(0, 0); dma(1, 1);
    int st = 0, st2 = 2;
#pragma unroll 1
    for (int kt = 0; kt < nkt - 1; ++kt) {
        wait_vm<4>();
        RAW_BARRIER();
        if (kt + 2 < nkt) dma(kt + 2, st2);
        compute(st);
        st = (st == 2) ? 0 : st + 1; st2 = (st2 == 2) ? 0 : st2 + 1;
    }
    wait_vm<0>();
    RAW_BARRIER();
    compute(st);
#pragma unroll
    for (int m = 0; m < 2; ++m) {
        float lt = lrow[m];
        lt += __shfl_xor(lt, 16); lt += __shfl_xor(lt, 32);
        const float inv = 1.f / lt;
        const size_t row = (size_t)(qrow0 + m * 16 + fr);
#pragma unroll
        for (int nd = 0; nd < 4; ++nd) {
            u32x2 pk; pk.x = pk2(o[m][nd][0] * inv, o[m][nd][1] * inv); pk.y = pk2(o[m][nd][2] * inv, o[m][nd][3] * inv);
            *(u32x2*)(Y + row * D + 256 + hh * 64 + nd * 16 + fq * 4) = pk;
        }
    }
}

constexpr int LDA = 128 + 8;
__device__ __forceinline__ void mixa_unit(const Params& p, int l, int u, unsigned char* smem) {
    const bf16_t* P = (const bf16_t*)(p.ws + WS_P);
    bf16_t* Y = (bf16_t*)(p.ws + WS_Y);
    const int n = u >> 2, h = u & 3;
    const float* W = p.in[8] + ((size_t)l * 4 + h) * 128 * 128;
    const float* bs = p.in[9] + (l * 4 + h) * 128;
    bf16_t* Ws = (bf16_t*)smem;
    bf16_t* Vs = Ws + 128 * LDA;
    const int tid = otid(), lane = tid & 63, wid = tid >> 6, fr = lane & 15, fq = lane >> 4;
#pragma unroll
    for (int i = 0; i < 16; ++i) {
        const int pc = tid + 256 * i, t = pc >> 5, s4 = (pc & 31) * 4;
        const f32x4 w = *(const f32x4*)(W + t * 128 + s4);
        u32x2 o; o.x = pk2(w[0], w[1]); o.y = pk2(w[2], w[3]);
        *(u32x2*)(Ws + t * LDA + s4) = o;
    }
#pragma unroll
    for (int i = 0; i < 2; ++i) {
        const int mb = tid + 256 * i, dg = mb & 15, sg = mb >> 4;
        u32x2 vr[4];
#pragma unroll
        for (int r = 0; r < 4; ++r) vr[r] = *(const u32x2*)(P + (size_t)(n * 128 + 4 * sg + r) * INW + 256 + h * 64 + 4 * dg);
#pragma unroll
        for (int di = 0; di < 4; ++di) {
            const int w = di >> 1;
            u32x2 ov;
            if ((di & 1) == 0) { ov.x = (vr[0][w] & 0xffffu) | (vr[1][w] << 16); ov.y = (vr[2][w] & 0xffffu) | (vr[3][w] << 16); }
            else { ov.x = (vr[0][w] >> 16) | (vr[1][w] & 0xffff0000u); ov.y = (vr[2][w] >> 16) | (vr[3][w] & 0xffff0000u); }
            *(u32x2*)(Vs + (4 * dg + di) * LDA + 4 * sg) = ov;
        }
    }
    __syncthreads();
    f32x4 acc[2][4];
#pragma unroll
    for (int m = 0; m < 2; ++m)
#pragma unroll
        for (int nd = 0; nd < 4; ++nd) acc[m][nd] = (f32x4){0.f, 0.f, 0.f, 0.f};
#pragma unroll
    for (int ks = 0; ks < 4; ++ks) {
        bf16x8 wf[2], vf[4];
#pragma unroll
        for (int m = 0; m < 2; ++m) wf[m] = *(const bf16x8*)(Ws + (32 * wid + 16 * m + fr) * LDA + ks * 32 + fq * 8);
#pragma unroll
        for (int nd = 0; nd < 4; ++nd) vf[nd] = *(const bf16x8*)(Vs + (16 * nd + fr) * LDA + ks * 32 + fq * 8);
#pragma unroll
        for (int m = 0; m < 2; ++m)
#pragma unroll
            for (int nd = 0; nd < 4; ++nd) acc[m][nd] = __builtin_amdgcn_mfma_f32_16x16x32_bf16(vf[nd], wf[m], acc[m][nd], 0, 0, 0);
    }
#pragma unroll
    for (int m = 0; m < 2; ++m) {
        const int t = 32 * wid + 16 * m + fr;
        const size_t row = (size_t)n * 128 + t;
        const float bias = bs[t];
#pragma unroll
        for (int nd = 0; nd < 4; ++nd) {
            const int c = h * 64 + 16 * nd + 4 * fq;
            const u32x2 uu = *(const u32x2*)(P + row * INW + c);
            u32x2 pk;
            pk.x = pk2(bflo(uu.x) * (acc[m][nd][0] + bias), bfhi(uu.x) * (acc[m][nd][1] + bias));
            pk.y = pk2(bflo(uu.y) * (acc[m][nd][2] + bias), bfhi(uu.y) * (acc[m][nd][3] + bias));
            *(u32x2*)(Y + row * D + c) = pk;
        }
    }
}

__device__ __forceinline__ int hg_pos(int I, int ii) { return 32 * (I >> 1) + 4 * (I & 1) + 8 * (ii >> 2) + (ii & 3); }
__device__ __forceinline__ void hgrn_state_unit(const Params& p, int l, int u, unsigned char* smem) {
    const bf16_t* P = (const bf16_t*)(p.ws + WS_P);
    const float* LF = (const float*)(p.ws + WS_LF);
    bf16_t* SST = (bf16_t*)(p.ws + WS_OFB);
    const int b = u >> 3, h = (u >> 1) & 3, dir = u & 1;
    const int tid = otid(), lane = tid & 63, wid = tid >> 6, fr = lane & 15, fq = lane >> 4;
    const int k = lane, I = wid;
    bf16_t* KT = (bf16_t*)smem;
    bf16_t* VT = KT + 64 * LDT;
    float* Tsub = (float*)(VT + 64 * LDT);
    float* Etot = Tsub + 256;
    f32x4 sacc[4];
#pragma unroll
    for (int nk = 0; nk < 4; ++nk) sacc[nk] = (f32x4){0.f, 0.f, 0.f, 0.f};
    float lf[16], vv[16];
    auto mcof = [&](int j) { return dir == 0 ? (j < 4 ? 256 + b * 4 + j : b * 32 + (j - 4)) : (j < 4 ? 256 + b * 4 + (3 - j) : b * 32 + (35 - j)); };
    auto gload = [&](int j) {
        const int mc = mcof(j);
#pragma unroll
        for (int ii = 0; ii < 16; ++ii) {
            const int tau = 16 * I + ii;
            const size_t row = (size_t)mc * 64 + (dir ? 63 - tau : tau);
            lf[ii] = LF[row * LFW + dir * 256 + h * 64 + k];
            vv[ii] = bf2f(P[row * INW + OFF_HV + h * 64 + k]);
        }
    };
    gload(0);
    for (int j = 0; j < 36; ++j) {
        float c[16];
        c[0] = lf[0];
#pragma unroll
        for (int ii = 1; ii < 16; ++ii) c[ii] = c[ii - 1] + lf[ii];
        Tsub[I * 64 + k] = c[15];
        __syncthreads();
        float Rs = 0.f;
#pragma unroll
        for (int M = 1; M < 4; ++M) Rs += (M > I) ? Tsub[M * 64 + k] : 0.f;
        if (I == 0) Etot[k] = __expf(c[15] + Rs);
#pragma unroll
        for (int g = 0; g < 4; ++g) {
            float kh[4];
#pragma unroll
            for (int jj = 0; jj < 4; ++jj) { const int ii = 4 * g + jj; kh[jj] = (1.f - __expf(lf[ii])) * __expf(c[15] - c[ii] + Rs); }
            u32x2 kw; kw.x = pk2(kh[0], kh[1]); kw.y = pk2(kh[2], kh[3]);
            u32x2 vw; vw.x = pk2(vv[4 * g], vv[4 * g + 1]); vw.y = pk2(vv[4 * g + 2], vv[4 * g + 3]);
            const int pos = hg_pos(I, 4 * g);
            *(u32x2*)(KT + k * LDT + pos) = kw;
            *(u32x2*)(VT + k * LDT + pos) = vw;
        }
        const int mc = mcof(j);
        {
            bf16_t* dst = SST + ((size_t)(mc * 4 + h) * 2 + dir) * 4096;
#pragma unroll
            for (int nk = 0; nk < 4; ++nk)
#pragma unroll
                for (int r = 0; r < 4; ++r) dst[(16 * wid + 4 * fq + r) * 64 + 16 * nk + fr] = f2bf(sacc[nk][r]);
        }
        if (j + 1 < 36) gload(j + 1);
        __builtin_amdgcn_sched_barrier(0);
        __syncthreads();
        bf16x8 vf[2];
#pragma unroll
        for (int ks = 0; ks < 2; ++ks) vf[ks] = *(const bf16x8*)(VT + (16 * wid + fr) * LDT + 32 * ks + 8 * fq);
#pragma unroll
        for (int nk = 0; nk < 4; ++nk) {
            const float e = Etot[16 * nk + fr];
            sacc[nk] = sacc[nk] * e;
#pragma unroll
            for (int ks = 0; ks < 2; ++ks) {
                const bf16x8 kf = *(const bf16x8*)(KT + (16 * nk + fr) * LDT + 32 * ks + 8 * fq);
                sacc[nk] = __builtin_amdgcn_mfma_f32_16x16x32_bf16(vf[ks], kf, sacc[nk], 0, 0, 0);
            }
        }
        __syncthreads();
    }
    asm volatile("s_waitcnt vmcnt(0)" ::: "memory");
    __syncthreads();
    if (otid() == 0) {
        __builtin_amdgcn_fence(__ATOMIC_RELEASE, "agent");
        asm volatile("s_waitcnt vmcnt(0)" ::: "memory");
        __hip_atomic_fetch_add((unsigned*)(p.ws + WS_CTL) + 160 + l, 1u, __ATOMIC_RELAXED, __HIP_MEMORY_SCOPE_AGENT);
    }
}


__device__ __forceinline__ void hgrn_out_unit(const Params& p, int l, int u, unsigned char* smem) {
    const bf16_t* P = (const bf16_t*)(p.ws + WS_P);
    const float* LF = (const float*)(p.ws + WS_LF);
    const bf16_t* SST = (const bf16_t*)(p.ws + WS_OFB);
    bf16_t* Y = (bf16_t*)(p.ws + WS_Y);
    const float* hw = p.in[13] + l * 64;
    const int mc = u >> 2, h = u & 3;
    const int tid = otid(), lane = tid & 63, wid = tid >> 6, fr = lane & 15, fq = lane >> 4;
    const int k = lane, I = wid;
    bf16_t* QT0 = (bf16_t*)smem;
    bf16_t* KD = QT0 + 64 * LDT;
    bf16_t* KO = KD + 64 * LDT;
    bf16_t* QS = KO + 64 * LDT;
    bf16_t* QT1 = QS + 64 * LDT;
    bf16_t* QT2 = QT1 + 32 * LDT;
    bf16_t* VT = QT2 + 16 * LDT;
    float* Tsub = (float*)(VT + 64 * LDT);
    float* SSQ = Tsub + 256;
    f32x4 om[4];
#pragma unroll 1
    for (int dd = 0; dd < 2; ++dd) {
        const int dir = 1 - dd;
        float lf[16], c[16];
#pragma unroll
        for (int ii = 0; ii < 16; ++ii) {
            const int tau = 16 * I + ii;
            const size_t row = (size_t)mc * 64 + (dir ? 63 - tau : tau);
            lf[ii] = LF[row * LFW + dir * 256 + h * 64 + k];
        }
        c[0] = lf[0];
#pragma unroll
        for (int ii = 1; ii < 16; ++ii) c[ii] = c[ii - 1] + lf[ii];
        Tsub[I * 64 + k] = c[15];
        __syncthreads();
        const float T0 = Tsub[k], T1 = Tsub[64 + k], T2 = Tsub[128 + k];
        const float pre = (I > 0 ? T0 : 0.f) + (I > 1 ? T1 : 0.f) + (I > 2 ? T2 : 0.f);
        const float epre = __expf(pre);
        const float g1 = __expf(I == 2 ? T1 : T2);
        const float g2 = __expf(T1 + T2);
#pragma unroll
        for (int g = 0; g < 4; ++g) {
            float vq[4];
#pragma unroll
            for (int jj = 0; jj < 4; ++jj) {
                const int ii = 4 * g + jj, tau = 16 * I + ii;
                const size_t row = (size_t)mc * 64 + (dir ? 63 - tau : tau);
                const float q = bf2f(P[row * INW + OFF_C + h * 64 + k]);
                vq[jj] = bf2f(P[row * INW + OFF_HV + h * 64 + k]);
                const float qt = q * __expf(c[ii]);
                const float kk = 1.f - __expf(lf[ii]);
                QT0[tau * LDT + k] = f2bf(qt);
                QS[tau * LDT + k] = f2bf(qt * epre);
                KD[tau * LDT + k] = f2bf(kk * __expf(fminf(-c[ii], 80.f)));
                KO[tau * LDT + k] = f2bf(kk * __expf(c[15] - c[ii]));
                if (I >= 2) QT1[(tau - 32) * LDT + k] = f2bf(qt * g1);
                if (I == 3) QT2[(tau - 48) * LDT + k] = f2bf(qt * g2);
            }
            u32x2 vw; vw.x = pk2(vq[0], vq[1]); vw.y = pk2(vq[2], vq[3]);
            *(u32x2*)(VT + k * LDT + hg_pos(I, 4 * g)) = vw;
        }
        bf16x8 stf[2];
        {
            const bf16_t* src = SST + ((size_t)(mc * 4 + h) * 2 + dir) * 4096 + (16 * wid + fr) * 64 + 8 * fq;
            stf[0] = *(const bf16x8*)(src); stf[1] = *(const bf16x8*)(src + 32);
        }
        __syncthreads();
        bf16x8 vf[2];
#pragma unroll
        for (int ks = 0; ks < 2; ++ks) vf[ks] = *(const bf16x8*)(VT + (16 * wid + fr) * LDT + 32 * ks + 8 * fq);
        f32x4 o[4];
#pragma unroll
        for (int I2 = 0; I2 < 4; ++I2) {
            f32x4 A[4];
#pragma unroll
            for (int J = 0; J < 4; ++J) {
                A[J] = (f32x4){0.f, 0.f, 0.f, 0.f};
                if (J <= I2) {
                    const bf16_t* kbase = (J == I2 ? KD : KO) + (16 * J + fr) * LDT + 8 * fq;
                    const bf16_t* qbase = (I2 - J <= 1) ? (QT0 + (16 * I2 + fr) * LDT) : ((I2 - J == 2) ? (QT1 + (16 * I2 - 32 + fr) * LDT) : (QT2 + fr * LDT));
#pragma unroll
                    for (int ks = 0; ks < 2; ++ks) {
                        const bf16x8 kf = *(const bf16x8*)(kbase + 32 * ks);
                        const bf16x8 qf = *(const bf16x8*)(qbase + 32 * ks + 8 * fq);
                        A[J] = __builtin_amdgcn_mfma_f32_16x16x32_bf16(kf, qf, A[J], 0, 0, 0);
                    }
                    if (J == I2) {
#pragma unroll
                        for (int r = 0; r < 4; ++r) A[J][r] = (4 * fq + r <= fr) ? A[J][r] : 0.f;
                    }
                }
            }
            o[I2] = (f32x4){0.f, 0.f, 0.f, 0.f};
#pragma unroll
            for (int ks = 0; ks < 2; ++ks) {
                if (2 * ks <= I2) {
                    u32x4 pw;
                    pw.x = pk2(A[2 * ks][0], A[2 * ks][1]); pw.y = pk2(A[2 * ks][2], A[2 * ks][3]);
                    pw.z = pk2(A[2 * ks + 1][0], A[2 * ks + 1][1]); pw.w = pk2(A[2 * ks + 1][2], A[2 * ks + 1][3]);
                    o[I2] = __builtin_amdgcn_mfma_f32_16x16x32_bf16(vf[ks], __builtin_bit_cast(bf16x8, pw), o[I2], 0, 0, 0);
                }
                const bf16x8 qsf = *(const bf16x8*)(QS + (16 * I2 + fr) * LDT + 32 * ks + 8 * fq);
                o[I2] = __builtin_amdgcn_mfma_f32_16x16x32_bf16(stf[ks], qsf, o[I2], 0, 0, 0);
            }
        }
        if (dir == 1) {
            const int src = (lane & 48) | (15 - fr);
#pragma unroll
            for (int Im = 0; Im < 4; ++Im)
#pragma unroll
                for (int r = 0; r < 4; ++r) om[Im][r] = __shfl(o[3 - Im][r], src);
        } else {
#pragma unroll
            for (int Im = 0; Im < 4; ++Im) om[Im] = om[Im] + o[Im];
        }
        __syncthreads();
    }
#pragma unroll
    for (int Im = 0; Im < 4; ++Im) {
        float s = om[Im][0] * om[Im][0] + om[Im][1] * om[Im][1] + om[Im][2] * om[Im][2] + om[Im][3] * om[Im][3];
        s += __shfl_xor(s, 16); s += __shfl_xor(s, 32);
        if (fq == 0) SSQ[wid * 64 + 16 * Im + fr] = s;
    }
    __syncthreads();
    const f32x4 wv = *(const f32x4*)(hw + 16 * wid + 4 * fq);
#pragma unroll
    for (int Im = 0; Im < 4; ++Im) {
        const int i = 16 * Im + fr;
        const float tot = SSQ[i] + SSQ[64 + i] + SSQ[128 + i] + SSQ[192 + i];
        const float rstd = rsqrtf(tot * (1.f / 64.f) + EPS);
        const size_t row = (size_t)mc * 64 + i;
        const u32x2 gg = *(const u32x2*)(P + row * INW + OFF_G + h * 64 + 16 * wid + 4 * fq);
        u32x2 pk;
        pk.x = pk2(om[Im][0] * rstd * wv[0] * bflo(gg.x), om[Im][1] * rstd * wv[1] * bfhi(gg.x));
        pk.y = pk2(om[Im][2] * rstd * wv[2] * bflo(gg.y), om[Im][3] * rstd * wv[3] * bfhi(gg.y));
        *(u32x2*)(Y + row * D + 768 + h * 64 + 16 * wid + 4 * fq) = pk;
    }
}

__device__ void phase_mix1(const Params& p, int l, unsigned char* smem, int rep) {
    unsigned* ctr = (unsigned*)(p.ws + WS_CTL) + 128 + l * 2 + rep * 4;
    unsigned* done = (unsigned*)(p.ws + WS_CTL) + 160 + l;
    const int n_attn = (l == 0) ? 1152 : 1024, n_mixa = (l == 0) ? 576 : 512, n_hout = ((l == 0) ? 288 : 256) * 4;
    const int total = 64 + n_attn + n_mixa + n_hout;
    bool acquired = false;
    for (;;) {
        const int u = next_unit(ctr, smem);
        if (u >= total) break;
        if (u < 64) hgrn_state_unit(p, l, u, smem);
        else if (u < 64 + n_attn) attn_unit(p, u - 64, smem);
        else if (u < 64 + n_attn + n_mixa) mixa_unit(p, l, u - 64 - n_attn, smem);
        else {
            if (!acquired) {
                if (otid() == 0) {
                    unsigned spins = 0;
                    while (__hip_atomic_load(done, __ATOMIC_RELAXED, __HIP_MEMORY_SCOPE_AGENT) < 64u * (unsigned)(rep + 1)) { __builtin_amdgcn_s_sleep(8); if (++spins > (1u << 24)) break; }
                    __builtin_amdgcn_fence(__ATOMIC_ACQUIRE, "agent");
                    asm volatile("s_waitcnt vmcnt(0)" ::: "memory");
                }
                __syncthreads();
                acquired = true;
            }
            hgrn_out_unit(p, l, u - 64 - n_attn - n_mixa, smem);
        }
    }
}

template <int WM>
__device__ __forceinline__ void phase_out_t(const Params& p, int l, unsigned char* smem) {
    const float* tab = (const float*)(p.ws + WS_TAB);
    const bf16_t* Y = (const bf16_t*)(p.ws + WS_Y);
    float* X1 = (float*)(p.ws + WS_X1);
    const float* X2 = (const float*)(p.ws + WS_X2);
    const bf16_t* W = (const bf16_t*)(p.ws + WS_WOUT) + (size_t)l * D * D;
    const int tid = otid(), lane = tid & 63, wid = tid >> 6, wr = wid >> 1, wc = wid & 1, fr = lane & 15, fq = lane >> 4;
    const int nrows = (l == 0) ? R : RL;
    constexpr int BMt = 32 * WM;
    const int nMT = (nrows + BMt - 1) / BMt, nNT = D / BN;
    for (int it = 0;; ++it) {
        int mt, nt;
        if (!xcd_unit(it, nMT, nNT, mt, nt, smem)) break;
        const int row0 = mt * BMt, col0 = nt * BN;
        f32x4 acc[WM][4];
        auto arow = [&](int i) { return (unsigned)((row0 + i) * D); };
        gemm_tile_dma<WM>(Y, arow, W + col0, D, D, smem, acc);
#pragma unroll
        for (int m = 0; m < WM; ++m) {
            const int row = row0 + wr * (16 * WM) + m * 16 + fr;
            const int mr = row_modrow(row);
            const float* g1 = tab + TAB_MOD + (l * 9 + mr) * 6144 + 2 * 1024;
            const float* xin = (l == 0) ? (row < RL ? p.in[0] + (size_t)row * D : p.in[2] + (size_t)(row - RL) * D) : X2 + (size_t)row * D;
#pragma unroll
            for (int n = 0; n < 4; ++n) {
                const int col = col0 + wc * 64 + n * 16 + fq * 4;
                const f32x4 xv = *(const f32x4*)(xin + col), gv = *(const f32x4*)(g1 + col);
                *(f32x4*)(X1 + (size_t)row * D + col) = xv + gv * acc[m][n];
            }
        }
    }
}
__device__ void phase_out(const Params& p, int l, unsigned char* smem) {
    if (l == 0) phase_out_t<6>(p, l, smem); else phase_out_t<4>(p, l, smem);
}

__device__ void phase_route(const Params& p, int l, unsigned char* smem) {
    const float* tab = (const float*)(p.ws + WS_TAB);
    bf16_t* H = (bf16_t*)(p.ws + WS_H);
    const float* X1 = (const float*)(p.ws + WS_X1);
    int* rt = (int*)(p.ws + WS_RT);
    unsigned* ctl = (unsigned*)(p.ws + WS_CTL);
    const float* nw = p.in[15] + l * 1024;
    const float* wg = p.in[16] + (size_t)l * 1024 * 4;
    const float* bg = p.in[17] + l * 4;
    const float* we = p.in[18] + (size_t)l * 1024 * 32;
    const float* be = p.in[19] + l * 32;
    const int tid = otid(), lane = tid & 63, wid = tid >> 6, wr = wid >> 1, wc = wid & 1, fr = lane & 15, fq = lane >> 4;
    const int nrows = (l == 0) ? R : RL;
    float* Ls = (float*)smem;
    constexpr int BM = 64;
    for (int u = obid(); u < nrows / BM; u += gridDim.x) {
        const int row0 = u * BM;
        {
            const int mr = row_modrow(row0);
            const float* sh = tab + TAB_MOD + (l * 9 + mr) * 6144 + 3 * 1024;
            const float* scv = sh + 1024;
            f32x4 ma[4], mb[4];
#pragma unroll
            for (int j = 0; j < 4; ++j) {
                const int k = 4 * lane + 256 * j;
                ma[j] = *(const f32x4*)(nw + k) * (1.f + *(const f32x4*)(scv + k)); mb[j] = *(const f32x4*)(sh + k);
            }
#pragma unroll 1
            for (int rb = 0; rb < 4; ++rb) {
                const int rowb = row0 + wid * 16 + rb * 4;
                f32x4 v[4][4];
#pragma unroll
                for (int q = 0; q < 4; ++q)
#pragma unroll
                    for (int j = 0; j < 4; ++j) v[q][j] = *(const f32x4*)(X1 + (size_t)(rowb + q) * D + 4 * lane + 256 * j);
                float ss[4];
#pragma unroll
                for (int q = 0; q < 4; ++q) {
                    ss[q] = 0.f;
#pragma unroll
                    for (int j = 0; j < 4; ++j) ss[q] += (v[q][j].x * v[q][j].x + v[q][j].y * v[q][j].y) + (v[q][j].z * v[q][j].z + v[q][j].w * v[q][j].w);
                }
#pragma unroll
                for (int o = 1; o < 64; o <<= 1) {
#pragma unroll
                    for (int q = 0; q < 4; ++q) ss[q] += __shfl_xor(ss[q], o);
                }
#pragma unroll
                for (int q = 0; q < 4; ++q) {
                    const float rstd = rsqrtf(ss[q] * (1.f / D) + EPS);
#pragma unroll
                    for (int j = 0; j < 4; ++j) {
                        const f32x4 o = v[q][j] * rstd * ma[j] + mb[j];
                        u32x2 pk; pk.x = pk2(o.x, o.y); pk.y = pk2(o.z, o.w);
                        *(u32x2*)(H + (size_t)(rowb + q) * D + 4 * lane + 256 * j) = pk;
                    }
                }
            }
        }
        asm volatile("s_waitcnt vmcnt(0)" ::: "memory");
        __syncthreads();
        {
            const bf16_t* WRl = (const bf16_t*)(p.ws + WS_WR) + (size_t)l * 48 * 1024;
            f32x4 acc[4][3];
#pragma unroll
            for (int m = 0; m < 4; ++m)
#pragma unroll
                for (int n = 0; n < 3; ++n) acc[m][n] = (f32x4){0.f, 0.f, 0.f, 0.f};
            const bf16_t* ap = H + (size_t)(row0 + fr) * D + wid * 256 + fq * 8;
            const bf16_t* bp = WRl + (size_t)fr * 1024 + wid * 256 + fq * 8;
#pragma unroll
            for (int kh = 0; kh < 2; ++kh) {
                bf16x8 af[4][4], bf[4][3];
#pragma unroll
                for (int ks = 0; ks < 4; ++ks) {
#pragma unroll
                    for (int m = 0; m < 4; ++m) af[ks][m] = *(const bf16x8*)(ap + (size_t)m * 16 * D + (kh * 4 + ks) * 32);
#pragma unroll
                    for (int n = 0; n < 3; ++n) bf[ks][n] = *(const bf16x8*)(bp + (size_t)n * 16 * 1024 + (kh * 4 + ks) * 32);
                }
#pragma unroll
                for (int ks = 0; ks < 4; ++ks)
#pragma unroll
                    for (int m = 0; m < 4; ++m)
#pragma unroll
                        for (int n = 0; n < 3; ++n) acc[m][n] = __builtin_amdgcn_mfma_f32_16x16x32_bf16(bf[ks][n], af[ks][m], acc[m][n], 0, 0, 0);
            }
            float* Lp = (float*)smem + wid * (64 * 48);
#pragma unroll
            for (int m = 0; m < 4; ++m)
#pragma unroll
                for (int n = 0; n < 3; ++n) *(f32x4*)(Lp + (m * 16 + fr) * 48 + n * 16 + fq * 4) = acc[m][n];
        }
        __syncthreads();
        unsigned* lcnt = (unsigned*)(smem + 49152);
        if (tid < 32) lcnt[tid] = 0u;
        int dec_ea = 0, dec_eb = 0, dec_la = 0, dec_lb = 0; float dec_ga = 0.f, dec_gb = 0.f;
        __syncthreads();
        if (tid < BM) {
            const int row = row0 + tid;
            const float* lp = (const float*)smem + tid * 48;
            float lg[36];
#pragma unroll
            for (int i = 0; i < 36; ++i) lg[i] = (lp[i] + lp[64 * 48 + i]) + (lp[2 * 64 * 48 + i] + lp[3 * 64 * 48 + i]);
            float gl[4];
#pragma unroll
            for (int i = 0; i < 4; ++i) gl[i] = lg[i] + bg[i];
            int grp = 0; float gm = gl[0];
#pragma unroll
            for (int i = 1; i < 4; ++i) if (gl[i] > gm) { gm = gl[i]; grp = i; }
            float gs = 0.f;
#pragma unroll
            for (int i = 0; i < 4; ++i) gs += expf(gl[i] - gm);
            const float pgrp = 1.f / gs;
            float ev[8];
#pragma unroll
            for (int i = 0; i < 8; ++i) {
                float x = lg[4 + i];
#pragma unroll
                for (int g = 1; g < 4; ++g) x = (grp == g) ? lg[4 + g * 8 + i] : x;
                ev[i] = x + be[grp * 8 + i];
            }
            int i0 = 0; float v0 = ev[0];
#pragma unroll
            for (int i = 1; i < 8; ++i) if (ev[i] > v0) { v0 = ev[i]; i0 = i; }
            int i1 = -1; float v1 = -3.0e38f;
#pragma unroll
            for (int i = 0; i < 8; ++i) if (i != i0 && ev[i] > v1) { v1 = ev[i]; i1 = i; }
            const float e1 = expf(v1 - v0);
            const float ga = pgrp / (1.f + e1), gb = pgrp * e1 / (1.f + e1);
            const int ea = grp * 8 + i0, eb = grp * 8 + i1;
            dec_ea = ea; dec_eb = eb; dec_ga = ga; dec_gb = gb;
            dec_la = (int)atomicAdd(&lcnt[ea], 1u);
            dec_lb = (int)atomicAdd(&lcnt[eb], 1u);
        }
        __syncthreads();
        if (tid < 32) { const unsigned c = lcnt[tid]; lcnt[32 + tid] = c ? atomicAdd(&ctl[cur_idx(l, tid)], c) : 0u; }
        __syncthreads();
        if (tid < BM) {
            const int row = row0 + tid;
            const int sa = (int)lcnt[32 + dec_ea] + dec_la, sb = (int)lcnt[32 + dec_eb] + dec_lb;
            rt[row * 2] = dec_ea; rt[row * 2 + 1] = dec_eb;
            rt[2 * R + row * 2] = sa; rt[2 * R + row * 2 + 1] = sb;
            ((float*)rt)[4 * R + row * 2] = dec_ga; ((float*)rt)[4 * R + row * 2 + 1] = dec_gb;
            rt[6 * R + dec_ea * R + sa] = row;
            rt[6 * R + dec_eb * R + sb] = row;
        }
        __syncthreads();
    }
}

constexpr int MOE_WM = 6, MOE_BM = 32 * MOE_WM;
__device__ __forceinline__ void moe_units(const Params& p, int l, int* s_cnt, int* s_base, int* s_tpre) {
    const unsigned* ctl = (const unsigned*)(p.ws + WS_CTL);
    if (otid() == 0) {
        int base = 0, tp = 0;
        for (int e = 0; e < NEXP; ++e) {
            const int c = (int)ctl[cur_idx(l, e)];
            s_cnt[e] = c; s_base[e] = base; s_tpre[e] = tp;
            base += c; tp += (c + MOE_BM - 1) / MOE_BM;
        }
        s_tpre[NEXP] = tp;
    }
    __syncthreads();
}

__device__ void phase_moe1(const Params& p, int l, unsigned char* smem) {
    int* s_cnt = (int*)(smem + 73728);
    int* s_base = s_cnt + 32;
    int* s_tpre = s_base + 32;
    moe_units(p, l, s_cnt, s_base, s_tpre);
    const bf16_t* H = (const bf16_t*)(p.ws + WS_H);
    bf16_t* HM = (bf16_t*)(p.ws + WS_LF);
    const int* list = (const int*)(p.ws + WS_RT) + 6 * R;
    const float* W1 = p.in[20] + (size_t)l * NEXP * D * FF;
    const float* W3 = p.in[21] + (size_t)l * NEXP * D * FF;
    const int tid = otid(), lane = tid & 63, wid = tid >> 6, wr = wid >> 1, wc = wid & 1, fr = lane & 15, fq = lane >> 4;
    const int ntiles = s_tpre[NEXP];
    constexpr int nNT = FF / 64;
    for (int it = 0;; ++it) {
        int tg, nt;
        if (!xcd_unit(it, ntiles, nNT, tg, nt, smem)) break;
        int e = 0;
        while (s_tpre[e + 1] <= tg) ++e;
        const int mt = tg - s_tpre[e], cnt = s_cnt[e], base = s_base[e];
        const float* w1 = W1 + (size_t)e * D * FF;
        const float* w3 = W3 + (size_t)e * D * FF;
        const int* lst = list + (size_t)e * R;
        f32x4 acc[MOE_WM][4];
        auto arow = [&](int i) { int s = mt * MOE_BM + i; s = s < cnt ? s : cnt - 1; return (unsigned)(lst[s] * D); };
        auto bptr = [&](int k, int rho) {
            const int n = (rho >> 4) & 3;
            const int col = nt * 64 + (rho >> 6) * 32 + (n & 1) * 16 + (rho & 15);
            return ((n >= 2) ? w3 : w1) + (size_t)k * FF + col;
        };
        gemm_tile<MOE_WM, 1>(H, arow, bptr, D, smem, acc);
#pragma unroll
        for (int m = 0; m < MOE_WM; ++m) {
            const int s = mt * MOE_BM + wr * (16 * MOE_WM) + m * 16 + fr;
            if (s < cnt) {
#pragma unroll
                for (int n = 0; n < 2; ++n) {
                    float hv[4];
#pragma unroll
                    for (int j = 0; j < 4; ++j) hv[j] = siluf_(acc[m][n][j]) * acc[m][n + 2][j];
                    u32x2 pk; pk.x = pk2(hv[0], hv[1]); pk.y = pk2(hv[2], hv[3]);
                    *(u32x2*)(HM + (size_t)(base + s) * FF + nt * 64 + wc * 32 + n * 16 + fq * 4) = pk;
                }
            }
        }
    }
}

__device__ void phase_moe2(const Params& p, int l, unsigned char* smem) {
    int* s_cnt = (int*)(smem + 73728);
    int* s_base = s_cnt + 32;
    int* s_tpre = s_base + 32;
    moe_units(p, l, s_cnt, s_base, s_tpre);
    const bf16_t* HM = (const bf16_t*)(p.ws + WS_LF);
    bf16_t* OUTM = (bf16_t*)(p.ws + WS_P);
    const float* W2 = p.in[22] + (size_t)l * NEXP * FF * D;
    const int tid = otid(), lane = tid & 63, wid = tid >> 6, wr = wid >> 1, wc = wid & 1, fr = lane & 15, fq = lane >> 4;
    const int ntiles = s_tpre[NEXP];
    constexpr int nNT = D / BN;
    for (int it = 0;; ++it) {
        int tg, nt;
        if (!xcd_unit(it, ntiles, nNT, tg, nt, smem)) break;
        int e = 0;
        while (s_tpre[e + 1] <= tg) ++e;
        const int mt = tg - s_tpre[e], cnt = s_cnt[e], base = s_base[e];
        const float* w2 = W2 + (size_t)e * FF * D;
        f32x4 acc[MOE_WM][4];
        auto arow = [&](int i) { int s = mt * MOE_BM + i; s = s < cnt ? s : cnt - 1; return (unsigned)((base + s) * FF); };
        auto bptr = [&](int k, int n) { return w2 + (size_t)k * D + nt * BN + n; };
        gemm_tile<MOE_WM, 1>(HM, arow, bptr, FF, smem, acc);
#pragma unroll
        for (int m = 0; m < MOE_WM; ++m) {
            const int s = mt * MOE_BM + wr * (16 * MOE_WM) + m * 16 + fr;
            if (s < cnt) {
#pragma unroll
                for (int n = 0; n < 4; ++n) {
                    u32x2 pk; pk.x = pk2(acc[m][n][0], acc[m][n][1]); pk.y = pk2(acc[m][n][2], acc[m][n][3]);
                    *(u32x2*)(OUTM + (size_t)(base + s) * D + nt * BN + wc * 64 + n * 16 + fq * 4) = pk;
                }
            }
        }
    }
}

#define XB_TMO      128
#define XB_XCNT(j)  (256  + 64 * (j))
#define XB_XSUB(j)  (1280 + 64 * (j))
#define XB_XGEN(j)  (2304 + 64 * (j))
#define XB_TOP      3328
#define XB_TOPGEN   3392
#define XCD_BAR_WORDS 3456
#define XB_SPIN_CAP (1u << 22)
#define LAS __attribute__((address_space(3)))
__device__ __forceinline__ unsigned xb_ld(unsigned* p)              { return __hip_atomic_load(p, __ATOMIC_RELAXED, __HIP_MEMORY_SCOPE_AGENT); }
__device__ __forceinline__ unsigned xb_add(unsigned* p, unsigned v) { return __hip_atomic_fetch_add(p, v, __ATOMIC_RELAXED, __HIP_MEMORY_SCOPE_AGENT); }
__device__ __forceinline__ unsigned xb_xcc_id() { return (unsigned)__builtin_amdgcn_s_getreg((3 << 11) | 20) & 0xFu; }
#define XB_SPIN(cond, bar) do { unsigned _sp = 0; while (cond) { __builtin_amdgcn_s_sleep(1); \
    if ((++_sp & 255u) == 0u) { if (xb_ld(&(bar)[XB_TMO])) break; if (_sp > XB_SPIN_CAP) { atomicAdd(&(bar)[XB_TMO], 1u); break; } } } } while (0)
struct XcdBarrier { unsigned* bar; unsigned x; volatile unsigned* st; };
__device__ __forceinline__ XcdBarrier xcd_barrier_post(unsigned* bar, volatile unsigned* st, volatile int* xinfo) {
    XcdBarrier b; b.bar = bar; b.x = xb_xcc_id(); b.st = st;
    if (threadIdx.x == 0) { const unsigned r = xb_add(&bar[XB_XCNT(b.x)], 1u); xinfo[0] = 0; xinfo[1] = (int)b.x; xinfo[2] = (int)r; xinfo[3] = 0; }
    return b;
}
__device__ __forceinline__ void xcd_barrier_complete(unsigned* bar, unsigned x, unsigned& nloc, unsigned& nx) {
    const unsigned G = gridDim.x * gridDim.y * gridDim.z;
    unsigned sum, cnt, mine, sp = 0u;
    for (;;) {
        sum = 0u; cnt = 0u; mine = 0u;
#pragma unroll
        for (unsigned j = 0; j < 16; ++j) { const unsigned c = xb_ld(&bar[XB_XCNT(j)]); sum += c; cnt += (c > 0u) ? 1u : 0u; mine = (j == x) ? c : mine; }
        if (sum == G) break;
        __builtin_amdgcn_s_sleep(1);
        if ((++sp & 255u) == 0u) { if (xb_ld(&bar[XB_TMO])) break; if (sp > XB_SPIN_CAP) { atomicAdd(&bar[XB_TMO], 1u); break; } }
    }
    nloc = mine > 0u ? mine : 1u; nx = cnt > 0u ? cnt : 1u;
}
__device__ __forceinline__ void xcd_barrier(const XcdBarrier& b) {
    asm volatile("s_waitcnt vmcnt(0)" ::: "memory");
    __syncthreads();
    if (threadIdx.x == 0) {
        unsigned* bar = b.bar;
        __builtin_amdgcn_s_waitcnt(0);
        unsigned nloc = b.st[0], nx = b.st[1];
        if (nloc == 0u) { xcd_barrier_complete(bar, b.x, nloc, nx); b.st[0] = nloc; b.st[1] = nx; }
        const unsigned old = xb_add(&bar[XB_XSUB(b.x)], 1u);
        const unsigned gen = old / nloc;
        if (old + 1u == (gen + 1u) * nloc) {
            __builtin_amdgcn_fence(__ATOMIC_RELEASE, "agent");
            asm volatile("s_waitcnt vmcnt(0)" ::: "memory");
            const unsigned og = xb_add(&bar[XB_TOP], 1u);
            const unsigned tg = og / nx;
            if (og + 1u == (tg + 1u) * nx) xb_add(&bar[XB_TOPGEN], 1u);
            else XB_SPIN(xb_ld(&bar[XB_TOPGEN]) == tg, bar);
            __builtin_amdgcn_fence(__ATOMIC_ACQUIRE, "agent");
            xb_add(&bar[XB_XGEN(b.x)], 1u);
            asm volatile("s_waitcnt vmcnt(0)" ::: "memory");
        } else {
            XB_SPIN(xb_ld(&bar[XB_XGEN(b.x)]) == gen, bar);
            __builtin_amdgcn_fence(__ATOMIC_ACQUIRE, "agent");
            asm volatile("s_waitcnt vmcnt(0)" ::: "memory");
        }
    }
    __syncthreads();
}

constexpr int NPHASES = 16;
#ifndef PROBE_S
#define PROBE_S -1
#define PROBE_REPS 1
#endif
constexpr int SMEM_BYTES = 4 * 64 * LDT * 2 + 4 * 64 * LDT * 2 + 1024;
__global__ void __launch_bounds__(NTHREADS, 2) mega(Params p) {
    __shared__ __attribute__((aligned(16))) unsigned char smem[SMEM_BYTES];
    cg::grid_group grid = cg::this_grid();
    {
        volatile unsigned* st = (volatile unsigned*)(smem + 73728 + 768);
        if (threadIdx.x < 2) st[threadIdx.x] = 0u;
        __syncthreads();
        volatile int* xinfo = (volatile int*)(smem + 73728 + 800);
        (void)xcd_barrier_post((unsigned*)(p.ws + WS_CTL) + 4096, st, xinfo);
    }
#define GRID_BAR() do { XcdBarrier bar_; bar_.bar = (unsigned*)(p.ws + WS_CTL) + 4096; bar_.x = xb_xcc_id(); bar_.st = (volatile unsigned*)(smem + 73728 + 768); xcd_barrier(bar_); } while (0)
    for (int ph = p.ph_lo; ph < p.ph_hi; ++ph) {
        if (ph == 0) phase_init(p, smem);
        else if (ph == NPHASES - 1) phase_final(p, 1);
        else {
            const int l = (ph - 1) / 7, s = (ph - 1) % 7;
            const int reps = (s == PROBE_S) ? PROBE_REPS : 1;
            for (int rep = 0; rep < reps; ++rep) {
                switch (s) {
                    case 0: phase_prep(p, l); break;
                    case 1: phase_gemm_in(p, l, smem); break;
                    case 2: phase_mix1(p, l, smem, rep); break;
                    case 3: phase_out(p, l, smem); break;
                    case 4: phase_route(p, l, smem); break;
                    case 5: phase_moe1(p, l, smem); break;
                    default: phase_moe2(p, l, smem); break;
                }
                if (rep + 1 < reps) GRID_BAR();
            }
        }
        if (ph + 1 < p.ph_hi) {
            if (ph == 0) {
                if (p.ph_hi < 0) grid.sync();
                GRID_BAR();
                if (threadIdx.x == 0) {
                    unsigned* bw = (unsigned*)(p.ws + WS_CTL) + 4096;
                    volatile int* xi = (volatile int*)(smem + 73728 + 800);
                    const unsigned myx = xb_xcc_id();
                    unsigned sum = 0, ok = 1;
                    for (int j = 0; j < 8; ++j) { const unsigned c = xb_ld(&bw[XB_XCNT(j)]); sum += c; ok &= (c > 0u); }
                    xi[3] = (int)xb_ld(&bw[XB_XCNT(myx & 7u)]);
                    xi[0] = (ok && sum == gridDim.x && myx < 8u) ? 1 : 0;
                }
                __syncthreads();
            } else GRID_BAR();
        }
    }
}

extern "C" void kernel_launch(void* const* d_in, const int* in_sizes, int n_in, void* d_out, int out_size, void* d_ws, size_t ws_size, hipStream_t stream) {
    static int grid_blocks = 0;
    if (grid_blocks == 0) {
        if (n_in != 23 || out_size != RL * D || ws_size < WS_END) { fprintf(stderr, "kernel_launch: unexpected shapes (n_in %d out %d ws %zu need %zu)\n", n_in, out_size, ws_size, (size_t)WS_END); grid_blocks = -1; return; }
        int dev = 0, cus = 0, per_cu = 0;
        hipGetDevice(&dev);
        hipDeviceGetAttribute(&cus, hipDeviceAttributeMultiprocessorCount, dev);
        hipOccupancyMaxActiveBlocksPerMultiprocessor(&per_cu, mega, NTHREADS, 0);
        if (per_cu > 2) per_cu = 2;
        if (per_cu < 1) per_cu = 1;
        grid_blocks = cus * per_cu;
    }
    if (grid_blocks < 0) return;
    hipMemsetAsync((char*)d_ws + WS_CTL, 0, 1 * MiB, stream);
    Params p{};
    for (int i = 0; i < 23; ++i) p.in[i] = (const float*)d_in[i];
    p.out = (float*)d_out; p.ws = (unsigned char*)d_ws; p.ph_lo = 0; p.ph_hi = NPHASES;
    void* args[] = {&p};
    hipError_t e = hipLaunchCooperativeKernel((void*)mega, dim3(grid_blocks), dim3(NTHREADS), args, 0, stream);
    if (e != hipSuccess) fprintf(stderr, "cooperative launch failed: %s (grid %d)\n", hipGetErrorString(e), grid_blocks);
}
```

```cpp
#include <hip/hip_runtime.h>
#include <hip/hip_cooperative_groups.h>
#include <cstdio>
#include <cstdint>
namespace cg = cooperative_groups;

constexpr int D = 1024, NB = 8, T = 2048, TC = 256;
constexpr int RL = NB * T, RC = NB * TC, R = RL + RC;
constexpr int INW = 2560, LFW = 512;
constexpr int OFF_B = 512, OFF_KV = 1024, OFF_V = 1152, OFF_C = 1280, OFF_ZF = 1536, OFF_ZB = 1792, OFF_HV = 2048, OFF_G = 2304;
constexpr int NEXP = 32, FF = 512;
constexpr float EPS = 1e-6f;
constexpr int NTHREADS = 256;

constexpr size_t MiB = 1ull << 20;
constexpr size_t WS_CTL = 0;
constexpr size_t WS_TAB = 1 * MiB;
constexpr size_t WS_H = 2 * MiB;
constexpr size_t WS_P = WS_H + 36 * MiB;
constexpr size_t WS_LF = WS_P + 90 * MiB;
constexpr size_t WS_Y = WS_LF + 36 * MiB;
constexpr size_t WS_X1 = WS_Y + 36 * MiB;
constexpr size_t WS_X2 = WS_X1;
constexpr size_t WS_OFB = WS_X1 + 72 * MiB;
constexpr size_t WS_RT = WS_OFB + 18 * MiB;
constexpr size_t WS_WIN = WS_RT + 4 * MiB;
constexpr size_t WS_WOUT = WS_WIN + 10 * MiB;
constexpr size_t WS_WR = WS_WOUT + 4 * MiB;
constexpr size_t WS_W13 = WS_WR + 1 * MiB;
constexpr size_t WS_W2 = WS_W13 + 128 * MiB;
constexpr size_t WS_END = WS_W2 + 64 * MiB;
constexpr int TAB_ROPE = 0;
constexpr int TAB_LB = 2048;
constexpr int TAB_MOD = 4096;

typedef unsigned short bf16_t;
typedef short bf16x8 __attribute__((ext_vector_type(8)));
typedef float f32x4 __attribute__((ext_vector_type(4)));
typedef float f32x2 __attribute__((ext_vector_type(2)));
typedef unsigned u32x4 __attribute__((ext_vector_type(4)));
typedef unsigned u32x2 __attribute__((ext_vector_type(2)));
typedef __bf16 bf16x2_t __attribute__((ext_vector_type(2)));

struct Params {
    const float* in[23];
    float* out;
    unsigned char* ws;
    int ph_lo, ph_hi;
};

__device__ __forceinline__ unsigned pk2(float lo, float hi) { f32x2 v = {lo, hi}; bf16x2_t b = __builtin_convertvector(v, bf16x2_t); return __builtin_bit_cast(unsigned, b); }
__device__ __forceinline__ bf16_t f2bf(float f) { return (bf16_t)(pk2(f, 0.f) & 0xffffu); }
__device__ __forceinline__ float bf2f(bf16_t u) { return __uint_as_float(((unsigned)u) << 16); }
__device__ __forceinline__ float bflo(unsigned w) { return __uint_as_float(w << 16); }
__device__ __forceinline__ float bfhi(unsigned w) { return __uint_as_float(w & 0xffff0000u); }
__device__ __forceinline__ float wave_sum(float v) {
#pragma unroll
    for (int o = 1; o < 64; o <<= 1) v += __shfl_xor(v, o);
    return v;
}
__device__ __forceinline__ float sigmoidf_(float x) { return __builtin_amdgcn_rcpf(1.f + __expf(-x)); }
__device__ __forceinline__ float siluf_(float x) { return x * sigmoidf_(x); }
__device__ __forceinline__ float gelu_tanh(float x) {
    const float u = 0.7978845608028654f * (x + 0.044715f * x * x * x);
    return x * __builtin_amdgcn_rcpf(1.f + __expf(-2.f * u));
}
__device__ __forceinline__ int otid() { int t = threadIdx.x; asm volatile("" : "+v"(t)); return t; }
__device__ __forceinline__ int obid() { int t = blockIdx.x; asm volatile("" : "+s"(t)); return t; }
__device__ __forceinline__ int cur_idx(int l, int e) { return 8192 + (l * 32 + e) * 64; }
__device__ __forceinline__ int row_modrow(int row) { return row < RL ? (row >> 11) : 8; }

__device__ void phase_init(const Params& p, unsigned char* smem) {
    float* tab = (float*)(p.ws + WS_TAB);
    const float* c = p.in[1];
    const float* c_ctx = p.in[3];
    const float* w_mod = p.in[4];
    const float* b_mod = p.in[5];
    float* sc = (float*)smem;
    const int tid = otid();
    for (int i = tid; i < 9 * 1024; i += NTHREADS) {
        const int b = i >> 10, k = i & 1023;
        const float v = (b < 8) ? c[b * 1024 + k] : c_ctx[k];
        sc[i] = siluf_(v);
    }
    __syncthreads();
    float* red = (float*)(smem + 36864);
    for (int it = obid(); it < 384; it += gridDim.x) {
        const int l = it / 192, j0 = (it % 192) * 32;
        const int jj = tid & 31, kg = tid >> 5;
        const float* w = w_mod + (size_t)l * 1024 * 6144 + (size_t)(kg * 128) * 6144 + j0 + jj;
        float acc[9];
#pragma unroll
        for (int b = 0; b < 9; ++b) acc[b] = 0.f;
        for (int k0 = 0; k0 < 128; k0 += 8) {
            float wv[8];
#pragma unroll
            for (int i = 0; i < 8; ++i) wv[i] = w[(size_t)(k0 + i) * 6144];
#pragma unroll
            for (int i = 0; i < 8; ++i)
#pragma unroll
                for (int b = 0; b < 9; ++b) acc[b] += sc[b * 1024 + kg * 128 + k0 + i] * wv[i];
        }
#pragma unroll
        for (int b = 0; b < 9; ++b) red[(kg * 9 + b) * 32 + jj] = acc[b];
        __syncthreads();
        for (int o = tid; o < 9 * 32; o += NTHREADS) {
            const int b = o >> 5, j2 = o & 31;
            float sum = 0.f;
#pragma unroll
            for (int g = 0; g < 8; ++g) sum += red[(g * 9 + b) * 32 + j2];
            tab[TAB_MOD + (l * 9 + b) * 6144 + j0 + j2] = sum + b_mod[l * 6144 + j0 + j2];
        }
        __syncthreads();
    }
    {
        const int gtid = obid() * NTHREADS + tid, gsize = gridDim.x * NTHREADS;
        const float* w_in = p.in[7]; const float* w_out = p.in[14];
        bf16_t* WIN = (bf16_t*)(p.ws + WS_WIN); bf16_t* WOUT = (bf16_t*)(p.ws + WS_WOUT); bf16_t* WR = (bf16_t*)(p.ws + WS_WR);
        for (int i = gtid; i < 2 * 1024 * INW / 4; i += gsize) { const f32x4 v = *(const f32x4*)(w_in + (size_t)i * 4); u32x2 o; o.x = pk2(v[0], v[1]); o.y = pk2(v[2], v[3]); *(u32x2*)(WIN + (size_t)i * 4) = o; }
        for (int i = gtid; i < 2 * 1024 * D / 4; i += gsize) { const f32x4 v = *(const f32x4*)(w_out + (size_t)i * 4); u32x2 o; o.x = pk2(v[0], v[1]); o.y = pk2(v[2], v[3]); *(u32x2*)(WOUT + (size_t)i * 4) = o; }
        for (int i = gtid; i < 2 * 48 * 1024; i += gsize) {
            const int k = i & 1023, n = (i >> 10) % 48, l = i / (48 * 1024);
            float v = 0.f;
            if (n < 4) v = p.in[16][((size_t)l * 1024 + k) * 4 + n];
            else if (n < 36) v = p.in[18][((size_t)l * 1024 + k) * 32 + (n - 4)];
            WR[i] = f2bf(v);
        }
    }
    if (obid() == gridDim.x - 1) {
        for (int i = tid; i < 64 * 16; i += NTHREADS) {
            const int pos = i >> 4, f = i & 15;
            const float inv = 1.0f / powf(10000.0f, (float)(2 * f) / 32.0f);
            const float ang = (float)pos * inv;
            tab[TAB_ROPE + i * 2] = cosf(ang);
            tab[TAB_ROPE + i * 2 + 1] = sinf(ang);
        }
        const float* lbl = p.in[12];
        for (int i = tid; i < 512; i += NTHREADS) {
            const float a0 = lbl[i], a1 = lbl[512 + i];
            const float m = fmaxf(a0, a1);
            const float e0 = expf(a0 - m), e1 = expf(a1 - m);
            const float s1 = e1 / (e0 + e1);
            tab[TAB_LB + i] = 0.f;
            tab[TAB_LB + 512 + i] = s1;
        }
    }
}

__device__ void phase_prep(const Params& p, int l) {
    const float* tab = (const float*)(p.ws + WS_TAB);
    bf16_t* H = (bf16_t*)(p.ws + WS_H);
    const int lane = otid() & 63;
    const int gw = obid() * (NTHREADS / 64) + (otid() >> 6), NGW = gridDim.x * (NTHREADS / 64);
    const float* nw = p.in[6] + l * 1024;
    const int* rt = (const int*)(p.ws + WS_RT);
    int basev = 0;
    if (l > 0) {
        const unsigned* ctl = (const unsigned*)(p.ws + WS_CTL);
        const int cnt = (lane < NEXP) ? (int)ctl[cur_idx(l - 1, lane & 31)] : 0;
        int incl = cnt;
#pragma unroll
        for (int o = 1; o < 32; o <<= 1) { const int t = __shfl_up(incl, o); if (lane >= o) incl += t; }
        basev = incl - cnt;
    }
    auto load_row = [&](int row, f32x4 (&v)[4]) {
        if (l == 0) {
            const float* src = row < RL ? p.in[0] + (size_t)row * D : p.in[2] + (size_t)(row - RL) * D;
#pragma unroll
            for (int j = 0; j < 4; ++j) v[j] = *(const f32x4*)(src + 4 * lane + 256 * j);
        } else {
            const int mr = row_modrow(row);
            const float* X1 = (const float*)(p.ws + WS_X1) + (size_t)row * D;
            const int e0 = rt[row * 2], e1 = rt[row * 2 + 1];
            const int s0 = rt[2 * R + row * 2], s1 = rt[2 * R + row * 2 + 1];
            const float g0 = ((const float*)rt)[4 * R + row * 2], g1 = ((const float*)rt)[4 * R + row * 2 + 1];
            const int base0 = __shfl(basev, e0), base1 = __shfl(basev, e1);
            const bf16_t* O0 = (const bf16_t*)(p.ws + WS_P) + (size_t)(base0 + s0) * D;
            const bf16_t* O1 = (const bf16_t*)(p.ws + WS_P) + (size_t)(base1 + s1) * D;
            const float* g2 = tab + TAB_MOD + ((l - 1) * 9 + mr) * 6144 + 5 * 1024;
            float* X2 = (float*)(p.ws + WS_X2) + (size_t)row * D;
#pragma unroll
            for (int j = 0; j < 4; ++j) {
                const int k = 4 * lane + 256 * j;
                const f32x4 x1 = *(const f32x4*)(X1 + k);
                const u32x2 a = *(const u32x2*)(O0 + k), b = *(const u32x2*)(O1 + k);
                const f32x4 gg = *(const f32x4*)(g2 + k);
                f32x4 m;
                m.x = g0 * bflo(a.x) + g1 * bflo(b.x); m.y = g0 * bfhi(a.x) + g1 * bfhi(b.x);
                m.z = g0 * bflo(a.y) + g1 * bflo(b.y); m.w = g0 * bfhi(a.y) + g1 * bfhi(b.y);
                v[j] = x1 + gg * m;
                *(f32x4*)(X2 + k) = v[j];
            }
        }
    };
    auto store_row = [&](int row, const f32x4 (&v)[4], float ss) {
        const int mr = row_modrow(row);
        const float rstd = rsqrtf(ss * (1.f / D) + EPS);
        const float* sh = tab + TAB_MOD + (l * 9 + mr) * 6144;
        const float* scv = sh + 1024;
#pragma unroll
        for (int j = 0; j < 4; ++j) {
            const int k = 4 * lane + 256 * j;
            const f32x4 w = *(const f32x4*)(nw + k), s = *(const f32x4*)(scv + k), h = *(const f32x4*)(sh + k);
            const f32x4 o = v[j] * rstd * w * (1.f + s) + h;
            u32x2 pk; pk.x = pk2(o.x, o.y); pk.y = pk2(o.z, o.w);
            *(u32x2*)(H + (size_t)row * D + k) = pk;
        }
    };
    for (int row = gw; row < R; row += 3 * NGW) {
        const int r1 = row + NGW, r2 = row + 2 * NGW;
        const bool h1 = r1 < R, h2 = r2 < R;
        f32x4 v0[4], v1[4], v2[4];
        load_row(row, v0);
        if (h1) load_row(r1, v1);
        if (h2) load_row(r2, v2);
        float s0 = 0.f, s1 = 0.f, s2 = 0.f;
#pragma unroll
        for (int j = 0; j < 4; ++j) {
            s0 += (v0[j].x * v0[j].x + v0[j].y * v0[j].y) + (v0[j].z * v0[j].z + v0[j].w * v0[j].w);
            if (h1) s1 += (v1[j].x * v1[j].x + v1[j].y * v1[j].y) + (v1[j].z * v1[j].z + v1[j].w * v1[j].w);
            if (h2) s2 += (v2[j].x * v2[j].x + v2[j].y * v2[j].y) + (v2[j].z * v2[j].z + v2[j].w * v2[j].w);
        }
#pragma unroll
        for (int o = 1; o < 64; o <<= 1) { s0 += __shfl_xor(s0, o); s1 += __shfl_xor(s1, o); s2 += __shfl_xor(s2, o); }
        store_row(row, v0, s0);
        if (h1) store_row(r1, v1, s1);
        if (h2) store_row(r2, v2, s2);
    }
}

__device__ void phase_final(const Params& p, int l) {
    const float* tab = (const float*)(p.ws + WS_TAB);
    const int lane = otid() & 63;
    const int gw = obid() * (NTHREADS / 64) + (otid() >> 6), NGW = gridDim.x * (NTHREADS / 64);
    const int* rt = (const int*)(p.ws + WS_RT);
    const unsigned* ctl = (const unsigned*)(p.ws + WS_CTL);
    int basev;
    {
        const int cnt = (lane < NEXP) ? (int)ctl[cur_idx(l, lane & 31)] : 0;
        int incl = cnt;
#pragma unroll
        for (int o = 1; o < 32; o <<= 1) { const int t = __shfl_up(incl, o); if (lane >= o) incl += t; }
        basev = incl - cnt;
    }
    for (int row0 = gw; row0 < RL; row0 += 2 * NGW) {
        f32x4 x1[2][4], gg[2][4]; u32x2 oa[2][4], ob[2][4]; float g0[2], g1[2];
#pragma unroll
        for (int q = 0; q < 2; ++q) {
            const int row = row0 + q * NGW;
            if (row < RL) {
                const int mr = row >> 11;
                const float* X1 = (const float*)(p.ws + WS_X1) + (size_t)row * D;
                const int e0 = rt[row * 2], e1 = rt[row * 2 + 1];
                const int s0 = rt[2 * R + row * 2], s1 = rt[2 * R + row * 2 + 1];
                g0[q] = ((const float*)rt)[4 * R + row * 2]; g1[q] = ((const float*)rt)[4 * R + row * 2 + 1];
                const int base0 = __shfl(basev, e0), base1 = __shfl(basev, e1);
                const bf16_t* O0 = (const bf16_t*)(p.ws + WS_P) + (size_t)(base0 + s0) * D;
                const bf16_t* O1 = (const bf16_t*)(p.ws + WS_P) + (size_t)(base1 + s1) * D;
                const float* g2 = tab + TAB_MOD + (l * 9 + mr) * 6144 + 5 * 1024;
#pragma unroll
                for (int j = 0; j < 4; ++j) {
                    const int k = 4 * lane + 256 * j;
                    x1[q][j] = *(const f32x4*)(X1 + k); oa[q][j] = *(const u32x2*)(O0 + k); ob[q][j] = *(const u32x2*)(O1 + k); gg[q][j] = *(const f32x4*)(g2 + k);
                }
            }
        }
#pragma unroll
        for (int q = 0; q < 2; ++q) {
            const int row = row0 + q * NGW;
            if (row < RL) {
                float* O = p.out + (size_t)row * D;
#pragma unroll
                for (int j = 0; j < 4; ++j) {
                    const u32x2 a = oa[q][j], b = ob[q][j];
                    f32x4 m;
                    m.x = g0[q] * bflo(a.x) + g1[q] * bflo(b.x); m.y = g0[q] * bfhi(a.x) + g1[q] * bfhi(b.x);
                    m.z = g0[q] * bflo(a.y) + g1[q] * bflo(b.y); m.w = g0[q] * bfhi(a.y) + g1[q] * bfhi(b.y);
                    *(f32x4*)(O + 4 * lane + 256 * j) = x1[q][j] + gg[q][j] * m;
                }
            }
        }
    }
}

constexpr int BN = 128;
constexpr int LDT = 64 + 8;
constexpr int LDN = BN + 16;
typedef short v4i16_t __attribute__((ext_vector_type(4)));
typedef __attribute__((address_space(3))) v4i16_t* lds_v4i16_ptr;
__device__ __forceinline__ v4i16_t lds_tr16(const bf16_t* p) { return __builtin_amdgcn_ds_read_tr16_b64_v4i16((lds_v4i16_ptr)(p)); }

template <int WM, int KS, class AF, class BF>
__device__ __forceinline__ void gemm_tile(const bf16_t* Abase, const AF& arow, const BF& bptr, int K, unsigned char* smem, f32x4 (&acc)[WM][4]) {
    constexpr int BMt = 32 * WM, BKt = 32 * KS, LDA_ = BKt + 16;
    constexpr int STAGE = BMt * LDA_ * 2 + BKt * LDN * 2;
    static_assert(2 * STAGE <= 73728, "GEMM LDS");
    constexpr int ACH = BKt / 8;
    constexpr int APT = BMt * ACH / NTHREADS;
    constexpr int BPT = BKt * 32 / NTHREADS;
    const int tid = otid(), lane = tid & 63, wid = tid >> 6, wr = wid >> 1, wc = wid & 1, fr = lane & 15, fq = lane >> 4;
    const int a_chunk = tid % ACH, a_row0 = tid / ACH;
    unsigned ap[APT];
#pragma unroll
    for (int i = 0; i < APT; ++i) ap[i] = arow(a_row0 + (NTHREADS / ACH) * i) + a_chunk * 8;
    const int b_n4 = tid & 31, b_k0 = tid >> 5;
    u32x4 ar[APT];
    f32x4 br[BPT];
#pragma unroll
    for (int m = 0; m < WM; ++m)
#pragma unroll
        for (int n = 0; n < 4; ++n) acc[m][n] = (f32x4){0.f, 0.f, 0.f, 0.f};
    const int nk = K / BKt;
    auto gload = [&](int kt) {
        const int k0 = kt * BKt;
#pragma unroll
        for (int i = 0; i < APT; ++i) ar[i] = *(const u32x4*)(Abase + (ap[i] + k0));
#pragma unroll
        for (int i = 0; i < BPT; ++i) br[i] = *(const f32x4*)bptr(k0 + b_k0 + 8 * i, 4 * b_n4);
    };
    auto lwrite = [&](int buf) {
        bf16_t* As = (bf16_t*)(smem + buf * STAGE);
        bf16_t* Bs = As + BMt * LDA_;
#pragma unroll
        for (int i = 0; i < APT; ++i) *(u32x4*)(As + (a_row0 + (NTHREADS / ACH) * i) * LDA_ + a_chunk * 8) = ar[i];
#pragma unroll
        for (int i = 0; i < BPT; ++i) {
            u32x2 w; w.x = pk2(br[i][0], br[i][1]); w.y = pk2(br[i][2], br[i][3]);
            *(u32x2*)(Bs + (b_k0 + 8 * i) * LDN + ((4 * b_n4) ^ ((((b_k0 + 8 * i) >> 3) & 1) << 6))) = w;
        }
    };
    gload(0); lwrite(0); __syncthreads();
    for (int kt = 0; kt < nk; ++kt) {
        if (kt + 1 < nk) gload(kt + 1);
        __builtin_amdgcn_sched_barrier(0);
        const bf16_t* As = (const bf16_t*)(smem + (kt & 1) * STAGE);
        const bf16_t* Bs = As + BMt * LDA_;
#pragma unroll
        for (int ks = 0; ks < KS; ++ks) {
            bf16x8 bfr[4];
#pragma unroll
            for (int n = 0; n < 4; ++n) {
                const bf16_t* bp = Bs + (ks * 32 + fq * 8 + (fr >> 2)) * LDN + ((wc ^ (fq & 1)) * 64) + n * 16 + 4 * (fr & 3);
                const v4i16_t lo = lds_tr16(bp), hi = lds_tr16(bp + 4 * LDN);
                bfr[n] = (bf16x8){lo[0], lo[1], lo[2], lo[3], hi[0], hi[1], hi[2], hi[3]};
            }
#pragma unroll
            for (int mh = 0; mh < WM; mh += WM / 2) {
                bf16x8 af[WM / 2];
#pragma unroll
                for (int m = 0; m < WM / 2; ++m) af[m] = *(const bf16x8*)(As + (wr * (16 * WM) + (mh + m) * 16 + fr) * LDA_ + ks * 32 + fq * 8);
#pragma unroll
                for (int m = 0; m < WM / 2; ++m)
#pragma unroll
                    for (int n = 0; n < 4; ++n) acc[mh + m][n] = __builtin_amdgcn_mfma_f32_16x16x32_bf16(bfr[n], af[m], acc[mh + m][n], 0, 0, 0);
            }
        }
        __builtin_amdgcn_sched_barrier(0);
        if (kt + 1 < nk) lwrite((kt + 1) & 1);
        __syncthreads();
    }
}

template <int WM, int KS, class AF, class BF>
__device__ __forceinline__ void gemm_tile_b16(const bf16_t* Abase, const AF& arow, const BF& bptr, int K, unsigned char* smem, f32x4 (&acc)[WM][4]) {
    constexpr int BMt = 32 * WM, BKt = 32 * KS, LDA_ = BKt + 16;
    constexpr int STAGE = BMt * LDA_ * 2 + BKt * LDN * 2;
    static_assert(2 * STAGE <= 73728, "GEMM LDS");
    constexpr int ACH = BKt / 8;
    constexpr int APT = BMt * ACH / NTHREADS;
    constexpr int BPT = BKt * 16 / NTHREADS;
    const int tid = otid(), lane = tid & 63, wid = tid >> 6, wr = wid >> 1, wc = wid & 1, fr = lane & 15, fq = lane >> 4;
    const int a_chunk = tid % ACH, a_row0 = tid / ACH;
    unsigned ap[APT];
#pragma unroll
    for (int i = 0; i < APT; ++i) ap[i] = arow(a_row0 + (NTHREADS / ACH) * i) + a_chunk * 8;
    const int b_n8 = tid & 15, b_k0 = tid >> 4;
    u32x4 ar0[APT], ar1[APT], br0[BPT], br1[BPT];
#pragma unroll
    for (int m = 0; m < WM; ++m)
#pragma unroll
        for (int n = 0; n < 4; ++n) acc[m][n] = (f32x4){0.f, 0.f, 0.f, 0.f};
    const int nk = K / BKt;
    auto gload = [&](int kt, u32x4 (&ar)[APT], u32x4 (&br)[BPT]) {
        const int k0 = kt * BKt;
#pragma unroll
        for (int i = 0; i < APT; ++i) ar[i] = *(const u32x4*)(Abase + (ap[i] + k0));
#pragma unroll
        for (int i = 0; i < BPT; ++i) br[i] = *(const u32x4*)bptr(k0 + b_k0 + 16 * i, 8 * b_n8);
    };
    auto lwrite = [&](int buf, const u32x4 (&ar)[APT], const u32x4 (&br)[BPT]) {
        bf16_t* As = (bf16_t*)(smem + buf * STAGE);
        bf16_t* Bs = As + BMt * LDA_;
#pragma unroll
        for (int i = 0; i < APT; ++i) *(u32x4*)(As + (a_row0 + (NTHREADS / ACH) * i) * LDA_ + a_chunk * 8) = ar[i];
#pragma unroll
        for (int i = 0; i < BPT; ++i) *(u32x4*)(Bs + (b_k0 + 16 * i) * LDN + ((8 * b_n8) ^ ((((b_k0 + 16 * i) >> 3) & 1) << 6))) = br[i];
    };
    auto compute = [&](int buf) {
        const bf16_t* As = (const bf16_t*)(smem + buf * STAGE);
        const bf16_t* Bs = As + BMt * LDA_;
#pragma unroll
        for (int ks = 0; ks < KS; ++ks) {
            bf16x8 bfr[4];
#pragma unroll
            for (int n = 0; n < 4; ++n) {
                const bf16_t* bp = Bs + (ks * 32 + fq * 8 + (fr >> 2)) * LDN + ((wc ^ (fq & 1)) * 64) + n * 16 + 4 * (fr & 3);
                const v4i16_t lo = lds_tr16(bp), hi = lds_tr16(bp + 4 * LDN);
                bfr[n] = (bf16x8){lo[0], lo[1], lo[2], lo[3], hi[0], hi[1], hi[2], hi[3]};
            }
#pragma unroll
            for (int mh = 0; mh < WM; mh += WM / 2) {
                bf16x8 af[WM / 2];
#pragma unroll
                for (int m = 0; m < WM / 2; ++m) af[m] = *(const bf16x8*)(As + (wr * (16 * WM) + (mh + m) * 16 + fr) * LDA_ + ks * 32 + fq * 8);
#pragma unroll
                for (int m = 0; m < WM / 2; ++m)
#pragma unroll
                    for (int n = 0; n < 4; ++n) acc[mh + m][n] = __builtin_amdgcn_mfma_f32_16x16x32_bf16(bfr[n], af[m], acc[mh + m][n], 0, 0, 0);
            }
        }
    };
    gload(0, ar0, br0); lwrite(0, ar0, br0);
    gload(1, ar1, br1);
    __syncthreads();
    for (int kt = 0; kt < nk; kt += 2) {
        gload(kt + 2 < nk ? kt + 2 : nk - 1, ar0, br0);
        __builtin_amdgcn_sched_barrier(0);
        compute(0);
        __builtin_amdgcn_sched_barrier(0);
        lwrite(1, ar1, br1);
        __syncthreads();
        gload(kt + 3 < nk ? kt + 3 : nk - 1, ar1, br1);
        __builtin_amdgcn_sched_barrier(0);
        compute(1);
        __builtin_amdgcn_sched_barrier(0);
        lwrite(0, ar0, br0);
        __syncthreads();
    }
    asm volatile("s_waitcnt vmcnt(0)" ::: "memory");
}

template <int N> __device__ __forceinline__ void wait_vm() {
    if constexpr (N == 0) asm volatile("s_waitcnt vmcnt(0)" ::: "memory");
    else if constexpr (N == 3) asm volatile("s_waitcnt vmcnt(3)" ::: "memory");
    else if constexpr (N == 4) asm volatile("s_waitcnt vmcnt(4)" ::: "memory");
    else if constexpr (N == 5) asm volatile("s_waitcnt vmcnt(5)" ::: "memory");
    else if constexpr (N == 6) asm volatile("s_waitcnt vmcnt(6)" ::: "memory");
    else static_assert(N < 0, "wait_vm");
}
#define RAW_BARRIER() do { asm volatile("s_waitcnt lgkmcnt(0)" ::: "memory"); __builtin_amdgcn_s_barrier(); } while (0)
__device__ __forceinline__ void glds16(const void* gsrc, unsigned lds_dst) {
    unsigned keep;
    asm volatile("s_mov_b32 %0, m0\n\ts_mov_b32 m0, %2\n\ts_nop 0\n\tglobal_load_lds_dwordx4 %1, off\n\ts_mov_b32 m0, %0" : "=&s"(keep) : "v"(gsrc), "s"(lds_dst) : "memory");
}
template <int WM, class AF>
__device__ __forceinline__ void gemm_tile_dma(const bf16_t* Abase, const AF& arow, const bf16_t* Btile, int ldb, int K, unsigned char* smem, f32x4 (&acc)[WM][4]) {
    constexpr int A_BYTES = 32 * WM * 64, B_BYTES = 8192, STAGE = A_BYTES + B_BYTES;
    constexpr int AI = WM / 2, NI = AI + 2;
    static_assert(WM % 2 == 0 && 3 * STAGE <= 73728, "gemm_tile_dma");
    const int tid = otid(), lane = tid & 63, wid = tid >> 6, wr = wid >> 1, wc = wid & 1, fr = lane & 15, fq = lane >> 4;
    unsigned aoff[AI], boff[2];
#pragma unroll
    for (int i = 0; i < AI; ++i) {
        const int r = 16 * (i * 4 + wid) + (lane >> 2);
        const int c = (lane & 3) ^ (((r >> 3) & 1) << 1);
        aoff[i] = arow(r) + 8 * c;
    }
#pragma unroll
    for (int i = 0; i < 2; ++i) {
        const int kr = 4 * (i * 4 + wid) + (lane >> 4), jp = lane & 15;
        const int g = (jp >> 1) ^ ((kr & 3) | (((kr >> 3) & 1) << 2));
        boff[i] = (unsigned)(kr * ldb + (g * 2 + (jp & 1)) * 8);
    }
#pragma unroll
    for (int m = 0; m < WM; ++m)
#pragma unroll
        for (int n = 0; n < 4; ++n) acc[m][n] = (f32x4){0.f, 0.f, 0.f, 0.f};
    const int nk = K / 32;
    const unsigned lds0 = (unsigned)(uintptr_t)smem;
    const unsigned wbase = (unsigned)__builtin_amdgcn_readfirstlane((int)(lds0 + (unsigned)wid * 1024u));
    auto dma = [&](int kt, int st) {
        const unsigned sa = wbase + (unsigned)(st * STAGE);
#pragma unroll
        for (int i = 0; i < AI; ++i) glds16(Abase + (aoff[i] + kt * 32), (unsigned)__builtin_amdgcn_readfirstlane((int)(sa + i * 4096)));
#pragma unroll
        for (int i = 0; i < 2; ++i) glds16(Btile + (boff[i] + (unsigned)(kt * 32 * ldb)), (unsigned)__builtin_amdgcn_readfirstlane((int)(sa + A_BYTES + i * 4096)));
    };
    const int a_lane = (wr * (16 * WM) + fr) * 64 + 16 * (fq ^ (((fr >> 3) & 1) << 1));
    const int fBl = (fr >> 2) | ((fq & 1) << 2);
    const int b_lane = A_BYTES + (fq * 8 + (fr >> 2)) * 256 + 8 * (fr & 3);
    auto compute = [&](int st) {
        const unsigned char* sb = smem + st * STAGE;
        bf16x8 bfr[4];
#pragma unroll
        for (int n = 0; n < 4; ++n) {
            const bf16_t* bp = (const bf16_t*)(sb + b_lane + 32 * ((wc * 4 + n) ^ fBl));
            const v4i16_t lo = lds_tr16(bp), hi = lds_tr16(bp + 512);
            bfr[n] = (bf16x8){lo[0], lo[1], lo[2], lo[3], hi[0], hi[1], hi[2], hi[3]};
        }
        bf16x8 af[WM];
#pragma unroll
        for (int m = 0; m < WM; ++m) af[m] = *(const bf16x8*)(sb + a_lane + m * 1024);
        __builtin_amdgcn_s_setprio(1);
#pragma unroll
        for (int m = 0; m < WM; ++m)
#pragma unroll
            for (int n = 0; n < 4; ++n) acc[m][n] = __builtin_amdgcn_mfma_f32_16x16x32_bf16(bfr[n], af[m], acc[m][n], 0, 0, 0);
        __builtin_amdgcn_s_setprio(0);
    };
    dma(0, 0); dma(1, 1);
    int st = 0, st2 = 2;
#pragma unroll 1
    for (int kt = 0; kt < nk - 1; ++kt) {
        wait_vm<NI>();
        RAW_BARRIER();
        if (kt + 2 < nk) dma(kt + 2, st2);
        compute(st);
        st = (st == 2) ? 0 : st + 1; st2 = (st2 == 2) ? 0 : st2 + 1;
    }
    wait_vm<0>();
    RAW_BARRIER();
    compute(st);
    RAW_BARRIER();
}

__device__ __forceinline__ void conv_some(const Params& p, int l, int maxn, unsigned char* smem);
__device__ __forceinline__ int xcd_max_units(int nMT, int nNT);
__device__ __forceinline__ bool xcd_unit(int it, int nMT, int nNT, int& mt, int& nt, const unsigned char* smem) {
    const volatile int* xinfo = (const volatile int*)(smem + 73728 + 800);
    const int G = gridDim.x, b = obid();
    if (xinfo[0]) {
        const int x = xinfo[1], rank = xinfo[2], cntx = xinfo[3];
        const int start = (x * nMT) >> 3, per = (((x + 1) * nMT) >> 3) - start;
        const int q = rank + it * cntx;
        if (q >= per * nNT) return false;
        mt = start + q % per; nt = q / per;
        return true;
    }
    const int u = b + it * G;
    if (u >= nMT * nNT) return false;
    mt = u / nNT; nt = u % nNT;
    return true;
}

__device__ __forceinline__ void epi_in_row(const f32x4 (&a)[4], int row, int cw, int fq, const float* tab, const f32x4 (&cv)[4], bf16_t* P, float* LF) {
    float v[4][4];
#pragma unroll
    for (int n = 0; n < 4; ++n)
#pragma unroll
        for (int j = 0; j < 4; ++j) v[n][j] = a[n][j];
    if (cw >= OFF_ZF && cw < OFF_HV) {
        const int dir = (cw >= OFF_ZB) ? 1 : 0;
        const int cb = cw - (dir ? OFF_ZB : OFF_ZF);
#pragma unroll
        for (int n = 0; n < 4; ++n) {
            f32x4 o;
#pragma unroll
            for (int j = 0; j < 4; ++j) {
                const float lb = cv[n][j];
                const float sg = sigmoidf_(fmaxf(v[n][j], -80.f));
                o[j] = __logf(lb + (1.f - lb) * sg);
            }
            *(f32x4*)(LF + (size_t)row * LFW + dir * 256 + cb + n * 16 + fq * 4) = o;
        }
        return;
    }
    if (cw < OFF_B) {
#pragma unroll
        for (int n = 0; n < 4; ++n)
#pragma unroll
            for (int j = 0; j < 4; ++j) v[n][j] = gelu_tanh(v[n][j]);
    }
    if ((cw >= 256 && cw < OFF_V)) {
        float ss = 0.f;
#pragma unroll
        for (int n = 0; n < 4; ++n)
#pragma unroll
            for (int j = 0; j < 4; ++j) ss += v[n][j] * v[n][j];
        ss += __shfl_xor(ss, 16); ss += __shfl_xor(ss, 32);
        const float rstd = rsqrtf(ss * (1.f / 64.f) + EPS);
        if (cw < OFF_B) {
#pragma unroll
            for (int n = 0; n < 4; ++n)
#pragma unroll
                for (int j = 0; j < 4; ++j) v[n][j] *= rstd;
        } else {
#pragma unroll
            for (int n = 0; n < 4; ++n)
#pragma unroll
                for (int j = 0; j < 4; ++j) v[n][j] *= rstd * cv[n][j];
            if (row < RL) {
                const int t = row & (T - 1);
#pragma unroll
                for (int ax = 0; ax < 2; ++ax) {
                    const int pos = ax == 0 ? (t >> 6) : (t & 63);
                    const f32x4 cs01 = *(const f32x4*)(tab + TAB_ROPE + (pos * 16 + fq * 4) * 2), cs23 = *(const f32x4*)(tab + TAB_ROPE + (pos * 16 + fq * 4) * 2 + 4);
                    const float csv[4] = {cs01[0], cs01[2], cs23[0], cs23[2]}, snv[4] = {cs01[1], cs01[3], cs23[1], cs23[3]};
#pragma unroll
                    for (int j = 0; j < 4; ++j) {
                        const float cs = csv[j], sn = snv[j];
                        const float x0 = v[2 * ax][j], x1 = v[2 * ax + 1][j];
                        v[2 * ax][j] = x0 * cs - x1 * sn;
                        v[2 * ax + 1][j] = x1 * cs + x0 * sn;
                    }
                }
            }
        }
    }
    if ((cw >= OFF_C && cw < OFF_ZF) || cw >= OFF_G) {
#pragma unroll
        for (int n = 0; n < 4; ++n)
#pragma unroll
            for (int j = 0; j < 4; ++j) v[n][j] = siluf_(v[n][j]);
    }
#pragma unroll
    for (int n = 0; n < 4; ++n) {
        u32x2 pk; pk.x = pk2(v[n][0], v[n][1]); pk.y = pk2(v[n][2], v[n][3]);
        *(u32x2*)(P + (size_t)row * INW + cw + n * 16 + fq * 4) = pk;
    }
}

__device__ void phase_gemm_in(const Params& p, int l, unsigned char* smem) {
    const float* tab = (const float*)(p.ws + WS_TAB);
    const bf16_t* H = (const bf16_t*)(p.ws + WS_H);
    bf16_t* P = (bf16_t*)(p.ws + WS_P);
    float* LF = (float*)(p.ws + WS_LF);
    const bf16_t* W = (const bf16_t*)(p.ws + WS_WIN) + (size_t)l * D * INW;
    const float* qw = p.in[10] + l * 64;
    const float* kw = p.in[11] + l * 64;
    const float* lbt = tab + TAB_LB + l * 512;
    const int tid = otid(), lane = tid & 63, wid = tid >> 6, wr = wid >> 1, wc = wid & 1, fr = lane & 15, fq = lane >> 4;
    constexpr int WM = 6, BMt = 32 * WM;
    const int nMT = R / BMt, nNT = INW / BN;
    int mine = 0;
    for (int it = 0;; ++it, ++mine) {
        int mt, nt;
        if (!xcd_unit(it, nMT, nNT, mt, nt, smem)) break;
        const int row0 = mt * BMt, col0 = nt * BN;
        f32x4 acc[WM][4];
        auto arow = [&](int i) { return (unsigned)((row0 + i) * D); };
        gemm_tile_dma<WM>(H, arow, W + col0, INW, D, smem, acc);
        const int cw = col0 + wc * 64;
        const int rbase = row0 + wr * (16 * WM) + fr;
        f32x4 cv[4];
        {
            const float* csrc = (cw >= OFF_ZF && cw < OFF_HV) ? (lbt + ((cw >= OFF_ZB) ? 256 + cw - OFF_ZB : cw - OFF_ZF)) : ((cw < OFF_KV) ? qw : kw);
#pragma unroll
            for (int n = 0; n < 4; ++n) cv[n] = *(const f32x4*)(csrc + n * 16 + fq * 4);
        }
        epi_in_row(acc[0], rbase, cw, fq, tab, cv, P, LF);
        epi_in_row(acc[1], rbase + 16, cw, fq, tab, cv, P, LF);
        epi_in_row(acc[2], rbase + 32, cw, fq, tab, cv, P, LF);
        epi_in_row(acc[3], rbase + 48, cw, fq, tab, cv, P, LF);
        epi_in_row(acc[4], rbase + 64, cw, fq, tab, cv, P, LF);
        epi_in_row(acc[5], rbase + 80, cw, fq, tab, cv, P, LF);
    }
    { const int idle = xcd_max_units(nMT, nNT) - mine; if (idle > 0) conv_some(p, l, 0 * idle, smem); }
}

__device__ __forceinline__ int next_unit(unsigned* ctr, unsigned char* smem) {
    int* slot = (int*)(smem + 73728 + 512);
    __syncthreads();
    if (otid() == 0) *slot = (int)atomicAdd(ctr, 1u);
    __syncthreads();
    return *slot;
}

constexpr int CONV_ITEMS = 2048, CONV_CHUNKS = NEXP * D * FF / 4 / CONV_ITEMS;
__device__ __forceinline__ void conv_unit(const Params& p, int l, int c) {
    const int tid = otid();
    const size_t lbase = (size_t)l * NEXP * D * FF;
    const float* w1 = p.in[20] + lbase; const float* w3 = p.in[21] + lbase; const float* w2 = p.in[22] + lbase;
    bf16_t* W13 = (bf16_t*)(p.ws + WS_W13) + (size_t)l * NEXP * D * 1024; bf16_t* W2b = (bf16_t*)(p.ws + WS_W2) + lbase;
    const int i0 = c * CONV_ITEMS + tid;
    f32x4 a[8], b[8], d[8];
#pragma unroll
    for (int u = 0; u < 8; ++u) {
        const int i = i0 + u * NTHREADS;
        a[u] = __builtin_nontemporal_load((const f32x4*)(w1 + (size_t)i * 4)); b[u] = __builtin_nontemporal_load((const f32x4*)(w3 + (size_t)i * 4));
        d[u] = __builtin_nontemporal_load((const f32x4*)(w2 + (size_t)i * 4));
    }
#pragma unroll
    for (int u = 0; u < 8; ++u) {
        const int i = i0 + u * NTHREADS;
        const int c4 = (i & 127) * 4, ek = i >> 7;
        const int dc = (c4 >> 6) * 128 + ((c4 >> 5) & 1) * 64 + (c4 & 31);
        u32x2 oa, ob, od; oa.x = pk2(a[u][0], a[u][1]); oa.y = pk2(a[u][2], a[u][3]); ob.x = pk2(b[u][0], b[u][1]); ob.y = pk2(b[u][2], b[u][3]);
        od.x = pk2(d[u][0], d[u][1]); od.y = pk2(d[u][2], d[u][3]);
        *(u32x2*)(W13 + (size_t)ek * 1024 + dc) = oa;
        *(u32x2*)(W13 + (size_t)ek * 1024 + dc + 32) = ob;
        *(u32x2*)(W2b + (size_t)i * 4) = od;
    }
}

__device__ __forceinline__ void conv_some(const Params& p, int l, int maxn, unsigned char* smem) {
    unsigned* ctr = (unsigned*)(p.ws + WS_CTL) + 192 + l;
    for (int n = 0; n < maxn; ++n) {
        const int c = next_unit(ctr, smem);
        if (c >= CONV_CHUNKS) break;
        conv_unit(p, l, c);
    }
}
__device__ __forceinline__ int xcd_max_units(int nMT, int nNT) {
    const int G8 = (gridDim.x >> 3) > 0 ? (gridDim.x >> 3) : 1;
    return (((nMT + 7) >> 3) * nNT + G8 - 1) / G8;
}

constexpr float ATT_C = 0.125f * 1.4426950408889634f;
constexpr int ATT_STAGE = 16384;
constexpr float ATT_THR = 8.0f / ATT_C;
__device__ __forceinline__ void attn_unit(const Params& p, int u, unsigned char* smem) {
    const bf16_t* P = (const bf16_t*)(p.ws + WS_P);
    bf16_t* Y = (bf16_t*)(p.ws + WS_Y);
    const int tid = otid(), lane = tid & 63, wid = tid >> 6, fr = lane & 15, fq = lane >> 4;
    int b, kvh, qrow0, nkt; const bool ctxq = u >= 1024;
    if (!ctxq) { b = u >> 7; kvh = (u >> 6) & 1; qrow0 = b * T + (u & 63) * 32; nkt = 36; }
    else { const int v = u - 1024; b = v >> 4; kvh = (v >> 3) & 1; qrow0 = RL + b * TC + (v & 7) * 32; nkt = 4; }
    const int hh = kvh * 4 + wid;
    unsigned char* Qs = smem + 3 * ATT_STAGE + wid * 4096;
#pragma unroll
    for (int i = 0; i < 4; ++i) {
        const int pc = i * 64 + lane, r = pc >> 3, c = pc & 7;
        *(u32x4*)(Qs + r * 128 + 16 * (c ^ ((r >> 1) & 7))) = *(const u32x4*)(P + (size_t)(qrow0 + r) * INW + OFF_B + hh * 64 + c * 8);
    }
    f32x4 o[2][4];
    float mrow[2], lrow[2];
#pragma unroll
    for (int m = 0; m < 2; ++m) { mrow[m] = -1e30f; lrow[m] = 0.f;
#pragma unroll
        for (int n = 0; n < 4; ++n) o[m][n] = (f32x4){0.f, 0.f, 0.f, 0.f}; }
    unsigned koff[2], voff[2];
#pragma unroll
    for (int i = 0; i < 2; ++i) {
        const int r = 32 * i + 8 * wid + (lane >> 3), cp = lane & 7;
        koff[i] = (unsigned)(r * INW + OFF_KV + kvh * 64 + (cp ^ ((r >> 1) & 7)) * 8);
        voff[i] = (unsigned)(r * INW + OFF_V + kvh * 64 + ((((cp >> 1) ^ ((r >> 1) & 3)) << 1) | (cp & 1)) * 8);
    }
    const unsigned lds0 = (unsigned)(uintptr_t)smem;
    const unsigned wbase = (unsigned)__builtin_amdgcn_readfirstlane((int)(lds0 + (unsigned)wid * 1024u));
    auto dma = [&](int kt, int st) {
        const int base = ctxq ? (RL + b * TC + kt * 64) : (kt < 32 ? (b * T + kt * 64) : (RL + b * TC + (kt - 32) * 64));
        const bf16_t* src = P + (size_t)base * INW;
        const unsigned sa = wbase + (unsigned)(st * ATT_STAGE);
#pragma unroll
        for (int i = 0; i < 2; ++i) {
            glds16(src + koff[i], (unsigned)__builtin_amdgcn_readfirstlane((int)(sa + i * 4096)));
            glds16(src + voff[i], (unsigned)__builtin_amdgcn_readfirstlane((int)(sa + 8192 + i * 4096)));
        }
    };
    const int kq_lane = fr * 128, kq_sw = (fr >> 1) & 7;
    const int hv = ((fq & 1) << 1) | (fr >> 3);
    const int v_lane = (4 * fq + (fr >> 2)) * 128 + 8 * (fr & 3);
    auto compute = [&](int st) {
        const unsigned char* kb = smem + st * ATT_STAGE;
        const unsigned char* vb = kb + 8192;
        f32x4 sc[2][4];
        {
            bf16x8 kf[4][2], qf[2][2];
#pragma unroll
            for (int n = 0; n < 4; ++n)
#pragma unroll
                for (int ks = 0; ks < 2; ++ks) kf[n][ks] = *(const bf16x8*)(kb + n * 2048 + kq_lane + 16 * ((ks * 4 + fq) ^ kq_sw));
#pragma unroll
            for (int m = 0; m < 2; ++m)
#pragma unroll
                for (int ks = 0; ks < 2; ++ks) qf[m][ks] = *(const bf16x8*)(Qs + m * 2048 + kq_lane + 16 * ((ks * 4 + fq) ^ kq_sw));
#pragma unroll
            for (int m = 0; m < 2; ++m)
#pragma unroll
                for (int n = 0; n < 4; ++n) {
                    sc[m][n] = (f32x4){0.f, 0.f, 0.f, 0.f};
#pragma unroll
                    for (int ks = 0; ks < 2; ++ks) sc[m][n] = __builtin_amdgcn_mfma_f32_16x16x32_bf16(kf[n][ks], qf[m][ks], sc[m][n], 0, 0, 0);
                }
        }
        bf16x8 vf[4][2];
#pragma unroll
        for (int n = 0; n < 4; ++n)
#pragma unroll
            for (int ks = 0; ks < 2; ++ks) {
                const bf16_t* vp = (const bf16_t*)(vb + ks * 4096 + v_lane + 32 * (n ^ hv));
                const v4i16_t lo = lds_tr16(vp), hi = lds_tr16(vp + 1024);
                vf[n][ks] = (bf16x8){lo[0], lo[1], lo[2], lo[3], hi[0], hi[1], hi[2], hi[3]};
            }
        bf16x8 pf[2][2];
#pragma unroll
        for (int m = 0; m < 2; ++m) {
            float mx = sc[m][0][0];
#pragma unroll
            for (int n = 0; n < 4; ++n)
#pragma unroll
                for (int j = 0; j < 4; ++j) mx = fmaxf(mx, sc[m][n][j]);
            mx = fmaxf(mx, __shfl_xor(mx, 16)); mx = fmaxf(mx, __shfl_xor(mx, 32));
            if (__any(mx - mrow[m] > ATT_THR)) {
                const float mnew = fmaxf(mrow[m], mx);
                const float alpha = __builtin_amdgcn_exp2f((mrow[m] - mnew) * ATT_C);
                mrow[m] = mnew;
                lrow[m] *= alpha;
#pragma unroll
                for (int n = 0; n < 4; ++n) o[m][n] = o[m][n] * alpha;
            }
            const float mc = mrow[m] * ATT_C;
            float ls = 0.f;
#pragma unroll
            for (int n = 0; n < 4; ++n)
#pragma unroll
                for (int j = 0; j < 4; ++j) { sc[m][n][j] = __builtin_amdgcn_exp2f(sc[m][n][j] * ATT_C - mc); ls += sc[m][n][j]; }
            lrow[m] += ls;
#pragma unroll
            for (int ks = 0; ks < 2; ++ks) {
                u32x4 pw;
                pw.x = pk2(sc[m][2 * ks][0], sc[m][2 * ks][1]); pw.y = pk2(sc[m][2 * ks][2], sc[m][2 * ks][3]);
                pw.z = pk2(sc[m][2 * ks + 1][0], sc[m][2 * ks + 1][1]); pw.w = pk2(sc[m][2 * ks + 1][2], sc[m][2 * ks + 1][3]);
                pf[m][ks] = __builtin_bit_cast(bf16x8, pw);
            }
        }
#pragma unroll
        for (int m = 0; m < 2; ++m)
#pragma unroll
            for (int ks = 0; ks < 2; ++ks)
#pragma unroll
                for (int nd = 0; nd < 4; ++nd) o[m][nd] = __builtin_amdgcn_mfma_f32_16x16x32_bf16(vf[nd][ks], pf[m][ks], o[m][nd], 0, 0, 0);
    };
    dma(0, 0); dma(1, 1);
    int st = 0, st2 = 2;
#pragma unroll 1
    for (int kt = 0; kt < nkt - 1; ++kt) {
        wait_vm<4>();
        RAW_BARRIER();
        if (kt + 2 < nkt) dma(kt + 2, st2);
        compute(st);
        st = (st == 2) ? 0 : st + 1; st2 = (st2 == 2) ? 0 : st2 + 1;
    }
    wait_vm<0>();
    RAW_BARRIER();
    compute(st);
#pragma unroll
    for (int m = 0; m < 2; ++m) {
        float lt = lrow[m];
        lt += __shfl_xor(lt, 16); lt += __shfl_xor(lt, 32);
        const float inv = 1.f / lt;
        const size_t row = (size_t)(qrow0 + m * 16 + fr);
#pragma unroll
        for (int nd = 0; nd < 4; ++nd) {
            u32x2 pk; pk.x = pk2(o[m][nd][0] * inv, o[m][nd][1] * inv); pk.y = pk2(o[m][nd][2] * inv, o[m][nd][3] * inv);
            *(u32x2*)(Y + row * D + 256 + hh * 64 + nd * 16 + fq * 4) = pk;
        }
    }
}

constexpr int LDA = 128 + 8;
__device__ __forceinline__ void mixa_unit(const Params& p, int l, int u, unsigned char* smem) {
    const bf16_t* P = (const bf16_t*)(p.ws + WS_P);
    bf16_t* Y = (bf16_t*)(p.ws + WS_Y);
    const int n = u >> 2, h = u & 3;
    const float* W = p.in[8] + ((size_t)l * 4 + h) * 128 * 128;
    const float* bs = p.in[9] + (l * 4 + h) * 128;
    bf16_t* Ws = (bf16_t*)smem;
    bf16_t* Vs = Ws + 128 * LDA;
    const int tid = otid(), lane = tid & 63, wid = tid >> 6, fr = lane & 15, fq = lane >> 4;
#pragma unroll
    for (int i = 0; i < 16; ++i) {
        const int pc = tid + 256 * i, t = pc >> 5, s4 = (pc & 31) * 4;
        const f32x4 w = *(const f32x4*)(W + t * 128 + s4);
        u32x2 o; o.x = pk2(w[0], w[1]); o.y = pk2(w[2], w[3]);
        *(u32x2*)(Ws + t * LDA + s4) = o;
    }
#pragma unroll
    for (int i = 0; i < 2; ++i) {
        const int mb = tid + 256 * i, dg = mb & 15, sg = mb >> 4;
        u32x2 vr[4];
#pragma unroll
        for (int r = 0; r < 4; ++r) vr[r] = *(const u32x2*)(P + (size_t)(n * 128 + 4 * sg + r) * INW + 256 + h * 64 + 4 * dg);
#pragma unroll
        for (int di = 0; di < 4; ++di) {
            const int w = di >> 1;
            u32x2 ov;
            if ((di & 1) == 0) { ov.x = (vr[0][w] & 0xffffu) | (vr[1][w] << 16); ov.y = (vr[2][w] & 0xffffu) | (vr[3][w] << 16); }
            else { ov.x = (vr[0][w] >> 16) | (vr[1][w] & 0xffff0000u); ov.y = (vr[2][w] >> 16) | (vr[3][w] & 0xffff0000u); }
            *(u32x2*)(Vs + (4 * dg + di) * LDA + 4 * sg) = ov;
        }
    }
    __syncthreads();
    f32x4 acc[2][4];
#pragma unroll
    for (int m = 0; m < 2; ++m)
#pragma unroll
        for (int nd = 0; nd < 4; ++nd) acc[m][nd] = (f32x4){0.f, 0.f, 0.f, 0.f};
#pragma unroll
    for (int ks = 0; ks < 4; ++ks) {
        bf16x8 wf[2], vf[4];
#pragma unroll
        for (int m = 0; m < 2; ++m) wf[m] = *(const bf16x8*)(Ws + (32 * wid + 16 * m + fr) * LDA + ks * 32 + fq * 8);
#pragma unroll
        for (int nd = 0; nd < 4; ++nd) vf[nd] = *(const bf16x8*)(Vs + (16 * nd + fr) * LDA + ks * 32 + fq * 8);
#pragma unroll
        for (int m = 0; m < 2; ++m)
#pragma unroll
            for (int nd = 0; nd < 4; ++nd) acc[m][nd] = __builtin_amdgcn_mfma_f32_16x16x32_bf16(vf[nd], wf[m], acc[m][nd], 0, 0, 0);
    }
#pragma unroll
    for (int m = 0; m < 2; ++m) {
        const int t = 32 * wid + 16 * m + fr;
        const size_t row = (size_t)n * 128 + t;
        const float bias = bs[t];
#pragma unroll
        for (int nd = 0; nd < 4; ++nd) {
            const int c = h * 64 + 16 * nd + 4 * fq;
            const u32x2 uu = *(const u32x2*)(P + row * INW + c);
            u32x2 pk;
            pk.x = pk2(bflo(uu.x) * (acc[m][nd][0] + bias), bfhi(uu.x) * (acc[m][nd][1] + bias));
            pk.y = pk2(bflo(uu.y) * (acc[m][nd][2] + bias), bfhi(uu.y) * (acc[m][nd][3] + bias));
            *(u32x2*)(Y + row * D + c) = pk;
        }
    }
}

__device__ __forceinline__ int hg_pos(int I, int ii) { return 32 * (I >> 1) + 4 * (I & 1) + 8 * (ii >> 2) + (ii & 3); }
__device__ __forceinline__ void hgrn_state_unit(const Params& p, int l, int u, unsigned char* smem) {
    const bf16_t* P = (const bf16_t*)(p.ws + WS_P);
    const float* LF = (const float*)(p.ws + WS_LF);
    bf16_t* SST = (bf16_t*)(p.ws + WS_OFB);
    const int b = u >> 3, h = (u >> 1) & 3, dir = u & 1;
    const int tid = otid(), lane = tid & 63, wid = tid >> 6, fr = lane & 15, fq = lane >> 4;
    const int k = lane, I = wid;
    bf16_t* KT = (bf16_t*)smem;
    bf16_t* VT = KT + 64 * LDT;
    float* Tsub = (float*)(VT + 64 * LDT);
    float* Etot = Tsub + 256;
    f32x4 sacc[4];
#pragma unroll
    for (int nk = 0; nk < 4; ++nk) sacc[nk] = (f32x4){0.f, 0.f, 0.f, 0.f};
    float lf[16], vv[16];
    auto mcof = [&](int j) { return dir == 0 ? (j < 4 ? 256 + b * 4 + j : b * 32 + (j - 4)) : (j < 4 ? 256 + b * 4 + (3 - j) : b * 32 + (35 - j)); };
    auto gload = [&](int j) {
        const int mc = mcof(j);
#pragma unroll
        for (int ii = 0; ii < 16; ++ii) {
            const int tau = 16 * I + ii;
            const size_t row = (size_t)mc * 64 + (dir ? 63 - tau : tau);
            lf[ii] = LF[row * LFW + dir * 256 + h * 64 + k];
            vv[ii] = bf2f(P[row * INW + OFF_HV + h * 64 + k]);
        }
    };
    gload(0);
    for (int j = 0; j < 36; ++j) {
        float c[16];
        c[0] = lf[0];
#pragma unroll
        for (int ii = 1; ii < 16; ++ii) c[ii] = c[ii - 1] + lf[ii];
        Tsub[I * 64 + k] = c[15];
        __syncthreads();
        float Rs = 0.f;
#pragma unroll
        for (int M = 1; M < 4; ++M) Rs += (M > I) ? Tsub[M * 64 + k] : 0.f;
        if (I == 0) Etot[k] = __expf(c[15] + Rs);
#pragma unroll
        for (int g = 0; g < 4; ++g) {
            float kh[4];
#pragma unroll
            for (int jj = 0; jj < 4; ++jj) { const int ii = 4 * g + jj; kh[jj] = (1.f - __expf(lf[ii])) * __expf(c[15] - c[ii] + Rs); }
            u32x2 kw; kw.x = pk2(kh[0], kh[1]); kw.y = pk2(kh[2], kh[3]);
            u32x2 vw; vw.x = pk2(vv[4 * g], vv[4 * g + 1]); vw.y = pk2(vv[4 * g + 2], vv[4 * g + 3]);
            const int pos = hg_pos(I, 4 * g);
            *(u32x2*)(KT + k * LDT + pos) = kw;
            *(u32x2*)(VT + k * LDT + pos) = vw;
        }
        const int mc = mcof(j);
        {
            bf16_t* dst = SST + ((size_t)(mc * 4 + h) * 2 + dir) * 4096;
#pragma unroll
            for (int nk = 0; nk < 4; ++nk)
#pragma unroll
                for (int r = 0; r < 4; ++r) dst[(16 * wid + 4 * fq + r) * 64 + 16 * nk + fr] = f2bf(sacc[nk][r]);
        }
        if (j + 1 < 36) gload(j + 1);
        __builtin_amdgcn_sched_barrier(0);
        __syncthreads();
        bf16x8 vf[2];
#pragma unroll
        for (int ks = 0; ks < 2; ++ks) vf[ks] = *(const bf16x8*)(VT + (16 * wid + fr) * LDT + 32 * ks + 8 * fq);
#pragma unroll
        for (int nk = 0; nk < 4; ++nk) {
            const float e = Etot[16 * nk + fr];
            sacc[nk] = sacc[nk] * e;
#pragma unroll
            for (int ks = 0; ks < 2; ++ks) {
                const bf16x8 kf = *(const bf16x8*)(KT + (16 * nk + fr) * LDT + 32 * ks + 8 * fq);
                sacc[nk] = __builtin_amdgcn_mfma_f32_16x16x32_bf16(vf[ks], kf, sacc[nk], 0, 0, 0);
            }
        }
        __syncthreads();
    }
    asm volatile("s_waitcnt vmcnt(0)" ::: "memory");
    __syncthreads();
    if (otid() == 0) {
        __builtin_amdgcn_fence(__ATOMIC_RELEASE, "agent");
        asm volatile("s_waitcnt vmcnt(0)" ::: "memory");
        __hip_atomic_fetch_add((unsigned*)(p.ws + WS_CTL) + 160 + l, 1u, __ATOMIC_RELAXED, __HIP_MEMORY_SCOPE_AGENT);
    }
}


__device__ __forceinline__ void hgrn_out_unit(const Params& p, int l, int u, unsigned char* smem) {
    const bf16_t* P = (const bf16_t*)(p.ws + WS_P);
    const float* LF = (const float*)(p.ws + WS_LF);
    const bf16_t* SST = (const bf16_t*)(p.ws + WS_OFB);
    bf16_t* Y = (bf16_t*)(p.ws + WS_Y);
    const float* hw = p.in[13] + l * 64;
    const int mc = u >> 2, h = u & 3;
    const int tid = otid(), lane = tid & 63, wid = tid >> 6, fr = lane & 15, fq = lane >> 4;
    const int k = lane, I = wid;
    bf16_t* QT0 = (bf16_t*)smem;
    bf16_t* KD = QT0 + 64 * LDT;
    bf16_t* KO = KD + 64 * LDT;
    bf16_t* QS = KO + 64 * LDT;
    bf16_t* QT1 = QS + 64 * LDT;
    bf16_t* QT2 = QT1 + 32 * LDT;
    bf16_t* VT = QT2 + 16 * LDT;
    float* Tsub = (float*)(VT + 64 * LDT);
    float* SSQ = Tsub + 256;
    f32x4 om[4];
#pragma unroll 1
    for (int dd = 0; dd < 2; ++dd) {
        const int dir = 1 - dd;
        float lf[16], c[16];
#pragma unroll
        for (int ii = 0; ii < 16; ++ii) {
            const int tau = 16 * I + ii;
            const size_t row = (size_t)mc * 64 + (dir ? 63 - tau : tau);
            lf[ii] = LF[row * LFW + dir * 256 + h * 64 + k];
        }
        c[0] = lf[0];
#pragma unroll
        for (int ii = 1; ii < 16; ++ii) c[ii] = c[ii - 1] + lf[ii];
        Tsub[I * 64 + k] = c[15];
        __syncthreads();
        const float T0 = Tsub[k], T1 = Tsub[64 + k], T2 = Tsub[128 + k];
        const float pre = (I > 0 ? T0 : 0.f) + (I > 1 ? T1 : 0.f) + (I > 2 ? T2 : 0.f);
        const float epre = __expf(pre);
        const float g1 = __expf(I == 2 ? T1 : T2);
        const float g2 = __expf(T1 + T2);
#pragma unroll
        for (int g = 0; g < 4; ++g) {
            float vq[4];
#pragma unroll
            for (int jj = 0; jj < 4; ++jj) {
                const int ii = 4 * g + jj, tau = 16 * I + ii;
                const size_t row = (size_t)mc * 64 + (dir ? 63 - tau : tau);
                const float q = bf2f(P[row * INW + OFF_C + h * 64 + k]);
                vq[jj] = bf2f(P[row * INW + OFF_HV + h * 64 + k]);
                const float qt = q * __expf(c[ii]);
                const float kk = 1.f - __expf(lf[ii]);
                QT0[tau * LDT + k] = f2bf(qt);
                QS[tau * LDT + k] = f2bf(qt * epre);
                KD[tau * LDT + k] = f2bf(kk * __expf(fminf(-c[ii], 80.f)));
                KO[tau * LDT + k] = f2bf(kk * __expf(c[15] - c[ii]));
                if (I >= 2) QT1[(tau - 32) * LDT + k] = f2bf(qt * g1);
                if (I == 3) QT2[(tau - 48) * LDT + k] = f2bf(qt * g2);
            }
            u32x2 vw; vw.x = pk2(vq[0], vq[1]); vw.y = pk2(vq[2], vq[3]);
            *(u32x2*)(VT + k * LDT + hg_pos(I, 4 * g)) = vw;
        }
        bf16x8 stf[2];
        {
            const bf16_t* src = SST + ((size_t)(mc * 4 + h) * 2 + dir) * 4096 + (16 * wid + fr) * 64 + 8 * fq;
            stf[0] = *(const bf16x8*)(src); stf[1] = *(const bf16x8*)(src + 32);
        }
        __syncthreads();
        bf16x8 vf[2];
#pragma unroll
        for (int ks = 0; ks < 2; ++ks) vf[ks] = *(const bf16x8*)(VT + (16 * wid + fr) * LDT + 32 * ks + 8 * fq);
        f32x4 o[4];
#pragma unroll
        for (int I2 = 0; I2 < 4; ++I2) {
            f32x4 A[4];
#pragma unroll
            for (int J = 0; J < 4; ++J) {
                A[J] = (f32x4){0.f, 0.f, 0.f, 0.f};
                if (J <= I2) {
                    const bf16_t* kbase = (J == I2 ? KD : KO) + (16 * J + fr) * LDT + 8 * fq;
                    const bf16_t* qbase = (I2 - J <= 1) ? (QT0 + (16 * I2 + fr) * LDT) : ((I2 - J == 2) ? (QT1 + (16 * I2 - 32 + fr) * LDT) : (QT2 + fr * LDT));
#pragma unroll
                    for (int ks = 0; ks < 2; ++ks) {
                        const bf16x8 kf = *(const bf16x8*)(kbase + 32 * ks);
                        const bf16x8 qf = *(const bf16x8*)(qbase + 32 * ks + 8 * fq);
                        A[J] = __builtin_amdgcn_mfma_f32_16x16x32_bf16(kf, qf, A[J], 0, 0, 0);
                    }
                    if (J == I2) {
#pragma unroll
                        for (int r = 0; r < 4; ++r) A[J][r] = (4 * fq + r <= fr) ? A[J][r] : 0.f;
                    }
                }
            }
            o[I2] = (f32x4){0.f, 0.f, 0.f, 0.f};
#pragma unroll
            for (int ks = 0; ks < 2; ++ks) {
                if (2 * ks <= I2) {
                    u32x4 pw;
                    pw.x = pk2(A[2 * ks][0], A[2 * ks][1]); pw.y = pk2(A[2 * ks][2], A[2 * ks][3]);
                    pw.z = pk2(A[2 * ks + 1][0], A[2 * ks + 1][1]); pw.w = pk2(A[2 * ks + 1][2], A[2 * ks + 1][3]);
                    o[I2] = __builtin_amdgcn_mfma_f32_16x16x32_bf16(vf[ks], __builtin_bit_cast(bf16x8, pw), o[I2], 0, 0, 0);
                }
                const bf16x8 qsf = *(const bf16x8*)(QS + (16 * I2 + fr) * LDT + 32 * ks + 8 * fq);
                o[I2] = __builtin_amdgcn_mfma_f32_16x16x32_bf16(stf[ks], qsf, o[I2], 0, 0, 0);
            }
        }
        if (dir == 1) {
            const int src = (lane & 48) | (15 - fr);
#pragma unroll
            for (int Im = 0; Im < 4; ++Im)
#pragma unroll
                for (int r = 0; r < 4; ++r) om[Im][r] = __shfl(o[3 - Im][r], src);
        } else {
#pragma unroll
            for (int Im = 0; Im < 4; ++Im) om[Im] = om[Im] + o[Im];
        }
        __syncthreads();
    }
#pragma unroll
    for (int Im = 0; Im < 4; ++Im) {
        float s = om[Im][0] * om[Im][0] + om[Im][1] * om[Im][1] + om[Im][2] * om[Im][2] + om[Im][3] * om[Im][3];
        s += __shfl_xor(s, 16); s += __shfl_xor(s, 32);
        if (fq == 0) SSQ[wid * 64 + 16 * Im + fr] = s;
    }
    __syncthreads();
    const f32x4 wv = *(const f32x4*)(hw + 16 * wid + 4 * fq);
#pragma unroll
    for (int Im = 0; Im < 4; ++Im) {
        const int i = 16 * Im + fr;
        const float tot = SSQ[i] + SSQ[64 + i] + SSQ[128 + i] + SSQ[192 + i];
        const float rstd = rsqrtf(tot * (1.f / 64.f) + EPS);
        const size_t row = (size_t)mc * 64 + i;
        const u32x2 gg = *(const u32x2*)(P + row * INW + OFF_G + h * 64 + 16 * wid + 4 * fq);
        u32x2 pk;
        pk.x = pk2(om[Im][0] * rstd * wv[0] * bflo(gg.x), om[Im][1] * rstd * wv[1] * bfhi(gg.x));
        pk.y = pk2(om[Im][2] * rstd * wv[2] * bflo(gg.y), om[Im][3] * rstd * wv[3] * bfhi(gg.y));
        *(u32x2*)(Y + row * D + 768 + h * 64 + 16 * wid + 4 * fq) = pk;
    }
}

__device__ void phase_mix1(const Params& p, int l, unsigned char* smem, int rep) {
    unsigned* ctr = (unsigned*)(p.ws + WS_CTL) + 128 + l * 2 + rep * 4;
    unsigned* done = (unsigned*)(p.ws + WS_CTL) + 160 + l;
    const int n_attn = (l == 0) ? 1152 : 1024, n_mixa = (l == 0) ? 576 : 512, n_hout = ((l == 0) ? 288 : 256) * 4;
    const int total = 64 + n_attn + n_mixa + n_hout;
    bool acquired = false;
    for (;;) {
        const int u = next_unit(ctr, smem);
        if (u >= total) break;
        if (u < 64) hgrn_state_unit(p, l, u, smem);
        else if (u < 64 + n_attn) attn_unit(p, u - 64, smem);
        else if (u < 64 + n_attn + n_mixa) mixa_unit(p, l, u - 64 - n_attn, smem);
        else {
            if (!acquired) {
                if (otid() == 0) {
                    unsigned spins = 0;
                    while (__hip_atomic_load(done, __ATOMIC_RELAXED, __HIP_MEMORY_SCOPE_AGENT) < 64u * (unsigned)(rep + 1)) { __builtin_amdgcn_s_sleep(8); if (++spins > (1u << 24)) break; }
                    __builtin_amdgcn_fence(__ATOMIC_ACQUIRE, "agent");
                    asm volatile("s_waitcnt vmcnt(0)" ::: "memory");
                }
                __syncthreads();
                acquired = true;
            }
            hgrn_out_unit(p, l, u - 64 - n_attn - n_mixa, smem);
        }
    }
}

template <int WM>
__device__ __forceinline__ void phase_out_t(const Params& p, int l, unsigned char* smem) {
    const float* tab = (const float*)(p.ws + WS_TAB);
    const bf16_t* Y = (const bf16_t*)(p.ws + WS_Y);
    float* X1 = (float*)(p.ws + WS_X1);
    const float* X2 = (const float*)(p.ws + WS_X2);
    const bf16_t* W = (const bf16_t*)(p.ws + WS_WOUT) + (size_t)l * D * D;
    const int tid = otid(), lane = tid & 63, wid = tid >> 6, wr = wid >> 1, wc = wid & 1, fr = lane & 15, fq = lane >> 4;
    const int nrows = (l == 0) ? R : RL;
    constexpr int BMt = 32 * WM;
    const int nMT = (nrows + BMt - 1) / BMt, nNT = D / BN;
    int mine = 0;
    for (int it = 0;; ++it, ++mine) {
        int mt, nt;
        if (!xcd_unit(it, nMT, nNT, mt, nt, smem)) break;
        const int row0 = mt * BMt, col0 = nt * BN;
        f32x4 acc[WM][4];
        auto arow = [&](int i) { return (unsigned)((row0 + i) * D); };
        gemm_tile_dma<WM>(Y, arow, W + col0, D, D, smem, acc);
#pragma unroll
        for (int m = 0; m < WM; ++m) {
            const int row = row0 + wr * (16 * WM) + m * 16 + fr;
            const int mr = row_modrow(row);
            const float* g1 = tab + TAB_MOD + (l * 9 + mr) * 6144 + 2 * 1024;
            const float* xin = (l == 0) ? (row < RL ? p.in[0] + (size_t)row * D : p.in[2] + (size_t)(row - RL) * D) : X2 + (size_t)row * D;
#pragma unroll
            for (int n = 0; n < 4; ++n) {
                const int col = col0 + wc * 64 + n * 16 + fq * 4;
                const f32x4 xv = *(const f32x4*)(xin + col), gv = *(const f32x4*)(g1 + col);
                *(f32x4*)(X1 + (size_t)row * D + col) = xv + gv * acc[m][n];
            }
        }
    }
    { const int idle = xcd_max_units(nMT, nNT) - mine; if (idle > 0) conv_some(p, l, 3 * idle, smem); }
}
__device__ void phase_out(const Params& p, int l, unsigned char* smem) {
    if (l == 0) phase_out_t<6>(p, l, smem); else phase_out_t<4>(p, l, smem);
}

__device__ void phase_route(const Params& p, int l, unsigned char* smem) {
    const float* tab = (const float*)(p.ws + WS_TAB);
    bf16_t* H = (bf16_t*)(p.ws + WS_H);
    const float* X1 = (const float*)(p.ws + WS_X1);
    int* rt = (int*)(p.ws + WS_RT);
    unsigned* ctl = (unsigned*)(p.ws + WS_CTL);
    const float* nw = p.in[15] + l * 1024;
    const float* wg = p.in[16] + (size_t)l * 1024 * 4;
    const float* bg = p.in[17] + l * 4;
    const float* we = p.in[18] + (size_t)l * 1024 * 32;
    const float* be = p.in[19] + l * 32;
    const int tid = otid(), lane = tid & 63, wid = tid >> 6, wr = wid >> 1, wc = wid & 1, fr = lane & 15, fq = lane >> 4;
    const int nrows = (l == 0) ? R : RL;
    float* Ls = (float*)smem;
    constexpr int BM = 64;
    for (int u = obid(); u < nrows / BM; u += gridDim.x) {
        const int row0 = u * BM;
        {
            const int mr = row_modrow(row0);
            const float* sh = tab + TAB_MOD + (l * 9 + mr) * 6144 + 3 * 1024;
            const float* scv = sh + 1024;
            f32x4 ma[4], mb[4];
#pragma unroll
            for (int j = 0; j < 4; ++j) {
                const int k = 4 * lane + 256 * j;
                ma[j] = *(const f32x4*)(nw + k) * (1.f + *(const f32x4*)(scv + k)); mb[j] = *(const f32x4*)(sh + k);
            }
#pragma unroll 1
            for (int rb = 0; rb < 4; ++rb) {
                const int rowb = row0 + wid * 16 + rb * 4;
                f32x4 v[4][4];
#pragma unroll
                for (int q = 0; q < 4; ++q)
#pragma unroll
                    for (int j = 0; j < 4; ++j) v[q][j] = *(const f32x4*)(X1 + (size_t)(rowb + q) * D + 4 * lane + 256 * j);
                float ss[4];
#pragma unroll
                for (int q = 0; q < 4; ++q) {
                    ss[q] = 0.f;
#pragma unroll
                    for (int j = 0; j < 4; ++j) ss[q] += (v[q][j].x * v[q][j].x + v[q][j].y * v[q][j].y) + (v[q][j].z * v[q][j].z + v[q][j].w * v[q][j].w);
                }
#pragma unroll
                for (int o = 1; o < 64; o <<= 1) {
#pragma unroll
                    for (int q = 0; q < 4; ++q) ss[q] += __shfl_xor(ss[q], o);
                }
#pragma unroll
                for (int q = 0; q < 4; ++q) {
                    const float rstd = rsqrtf(ss[q] * (1.f / D) + EPS);
#pragma unroll
                    for (int j = 0; j < 4; ++j) {
                        const f32x4 o = v[q][j] * rstd * ma[j] + mb[j];
                        u32x2 pk; pk.x = pk2(o.x, o.y); pk.y = pk2(o.z, o.w);
                        *(u32x2*)(H + (size_t)(rowb + q) * D + 4 * lane + 256 * j) = pk;
                    }
                }
            }
        }
        asm volatile("s_waitcnt vmcnt(0)" ::: "memory");
        __syncthreads();
        {
            const bf16_t* WRl = (const bf16_t*)(p.ws + WS_WR) + (size_t)l * 48 * 1024;
            f32x4 acc[4][3];
#pragma unroll
            for (int m = 0; m < 4; ++m)
#pragma unroll
                for (int n = 0; n < 3; ++n) acc[m][n] = (f32x4){0.f, 0.f, 0.f, 0.f};
            const bf16_t* ap = H + (size_t)(row0 + fr) * D + wid * 256 + fq * 8;
            const bf16_t* bp = WRl + (size_t)fr * 1024 + wid * 256 + fq * 8;
#pragma unroll 1
            for (int kh = 0; kh < 4; ++kh) {
                bf16x8 af[2][4], bf[2][3];
#pragma unroll
                for (int ks = 0; ks < 2; ++ks) {
#pragma unroll
                    for (int m = 0; m < 4; ++m) af[ks][m] = *(const bf16x8*)(ap + (size_t)m * 16 * D + (kh * 2 + ks) * 32);
#pragma unroll
                    for (int n = 0; n < 3; ++n) bf[ks][n] = *(const bf16x8*)(bp + (size_t)n * 16 * 1024 + (kh * 2 + ks) * 32);
                }
#pragma unroll
                for (int ks = 0; ks < 2; ++ks)
#pragma unroll
                    for (int m = 0; m < 4; ++m)
#pragma unroll
                        for (int n = 0; n < 3; ++n) acc[m][n] = __builtin_amdgcn_mfma_f32_16x16x32_bf16(bf[ks][n], af[ks][m], acc[m][n], 0, 0, 0);
            }
            float* Lp = (float*)smem + wid * (64 * 48);
#pragma unroll
            for (int m = 0; m < 4; ++m)
#pragma unroll
                for (int n = 0; n < 3; ++n) *(f32x4*)(Lp + (m * 16 + fr) * 48 + n * 16 + fq * 4) = acc[m][n];
        }
        __syncthreads();
        unsigned* lcnt = (unsigned*)(smem + 49152);
        if (tid < 32) lcnt[tid] = 0u;
        int dec_ea = 0, dec_eb = 0, dec_la = 0, dec_lb = 0; float dec_ga = 0.f, dec_gb = 0.f;
        __syncthreads();
        if (tid < BM) {
            const int row = row0 + tid;
            const float* lp = (const float*)smem + tid * 48;
            float lg[36];
#pragma unroll
            for (int i = 0; i < 36; ++i) lg[i] = (lp[i] + lp[64 * 48 + i]) + (lp[2 * 64 * 48 + i] + lp[3 * 64 * 48 + i]);
            float gl[4];
#pragma unroll
            for (int i = 0; i < 4; ++i) gl[i] = lg[i] + bg[i];
            int grp = 0; float gm = gl[0];
#pragma unroll
            for (int i = 1; i < 4; ++i) if (gl[i] > gm) { gm = gl[i]; grp = i; }
            float gs = 0.f;
#pragma unroll
            for (int i = 0; i < 4; ++i) gs += expf(gl[i] - gm);
            const float pgrp = 1.f / gs;
            float ev[8];
#pragma unroll
            for (int i = 0; i < 8; ++i) {
                float x = lg[4 + i];
#pragma unroll
                for (int g = 1; g < 4; ++g) x = (grp == g) ? lg[4 + g * 8 + i] : x;
                ev[i] = x + be[grp * 8 + i];
            }
            int i0 = 0; float v0 = ev[0];
#pragma unroll
            for (int i = 1; i < 8; ++i) if (ev[i] > v0) { v0 = ev[i]; i0 = i; }
            int i1 = -1; float v1 = -3.0e38f;
#pragma unroll
            for (int i = 0; i < 8; ++i) if (i != i0 && ev[i] > v1) { v1 = ev[i]; i1 = i; }
            const float e1 = expf(v1 - v0);
            const float ga = pgrp / (1.f + e1), gb = pgrp * e1 / (1.f + e1);
            const int ea = grp * 8 + i0, eb = grp * 8 + i1;
            dec_ea = ea; dec_eb = eb; dec_ga = ga; dec_gb = gb;
            dec_la = (int)atomicAdd(&lcnt[ea], 1u);
            dec_lb = (int)atomicAdd(&lcnt[eb], 1u);
        }
        __syncthreads();
        if (tid < 32) { const unsigned c = lcnt[tid]; lcnt[32 + tid] = c ? atomicAdd(&ctl[cur_idx(l, tid)], c) : 0u; }
        __syncthreads();
        if (tid < BM) {
            const int row = row0 + tid;
            const int sa = (int)lcnt[32 + dec_ea] + dec_la, sb = (int)lcnt[32 + dec_eb] + dec_lb;
            rt[row * 2] = dec_ea; rt[row * 2 + 1] = dec_eb;
            rt[2 * R + row * 2] = sa; rt[2 * R + row * 2 + 1] = sb;
            ((float*)rt)[4 * R + row * 2] = dec_ga; ((float*)rt)[4 * R + row * 2 + 1] = dec_gb;
            rt[6 * R + dec_ea * R + sa] = row;
            rt[6 * R + dec_eb * R + sb] = row;
        }
        __syncthreads();
    }
    conv_some(p, l, 1 << 30, smem);
}

constexpr int MOE_WM = 6, MOE_BM = 32 * MOE_WM;
__device__ __forceinline__ void moe_units(const Params& p, int l, int* s_cnt, int* s_base, int* s_tpre) {
    const unsigned* ctl = (const unsigned*)(p.ws + WS_CTL);
    if (otid() == 0) {
        int base = 0, tp = 0;
        for (int e = 0; e < NEXP; ++e) {
            const int c = (int)ctl[cur_idx(l, e)];
            s_cnt[e] = c; s_base[e] = base; s_tpre[e] = tp;
            base += c; tp += (c + MOE_BM - 1) / MOE_BM;
        }
        s_tpre[NEXP] = tp;
    }
    __syncthreads();
}

__device__ void phase_moe1(const Params& p, int l, unsigned char* smem) {
    int* s_cnt = (int*)(smem + 73728);
    int* s_base = s_cnt + 32;
    int* s_tpre = s_base + 32;
    moe_units(p, l, s_cnt, s_base, s_tpre);
    const bf16_t* H = (const bf16_t*)(p.ws + WS_H);
    bf16_t* HM = (bf16_t*)(p.ws + WS_LF);
    const int* list = (const int*)(p.ws + WS_RT) + 6 * R;
    const float* W1 = p.in[20] + (size_t)l * NEXP * D * FF;
    const float* W3 = p.in[21] + (size_t)l * NEXP * D * FF;
    const int tid = otid(), lane = tid & 63, wid = tid >> 6, wr = wid >> 1, wc = wid & 1, fr = lane & 15, fq = lane >> 4;
    const int ntiles = s_tpre[NEXP];
    constexpr int nNT = FF / 64;
    int mine = 0;
    for (int it = 0;; ++it, ++mine) {
        int tg, nt;
        if (!xcd_unit(it, ntiles, nNT, tg, nt, smem)) break;
        int e = 0;
        while (s_tpre[e + 1] <= tg) ++e;
        const int mt = tg - s_tpre[e], cnt = s_cnt[e], base = s_base[e];
        const bf16_t* w13 = (const bf16_t*)(p.ws + WS_W13) + ((size_t)l * NEXP + e) * D * 1024;
        const int* lst = list + (size_t)e * R;
        f32x4 acc[MOE_WM][4];
        auto arow = [&](int i) { int s = mt * MOE_BM + i; s = s < cnt ? s : cnt - 1; return (unsigned)(lst[s] * D); };
        gemm_tile_dma<MOE_WM>(H, arow, w13 + nt * 128, 1024, D, smem, acc);
#pragma unroll
        for (int m = 0; m < MOE_WM; ++m) {
            const int s = mt * MOE_BM + wr * (16 * MOE_WM) + m * 16 + fr;
            if (s < cnt) {
#pragma unroll
                for (int n = 0; n < 2; ++n) {
                    float hv[4];
#pragma unroll
                    for (int j = 0; j < 4; ++j) hv[j] = siluf_(acc[m][n][j]) * acc[m][n + 2][j];
                    u32x2 pk; pk.x = pk2(hv[0], hv[1]); pk.y = pk2(hv[2], hv[3]);
                    *(u32x2*)(HM + (size_t)(base + s) * FF + nt * 64 + wc * 32 + n * 16 + fq * 4) = pk;
                }
            }
        }
    }
    if (l + 1 < 2) { const int idle = xcd_max_units(ntiles, nNT) - mine; if (idle > 0) conv_some(p, l + 1, 3 * idle, smem); }
}

__device__ void phase_moe2(const Params& p, int l, unsigned char* smem) {
    int* s_cnt = (int*)(smem + 73728);
    int* s_base = s_cnt + 32;
    int* s_tpre = s_base + 32;
    moe_units(p, l, s_cnt, s_base, s_tpre);
    const bf16_t* HM = (const bf16_t*)(p.ws + WS_LF);
    bf16_t* OUTM = (bf16_t*)(p.ws + WS_P);
    const float* W2 = p.in[22] + (size_t)l * NEXP * FF * D;
    const int tid = otid(), lane = tid & 63, wid = tid >> 6, wr = wid >> 1, wc = wid & 1, fr = lane & 15, fq = lane >> 4;
    const int ntiles = s_tpre[NEXP];
    constexpr int nNT = D / BN;
    int mine = 0;
    for (int it = 0;; ++it, ++mine) {
        int tg, nt;
        if (!xcd_unit(it, ntiles, nNT, tg, nt, smem)) break;
        int e = 0;
        while (s_tpre[e + 1] <= tg) ++e;
        const int mt = tg - s_tpre[e], cnt = s_cnt[e], base = s_base[e];
        const bf16_t* w2 = (const bf16_t*)(p.ws + WS_W2) + ((size_t)l * NEXP + e) * FF * D;
        f32x4 acc[MOE_WM][4];
        auto arow = [&](int i) { int s = mt * MOE_BM + i; s = s < cnt ? s : cnt - 1; return (unsigned)((base + s) * FF); };
        gemm_tile_dma<MOE_WM>(HM, arow, w2 + nt * BN, D, FF, smem, acc);
#pragma unroll
        for (int m = 0; m < MOE_WM; ++m) {
            const int s = mt * MOE_BM + wr * (16 * MOE_WM) + m * 16 + fr;
            if (s < cnt) {
#pragma unroll
                for (int n = 0; n < 4; ++n) {
                    u32x2 pk; pk.x = pk2(acc[m][n][0], acc[m][n][1]); pk.y = pk2(acc[m][n][2], acc[m][n][3]);
                    *(u32x2*)(OUTM + (size_t)(base + s) * D + nt * BN + wc * 64 + n * 16 + fq * 4) = pk;
                }
            }
        }
    }
    if (l + 1 < 2) { const int idle = xcd_max_units(ntiles, nNT) - mine; if (idle > 0) conv_some(p, l + 1, 3 * idle, smem); }
}

#define XB_TMO      128
#define XB_XCNT(j)  (256  + 64 * (j))
#define XB_XSUB(j)  (1280 + 64 * (j))
#define XB_XGEN(j)  (2304 + 64 * (j))
#define XB_TOP      3328
#define XB_TOPGEN   3392
#define XCD_BAR_WORDS 3456
#define XB_SPIN_CAP (1u << 22)
#define LAS __attribute__((address_space(3)))
__device__ __forceinline__ unsigned xb_ld(unsigned* p)              { return __hip_atomic_load(p, __ATOMIC_RELAXED, __HIP_MEMORY_SCOPE_AGENT); }
__device__ __forceinline__ unsigned xb_add(unsigned* p, unsigned v) { return __hip_atomic_fetch_add(p, v, __ATOMIC_RELAXED, __HIP_MEMORY_SCOPE_AGENT); }
__device__ __forceinline__ unsigned xb_xcc_id() { return (unsigned)__builtin_amdgcn_s_getreg((3 << 11) | 20) & 0xFu; }
#define XB_SPIN(cond, bar) do { unsigned _sp = 0; while (cond) { __builtin_amdgcn_s_sleep(1); \
    if ((++_sp & 255u) == 0u) { if (xb_ld(&(bar)[XB_TMO])) break; if (_sp > XB_SPIN_CAP) { atomicAdd(&(bar)[XB_TMO], 1u); break; } } } } while (0)
struct XcdBarrier { unsigned* bar; unsigned x; volatile unsigned* st; };
__device__ __forceinline__ XcdBarrier xcd_barrier_post(unsigned* bar, volatile unsigned* st, volatile int* xinfo) {
    XcdBarrier b; b.bar = bar; b.x = xb_xcc_id(); b.st = st;
    if (threadIdx.x == 0) { const unsigned r = xb_add(&bar[XB_XCNT(b.x)], 1u); xinfo[0] = 0; xinfo[1] = (int)b.x; xinfo[2] = (int)r; xinfo[3] = 0; }
    return b;
}
__device__ __forceinline__ void xcd_barrier_complete(unsigned* bar, unsigned x, unsigned& nloc, unsigned& nx) {
    const unsigned G = gridDim.x * gridDim.y * gridDim.z;
    unsigned sum, cnt, mine, sp = 0u;
    for (;;) {
        sum = 0u; cnt = 0u; mine = 0u;
#pragma unroll
        for (unsigned j = 0; j < 16; ++j) { const unsigned c = xb_ld(&bar[XB_XCNT(j)]); sum += c; cnt += (c > 0u) ? 1u : 0u; mine = (j == x) ? c : mine; }
        if (sum == G) break;
        __builtin_amdgcn_s_sleep(1);
        if ((++sp & 255u) == 0u) { if (xb_ld(&bar[XB_TMO])) break; if (sp > XB_SPIN_CAP) { atomicAdd(&bar[XB_TMO], 1u); break; } }
    }
    nloc = mine > 0u ? mine : 1u; nx = cnt > 0u ? cnt : 1u;
}
__device__ __forceinline__ void xcd_barrier(const XcdBarrier& b) {
    asm volatile("s_waitcnt vmcnt(0)" ::: "memory");
    __syncthreads();
    if (threadIdx.x == 0) {
        unsigned* bar = b.bar;
        __builtin_amdgcn_s_waitcnt(0);
        unsigned nloc = b.st[0], nx = b.st[1];
        if (nloc == 0u) { xcd_barrier_complete(bar, b.x, nloc, nx); b.st[0] = nloc; b.st[1] = nx; }
        const unsigned old = xb_add(&bar[XB_XSUB(b.x)], 1u);
        const unsigned gen = old / nloc;
        if (old + 1u == (gen + 1u) * nloc) {
            __builtin_amdgcn_fence(__ATOMIC_RELEASE, "agent");
            asm volatile("s_waitcnt vmcnt(0)" ::: "memory");
            const unsigned og = xb_add(&bar[XB_TOP], 1u);
            const unsigned tg = og / nx;
            if (og + 1u == (tg + 1u) * nx) xb_add(&bar[XB_TOPGEN], 1u);
            else XB_SPIN(xb_ld(&bar[XB_TOPGEN]) == tg, bar);
            __builtin_amdgcn_fence(__ATOMIC_ACQUIRE, "agent");
            xb_add(&bar[XB_XGEN(b.x)], 1u);
            asm volatile("s_waitcnt vmcnt(0)" ::: "memory");
        } else {
            XB_SPIN(xb_ld(&bar[XB_XGEN(b.x)]) == gen, bar);
            __builtin_amdgcn_fence(__ATOMIC_ACQUIRE, "agent");
            asm volatile("s_waitcnt vmcnt(0)" ::: "memory");
        }
    }
    __syncthreads();
}

constexpr int NPHASES = 16;
#ifndef PROBE_S
#define PROBE_S -1
#define PROBE_REPS 1
#endif
constexpr int SMEM_BYTES = 4 * 64 * LDT * 2 + 4 * 64 * LDT * 2 + 1024;
__global__ void __launch_bounds__(NTHREADS, 2) mega(Params p) {
    __shared__ __attribute__((aligned(16))) unsigned char smem[SMEM_BYTES];
    cg::grid_group grid = cg::this_grid();
    {
        volatile unsigned* st = (volatile unsigned*)(smem + 73728 + 768);
        if (threadIdx.x < 2) st[threadIdx.x] = 0u;
        __syncthreads();
        volatile int* xinfo = (volatile int*)(smem + 73728 + 800);
        (void)xcd_barrier_post((unsigned*)(p.ws + WS_CTL) + 4096, st, xinfo);
    }
#define GRID_BAR() do { XcdBarrier bar_; bar_.bar = (unsigned*)(p.ws + WS_CTL) + 4096; bar_.x = xb_xcc_id(); bar_.st = (volatile unsigned*)(smem + 73728 + 768); xcd_barrier(bar_); } while (0)
    for (int ph = p.ph_lo; ph < p.ph_hi; ++ph) {
        if (ph == 0) phase_init(p, smem);
        else if (ph == NPHASES - 1) phase_final(p, 1);
        else {
            const int l = (ph - 1) / 7, s = (ph - 1) % 7;
            const int reps = (s == PROBE_S) ? PROBE_REPS : 1;
            for (int rep = 0; rep < reps; ++rep) {
                switch (s) {
                    case 0: phase_prep(p, l); break;
                    case 1: phase_gemm_in(p, l, smem); break;
                    case 2: phase_mix1(p, l, smem, rep); break;
                    case 3: phase_out(p, l, smem); break;
                    case 4: phase_route(p, l, smem); break;
                    case 5: phase_moe1(p, l, smem); break;
                    default: phase_moe2(p, l, smem); break;
                }
                if (rep + 1 < reps) GRID_BAR();
            }
        }
        if (ph + 1 < p.ph_hi) {
            if (ph == 0) {
                if (p.ph_hi < 0) grid.sync();
                GRID_BAR();
                if (threadIdx.x == 0) {
                    unsigned* bw = (unsigned*)(p.ws + WS_CTL) + 4096;
                    volatile int* xi = (volatile int*)(smem + 73728 + 800);
                    const unsigned myx = xb_xcc_id();
                    unsigned sum = 0, ok = 1;
                    for (int j = 0; j < 8; ++j) { const unsigned c = xb_ld(&bw[XB_XCNT(j)]); sum += c; ok &= (c > 0u); }
                    xi[3] = (int)xb_ld(&bw[XB_XCNT(myx & 7u)]);
                    xi[0] = (ok && sum == gridDim.x && myx < 8u) ? 1 : 0;
                }
                __syncthreads();
            } else GRID_BAR();
        }
    }
}

extern "C" void kernel_launch(void* const* d_in, const int* in_sizes, int n_in, void* d_out, int out_size, void* d_ws, size_t ws_size, hipStream_t stream) {
    static int grid_blocks = 0;
    if (grid_blocks == 0) {
        if (n_in != 23 || out_size != RL * D || ws_size < WS_END) { fprintf(stderr, "kernel_launch: unexpected shapes (n_in %d out %d ws %zu need %zu)\n", n_in, out_size, ws_size, (size_t)WS_END); grid_blocks = -1; return; }
        int dev = 0, cus = 0, per_cu = 0;
        hipGetDevice(&dev);
        hipDeviceGetAttribute(&cus, hipDeviceAttributeMultiprocessorCount, dev);
        hipOccupancyMaxActiveBlocksPerMultiprocessor(&per_cu, mega, NTHREADS, 0);
        if (per_cu > 2) per_cu = 2;
        if (per_cu < 1) per_cu = 1;
        grid_blocks = cus * per_cu;
    }
    if (grid_blocks < 0) return;
    hipMemsetAsync((char*)d_ws + WS_CTL, 0, 1 * MiB, stream);
    Params p{};
    for (int i = 0; i < 23; ++i) p.in[i] = (const float*)d_in[i];
    p.out = (float*)d_out; p.ws = (unsigned char*)d_ws; p.ph_lo = 0; p.ph_hi = NPHASES;
    void* args[] = {&p};
    hipError_t e = hipLaunchCooperativeKernel((void*)mega, dim3(grid_blocks), dim3(NTHREADS), args, 0, stream);
    if (e != hipSuccess) fprintf(stderr, "cooperative launch failed: %s (grid %d)\n", hipGetErrorString(e), grid_blocks);
}
```

```cpp
#include <hip/hip_runtime.h>
#include <hip/hip_cooperative_groups.h>
#include <cstdio>
#include <cstdint>
namespace cg = cooperative_groups;

constexpr int D = 1024, NB = 8, T = 2048, TC = 256;
constexpr int RL = NB * T, RC = NB * TC, R = RL + RC;
constexpr int INW = 2560, LFW = 512;
constexpr int OFF_B = 512, OFF_KV = 1024, OFF_V = 1152, OFF_C = 1280, OFF_ZF = 1536, OFF_ZB = 1792, OFF_HV = 2048, OFF_G = 2304;
constexpr int NEXP = 32, FF = 512;
constexpr float EPS = 1e-6f;
constexpr int NTHREADS = 256;

constexpr size_t MiB = 1ull << 20;
constexpr size_t WS_CTL = 0;
constexpr size_t WS_TAB = 1 * MiB;
constexpr size_t WS_H = 2 * MiB;
constexpr size_t WS_P = WS_H + 36 * MiB;
constexpr size_t WS_LF = WS_P + 90 * MiB;
constexpr size_t WS_Y = WS_LF + 36 * MiB;
constexpr size_t WS_X1 = WS_Y + 36 * MiB;
constexpr size_t WS_X2 = WS_X1;
constexpr size_t WS_OFB = WS_X1 + 72 * MiB;
constexpr size_t WS_RT = WS_OFB + 18 * MiB;
constexpr size_t WS_WIN = WS_RT + 4 * MiB;
constexpr size_t WS_WOUT = WS_WIN + 10 * MiB;
constexpr size_t WS_WR = WS_WOUT + 4 * MiB;
constexpr size_t WS_W13 = WS_WR + 1 * MiB;
constexpr size_t WS_W2 = WS_W13 + 128 * MiB;
constexpr size_t WS_END = WS_W2 + 64 * MiB;
constexpr int TAB_ROPE = 0;
constexpr int TAB_LB = 2048;
constexpr int TAB_MOD = 4096;

typedef unsigned short bf16_t;
typedef short bf16x8 __attribute__((ext_vector_type(8)));
typedef float f32x4 __attribute__((ext_vector_type(4)));
typedef float f32x2 __attribute__((ext_vector_type(2)));
typedef unsigned u32x4 __attribute__((ext_vector_type(4)));
typedef unsigned u32x2 __attribute__((ext_vector_type(2)));
typedef __bf16 bf16x2_t __attribute__((ext_vector_type(2)));

struct Params {
    const float* in[23];
    float* out;
    unsigned char* ws;
    int ph_lo, ph_hi;
};

__device__ __forceinline__ unsigned pk2(float lo, float hi) { f32x2 v = {lo, hi}; bf16x2_t b = __builtin_convertvector(v, bf16x2_t); return __builtin_bit_cast(unsigned, b); }
__device__ __forceinline__ bf16_t f2bf(float f) { return (bf16_t)(pk2(f, 0.f) & 0xffffu); }
__device__ __forceinline__ float bf2f(bf16_t u) { return __uint_as_float(((unsigned)u) << 16); }
__device__ __forceinline__ float bflo(unsigned w) { return __uint_as_float(w << 16); }
__device__ __forceinline__ float bfhi(unsigned w) { return __uint_as_float(w & 0xffff0000u); }
__device__ __forceinline__ float wave_sum(float v) {
#pragma unroll
    for (int o = 1; o < 64; o <<= 1) v += __shfl_xor(v, o);
    return v;
}
__device__ __forceinline__ float sigmoidf_(float x) { return __builtin_amdgcn_rcpf(1.f + __expf(-x)); }
__device__ __forceinline__ float siluf_(float x) { return x * sigmoidf_(x); }
__device__ __forceinline__ float gelu_tanh(float x) {
    const float u = 0.7978845608028654f * (x + 0.044715f * x * x * x);
    return x * __builtin_amdgcn_rcpf(1.f + __expf(-2.f * u));
}
__device__ __forceinline__ int otid() { int t = threadIdx.x; asm volatile("" : "+v"(t)); return t; }
__device__ __forceinline__ int obid() { int t = blockIdx.x; asm volatile("" : "+s"(t)); return t; }
__device__ __forceinline__ int cur_idx(int l, int e) { return 8192 + (l * 32 + e) * 64; }
__device__ __forceinline__ int row_modrow(int row) { return row < RL ? (row >> 11) : 8; }

__device__ void phase_init(const Params& p, unsigned char* smem) {
    float* tab = (float*)(p.ws + WS_TAB);
    const float* c = p.in[1];
    const float* c_ctx = p.in[3];
    const float* w_mod = p.in[4];
    const float* b_mod = p.in[5];
    float* sc = (float*)smem;
    const int tid = otid();
    for (int i = tid; i < 9 * 1024; i += NTHREADS) {
        const int b = i >> 10, k = i & 1023;
        const float v = (b < 8) ? c[b * 1024 + k] : c_ctx[k];
        sc[i] = siluf_(v);
    }
    __syncthreads();
    float* red = (float*)(smem + 36864);
    for (int it = obid(); it < 384; it += gridDim.x) {
        const int l = it / 192, j0 = (it % 192) * 32;
        const int jj = tid & 31, kg = tid >> 5;
        const float* w = w_mod + (size_t)l * 1024 * 6144 + (size_t)(kg * 128) * 6144 + j0 + jj;
        float acc[9];
#pragma unroll
        for (int b = 0; b < 9; ++b) acc[b] = 0.f;
        for (int k0 = 0; k0 < 128; k0 += 8) {
            float wv[8];
#pragma unroll
            for (int i = 0; i < 8; ++i) wv[i] = w[(size_t)(k0 + i) * 6144];
#pragma unroll
            for (int i = 0; i < 8; ++i)
#pragma unroll
                for (int b = 0; b < 9; ++b) acc[b] += sc[b * 1024 + kg * 128 + k0 + i] * wv[i];
        }
#pragma unroll
        for (int b = 0; b < 9; ++b) red[(kg * 9 + b) * 32 + jj] = acc[b];
        __syncthreads();
        for (int o = tid; o < 9 * 32; o += NTHREADS) {
            const int b = o >> 5, j2 = o & 31;
            float sum = 0.f;
#pragma unroll
            for (int g = 0; g < 8; ++g) sum += red[(g * 9 + b) * 32 + j2];
            tab[TAB_MOD + (l * 9 + b) * 6144 + j0 + j2] = sum + b_mod[l * 6144 + j0 + j2];
        }
        __syncthreads();
    }
    {
        const int gtid = obid() * NTHREADS + tid, gsize = gridDim.x * NTHREADS;
        const float* w_in = p.in[7]; const float* w_out = p.in[14];
        bf16_t* WIN = (bf16_t*)(p.ws + WS_WIN); bf16_t* WOUT = (bf16_t*)(p.ws + WS_WOUT); bf16_t* WR = (bf16_t*)(p.ws + WS_WR);
        for (int i = gtid; i < 2 * 1024 * INW / 4; i += gsize) { const f32x4 v = *(const f32x4*)(w_in + (size_t)i * 4); u32x2 o; o.x = pk2(v[0], v[1]); o.y = pk2(v[2], v[3]); *(u32x2*)(WIN + (size_t)i * 4) = o; }
        for (int i = gtid; i < 2 * 1024 * D / 4; i += gsize) { const f32x4 v = *(const f32x4*)(w_out + (size_t)i * 4); u32x2 o; o.x = pk2(v[0], v[1]); o.y = pk2(v[2], v[3]); *(u32x2*)(WOUT + (size_t)i * 4) = o; }
        for (int i = gtid; i < 2 * 48 * 1024; i += gsize) {
            const int k = i & 1023, n = (i >> 10) % 48, l = i / (48 * 1024);
            float v = 0.f;
            if (n < 4) v = p.in[16][((size_t)l * 1024 + k) * 4 + n];
            else if (n < 36) v = p.in[18][((size_t)l * 1024 + k) * 32 + (n - 4)];
            WR[i] = f2bf(v);
        }
    }
    if (obid() == gridDim.x - 1) {
        for (int i = tid; i < 64 * 16; i += NTHREADS) {
            const int pos = i >> 4, f = i & 15;
            const float inv = 1.0f / powf(10000.0f, (float)(2 * f) / 32.0f);
            const float ang = (float)pos * inv;
            tab[TAB_ROPE + i * 2] = cosf(ang);
            tab[TAB_ROPE + i * 2 + 1] = sinf(ang);
        }
        const float* lbl = p.in[12];
        for (int i = tid; i < 512; i += NTHREADS) {
            const float a0 = lbl[i], a1 = lbl[512 + i];
            const float m = fmaxf(a0, a1);
            const float e0 = expf(a0 - m), e1 = expf(a1 - m);
            const float s1 = e1 / (e0 + e1);
            tab[TAB_LB + i] = 0.f;
            tab[TAB_LB + 512 + i] = s1;
        }
    }
}

__device__ void phase_prep(const Params& p, int l) {
    const float* tab = (const float*)(p.ws + WS_TAB);
    bf16_t* H = (bf16_t*)(p.ws + WS_H);
    const int lane = otid() & 63;
    const int gw = obid() * (NTHREADS / 64) + (otid() >> 6), NGW = gridDim.x * (NTHREADS / 64);
    const float* nw = p.in[6] + l * 1024;
    const int* rt = (const int*)(p.ws + WS_RT);
    int basev = 0;
    if (l > 0) {
        const unsigned* ctl = (const unsigned*)(p.ws + WS_CTL);
        const int cnt = (lane < NEXP) ? (int)ctl[cur_idx(l - 1, lane & 31)] : 0;
        int incl = cnt;
#pragma unroll
        for (int o = 1; o < 32; o <<= 1) { const int t = __shfl_up(incl, o); if (lane >= o) incl += t; }
        basev = incl - cnt;
    }
    auto load_row = [&](int row, f32x4 (&v)[4]) {
        if (l == 0) {
            const float* src = row < RL ? p.in[0] + (size_t)row * D : p.in[2] + (size_t)(row - RL) * D;
#pragma unroll
            for (int j = 0; j < 4; ++j) v[j] = *(const f32x4*)(src + 4 * lane + 256 * j);
        } else {
            const int mr = row_modrow(row);
            const float* X1 = (const float*)(p.ws + WS_X1) + (size_t)row * D;
            const int e0 = rt[row * 2], e1 = rt[row * 2 + 1];
            const int s0 = rt[2 * R + row * 2], s1 = rt[2 * R + row * 2 + 1];
            const float g0 = ((const float*)rt)[4 * R + row * 2], g1 = ((const float*)rt)[4 * R + row * 2 + 1];
            const int base0 = __shfl(basev, e0), base1 = __shfl(basev, e1);
            const bf16_t* O0 = (const bf16_t*)(p.ws + WS_P) + (size_t)(base0 + s0) * D;
            const bf16_t* O1 = (const bf16_t*)(p.ws + WS_P) + (size_t)(base1 + s1) * D;
            const float* g2 = tab + TAB_MOD + ((l - 1) * 9 + mr) * 6144 + 5 * 1024;
            float* X2 = (float*)(p.ws + WS_X2) + (size_t)row * D;
#pragma unroll
            for (int j = 0; j < 4; ++j) {
                const int k = 4 * lane + 256 * j;
                const f32x4 x1 = *(const f32x4*)(X1 + k);
                const u32x2 a = *(const u32x2*)(O0 + k), b = *(const u32x2*)(O1 + k);
                const f32x4 gg = *(const f32x4*)(g2 + k);
                f32x4 m;
                m.x = g0 * bflo(a.x) + g1 * bflo(b.x); m.y = g0 * bfhi(a.x) + g1 * bfhi(b.x);
                m.z = g0 * bflo(a.y) + g1 * bflo(b.y); m.w = g0 * bfhi(a.y) + g1 * bfhi(b.y);
                v[j] = x1 + gg * m;
                *(f32x4*)(X2 + k) = v[j];
            }
        }
    };
    auto store_row = [&](int row, const f32x4 (&v)[4], float ss) {
        const int mr = row_modrow(row);
        const float rstd = rsqrtf(ss * (1.f / D) + EPS);
        const float* sh = tab + TAB_MOD + (l * 9 + mr) * 6144;
        const float* scv = sh + 1024;
#pragma unroll
        for (int j = 0; j < 4; ++j) {
            const int k = 4 * lane + 256 * j;
            const f32x4 w = *(const f32x4*)(nw + k), s = *(const f32x4*)(scv + k), h = *(const f32x4*)(sh + k);
            const f32x4 o = v[j] * rstd * w * (1.f + s) + h;
            u32x2 pk; pk.x = pk2(o.x, o.y); pk.y = pk2(o.z, o.w);
            *(u32x2*)(H + (size_t)row * D + k) = pk;
        }
    };
    for (int row = gw; row < R; row += 3 * NGW) {
        const int r1 = row + NGW, r2 = row + 2 * NGW;
        const bool h1 = r1 < R, h2 = r2 < R;
        f32x4 v0[4], v1[4], v2[4];
        load_row(row, v0);
        if (h1) load_row(r1, v1);
        if (h2) load_row(r2, v2);
        float s0 = 0.f, s1 = 0.f, s2 = 0.f;
#pragma unroll
        for (int j = 0; j < 4; ++j) {
            s0 += (v0[j].x * v0[j].x + v0[j].y * v0[j].y) + (v0[j].z * v0[j].z + v0[j].w * v0[j].w);
            if (h1) s1 += (v1[j].x * v1[j].x + v1[j].y * v1[j].y) + (v1[j].z * v1[j].z + v1[j].w * v1[j].w);
            if (h2) s2 += (v2[j].x * v2[j].x + v2[j].y * v2[j].y) + (v2[j].z * v2[j].z + v2[j].w * v2[j].w);
        }
#pragma unroll
        for (int o = 1; o < 64; o <<= 1) { s0 += __shfl_xor(s0, o); s1 += __shfl_xor(s1, o); s2 += __shfl_xor(s2, o); }
        store_row(row, v0, s0);
        if (h1) store_row(r1, v1, s1);
        if (h2) store_row(r2, v2, s2);
    }
}

__device__ void phase_final(const Params& p, int l) {
    const float* tab = (const float*)(p.ws + WS_TAB);
    const int lane = otid() & 63;
    const int gw = obid() * (NTHREADS / 64) + (otid() >> 6), NGW = gridDim.x * (NTHREADS / 64);
    const int* rt = (const int*)(p.ws + WS_RT);
    const unsigned* ctl = (const unsigned*)(p.ws + WS_CTL);
    int basev;
    {
        const int cnt = (lane < NEXP) ? (int)ctl[cur_idx(l, lane & 31)] : 0;
        int incl = cnt;
#pragma unroll
        for (int o = 1; o < 32; o <<= 1) { const int t = __shfl_up(incl, o); if (lane >= o) incl += t; }
        basev = incl - cnt;
    }
    for (int row0 = gw; row0 < RL; row0 += 2 * NGW) {
        f32x4 x1[2][4], gg[2][4]; u32x2 oa[2][4], ob[2][4]; float g0[2], g1[2];
#pragma unroll
        for (int q = 0; q < 2; ++q) {
            const int row = row0 + q * NGW;
            if (row < RL) {
                const int mr = row >> 11;
                const float* X1 = (const float*)(p.ws + WS_X1) + (size_t)row * D;
                const int e0 = rt[row * 2], e1 = rt[row * 2 + 1];
                const int s0 = rt[2 * R + row * 2], s1 = rt[2 * R + row * 2 + 1];
                g0[q] = ((const float*)rt)[4 * R + row * 2]; g1[q] = ((const float*)rt)[4 * R + row * 2 + 1];
                const int base0 = __shfl(basev, e0), base1 = __shfl(basev, e1);
                const bf16_t* O0 = (const bf16_t*)(p.ws + WS_P) + (size_t)(base0 + s0) * D;
                const bf16_t* O1 = (const bf16_t*)(p.ws + WS_P) + (size_t)(base1 + s1) * D;
                const float* g2 = tab + TAB_MOD + (l * 9 + mr) * 6144 + 5 * 1024;
#pragma unroll
                for (int j = 0; j < 4; ++j) {
                    const int k = 4 * lane + 256 * j;
                    x1[q][j] = *(const f32x4*)(X1 + k); oa[q][j] = *(const u32x2*)(O0 + k); ob[q][j] = *(const u32x2*)(O1 + k); gg[q][j] = *(const f32x4*)(g2 + k);
                }
            }
        }
#pragma unroll
        for (int q = 0; q < 2; ++q) {
            const int row = row0 + q * NGW;
            if (row < RL) {
                float* O = p.out + (size_t)row * D;
#pragma unroll
                for (int j = 0; j < 4; ++j) {
                    const u32x2 a = oa[q][j], b = ob[q][j];
                    f32x4 m;
                    m.x = g0[q] * bflo(a.x) + g1[q] * bflo(b.x); m.y = g0[q] * bfhi(a.x) + g1[q] * bfhi(b.x);
                    m.z = g0[q] * bflo(a.y) + g1[q] * bflo(b.y); m.w = g0[q] * bfhi(a.y) + g1[q] * bfhi(b.y);
                    *(f32x4*)(O + 4 * lane + 256 * j) = x1[q][j] + gg[q][j] * m;
                }
            }
        }
    }
}

constexpr int BN = 128;
constexpr int LDT = 64 + 8;
typedef short v4i16_t __attribute__((ext_vector_type(4)));
typedef __attribute__((address_space(3))) v4i16_t* lds_v4i16_ptr;
__device__ __forceinline__ v4i16_t lds_tr16(const bf16_t* p) { return __builtin_amdgcn_ds_read_tr16_b64_v4i16((lds_v4i16_ptr)(p)); }

template <int N> __device__ __forceinline__ void wait_vm() {
    if constexpr (N == 0) asm volatile("s_waitcnt vmcnt(0)" ::: "memory");
    else if constexpr (N == 3) asm volatile("s_waitcnt vmcnt(3)" ::: "memory");
    else if constexpr (N == 4) asm volatile("s_waitcnt vmcnt(4)" ::: "memory");
    else if constexpr (N == 5) asm volatile("s_waitcnt vmcnt(5)" ::: "memory");
    else if constexpr (N == 6) asm volatile("s_waitcnt vmcnt(6)" ::: "memory");
    else static_assert(N < 0, "wait_vm");
}
#define RAW_BARRIER() do { asm volatile("s_waitcnt lgkmcnt(0)" ::: "memory"); __builtin_amdgcn_s_barrier(); } while (0)
__device__ __forceinline__ void glds16(const void* gsrc, unsigned lds_dst) {
    unsigned keep;
    asm volatile("s_mov_b32 %0, m0\n\ts_mov_b32 m0, %2\n\ts_nop 0\n\tglobal_load_lds_dwordx4 %1, off\n\ts_mov_b32 m0, %0" : "=&s"(keep) : "v"(gsrc), "s"(lds_dst) : "memory");
}
template <int WM, class AF>
__device__ __forceinline__ void gemm_tile_dma(const bf16_t* Abase, const AF& arow, const bf16_t* Btile, int ldb, int K, unsigned char* smem, f32x4 (&acc)[WM][4]) {
    constexpr int A_BYTES = 32 * WM * 64, B_BYTES = 8192, STAGE = A_BYTES + B_BYTES;
    constexpr int AI = WM / 2, NI = AI + 2;
    static_assert(WM % 2 == 0 && 3 * STAGE <= 73728, "gemm_tile_dma");
    const int tid = otid(), lane = tid & 63, wid = tid >> 6, wr = wid >> 1, wc = wid & 1, fr = lane & 15, fq = lane >> 4;
    unsigned aoff[AI], boff[2];
#pragma unroll
    for (int i = 0; i < AI; ++i) {
        const int r = 16 * (i * 4 + wid) + (lane >> 2);
        const int c = (lane & 3) ^ (((r >> 3) & 1) << 1);
        aoff[i] = arow(r) + 8 * c;
    }
#pragma unroll
    for (int i = 0; i < 2; ++i) {
        const int kr = 4 * (i * 4 + wid) + (lane >> 4), jp = lane & 15;
        const int g = (jp >> 1) ^ ((kr & 3) | (((kr >> 3) & 1) << 2));
        boff[i] = (unsigned)(kr * ldb + (g * 2 + (jp & 1)) * 8);
    }
#pragma unroll
    for (int m = 0; m < WM; ++m)
#pragma unroll
        for (int n = 0; n < 4; ++n) acc[m][n] = (f32x4){0.f, 0.f, 0.f, 0.f};
    const int nk = K / 32;
    const unsigned lds0 = (unsigned)(uintptr_t)smem;
    const unsigned wbase = (unsigned)__builtin_amdgcn_readfirstlane((int)(lds0 + (unsigned)wid * 1024u));
    auto dma = [&](int kt, int st) {
        const unsigned sa = wbase + (unsigned)(st * STAGE);
#pragma unroll
        for (int i = 0; i < AI; ++i) glds16(Abase + (aoff[i] + kt * 32), (unsigned)__builtin_amdgcn_readfirstlane((int)(sa + i * 4096)));
#pragma unroll
        for (int i = 0; i < 2; ++i) glds16(Btile + (boff[i] + (unsigned)(kt * 32 * ldb)), (unsigned)__builtin_amdgcn_readfirstlane((int)(sa + A_BYTES + i * 4096)));
    };
    const int a_lane = (wr * (16 * WM) + fr) * 64 + 16 * (fq ^ (((fr >> 3) & 1) << 1));
    const int fBl = (fr >> 2) | ((fq & 1) << 2);
    const int b_lane = A_BYTES + (fq * 8 + (fr >> 2)) * 256 + 8 * (fr & 3);
    auto compute = [&](int st) {
        const unsigned char* sb = smem + st * STAGE;
        bf16x8 bfr[4];
#pragma unroll
        for (int n = 0; n < 4; ++n) {
            const bf16_t* bp = (const bf16_t*)(sb + b_lane + 32 * ((wc * 4 + n) ^ fBl));
            const v4i16_t lo = lds_tr16(bp), hi = lds_tr16(bp + 512);
            bfr[n] = (bf16x8){lo[0], lo[1], lo[2], lo[3], hi[0], hi[1], hi[2], hi[3]};
        }
        bf16x8 af[WM];
#pragma unroll
        for (int m = 0; m < WM; ++m) af[m] = *(const bf16x8*)(sb + a_lane + m * 1024);
        __builtin_amdgcn_s_setprio(1);
#pragma unroll
        for (int m = 0; m < WM; ++m)
#pragma unroll
            for (int n = 0; n < 4; ++n) acc[m][n] = __builtin_amdgcn_mfma_f32_16x16x32_bf16(bfr[n], af[m], acc[m][n], 0, 0, 0);
        __builtin_amdgcn_s_setprio(0);
    };
    dma(0, 0); dma(1, 1);
    int st = 0, st2 = 2;
#pragma unroll 1
    for (int kt = 0; kt < nk - 1; ++kt) {
        wait_vm<NI>();
        RAW_BARRIER();
        if (kt + 2 < nk) dma(kt + 2, st2);
        compute(st);
        st = (st == 2) ? 0 : st + 1; st2 = (st2 == 2) ? 0 : st2 + 1;
    }
    wait_vm<0>();
    RAW_BARRIER();
    compute(st);
    RAW_BARRIER();
}

__device__ __forceinline__ void conv_some(const Params& p, int l, int maxn, unsigned char* smem);
__device__ __forceinline__ int xcd_max_units(int nMT, int nNT);
__device__ __forceinline__ bool xcd_unit(int it, int nMT, int nNT, int& mt, int& nt, const unsigned char* smem) {
    const volatile int* xinfo = (const volatile int*)(smem + 73728 + 800);
    const int G = gridDim.x, b = obid();
    if (xinfo[0]) {
        const int x = xinfo[1], rank = xinfo[2], cntx = xinfo[3];
        const int start = (x * nMT) >> 3, per = (((x + 1) * nMT) >> 3) - start;
        const int q = rank + it * cntx;
        if (q >= per * nNT) return false;
        mt = start + q % per; nt = q / per;
        return true;
    }
    const int u = b + it * G;
    if (u >= nMT * nNT) return false;
    mt = u / nNT; nt = u % nNT;
    return true;
}

__device__ __forceinline__ void epi_in_row(const f32x4 (&a)[4], int row, int cw, int fq, const float* tab, const f32x4 (&cv)[4], bf16_t* P, float* LF) {
    float v[4][4];
#pragma unroll
    for (int n = 0; n < 4; ++n)
#pragma unroll
        for (int j = 0; j < 4; ++j) v[n][j] = a[n][j];
    if (cw >= OFF_ZF && cw < OFF_HV) {
        const int dir = (cw >= OFF_ZB) ? 1 : 0;
        const int cb = cw - (dir ? OFF_ZB : OFF_ZF);
#pragma unroll
        for (int n = 0; n < 4; ++n) {
            f32x4 o;
#pragma unroll
            for (int j = 0; j < 4; ++j) {
                const float lb = cv[n][j];
                const float sg = sigmoidf_(fmaxf(v[n][j], -80.f));
                o[j] = __logf(lb + (1.f - lb) * sg);
            }
            *(f32x4*)(LF + (size_t)row * LFW + dir * 256 + cb + n * 16 + fq * 4) = o;
        }
        return;
    }
    if (cw < OFF_B) {
#pragma unroll
        for (int n = 0; n < 4; ++n)
#pragma unroll
            for (int j = 0; j < 4; ++j) v[n][j] = gelu_tanh(v[n][j]);
    }
    if ((cw >= 256 && cw < OFF_V)) {
        float ss = 0.f;
#pragma unroll
        for (int n = 0; n < 4; ++n)
#pragma unroll
            for (int j = 0; j < 4; ++j) ss += v[n][j] * v[n][j];
        ss += __shfl_xor(ss, 16); ss += __shfl_xor(ss, 32);
        const float rstd = rsqrtf(ss * (1.f / 64.f) + EPS);
        if (cw < OFF_B) {
#pragma unroll
            for (int n = 0; n < 4; ++n)
#pragma unroll
                for (int j = 0; j < 4; ++j) v[n][j] *= rstd;
        } else {
#pragma unroll
            for (int n = 0; n < 4; ++n)
#pragma unroll
                for (int j = 0; j < 4; ++j) v[n][j] *= rstd * cv[n][j];
            if (row < RL) {
                const int t = row & (T - 1);
#pragma unroll
                for (int ax = 0; ax < 2; ++ax) {
                    const int pos = ax == 0 ? (t >> 6) : (t & 63);
                    const f32x4 cs01 = *(const f32x4*)(tab + TAB_ROPE + (pos * 16 + fq * 4) * 2), cs23 = *(const f32x4*)(tab + TAB_ROPE + (pos * 16 + fq * 4) * 2 + 4);
                    const float csv[4] = {cs01[0], cs01[2], cs23[0], cs23[2]}, snv[4] = {cs01[1], cs01[3], cs23[1], cs23[3]};
#pragma unroll
                    for (int j = 0; j < 4; ++j) {
                        const float cs = csv[j], sn = snv[j];
                        const float x0 = v[2 * ax][j], x1 = v[2 * ax + 1][j];
                        v[2 * ax][j] = x0 * cs - x1 * sn;
                        v[2 * ax + 1][j] = x1 * cs + x0 * sn;
                    }
                }
            }
        }
    }
    if ((cw >= OFF_C && cw < OFF_ZF) || cw >= OFF_G) {
#pragma unroll
        for (int n = 0; n < 4; ++n)
#pragma unroll
            for (int j = 0; j < 4; ++j) v[n][j] = siluf_(v[n][j]);
    }
#pragma unroll
    for (int n = 0; n < 4; ++n) {
        u32x2 pk; pk.x = pk2(v[n][0], v[n][1]); pk.y = pk2(v[n][2], v[n][3]);
        *(u32x2*)(P + (size_t)row * INW + cw + n * 16 + fq * 4) = pk;
    }
}

__device__ void phase_gemm_in(const Params& p, int l, unsigned char* smem) {
    const float* tab = (const float*)(p.ws + WS_TAB);
    const bf16_t* H = (const bf16_t*)(p.ws + WS_H);
    bf16_t* P = (bf16_t*)(p.ws + WS_P);
    float* LF = (float*)(p.ws + WS_LF);
    const bf16_t* W = (const bf16_t*)(p.ws + WS_WIN) + (size_t)l * D * INW;
    const float* qw = p.in[10] + l * 64;
    const float* kw = p.in[11] + l * 64;
    const float* lbt = tab + TAB_LB + l * 512;
    const int tid = otid(), lane = tid & 63, wid = tid >> 6, wr = wid >> 1, wc = wid & 1, fr = lane & 15, fq = lane >> 4;
    constexpr int WM = 6, BMt = 32 * WM;
    const int nMT = R / BMt, nNT = INW / BN;
    int mine = 0;
    for (int it = 0;; ++it, ++mine) {
        int mt, nt;
        if (!xcd_unit(it, nMT, nNT, mt, nt, smem)) break;
        const int row0 = mt * BMt, col0 = nt * BN;
        f32x4 acc[WM][4];
        auto arow = [&](int i) { return (unsigned)((row0 + i) * D); };
        gemm_tile_dma<WM>(H, arow, W + col0, INW, D, smem, acc);
        const int cw = col0 + wc * 64;
        const int rbase = row0 + wr * (16 * WM) + fr;
        f32x4 cv[4];
        {
            const float* csrc = (cw >= OFF_ZF && cw < OFF_HV) ? (lbt + ((cw >= OFF_ZB) ? 256 + cw - OFF_ZB : cw - OFF_ZF)) : ((cw < OFF_KV) ? qw : kw);
#pragma unroll
            for (int n = 0; n < 4; ++n) cv[n] = *(const f32x4*)(csrc + n * 16 + fq * 4);
        }
        epi_in_row(acc[0], rbase, cw, fq, tab, cv, P, LF);
        epi_in_row(acc[1], rbase + 16, cw, fq, tab, cv, P, LF);
        epi_in_row(acc[2], rbase + 32, cw, fq, tab, cv, P, LF);
        epi_in_row(acc[3], rbase + 48, cw, fq, tab, cv, P, LF);
        epi_in_row(acc[4], rbase + 64, cw, fq, tab, cv, P, LF);
        epi_in_row(acc[5], rbase + 80, cw, fq, tab, cv, P, LF);
    }
    { const int idle = xcd_max_units(nMT, nNT) - mine; if (idle > 0) conv_some(p, l, 0 * idle, smem); }
}

__device__ __forceinline__ int next_unit(unsigned* ctr, unsigned char* smem) {
    int* slot = (int*)(smem + 73728 + 512);
    __syncthreads();
    if (otid() == 0) *slot = (int)atomicAdd(ctr, 1u);
    __syncthreads();
    return *slot;
}

constexpr int CONV_ITEMS = 2048, CONV_CHUNKS = NEXP * D * FF / 4 / CONV_ITEMS;
__device__ __forceinline__ void conv_unit(const Params& p, int l, int c) {
    const int tid = otid();
    const size_t lbase = (size_t)l * NEXP * D * FF;
    const float* w1 = p.in[20] + lbase; const float* w3 = p.in[21] + lbase; const float* w2 = p.in[22] + lbase;
    bf16_t* W13 = (bf16_t*)(p.ws + WS_W13) + (size_t)l * NEXP * D * 1024; bf16_t* W2b = (bf16_t*)(p.ws + WS_W2) + lbase;
    const int i0 = c * CONV_ITEMS + tid;
    f32x4 a[8], b[8], d[8];
#pragma unroll
    for (int u = 0; u < 8; ++u) {
        const int i = i0 + u * NTHREADS;
        a[u] = __builtin_nontemporal_load((const f32x4*)(w1 + (size_t)i * 4)); b[u] = __builtin_nontemporal_load((const f32x4*)(w3 + (size_t)i * 4));
        d[u] = __builtin_nontemporal_load((const f32x4*)(w2 + (size_t)i * 4));
    }
#pragma unroll
    for (int u = 0; u < 8; ++u) {
        const int i = i0 + u * NTHREADS;
        const int c4 = (i & 127) * 4, ek = i >> 7;
        const int dc = (c4 >> 6) * 128 + ((c4 >> 5) & 1) * 64 + (c4 & 31);
        u32x2 oa, ob, od; oa.x = pk2(a[u][0], a[u][1]); oa.y = pk2(a[u][2], a[u][3]); ob.x = pk2(b[u][0], b[u][1]); ob.y = pk2(b[u][2], b[u][3]);
        od.x = pk2(d[u][0], d[u][1]); od.y = pk2(d[u][2], d[u][3]);
        *(u32x2*)(W13 + (size_t)ek * 1024 + dc) = oa;
        *(u32x2*)(W13 + (size_t)ek * 1024 + dc + 32) = ob;
        *(u32x2*)(W2b + (size_t)i * 4) = od;
    }
}

__device__ __forceinline__ void conv_some(const Params& p, int l, int maxn, unsigned char* smem) {
    unsigned* ctr = (unsigned*)(p.ws + WS_CTL) + 192 + l;
    for (int n = 0; n < maxn; ++n) {
        const int c = next_unit(ctr, smem);
        if (c >= CONV_CHUNKS) break;
        conv_unit(p, l, c);
    }
}
__device__ __forceinline__ int xcd_max_units(int nMT, int nNT) {
    const int G8 = (gridDim.x >> 3) > 0 ? (gridDim.x >> 3) : 1;
    return (((nMT + 7) >> 3) * nNT + G8 - 1) / G8;
}

constexpr float ATT_C = 0.125f * 1.4426950408889634f;
constexpr int ATT_STAGE = 16384;
constexpr float ATT_THR = 8.0f / ATT_C;
__device__ __forceinline__ void attn_unit(const Params& p, int u, unsigned char* smem) {
    const bf16_t* P = (const bf16_t*)(p.ws + WS_P);
    bf16_t* Y = (bf16_t*)(p.ws + WS_Y);
    const int tid = otid(), lane = tid & 63, wid = tid >> 6, fr = lane & 15, fq = lane >> 4;
    int b, kvh, qrow0, nkt; const bool ctxq = u >= 1024;
    if (!ctxq) { b = u >> 7; kvh = (u >> 6) & 1; qrow0 = b * T + (u & 63) * 32; nkt = 36; }
    else { const int v = u - 1024; b = v >> 4; kvh = (v >> 3) & 1; qrow0 = RL + b * TC + (v & 7) * 32; nkt = 4; }
    const int hh = kvh * 4 + wid;
    unsigned char* Qs = smem + 3 * ATT_STAGE + wid * 4096;
#pragma unroll
    for (int i = 0; i < 4; ++i) {
        const int pc = i * 64 + lane, r = pc >> 3, c = pc & 7;
        *(u32x4*)(Qs + r * 128 + 16 * (c ^ ((r >> 1) & 7))) = *(const u32x4*)(P + (size_t)(qrow0 + r) * INW + OFF_B + hh * 64 + c * 8);
    }
    f32x4 o[2][4];
    float mrow[2], lrow[2];
#pragma unroll
    for (int m = 0; m < 2; ++m) { mrow[m] = -1e30f; lrow[m] = 0.f;
#pragma unroll
        for (int n = 0; n < 4; ++n) o[m][n] = (f32x4){0.f, 0.f, 0.f, 0.f}; }
    unsigned koff[2], voff[2];
#pragma unroll
    for (int i = 0; i < 2; ++i) {
        const int r = 32 * i + 8 * wid + (lane >> 3), cp = lane & 7;
        koff[i] = (unsigned)(r * INW + OFF_KV + kvh * 64 + (cp ^ ((r >> 1) & 7)) * 8);
        voff[i] = (unsigned)(r * INW + OFF_V + kvh * 64 + ((((cp >> 1) ^ ((r >> 1) & 3)) << 1) | (cp & 1)) * 8);
    }
    const unsigned lds0 = (unsigned)(uintptr_t)smem;
    const unsigned wbase = (unsigned)__builtin_amdgcn_readfirstlane((int)(lds0 + (unsigned)wid * 1024u));
    auto dma = [&](int kt, int st) {
        const int base = ctxq ? (RL + b * TC + kt * 64) : (kt < 32 ? (b * T + kt * 64) : (RL + b * TC + (kt - 32) * 64));
        const bf16_t* src = P + (size_t)base * INW;
        const unsigned sa = wbase + (unsigned)(st * ATT_STAGE);
#pragma unroll
        for (int i = 0; i < 2; ++i) {
            glds16(src + koff[i], (unsigned)__builtin_amdgcn_readfirstlane((int)(sa + i * 4096)));
            glds16(src + voff[i], (unsigned)__builtin_amdgcn_readfirstlane((int)(sa + 8192 + i * 4096)));
        }
    };
    const int kq_lane = fr * 128, kq_sw = (fr >> 1) & 7;
    const int hv = ((fq & 1) << 1) | (fr >> 3);
    const int v_lane = (4 * fq + (fr >> 2)) * 128 + 8 * (fr & 3);
    auto compute = [&](int st) {
        const unsigned char* kb = smem + st * ATT_STAGE;
        const unsigned char* vb = kb + 8192;
        f32x4 sc[2][4];
        {
            bf16x8 kf[4][2], qf[2][2];
#pragma unroll
            for (int n = 0; n < 4; ++n)
#pragma unroll
                for (int ks = 0; ks < 2; ++ks) kf[n][ks] = *(const bf16x8*)(kb + n * 2048 + kq_lane + 16 * ((ks * 4 + fq) ^ kq_sw));
#pragma unroll
            for (int m = 0; m < 2; ++m)
#pragma unroll
                for (int ks = 0; ks < 2; ++ks) qf[m][ks] = *(const bf16x8*)(Qs + m * 2048 + kq_lane + 16 * ((ks * 4 + fq) ^ kq_sw));
#pragma unroll
            for (int m = 0; m < 2; ++m)
#pragma unroll
                for (int n = 0; n < 4; ++n) {
                    sc[m][n] = (f32x4){0.f, 0.f, 0.f, 0.f};
#pragma unroll
                    for (int ks = 0; ks < 2; ++ks) sc[m][n] = __builtin_amdgcn_mfma_f32_16x16x32_bf16(kf[n][ks], qf[m][ks], sc[m][n], 0, 0, 0);
                }
        }
        bf16x8 vf[4][2];
#pragma unroll
        for (int n = 0; n < 4; ++n)
#pragma unroll
            for (int ks = 0; ks < 2; ++ks) {
                const bf16_t* vp = (const bf16_t*)(vb + ks * 4096 + v_lane + 32 * (n ^ hv));
                const v4i16_t lo = lds_tr16(vp), hi = lds_tr16(vp + 1024);
                vf[n][ks] = (bf16x8){lo[0], lo[1], lo[2], lo[3], hi[0], hi[1], hi[2], hi[3]};
            }
        bf16x8 pf[2][2];
#pragma unroll
        for (int m = 0; m < 2; ++m) {
            float mx = sc[m][0][0];
#pragma unroll
            for (int n = 0; n < 4; ++n)
#pragma unroll
                for (int j = 0; j < 4; ++j) mx = fmaxf(mx, sc[m][n][j]);
            mx = fmaxf(mx, __shfl_xor(mx, 16)); mx = fmaxf(mx, __shfl_xor(mx, 32));
            if (__any(mx - mrow[m] > ATT_THR)) {
                const float mnew = fmaxf(mrow[m], mx);
                const float alpha = __builtin_amdgcn_exp2f((mrow[m] - mnew) * ATT_C);
                mrow[m] = mnew;
                lrow[m] *= alpha;
#pragma unroll
                for (int n = 0; n < 4; ++n) o[m][n] = o[m][n] * alpha;
            }
            const float mc = mrow[m] * ATT_C;
            float ls = 0.f;
#pragma unroll
            for (int n = 0; n < 4; ++n)
#pragma unroll
                for (int j = 0; j < 4; ++j) { sc[m][n][j] = __builtin_amdgcn_exp2f(sc[m][n][j] * ATT_C - mc); ls += sc[m][n][j]; }
            lrow[m] += ls;
#pragma unroll
            for (int ks = 0; ks < 2; ++ks) {
                u32x4 pw;
                pw.x = pk2(sc[m][2 * ks][0], sc[m][2 * ks][1]); pw.y = pk2(sc[m][2 * ks][2], sc[m][2 * ks][3]);
                pw.z = pk2(sc[m][2 * ks + 1][0], sc[m][2 * ks + 1][1]); pw.w = pk2(sc[m][2 * ks + 1][2], sc[m][2 * ks + 1][3]);
                pf[m][ks] = __builtin_bit_cast(bf16x8, pw);
            }
        }
#pragma unroll
        for (int m = 0; m < 2; ++m)
#pragma unroll
            for (int ks = 0; ks < 2; ++ks)
#pragma unroll
                for (int nd = 0; nd < 4; ++nd) o[m][nd] = __builtin_amdgcn_mfma_f32_16x16x32_bf16(vf[nd][ks], pf[m][ks], o[m][nd], 0, 0, 0);
    };
    dma(0, 0); dma(1, 1);
    int st = 0, st2 = 2;
#pragma unroll 1
    for (int kt = 0; kt < nkt - 1; ++kt) {
        wait_vm<4>();
        RAW_BARRIER();
        if (kt + 2 < nkt) dma(kt + 2, st2);
        compute(st);
        st = (st == 2) ? 0 : st + 1; st2 = (st2 == 2) ? 0 : st2 + 1;
    }
    wait_vm<0>();
    RAW_BARRIER();
    compute(st);
#pragma unroll
    for (int m = 0; m < 2; ++m) {
        float lt = lrow[m];
        lt += __shfl_xor(lt, 16); lt += __shfl_xor(lt, 32);
        const float inv = 1.f / lt;
        const size_t row = (size_t)(qrow0 + m * 16 + fr);
#pragma unroll
        for (int nd = 0; nd < 4; ++nd) {
            u32x2 pk; pk.x = pk2(o[m][nd][0] * inv, o[m][nd][1] * inv); pk.y = pk2(o[m][nd][2] * inv, o[m][nd][3] * inv);
            *(u32x2*)(Y + row * D + 256 + hh * 64 + nd * 16 + fq * 4) = pk;
        }
    }
}

constexpr int LDA = 128 + 8;
__device__ __forceinline__ void mixa_unit(const Params& p, int l, int u, unsigned char* smem) {
    const bf16_t* P = (const bf16_t*)(p.ws + WS_P);
    bf16_t* Y = (bf16_t*)(p.ws + WS_Y);
    const int n = u >> 2, h = u & 3;
    const float* W = p.in[8] + ((size_t)l * 4 + h) * 128 * 128;
    const float* bs = p.in[9] + (l * 4 + h) * 128;
    bf16_t* Ws = (bf16_t*)smem;
    bf16_t* Vs = Ws + 128 * LDA;
    const int tid = otid(), lane = tid & 63, wid = tid >> 6, fr = lane & 15, fq = lane >> 4;
#pragma unroll
    for (int i = 0; i < 16; ++i) {
        const int pc = tid + 256 * i, t = pc >> 5, s4 = (pc & 31) * 4;
        const f32x4 w = *(const f32x4*)(W + t * 128 + s4);
        u32x2 o; o.x = pk2(w[0], w[1]); o.y = pk2(w[2], w[3]);
        *(u32x2*)(Ws + t * LDA + s4) = o;
    }
#pragma unroll
    for (int i = 0; i < 2; ++i) {
        const int mb = tid + 256 * i, dg = mb & 15, sg = mb >> 4;
        u32x2 vr[4];
#pragma unroll
        for (int r = 0; r < 4; ++r) vr[r] = *(const u32x2*)(P + (size_t)(n * 128 + 4 * sg + r) * INW + 256 + h * 64 + 4 * dg);
#pragma unroll
        for (int di = 0; di < 4; ++di) {
            const int w = di >> 1;
            u32x2 ov;
            if ((di & 1) == 0) { ov.x = (vr[0][w] & 0xffffu) | (vr[1][w] << 16); ov.y = (vr[2][w] & 0xffffu) | (vr[3][w] << 16); }
            else { ov.x = (vr[0][w] >> 16) | (vr[1][w] & 0xffff0000u); ov.y = (vr[2][w] >> 16) | (vr[3][w] & 0xffff0000u); }
            *(u32x2*)(Vs + (4 * dg + di) * LDA + 4 * sg) = ov;
        }
    }
    __syncthreads();
    f32x4 acc[2][4];
#pragma unroll
    for (int m = 0; m < 2; ++m)
#pragma unroll
        for (int nd = 0; nd < 4; ++nd) acc[m][nd] = (f32x4){0.f, 0.f, 0.f, 0.f};
#pragma unroll
    for (int ks = 0; ks < 4; ++ks) {
        bf16x8 wf[2], vf[4];
#pragma unroll
        for (int m = 0; m < 2; ++m) wf[m] = *(const bf16x8*)(Ws + (32 * wid + 16 * m + fr) * LDA + ks * 32 + fq * 8);
#pragma unroll
        for (int nd = 0; nd < 4; ++nd) vf[nd] = *(const bf16x8*)(Vs + (16 * nd + fr) * LDA + ks * 32 + fq * 8);
#pragma unroll
        for (int m = 0; m < 2; ++m)
#pragma unroll
            for (int nd = 0; nd < 4; ++nd) acc[m][nd] = __builtin_amdgcn_mfma_f32_16x16x32_bf16(vf[nd], wf[m], acc[m][nd], 0, 0, 0);
    }
#pragma unroll
    for (int m = 0; m < 2; ++m) {
        const int t = 32 * wid + 16 * m + fr;
        const size_t row = (size_t)n * 128 + t;
        const float bias = bs[t];
#pragma unroll
        for (int nd = 0; nd < 4; ++nd) {
            const int c = h * 64 + 16 * nd + 4 * fq;
            const u32x2 uu = *(const u32x2*)(P + row * INW + c);
            u32x2 pk;
            pk.x = pk2(bflo(uu.x) * (acc[m][nd][0] + bias), bfhi(uu.x) * (acc[m][nd][1] + bias));
            pk.y = pk2(bflo(uu.y) * (acc[m][nd][2] + bias), bfhi(uu.y) * (acc[m][nd][3] + bias));
            *(u32x2*)(Y + row * D + c) = pk;
        }
    }
}

__device__ __forceinline__ int hg_pos(int I, int ii) { return 32 * (I >> 1) + 4 * (I & 1) + 8 * (ii >> 2) + (ii & 3); }
__device__ __forceinline__ void hgrn_state_unit(const Params& p, int l, int u, unsigned char* smem) {
    const bf16_t* P = (const bf16_t*)(p.ws + WS_P);
    const float* LF = (const float*)(p.ws + WS_LF);
    bf16_t* SST = (bf16_t*)(p.ws + WS_OFB);
    const int b = u >> 3, h = (u >> 1) & 3, dir = u & 1;
    const int tid = otid(), lane = tid & 63, wid = tid >> 6, fr = lane & 15, fq = lane >> 4;
    const int k = lane, I = wid;
    bf16_t* KT = (bf16_t*)smem;
    bf16_t* VT = KT + 64 * LDT;
    float* Tsub = (float*)(VT + 64 * LDT);
    float* Etot = Tsub + 256;
    f32x4 sacc[4];
#pragma unroll
    for (int nk = 0; nk < 4; ++nk) sacc[nk] = (f32x4){0.f, 0.f, 0.f, 0.f};
    float lf[16], vv[16];
    auto mcof = [&](int j) { return dir == 0 ? (j < 4 ? 256 + b * 4 + j : b * 32 + (j - 4)) : (j < 4 ? 256 + b * 4 + (3 - j) : b * 32 + (35 - j)); };
    auto gload = [&](int j) {
        const int mc = mcof(j);
#pragma unroll
        for (int ii = 0; ii < 16; ++ii) {
            const int tau = 16 * I + ii;
            const size_t row = (size_t)mc * 64 + (dir ? 63 - tau : tau);
            lf[ii] = LF[row * LFW + dir * 256 + h * 64 + k];
            vv[ii] = bf2f(P[row * INW + OFF_HV + h * 64 + k]);
        }
    };
    gload(0);
    for (int j = 0; j < 36; ++j) {
        float c[16];
        c[0] = lf[0];
#pragma unroll
        for (int ii = 1; ii < 16; ++ii) c[ii] = c[ii - 1] + lf[ii];
        Tsub[I * 64 + k] = c[15];
        __syncthreads();
        float Rs = 0.f;
#pragma unroll
        for (int M = 1; M < 4; ++M) Rs += (M > I) ? Tsub[M * 64 + k] : 0.f;
        if (I == 0) Etot[k] = __expf(c[15] + Rs);
#pragma unroll
        for (int g = 0; g < 4; ++g) {
            float kh[4];
#pragma unroll
            for (int jj = 0; jj < 4; ++jj) { const int ii = 4 * g + jj; kh[jj] = (1.f - __expf(lf[ii])) * __expf(c[15] - c[ii] + Rs); }
            u32x2 kw; kw.x = pk2(kh[0], kh[1]); kw.y = pk2(kh[2], kh[3]);
            u32x2 vw; vw.x = pk2(vv[4 * g], vv[4 * g + 1]); vw.y = pk2(vv[4 * g + 2], vv[4 * g + 3]);
            const int pos = hg_pos(I, 4 * g);
            *(u32x2*)(KT + k * LDT + pos) = kw;
            *(u32x2*)(VT + k * LDT + pos) = vw;
        }
        const int mc = mcof(j);
        {
            bf16_t* dst = SST + ((size_t)(mc * 4 + h) * 2 + dir) * 4096;
#pragma unroll
            for (int nk = 0; nk < 4; ++nk)
#pragma unroll
                for (int r = 0; r < 4; ++r) dst[(16 * wid + 4 * fq + r) * 64 + 16 * nk + fr] = f2bf(sacc[nk][r]);
        }
        if (j + 1 < 36) gload(j + 1);
        __builtin_amdgcn_sched_barrier(0);
        __syncthreads();
        bf16x8 vf[2];
#pragma unroll
        for (int ks = 0; ks < 2; ++ks) vf[ks] = *(const bf16x8*)(VT + (16 * wid + fr) * LDT + 32 * ks + 8 * fq);
#pragma unroll
        for (int nk = 0; nk < 4; ++nk) {
            const float e = Etot[16 * nk + fr];
            sacc[nk] = sacc[nk] * e;
#pragma unroll
            for (int ks = 0; ks < 2; ++ks) {
                const bf16x8 kf = *(const bf16x8*)(KT + (16 * nk + fr) * LDT + 32 * ks + 8 * fq);
                sacc[nk] = __builtin_amdgcn_mfma_f32_16x16x32_bf16(vf[ks], kf, sacc[nk], 0, 0, 0);
            }
        }
        __syncthreads();
    }
    asm volatile("s_waitcnt vmcnt(0)" ::: "memory");
    __syncthreads();
    if (otid() == 0) {
        __builtin_amdgcn_fence(__ATOMIC_RELEASE, "agent");
        asm volatile("s_waitcnt vmcnt(0)" ::: "memory");
        __hip_atomic_fetch_add((unsigned*)(p.ws + WS_CTL) + 160 + l, 1u, __ATOMIC_RELAXED, __HIP_MEMORY_SCOPE_AGENT);
    }
}


__device__ __forceinline__ void hgrn_out_unit(const Params& p, int l, int u, unsigned char* smem) {
    const bf16_t* P = (const bf16_t*)(p.ws + WS_P);
    const float* LF = (const float*)(p.ws + WS_LF);
    const bf16_t* SST = (const bf16_t*)(p.ws + WS_OFB);
    bf16_t* Y = (bf16_t*)(p.ws + WS_Y);
    const float* hw = p.in[13] + l * 64;
    const int mc = u >> 2, h = u & 3;
    const int tid = otid(), lane = tid & 63, wid = tid >> 6, fr = lane & 15, fq = lane >> 4;
    const int k = lane, I = wid;
    bf16_t* QT0 = (bf16_t*)smem;
    bf16_t* KD = QT0 + 64 * LDT;
    bf16_t* KO = KD + 64 * LDT;
    bf16_t* QS = KO + 64 * LDT;
    bf16_t* QT1 = QS + 64 * LDT;
    bf16_t* QT2 = QT1 + 32 * LDT;
    bf16_t* VT = QT2 + 16 * LDT;
    float* Tsub = (float*)(VT + 64 * LDT);
    float* SSQ = Tsub + 256;
    f32x4 om[4];
#pragma unroll 1
    for (int dd = 0; dd < 2; ++dd) {
        const int dir = 1 - dd;
        float lf[16], c[16];
#pragma unroll
        for (int ii = 0; ii < 16; ++ii) {
            const int tau = 16 * I + ii;
            const size_t row = (size_t)mc * 64 + (dir ? 63 - tau : tau);
            lf[ii] = LF[row * LFW + dir * 256 + h * 64 + k];
        }
        c[0] = lf[0];
#pragma unroll
        for (int ii = 1; ii < 16; ++ii) c[ii] = c[ii - 1] + lf[ii];
        Tsub[I * 64 + k] = c[15];
        __syncthreads();
        const float T0 = Tsub[k], T1 = Tsub[64 + k], T2 = Tsub[128 + k];
        const float pre = (I > 0 ? T0 : 0.f) + (I > 1 ? T1 : 0.f) + (I > 2 ? T2 : 0.f);
        const float epre = __expf(pre);
        const float g1 = __expf(I == 2 ? T1 : T2);
        const float g2 = __expf(T1 + T2);
#pragma unroll
        for (int g = 0; g < 4; ++g) {
            float vq[4];
#pragma unroll
            for (int jj = 0; jj < 4; ++jj) {
                const int ii = 4 * g + jj, tau = 16 * I + ii;
                const size_t row = (size_t)mc * 64 + (dir ? 63 - tau : tau);
                const float q = bf2f(P[row * INW + OFF_C + h * 64 + k]);
                vq[jj] = bf2f(P[row * INW + OFF_HV + h * 64 + k]);
                const float qt = q * __expf(c[ii]);
                const float kk = 1.f - __expf(lf[ii]);
                QT0[tau * LDT + k] = f2bf(qt);
                QS[tau * LDT + k] = f2bf(qt * epre);
                KD[tau * LDT + k] = f2bf(kk * __expf(fminf(-c[ii], 80.f)));
                KO[tau * LDT + k] = f2bf(kk * __expf(c[15] - c[ii]));
                if (I >= 2) QT1[(tau - 32) * LDT + k] = f2bf(qt * g1);
                if (I == 3) QT2[(tau - 48) * LDT + k] = f2bf(qt * g2);
            }
            u32x2 vw; vw.x = pk2(vq[0], vq[1]); vw.y = pk2(vq[2], vq[3]);
            *(u32x2*)(VT + k * LDT + hg_pos(I, 4 * g)) = vw;
        }
        bf16x8 stf[2];
        {
            const bf16_t* src = SST + ((size_t)(mc * 4 + h) * 2 + dir) * 4096 + (16 * wid + fr) * 64 + 8 * fq;
            stf[0] = *(const bf16x8*)(src); stf[1] = *(const bf16x8*)(src + 32);
        }
        __syncthreads();
        bf16x8 vf[2];
#pragma unroll
        for (int ks = 0; ks < 2; ++ks) vf[ks] = *(const bf16x8*)(VT + (16 * wid + fr) * LDT + 32 * ks + 8 * fq);
        f32x4 o[4];
#pragma unroll
        for (int I2 = 0; I2 < 4; ++I2) {
            f32x4 A[4];
#pragma unroll
            for (int J = 0; J < 4; ++J) {
                A[J] = (f32x4){0.f, 0.f, 0.f, 0.f};
                if (J <= I2) {
                    const bf16_t* kbase = (J == I2 ? KD : KO) + (16 * J + fr) * LDT + 8 * fq;
                    const bf16_t* qbase = (I2 - J <= 1) ? (QT0 + (16 * I2 + fr) * LDT) : ((I2 - J == 2) ? (QT1 + (16 * I2 - 32 + fr) * LDT) : (QT2 + fr * LDT));
#pragma unroll
                    for (int ks = 0; ks < 2; ++ks) {
                        const bf16x8 kf = *(const bf16x8*)(kbase + 32 * ks);
                        const bf16x8 qf = *(const bf16x8*)(qbase + 32 * ks + 8 * fq);
                        A[J] = __builtin_amdgcn_mfma_f32_16x16x32_bf16(kf, qf, A[J], 0, 0, 0);
                    }
                    if (J == I2) {
#pragma unroll
                        for (int r = 0; r < 4; ++r) A[J][r] = (4 * fq + r <= fr) ? A[J][r] : 0.f;
                    }
                }
            }
            o[I2] = (f32x4){0.f, 0.f, 0.f, 0.f};
#pragma unroll
            for (int ks = 0; ks < 2; ++ks) {
                if (2 * ks <= I2) {
                    u32x4 pw;
                    pw.x = pk2(A[2 * ks][0], A[2 * ks][1]); pw.y = pk2(A[2 * ks][2], A[2 * ks][3]);
                    pw.z = pk2(A[2 * ks + 1][0], A[2 * ks + 1][1]); pw.w = pk2(A[2 * ks + 1][2], A[2 * ks + 1][3]);
                    o[I2] = __builtin_amdgcn_mfma_f32_16x16x32_bf16(vf[ks], __builtin_bit_cast(bf16x8, pw), o[I2], 0, 0, 0);
                }
                const bf16x8 qsf = *(const bf16x8*)(QS + (16 * I2 + fr) * LDT + 32 * ks + 8 * fq);
                o[I2] = __builtin_amdgcn_mfma_f32_16x16x32_bf16(stf[ks], qsf, o[I2], 0, 0, 0);
            }
        }
        if (dir == 1) {
            const int src = (lane & 48) | (15 - fr);
#pragma unroll
            for (int Im = 0; Im < 4; ++Im)
#pragma unroll
                for (int r = 0; r < 4; ++r) om[Im][r] = __shfl(o[3 - Im][r], src);
        } else {
#pragma unroll
            for (int Im = 0; Im < 4; ++Im) om[Im] = om[Im] + o[Im];
        }
        __syncthreads();
    }
#pragma unroll
    for (int Im = 0; Im < 4; ++Im) {
        float s = om[Im][0] * om[Im][0] + om[Im][1] * om[Im][1] + om[Im][2] * om[Im][2] + om[Im][3] * om[Im][3];
        s += __shfl_xor(s, 16); s += __shfl_xor(s, 32);
        if (fq == 0) SSQ[wid * 64 + 16 * Im + fr] = s;
    }
    __syncthreads();
    const f32x4 wv = *(const f32x4*)(hw + 16 * wid + 4 * fq);
#pragma unroll
    for (int Im = 0; Im < 4; ++Im) {
        const int i = 16 * Im + fr;
        const float tot = SSQ[i] + SSQ[64 + i] + SSQ[128 + i] + SSQ[192 + i];
        const float rstd = rsqrtf(tot * (1.f / 64.f) + EPS);
        const size_t row = (size_t)mc * 64 + i;
        const u32x2 gg = *(const u32x2*)(P + row * INW + OFF_G + h * 64 + 16 * wid + 4 * fq);
        u32x2 pk;
        pk.x = pk2(om[Im][0] * rstd * wv[0] * bflo(gg.x), om[Im][1] * rstd * wv[1] * bfhi(gg.x));
        pk.y = pk2(om[Im][2] * rstd * wv[2] * bflo(gg.y), om[Im][3] * rstd * wv[3] * bfhi(gg.y));
        *(u32x2*)(Y + row * D + 768 + h * 64 + 16 * wid + 4 * fq) = pk;
    }
}

__device__ void phase_mix1(const Params& p, int l, unsigned char* smem, int rep) {
    unsigned* ctr = (unsigned*)(p.ws + WS_CTL) + 128 + l * 2 + rep * 4;
    unsigned* done = (unsigned*)(p.ws + WS_CTL) + 160 + l;
    const int n_attn = (l == 0) ? 1152 : 1024, n_mixa = (l == 0) ? 576 : 512, n_hout = ((l == 0) ? 288 : 256) * 4;
    const int total = 64 + n_attn + n_mixa + n_hout;
    bool acquired = false;
    for (;;) {
        const int u = next_unit(ctr, smem);
        if (u >= total) break;
        if (u < 64) hgrn_state_unit(p, l, u, smem);
        else if (u < 64 + n_attn) attn_unit(p, u - 64, smem);
        else if (u < 64 + n_attn + n_mixa) mixa_unit(p, l, u - 64 - n_attn, smem);
        else {
            if (!acquired) {
                if (otid() == 0) {
                    unsigned spins = 0;
                    while (__hip_atomic_load(done, __ATOMIC_RELAXED, __HIP_MEMORY_SCOPE_AGENT) < 64u * (unsigned)(rep + 1)) { __builtin_amdgcn_s_sleep(8); if (++spins > (1u << 24)) break; }
                    __builtin_amdgcn_fence(__ATOMIC_ACQUIRE, "agent");
                    asm volatile("s_waitcnt vmcnt(0)" ::: "memory");
                }
                __syncthreads();
                acquired = true;
            }
            hgrn_out_unit(p, l, u - 64 - n_attn - n_mixa, smem);
        }
    }
}

template <int WM>
__device__ __forceinline__ void phase_out_t(const Params& p, int l, unsigned char* smem) {
    const float* tab = (const float*)(p.ws + WS_TAB);
    const bf16_t* Y = (const bf16_t*)(p.ws + WS_Y);
    float* X1 = (float*)(p.ws + WS_X1);
    const float* X2 = (const float*)(p.ws + WS_X2);
    const bf16_t* W = (const bf16_t*)(p.ws + WS_WOUT) + (size_t)l * D * D;
    const int tid = otid(), lane = tid & 63, wid = tid >> 6, wr = wid >> 1, wc = wid & 1, fr = lane & 15, fq = lane >> 4;
    const int nrows = (l == 0) ? R : RL;
    constexpr int BMt = 32 * WM;
    const int nMT = (nrows + BMt - 1) / BMt, nNT = D / BN;
    int mine = 0;
    for (int it = 0;; ++it, ++mine) {
        int mt, nt;
        if (!xcd_unit(it, nMT, nNT, mt, nt, smem)) break;
        const int row0 = mt * BMt, col0 = nt * BN;
        f32x4 acc[WM][4];
        auto arow = [&](int i) { return (unsigned)((row0 + i) * D); };
        gemm_tile_dma<WM>(Y, arow, W + col0, D, D, smem, acc);
#pragma unroll
        for (int m = 0; m < WM; ++m) {
            const int row = row0 + wr * (16 * WM) + m * 16 + fr;
            const int mr = row_modrow(row);
            const float* g1 = tab + TAB_MOD + (l * 9 + mr) * 6144 + 2 * 1024;
            const float* xin = (l == 0) ? (row < RL ? p.in[0] + (size_t)row * D : p.in[2] + (size_t)(row - RL) * D) : X2 + (size_t)row * D;
#pragma unroll
            for (int n = 0; n < 4; ++n) {
                const int col = col0 + wc * 64 + n * 16 + fq * 4;
                const f32x4 xv = *(const f32x4*)(xin + col), gv = *(const f32x4*)(g1 + col);
                *(f32x4*)(X1 + (size_t)row * D + col) = xv + gv * acc[m][n];
            }
        }
    }
    { const int idle = xcd_max_units(nMT, nNT) - mine; if (idle > 0) conv_some(p, l, 3 * idle, smem); }
}
__device__ void phase_out(const Params& p, int l, unsigned char* smem) {
    if (l == 0) phase_out_t<6>(p, l, smem); else phase_out_t<4>(p, l, smem);
}

__device__ void phase_route(const Params& p, int l, unsigned char* smem) {
    const float* tab = (const float*)(p.ws + WS_TAB);
    bf16_t* H = (bf16_t*)(p.ws + WS_H);
    const float* X1 = (const float*)(p.ws + WS_X1);
    int* rt = (int*)(p.ws + WS_RT);
    unsigned* ctl = (unsigned*)(p.ws + WS_CTL);
    const float* nw = p.in[15] + l * 1024;
    const float* wg = p.in[16] + (size_t)l * 1024 * 4;
    const float* bg = p.in[17] + l * 4;
    const float* we = p.in[18] + (size_t)l * 1024 * 32;
    const float* be = p.in[19] + l * 32;
    const int tid = otid(), lane = tid & 63, wid = tid >> 6, wr = wid >> 1, wc = wid & 1, fr = lane & 15, fq = lane >> 4;
    const int nrows = (l == 0) ? R : RL;
    float* Ls = (float*)smem;
    constexpr int BM = 64;
    for (int u = obid(); u < nrows / BM; u += gridDim.x) {
        const int row0 = u * BM;
        {
            const int mr = row_modrow(row0);
            const float* sh = tab + TAB_MOD + (l * 9 + mr) * 6144 + 3 * 1024;
            const float* scv = sh + 1024;
            f32x4 ma[4], mb[4];
#pragma unroll
            for (int j = 0; j < 4; ++j) {
                const int k = 4 * lane + 256 * j;
                ma[j] = *(const f32x4*)(nw + k) * (1.f + *(const f32x4*)(scv + k)); mb[j] = *(const f32x4*)(sh + k);
            }
#pragma unroll 1
            for (int rb = 0; rb < 4; ++rb) {
                const int rowb = row0 + wid * 16 + rb * 4;
                f32x4 v[4][4];
#pragma unroll
                for (int q = 0; q < 4; ++q)
#pragma unroll
                    for (int j = 0; j < 4; ++j) v[q][j] = *(const f32x4*)(X1 + (size_t)(rowb + q) * D + 4 * lane + 256 * j);
                float ss[4];
#pragma unroll
                for (int q = 0; q < 4; ++q) {
                    ss[q] = 0.f;
#pragma unroll
                    for (int j = 0; j < 4; ++j) ss[q] += (v[q][j].x * v[q][j].x + v[q][j].y * v[q][j].y) + (v[q][j].z * v[q][j].z + v[q][j].w * v[q][j].w);
                }
#pragma unroll
                for (int o = 1; o < 64; o <<= 1) {
#pragma unroll
                    for (int q = 0; q < 4; ++q) ss[q] += __shfl_xor(ss[q], o);
                }
#pragma unroll
                for (int q = 0; q < 4; ++q) {
                    const float rstd = rsqrtf(ss[q] * (1.f / D) + EPS);
#pragma unroll
                    for (int j = 0; j < 4; ++j) {
                        const f32x4 o = v[q][j] * rstd * ma[j] + mb[j];
                        u32x2 pk; pk.x = pk2(o.x, o.y); pk.y = pk2(o.z, o.w);
                        *(u32x2*)(H + (size_t)(rowb + q) * D + 4 * lane + 256 * j) = pk;
                    }
                }
            }
        }
        asm volatile("s_waitcnt vmcnt(0)" ::: "memory");
        __syncthreads();
        {
            const bf16_t* WRl = (const bf16_t*)(p.ws + WS_WR) + (size_t)l * 48 * 1024;
            f32x4 acc[4][3];
#pragma unroll
            for (int m = 0; m < 4; ++m)
#pragma unroll
                for (int n = 0; n < 3; ++n) acc[m][n] = (f32x4){0.f, 0.f, 0.f, 0.f};
            const bf16_t* ap = H + (size_t)(row0 + fr) * D + wid * 256 + fq * 8;
            const bf16_t* bp = WRl + (size_t)fr * 1024 + wid * 256 + fq * 8;
#pragma unroll 1
            for (int kh = 0; kh < 4; ++kh) {
                bf16x8 af[2][4], bf[2][3];
#pragma unroll
                for (int ks = 0; ks < 2; ++ks) {
#pragma unroll
                    for (int m = 0; m < 4; ++m) af[ks][m] = *(const bf16x8*)(ap + (size_t)m * 16 * D + (kh * 2 + ks) * 32);
#pragma unroll
                    for (int n = 0; n < 3; ++n) bf[ks][n] = *(const bf16x8*)(bp + (size_t)n * 16 * 1024 + (kh * 2 + ks) * 32);
                }
#pragma unroll
                for (int ks = 0; ks < 2; ++ks)
#pragma unroll
                    for (int m = 0; m < 4; ++m)
#pragma unroll
                        for (int n = 0; n < 3; ++n) acc[m][n] = __builtin_amdgcn_mfma_f32_16x16x32_bf16(bf[ks][n], af[ks][m], acc[m][n], 0, 0, 0);
            }
            float* Lp = (float*)smem + wid * (64 * 48);
#pragma unroll
            for (int m = 0; m < 4; ++m)
#pragma unroll
                for (int n = 0; n < 3; ++n) *(f32x4*)(Lp + (m * 16 + fr) * 48 + n * 16 + fq * 4) = acc[m][n];
        }
        __syncthreads();
        unsigned* lcnt = (unsigned*)(smem + 49152);
        if (tid < 32) lcnt[tid] = 0u;
        int dec_ea = 0, dec_eb = 0, dec_la = 0, dec_lb = 0; float dec_ga = 0.f, dec_gb = 0.f;
        __syncthreads();
        if (tid < BM) {
            const int row = row0 + tid;
            const float* lp = (const float*)smem + tid * 48;
            float lg[36];
#pragma unroll
            for (int i = 0; i < 36; ++i) lg[i] = (lp[i] + lp[64 * 48 + i]) + (lp[2 * 64 * 48 + i] + lp[3 * 64 * 48 + i]);
            float gl[4];
#pragma unroll
            for (int i = 0; i < 4; ++i) gl[i] = lg[i] + bg[i];
            int grp = 0; float gm = gl[0];
#pragma unroll
            for (int i = 1; i < 4; ++i) if (gl[i] > gm) { gm = gl[i]; grp = i; }
            float gs = 0.f;
#pragma unroll
            for (int i = 0; i < 4; ++i) gs += expf(gl[i] - gm);
            const float pgrp = 1.f / gs;
            float ev[8];
#pragma unroll
            for (int i = 0; i < 8; ++i) {
                float x = lg[4 + i];
#pragma unroll
                for (int g = 1; g < 4; ++g) x = (grp == g) ? lg[4 + g * 8 + i] : x;
                ev[i] = x + be[grp * 8 + i];
            }
            int i0 = 0; float v0 = ev[0];
#pragma unroll
            for (int i = 1; i < 8; ++i) if (ev[i] > v0) { v0 = ev[i]; i0 = i; }
            int i1 = -1; float v1 = -3.0e38f;
#pragma unroll
            for (int i = 0; i < 8; ++i) if (i != i0 && ev[i] > v1) { v1 = ev[i]; i1 = i; }
            const float e1 = expf(v1 - v0);
            const float ga = pgrp / (1.f + e1), gb = pgrp * e1 / (1.f + e1);
            const int ea = grp * 8 + i0, eb = grp * 8 + i1;
            dec_ea = ea; dec_eb = eb; dec_ga = ga; dec_gb = gb;
            dec_la = (int)atomicAdd(&lcnt[ea], 1u);
            dec_lb = (int)atomicAdd(&lcnt[eb], 1u);
        }
        __syncthreads();
        if (tid < 32) { const unsigned c = lcnt[tid]; lcnt[32 + tid] = c ? atomicAdd(&ctl[cur_idx(l, tid)], c) : 0u; }
        __syncthreads();
        if (tid < BM) {
            const int row = row0 + tid;
            const int sa = (int)lcnt[32 + dec_ea] + dec_la, sb = (int)lcnt[32 + dec_eb] + dec_lb;
            rt[row * 2] = dec_ea; rt[row * 2 + 1] = dec_eb;
            rt[2 * R + row * 2] = sa; rt[2 * R + row * 2 + 1] = sb;
            ((float*)rt)[4 * R + row * 2] = dec_ga; ((float*)rt)[4 * R + row * 2 + 1] = dec_gb;
            rt[6 * R + dec_ea * R + sa] = row;
            rt[6 * R + dec_eb * R + sb] = row;
        }
        __syncthreads();
    }
    conv_some(p, l, 1 << 30, smem);
}

constexpr int MOE_WM = 6, MOE_BM = 32 * MOE_WM;
__device__ __forceinline__ void moe_units(const Params& p, int l, int* s_cnt, int* s_base, int* s_tpre) {
    const unsigned* ctl = (const unsigned*)(p.ws + WS_CTL);
    if (otid() == 0) {
        int base = 0, tp = 0;
        for (int e = 0; e < NEXP; ++e) {
            const int c = (int)ctl[cur_idx(l, e)];
            s_cnt[e] = c; s_base[e] = base; s_tpre[e] = tp;
            base += c; tp += (c + MOE_BM - 1) / MOE_BM;
        }
        s_tpre[NEXP] = tp;
    }
    __syncthreads();
}

__device__ void phase_moe1(const Params& p, int l, unsigned char* smem) {
    int* s_cnt = (int*)(smem + 73728);
    int* s_base = s_cnt + 32;
    int* s_tpre = s_base + 32;
    moe_units(p, l, s_cnt, s_base, s_tpre);
    const bf16_t* H = (const bf16_t*)(p.ws + WS_H);
    bf16_t* HM = (bf16_t*)(p.ws + WS_LF);
    const int* list = (const int*)(p.ws + WS_RT) + 6 * R;
    const int tid = otid(), lane = tid & 63, wid = tid >> 6, wr = wid >> 1, wc = wid & 1, fr = lane & 15, fq = lane >> 4;
    const int ntiles = s_tpre[NEXP];
    constexpr int nNT = FF / 64;
    int mine = 0;
    for (int it = 0;; ++it, ++mine) {
        int tg, nt;
        if (!xcd_unit(it, ntiles, nNT, tg, nt, smem)) break;
        int e = 0;
        while (s_tpre[e + 1] <= tg) ++e;
        const int mt = tg - s_tpre[e], cnt = s_cnt[e], base = s_base[e];
        const bf16_t* w13 = (const bf16_t*)(p.ws + WS_W13) + ((size_t)l * NEXP + e) * D * 1024;
        const int* lst = list + (size_t)e * R;
        f32x4 acc[MOE_WM][4];
        auto arow = [&](int i) { int s = mt * MOE_BM + i; s = s < cnt ? s : cnt - 1; return (unsigned)(lst[s] * D); };
        gemm_tile_dma<MOE_WM>(H, arow, w13 + nt * 128, 1024, D, smem, acc);
#pragma unroll
        for (int m = 0; m < MOE_WM; ++m) {
            const int s = mt * MOE_BM + wr * (16 * MOE_WM) + m * 16 + fr;
            if (s < cnt) {
#pragma unroll
                for (int n = 0; n < 2; ++n) {
                    float hv[4];
#pragma unroll
                    for (int j = 0; j < 4; ++j) hv[j] = siluf_(acc[m][n][j]) * acc[m][n + 2][j];
                    u32x2 pk; pk.x = pk2(hv[0], hv[1]); pk.y = pk2(hv[2], hv[3]);
                    *(u32x2*)(HM + (size_t)(base + s) * FF + nt * 64 + wc * 32 + n * 16 + fq * 4) = pk;
                }
            }
        }
    }
    if (l + 1 < 2) { const int idle = xcd_max_units(ntiles, nNT) - mine; if (idle > 0) conv_some(p, l + 1, 3 * idle, smem); }
}

__device__ void phase_moe2(const Params& p, int l, unsigned char* smem) {
    int* s_cnt = (int*)(smem + 73728);
    int* s_base = s_cnt + 32;
    int* s_tpre = s_base + 32;
    moe_units(p, l, s_cnt, s_base, s_tpre);
    const bf16_t* HM = (const bf16_t*)(p.ws + WS_LF);
    bf16_t* OUTM = (bf16_t*)(p.ws + WS_P);
    const int tid = otid(), lane = tid & 63, wid = tid >> 6, wr = wid >> 1, wc = wid & 1, fr = lane & 15, fq = lane >> 4;
    const int ntiles = s_tpre[NEXP];
    constexpr int nNT = D / BN;
    int mine = 0;
    for (int it = 0;; ++it, ++mine) {
        int tg, nt;
        if (!xcd_unit(it, ntiles, nNT, tg, nt, smem)) break;
        int e = 0;
        while (s_tpre[e + 1] <= tg) ++e;
        const int mt = tg - s_tpre[e], cnt = s_cnt[e], base = s_base[e];
        const bf16_t* w2 = (const bf16_t*)(p.ws + WS_W2) + ((size_t)l * NEXP + e) * FF * D;
        f32x4 acc[MOE_WM][4];
        auto arow = [&](int i) { int s = mt * MOE_BM + i; s = s < cnt ? s : cnt - 1; return (unsigned)((base + s) * FF); };
        gemm_tile_dma<MOE_WM>(HM, arow, w2 + nt * BN, D, FF, smem, acc);
#pragma unroll
        for (int m = 0; m < MOE_WM; ++m) {
            const int s = mt * MOE_BM + wr * (16 * MOE_WM) + m * 16 + fr;
            if (s < cnt) {
#pragma unroll
                for (int n = 0; n < 4; ++n) {
                    u32x2 pk; pk.x = pk2(acc[m][n][0], acc[m][n][1]); pk.y = pk2(acc[m][n][2], acc[m][n][3]);
                    *(u32x2*)(OUTM + (size_t)(base + s) * D + nt * BN + wc * 64 + n * 16 + fq * 4) = pk;
                }
            }
        }
    }
    if (l + 1 < 2) { const int idle = xcd_max_units(ntiles, nNT) - mine; if (idle > 0) conv_some(p, l + 1, 3 * idle, smem); }
}

#define XB_TMO      128
#define XB_XCNT(j)  (256  + 64 * (j))
#define XB_XSUB(j)  (1280 + 64 * (j))
#define XB_XGEN(j)  (2304 + 64 * (j))
#define XB_TOP      3328
#define XB_TOPGEN   3392
#define XCD_BAR_WORDS 3456
#define XB_SPIN_CAP (1u << 22)
#define LAS __attribute__((address_space(3)))
__device__ __forceinline__ unsigned xb_ld(unsigned* p)              { return __hip_atomic_load(p, __ATOMIC_RELAXED, __HIP_MEMORY_SCOPE_AGENT); }
__device__ __forceinline__ unsigned xb_add(unsigned* p, unsigned v) { return __hip_atomic_fetch_add(p, v, __ATOMIC_RELAXED, __HIP_MEMORY_SCOPE_AGENT); }
__device__ __forceinline__ unsigned xb_xcc_id() { return (unsigned)__builtin_amdgcn_s_getreg((3 << 11) | 20) & 0xFu; }
#define XB_SPIN(cond, bar) do { unsigned _sp = 0; while (cond) { __builtin_amdgcn_s_sleep(1); \
    if ((++_sp & 255u) == 0u) { if (xb_ld(&(bar)[XB_TMO])) break; if (_sp > XB_SPIN_CAP) { atomicAdd(&(bar)[XB_TMO], 1u); break; } } } } while (0)
struct XcdBarrier { unsigned* bar; unsigned x; volatile unsigned* st; };
__device__ __forceinline__ XcdBarrier xcd_barrier_post(unsigned* bar, volatile unsigned* st, volatile int* xinfo) {
    XcdBarrier b; b.bar = bar; b.x = xb_xcc_id(); b.st = st;
    if (threadIdx.x == 0) { const unsigned r = xb_add(&bar[XB_XCNT(b.x)], 1u); xinfo[0] = 0; xinfo[1] = (int)b.x; xinfo[2] = (int)r; xinfo[3] = 0; }
    return b;
}
__device__ __forceinline__ void xcd_barrier_complete(unsigned* bar, unsigned x, unsigned& nloc, unsigned& nx) {
    const unsigned G = gridDim.x * gridDim.y * gridDim.z;
    unsigned sum, cnt, mine, sp = 0u;
    for (;;) {
        sum = 0u; cnt = 0u; mine = 0u;
#pragma unroll
        for (unsigned j = 0; j < 16; ++j) { const unsigned c = xb_ld(&bar[XB_XCNT(j)]); sum += c; cnt += (c > 0u) ? 1u : 0u; mine = (j == x) ? c : mine; }
        if (sum == G) break;
        __builtin_amdgcn_s_sleep(1);
        if ((++sp & 255u) == 0u) { if (xb_ld(&bar[XB_TMO])) break; if (sp > XB_SPIN_CAP) { atomicAdd(&bar[XB_TMO], 1u); break; } }
    }
    nloc = mine > 0u ? mine : 1u; nx = cnt > 0u ? cnt : 1u;
}
__device__ __forceinline__ void xcd_barrier(const XcdBarrier& b) {
    asm volatile("s_waitcnt vmcnt(0)" ::: "memory");
    __syncthreads();
    if (threadIdx.x == 0) {
        unsigned* bar = b.bar;
        __builtin_amdgcn_s_waitcnt(0);
        unsigned nloc = b.st[0], nx = b.st[1];
        if (nloc == 0u) { xcd_barrier_complete(bar, b.x, nloc, nx); b.st[0] = nloc; b.st[1] = nx; }
        const unsigned old = xb_add(&bar[XB_XSUB(b.x)], 1u);
        const unsigned gen = old / nloc;
        if (old + 1u == (gen + 1u) * nloc) {
            __builtin_amdgcn_fence(__ATOMIC_RELEASE, "agent");
            asm volatile("s_waitcnt vmcnt(0)" ::: "memory");
            const unsigned og = xb_add(&bar[XB_TOP], 1u);
            const unsigned tg = og / nx;
            if (og + 1u == (tg + 1u) * nx) xb_add(&bar[XB_TOPGEN], 1u);
            else XB_SPIN(xb_ld(&bar[XB_TOPGEN]) == tg, bar);
            __builtin_amdgcn_fence(__ATOMIC_ACQUIRE, "agent");
            xb_add(&bar[XB_XGEN(b.x)], 1u);
            asm volatile("s_waitcnt vmcnt(0)" ::: "memory");
        } else {
            XB_SPIN(xb_ld(&bar[XB_XGEN(b.x)]) == gen, bar);
            __builtin_amdgcn_fence(__ATOMIC_ACQUIRE, "agent");
            asm volatile("s_waitcnt vmcnt(0)" ::: "memory");
        }
    }
    __syncthreads();
}

constexpr int NPHASES = 16;
#ifndef PROBE_S
#define PROBE_S -1
#define PROBE_REPS 1
#endif
constexpr int SMEM_BYTES = 4 * 64 * LDT * 2 + 4 * 64 * LDT * 2 + 1024;
__global__ void __launch_bounds__(NTHREADS, 2) mega(Params p) {
    __shared__ __attribute__((aligned(16))) unsigned char smem[SMEM_BYTES];
    cg::grid_group grid = cg::this_grid();
    {
        volatile unsigned* st = (volatile unsigned*)(smem + 73728 + 768);
        if (threadIdx.x < 2) st[threadIdx.x] = 0u;
        __syncthreads();
        volatile int* xinfo = (volatile int*)(smem + 73728 + 800);
        (void)xcd_barrier_post((unsigned*)(p.ws + WS_CTL) + 4096, st, xinfo);
    }
#define GRID_BAR() do { XcdBarrier bar_; bar_.bar = (unsigned*)(p.ws + WS_CTL) + 4096; bar_.x = xb_xcc_id(); bar_.st = (volatile unsigned*)(smem + 73728 + 768); xcd_barrier(bar_); } while (0)
    for (int ph = p.ph_lo; ph < p.ph_hi; ++ph) {
        if (ph == 0) phase_init(p, smem);
        else if (ph == NPHASES - 1) phase_final(p, 1);
        else {
            const int l = (ph - 1) / 7, s = (ph - 1) % 7;
            const int reps = (s == PROBE_S) ? PROBE_REPS : 1;
            for (int rep = 0; rep < reps; ++rep) {
                switch (s) {
                    case 0: phase_prep(p, l); break;
                    case 1: phase_gemm_in(p, l, smem); break;
                    case 2: phase_mix1(p, l, smem, rep); break;
                    case 3: phase_out(p, l, smem); break;
                    case 4: phase_route(p, l, smem); break;
                    case 5: phase_moe1(p, l, smem); break;
                    default: phase_moe2(p, l, smem); break;
                }
                if (rep + 1 < reps) GRID_BAR();
            }
        }
        if (ph + 1 < p.ph_hi) {
            if (ph == 0) {
                if (p.ph_hi < 0) grid.sync();
                GRID_BAR();
                if (threadIdx.x == 0) {
                    unsigned* bw = (unsigned*)(p.ws + WS_CTL) + 4096;
                    volatile int* xi = (volatile int*)(smem + 73728 + 800);
                    const unsigned myx = xb_xcc_id();
                    unsigned sum = 0, ok = 1;
                    for (int j = 0; j < 8; ++j) { const unsigned c = xb_ld(&bw[XB_XCNT(j)]); sum += c; ok &= (c > 0u); }
                    xi[3] = (int)xb_ld(&bw[XB_XCNT(myx & 7u)]);
                    xi[0] = (ok && sum == gridDim.x && myx < 8u) ? 1 : 0;
                }
                __syncthreads();
            } else GRID_BAR();
        }
    }
}

extern "C" void kernel_launch(void* const* d_in, const int* in_sizes, int n_in, void* d_out, int out_size, void* d_ws, size_t ws_size, hipStream_t stream) {
    static int grid_blocks = 0;
    if (grid_blocks == 0) {
        if (n_in != 23 || out_size != RL * D || ws_size < WS_END) { fprintf(stderr, "kernel_launch: unexpected shapes (n_in %d out %d ws %zu need %zu)\n", n_in, out_size, ws_size, (size_t)WS_END); grid_blocks = -1; return; }
        int dev = 0, cus = 0, per_cu = 0;
        hipGetDevice(&dev);
        hipDeviceGetAttribute(&cus, hipDeviceAttributeMultiprocessorCount, dev);
        hipOccupancyMaxActiveBlocksPerMultiprocessor(&per_cu, mega, NTHREADS, 0);
        if (per_cu > 2) per_cu = 2;
        if (per_cu < 1) per_cu = 1;
        grid_blocks = cus * per_cu;
    }
    if (grid_blocks < 0) return;
    hipMemsetAsync((char*)d_ws + WS_CTL, 0, 1 * MiB, stream);
    Params p{};
    for (int i = 0; i < 23; ++i) p.in[i] = (const float*)d_in[i];
    p.out = (float*)d_out; p.ws = (unsigned char*)d_ws; p.ph_lo = 0; p.ph_hi = NPHASES;
    void* args[] = {&p};
    hipError_t e = hipLaunchCooperativeKernel((void*)mega, dim3(grid_blocks), dim3(NTHREADS), args, 0, stream);
    if (e != hipSuccess) fprintf(stderr, "cooperative launch failed: %s (grid %d)\n", hipGetErrorString(e), grid_blocks);
}
```

```cpp
#include <hip/hip_runtime.h>
#include <hip/hip_cooperative_groups.h>
#include <cstdio>
#include <cstdint>
namespace cg = cooperative_groups;

constexpr int D = 1024, NB = 8, T = 2048, TC = 256;
constexpr int RL = NB * T, RC = NB * TC, R = RL + RC;
constexpr int INW = 2560, LFW = 512;
constexpr int OFF_B = 512, OFF_KV = 1024, OFF_V = 1152, OFF_C = 1280, OFF_ZF = 1536, OFF_ZB = 1792, OFF_HV = 2048, OFF_G = 2304;
constexpr int NEXP = 32, FF = 512;
constexpr float EPS = 1e-6f;
constexpr int NTHREADS = 256;

constexpr size_t MiB = 1ull << 20;
constexpr size_t WS_CTL = 0;
constexpr size_t WS_TAB = 1 * MiB;
constexpr size_t WS_H = 2 * MiB;
constexpr size_t WS_P = WS_H + 36 * MiB;
constexpr size_t WS_LF = WS_P + 90 * MiB;
constexpr size_t WS_Y = WS_LF + 36 * MiB;
constexpr size_t WS_X1 = WS_Y + 36 * MiB;
constexpr size_t WS_X2 = WS_X1;
constexpr size_t WS_OFB = WS_X1 + 72 * MiB;
constexpr size_t WS_RT = WS_OFB + 18 * MiB;
constexpr size_t WS_WIN = WS_RT + 4 * MiB;
constexpr size_t WS_WOUT = WS_WIN + 10 * MiB;
constexpr size_t WS_WR = WS_WOUT + 4 * MiB;
constexpr size_t WS_W13 = WS_WR + 1 * MiB;
constexpr size_t WS_W2 = WS_W13 + 128 * MiB;
constexpr size_t WS_END = WS_W2 + 64 * MiB;
constexpr int TAB_ROPE = 0;
constexpr int TAB_LB = 2048;
constexpr int TAB_MOD = 4096;

typedef unsigned short bf16_t;
typedef short bf16x8 __attribute__((ext_vector_type(8)));
typedef float f32x4 __attribute__((ext_vector_type(4)));
typedef float f32x2 __attribute__((ext_vector_type(2)));
typedef unsigned u32x4 __attribute__((ext_vector_type(4)));
typedef unsigned u32x2 __attribute__((ext_vector_type(2)));
typedef __bf16 bf16x2_t __attribute__((ext_vector_type(2)));

struct Params {
    const float* in[23];
    float* out;
    unsigned char* ws;
    int ph_lo, ph_hi;
};

__device__ __forceinline__ unsigned pk2(float lo, float hi) { f32x2 v = {lo, hi}; bf16x2_t b = __builtin_convertvector(v, bf16x2_t); return __builtin_bit_cast(unsigned, b); }
__device__ __forceinline__ bf16_t f2bf(float f) { return (bf16_t)(pk2(f, 0.f) & 0xffffu); }
__device__ __forceinline__ float bf2f(bf16_t u) { return __uint_as_float(((unsigned)u) << 16); }
__device__ __forceinline__ float bflo(unsigned w) { return __uint_as_float(w << 16); }
__device__ __forceinline__ float bfhi(unsigned w) { return __uint_as_float(w & 0xffff0000u); }
__device__ __forceinline__ float wave_sum(float v) {
#pragma unroll
    for (int o = 1; o < 64; o <<= 1) v += __shfl_xor(v, o);
    return v;
}
__device__ __forceinline__ float sigmoidf_(float x) { return __builtin_amdgcn_rcpf(1.f + __expf(-x)); }
__device__ __forceinline__ float siluf_(float x) { return x * sigmoidf_(x); }
__device__ __forceinline__ float gelu_tanh(float x) {
    const float u = 0.7978845608028654f * (x + 0.044715f * x * x * x);
    return x * __builtin_amdgcn_rcpf(1.f + __expf(-2.f * u));
}
__device__ __forceinline__ int otid() { int t = threadIdx.x; asm volatile("" : "+v"(t)); return t; }
__device__ __forceinline__ int obid() { int t = blockIdx.x; asm volatile("" : "+s"(t)); return t; }
__device__ __forceinline__ int cur_idx(int l, int e) { return 8192 + (l * 32 + e) * 64; }
__device__ __forceinline__ int row_modrow(int row) { return row < RL ? (row >> 11) : 8; }

__device__ void phase_init(const Params& p, unsigned char* smem) {
    float* tab = (float*)(p.ws + WS_TAB);
    const float* c = p.in[1];
    const float* c_ctx = p.in[3];
    const float* w_mod = p.in[4];
    const float* b_mod = p.in[5];
    float* sc = (float*)smem;
    const int tid = otid();
    for (int i = tid; i < 9 * 1024; i += NTHREADS) {
        const int b = i >> 10, k = i & 1023;
        const float v = (b < 8) ? c[b * 1024 + k] : c_ctx[k];
        sc[i] = siluf_(v);
    }
    __syncthreads();
    float* red = (float*)(smem + 36864);
    for (int it = obid(); it < 384; it += gridDim.x) {
        const int l = it / 192, j0 = (it % 192) * 32;
        const int jj = tid & 31, kg = tid >> 5;
        const float* w = w_mod + (size_t)l * 1024 * 6144 + (size_t)(kg * 128) * 6144 + j0 + jj;
        float acc[9];
#pragma unroll
        for (int b = 0; b < 9; ++b) acc[b] = 0.f;
        for (int k0 = 0; k0 < 128; k0 += 8) {
            float wv[8];
#pragma unroll
            for (int i = 0; i < 8; ++i) wv[i] = w[(size_t)(k0 + i) * 6144];
#pragma unroll
            for (int i = 0; i < 8; ++i)
#pragma unroll
                for (int b = 0; b < 9; ++b) acc[b] += sc[b * 1024 + kg * 128 + k0 + i] * wv[i];
        }
#pragma unroll
        for (int b = 0; b < 9; ++b) red[(kg * 9 + b) * 32 + jj] = acc[b];
        __syncthreads();
        for (int o = tid; o < 9 * 32; o += NTHREADS) {
            const int b = o >> 5, j2 = o & 31;
            float sum = 0.f;
#pragma unroll
            for (int g = 0; g < 8; ++g) sum += red[(g * 9 + b) * 32 + j2];
            tab[TAB_MOD + (l * 9 + b) * 6144 + j0 + j2] = sum + b_mod[l * 6144 + j0 + j2];
        }
        __syncthreads();
    }
    {
        const int gtid = obid() * NTHREADS + tid, gsize = gridDim.x * NTHREADS;
        const float* w_in = p.in[7]; const float* w_out = p.in[14];
        bf16_t* WIN = (bf16_t*)(p.ws + WS_WIN); bf16_t* WOUT = (bf16_t*)(p.ws + WS_WOUT); bf16_t* WR = (bf16_t*)(p.ws + WS_WR);
        for (int i = gtid; i < 2 * 1024 * INW / 4; i += gsize) { const f32x4 v = *(const f32x4*)(w_in + (size_t)i * 4); u32x2 o; o.x = pk2(v[0], v[1]); o.y = pk2(v[2], v[3]); *(u32x2*)(WIN + (size_t)i * 4) = o; }
        for (int i = gtid; i < 2 * 1024 * D / 4; i += gsize) { const f32x4 v = *(const f32x4*)(w_out + (size_t)i * 4); u32x2 o; o.x = pk2(v[0], v[1]); o.y = pk2(v[2], v[3]); *(u32x2*)(WOUT + (size_t)i * 4) = o; }
        for (int i = gtid; i < 2 * 48 * 1024; i += gsize) {
            const int k = i & 1023, n = (i >> 10) % 48, l = i / (48 * 1024);
            float v = 0.f;
            if (n < 4) v = p.in[16][((size_t)l * 1024 + k) * 4 + n];
            else if (n < 36) v = p.in[18][((size_t)l * 1024 + k) * 32 + (n - 4)];
            WR[i] = f2bf(v);
        }
    }
    if (obid() == gridDim.x - 1) {
        for (int i = tid; i < 64 * 16; i += NTHREADS) {
            const int pos = i >> 4, f = i & 15;
            const float inv = 1.0f / powf(10000.0f, (float)(2 * f) / 32.0f);
            const float ang = (float)pos * inv;
            tab[TAB_ROPE + i * 2] = cosf(ang);
            tab[TAB_ROPE + i * 2 + 1] = sinf(ang);
        }
        const float* lbl = p.in[12];
        for (int i = tid; i < 512; i += NTHREADS) {
            const float a0 = lbl[i], a1 = lbl[512 + i];
            const float m = fmaxf(a0, a1);
            const float e0 = expf(a0 - m), e1 = expf(a1 - m);
            const float s1 = e1 / (e0 + e1);
            tab[TAB_LB + i] = 0.f;
            tab[TAB_LB + 512 + i] = s1;
        }
    }
}

__device__ void phase_prep(const Params& p, int l) {
    const float* tab = (const float*)(p.ws + WS_TAB);
    bf16_t* H = (bf16_t*)(p.ws + WS_H);
    const int lane = otid() & 63;
    const int gw = obid() * (NTHREADS / 64) + (otid() >> 6), NGW = gridDim.x * (NTHREADS / 64);
    const float* nw = p.in[6] + l * 1024;
    const int* rt = (const int*)(p.ws + WS_RT);
    int basev = 0;
    if (l > 0) {
        const unsigned* ctl = (const unsigned*)(p.ws + WS_CTL);
        const int cnt = (lane < NEXP) ? (int)ctl[cur_idx(l - 1, lane & 31)] : 0;
        int incl = cnt;
#pragma unroll
        for (int o = 1; o < 32; o <<= 1) { const int t = __shfl_up(incl, o); if (lane >= o) incl += t; }
        basev = incl - cnt;
    }
    auto load_row = [&](int row, f32x4 (&v)[4]) {
        if (l == 0) {
            const float* src = row < RL ? p.in[0] + (size_t)row * D : p.in[2] + (size_t)(row - RL) * D;
#pragma unroll
            for (int j = 0; j < 4; ++j) v[j] = *(const f32x4*)(src + 4 * lane + 256 * j);
        } else {
            const int mr = row_modrow(row);
            const float* X1 = (const float*)(p.ws + WS_X1) + (size_t)row * D;
            const int e0 = rt[row * 2], e1 = rt[row * 2 + 1];
            const int s0 = rt[2 * R + row * 2], s1 = rt[2 * R + row * 2 + 1];
            const float g0 = ((const float*)rt)[4 * R + row * 2], g1 = ((const float*)rt)[4 * R + row * 2 + 1];
            const int base0 = __shfl(basev, e0), base1 = __shfl(basev, e1);
            const bf16_t* O0 = (const bf16_t*)(p.ws + WS_P) + (size_t)(base0 + s0) * D;
            const bf16_t* O1 = (const bf16_t*)(p.ws + WS_P) + (size_t)(base1 + s1) * D;
            const float* g2 = tab + TAB_MOD + ((l - 1) * 9 + mr) * 6144 + 5 * 1024;
            float* X2 = (float*)(p.ws + WS_X2) + (size_t)row * D;
#pragma unroll
            for (int j = 0; j < 4; ++j) {
                const int k = 4 * lane + 256 * j;
                const f32x4 x1 = *(const f32x4*)(X1 + k);
                const u32x2 a = *(const u32x2*)(O0 + k), b = *(const u32x2*)(O1 + k);
                const f32x4 gg = *(const f32x4*)(g2 + k);
                f32x4 m;
                m.x = g0 * bflo(a.x) + g1 * bflo(b.x); m.y = g0 * bfhi(a.x) + g1 * bfhi(b.x);
                m.z = g0 * bflo(a.y) + g1 * bflo(b.y); m.w = g0 * bfhi(a.y) + g1 * bfhi(b.y);
                v[j] = x1 + gg * m;
                *(f32x4*)(X2 + k) = v[j];
            }
        }
    };
    const int per = (R + NGW - 1) / NGW;
    const int rbeg = gw * per, rend = (rbeg + per < R) ? rbeg + per : R;
    int cur_mr = -1;
    f32x4 ma[4], mb[4];
    auto store_row = [&](int row, const f32x4 (&v)[4], float ss) {
        const float rstd = rsqrtf(ss * (1.f / D) + EPS);
#pragma unroll
        for (int j = 0; j < 4; ++j) {
            const f32x4 o = v[j] * rstd * ma[j] + mb[j];
            u32x2 pk; pk.x = pk2(o.x, o.y); pk.y = pk2(o.z, o.w);
            *(u32x2*)(H + (size_t)row * D + 4 * lane + 256 * j) = pk;
        }
    };
    for (int row = rbeg; row < rend; row += 3) {
        const int r1 = row + 1, r2 = row + 2;
        const bool h1 = r1 < rend, h2 = r2 < rend;
        f32x4 v0[4], v1[4], v2[4];
        load_row(row, v0);
        if (h1) load_row(r1, v1);
        if (h2) load_row(r2, v2);
        float s0 = 0.f, s1 = 0.f, s2 = 0.f;
#pragma unroll
        for (int j = 0; j < 4; ++j) {
            s0 += (v0[j].x * v0[j].x + v0[j].y * v0[j].y) + (v0[j].z * v0[j].z + v0[j].w * v0[j].w);
            if (h1) s1 += (v1[j].x * v1[j].x + v1[j].y * v1[j].y) + (v1[j].z * v1[j].z + v1[j].w * v1[j].w);
            if (h2) s2 += (v2[j].x * v2[j].x + v2[j].y * v2[j].y) + (v2[j].z * v2[j].z + v2[j].w * v2[j].w);
        }
#pragma unroll
        for (int o = 1; o < 64; o <<= 1) { s0 += __shfl_xor(s0, o); s1 += __shfl_xor(s1, o); s2 += __shfl_xor(s2, o); }
        auto mod_for = [&](int r) {
            const int mr = row_modrow(r);
            if (mr != cur_mr) {
                cur_mr = mr;
                const float* sh = tab + TAB_MOD + (l * 9 + mr) * 6144;
#pragma unroll
                for (int j = 0; j < 4; ++j) { const int k = 4 * lane + 256 * j; ma[j] = *(const f32x4*)(nw + k) * (1.f + *(const f32x4*)(sh + 1024 + k)); mb[j] = *(const f32x4*)(sh + k); }
            }
        };
        mod_for(row); store_row(row, v0, s0);
        if (h1) { mod_for(r1); store_row(r1, v1, s1); }
        if (h2) { mod_for(r2); store_row(r2, v2, s2); }
    }
}

__device__ void phase_final(const Params& p, int l) {
    const float* tab = (const float*)(p.ws + WS_TAB);
    const int lane = otid() & 63;
    const int gw = obid() * (NTHREADS / 64) + (otid() >> 6), NGW = gridDim.x * (NTHREADS / 64);
    const int* rt = (const int*)(p.ws + WS_RT);
    const unsigned* ctl = (const unsigned*)(p.ws + WS_CTL);
    int basev;
    {
        const int cnt = (lane < NEXP) ? (int)ctl[cur_idx(l, lane & 31)] : 0;
        int incl = cnt;
#pragma unroll
        for (int o = 1; o < 32; o <<= 1) { const int t = __shfl_up(incl, o); if (lane >= o) incl += t; }
        basev = incl - cnt;
    }
    for (int row0 = gw; row0 < RL; row0 += 2 * NGW) {
        f32x4 x1[2][4], gg[2][4]; u32x2 oa[2][4], ob[2][4]; float g0[2], g1[2];
#pragma unroll
        for (int q = 0; q < 2; ++q) {
            const int row = row0 + q * NGW;
            if (row < RL) {
                const int mr = row >> 11;
                const float* X1 = (const float*)(p.ws + WS_X1) + (size_t)row * D;
                const int e0 = rt[row * 2], e1 = rt[row * 2 + 1];
                const int s0 = rt[2 * R + row * 2], s1 = rt[2 * R + row * 2 + 1];
                g0[q] = ((const float*)rt)[4 * R + row * 2]; g1[q] = ((const float*)rt)[4 * R + row * 2 + 1];
                const int base0 = __shfl(basev, e0), base1 = __shfl(basev, e1);
                const bf16_t* O0 = (const bf16_t*)(p.ws + WS_P) + (size_t)(base0 + s0) * D;
                const bf16_t* O1 = (const bf16_t*)(p.ws + WS_P) + (size_t)(base1 + s1) * D;
                const float* g2 = tab + TAB_MOD + (l * 9 + mr) * 6144 + 5 * 1024;
#pragma unroll
                for (int j = 0; j < 4; ++j) {
                    const int k = 4 * lane + 256 * j;
                    x1[q][j] = *(const f32x4*)(X1 + k); oa[q][j] = *(const u32x2*)(O0 + k); ob[q][j] = *(const u32x2*)(O1 + k); gg[q][j] = *(const f32x4*)(g2 + k);
                }
            }
        }
#pragma unroll
        for (int q = 0; q < 2; ++q) {
            const int row = row0 + q * NGW;
            if (row < RL) {
                float* O = p.out + (size_t)row * D;
#pragma unroll
                for (int j = 0; j < 4; ++j) {
                    const u32x2 a = oa[q][j], b = ob[q][j];
                    f32x4 m;
                    m.x = g0[q] * bflo(a.x) + g1[q] * bflo(b.x); m.y = g0[q] * bfhi(a.x) + g1[q] * bfhi(b.x);
                    m.z = g0[q] * bflo(a.y) + g1[q] * bflo(b.y); m.w = g0[q] * bfhi(a.y) + g1[q] * bfhi(b.y);
                    *(f32x4*)(O + 4 * lane + 256 * j) = x1[q][j] + gg[q][j] * m;
                }
            }
        }
    }
}

constexpr int BN = 128;
constexpr int LDT = 64 + 8;
typedef short v4i16_t __attribute__((ext_vector_type(4)));
typedef __attribute__((address_space(3))) v4i16_t* lds_v4i16_ptr;
__device__ __forceinline__ v4i16_t lds_tr16(const bf16_t* p) { return __builtin_amdgcn_ds_read_tr16_b64_v4i16((lds_v4i16_ptr)(p)); }

template <int N> __device__ __forceinline__ void wait_vm() {
    if constexpr (N == 0) asm volatile("s_waitcnt vmcnt(0)" ::: "memory");
    else if constexpr (N == 3) asm volatile("s_waitcnt vmcnt(3)" ::: "memory");
    else if constexpr (N == 4) asm volatile("s_waitcnt vmcnt(4)" ::: "memory");
    else if constexpr (N == 5) asm volatile("s_waitcnt vmcnt(5)" ::: "memory");
    else if constexpr (N == 6) asm volatile("s_waitcnt vmcnt(6)" ::: "memory");
    else static_assert(N < 0, "wait_vm");
}
#define RAW_BARRIER() do { asm volatile("s_waitcnt lgkmcnt(0)" ::: "memory"); __builtin_amdgcn_s_barrier(); } while (0)
__device__ __forceinline__ void glds16(const void* gsrc, unsigned lds_dst) {
    unsigned keep;
    asm volatile("s_mov_b32 %0, m0\n\ts_mov_b32 m0, %2\n\ts_nop 0\n\tglobal_load_lds_dwordx4 %1, off\n\ts_mov_b32 m0, %0" : "=&s"(keep) : "v"(gsrc), "s"(lds_dst) : "memory");
}
template <int WM, class AF>
__device__ __forceinline__ void gemm_tile_dma(const bf16_t* Abase, const AF& arow, const bf16_t* Btile, int ldb, int K, unsigned char* smem, f32x4 (&acc)[WM][4]) {
    constexpr int A_BYTES = 32 * WM * 64, B_BYTES = 8192, STAGE = A_BYTES + B_BYTES;
    constexpr int AI = WM / 2, NI = AI + 2;
    static_assert(WM % 2 == 0 && 3 * STAGE <= 73728, "gemm_tile_dma");
    const int tid = otid(), lane = tid & 63, wid = tid >> 6, wr = wid >> 1, wc = wid & 1, fr = lane & 15, fq = lane >> 4;
    unsigned aoff[AI], boff[2];
#pragma unroll
    for (int i = 0; i < AI; ++i) {
        const int r = 16 * (i * 4 + wid) + (lane >> 2);
        const int c = (lane & 3) ^ (((r >> 3) & 1) << 1);
        aoff[i] = arow(r) + 8 * c;
    }
#pragma unroll
    for (int i = 0; i < 2; ++i) {
        const int kr = 4 * (i * 4 + wid) + (lane >> 4), jp = lane & 15;
        const int g = (jp >> 1) ^ ((kr & 3) | (((kr >> 3) & 1) << 2));
        boff[i] = (unsigned)(kr * ldb + (g * 2 + (jp & 1)) * 8);
    }
#pragma unroll
    for (int m = 0; m < WM; ++m)
#pragma unroll
        for (int n = 0; n < 4; ++n) acc[m][n] = (f32x4){0.f, 0.f, 0.f, 0.f};
    const int nk = K / 32;
    const unsigned lds0 = (unsigned)(uintptr_t)smem;
    const unsigned wbase = (unsigned)__builtin_amdgcn_readfirstlane((int)(lds0 + (unsigned)wid * 1024u));
    auto dma = [&](int kt, int st) {
        const unsigned sa = wbase + (unsigned)(st * STAGE);
#pragma unroll
        for (int i = 0; i < AI; ++i) glds16(Abase + (aoff[i] + kt * 32), (unsigned)__builtin_amdgcn_readfirstlane((int)(sa + i * 4096)));
#pragma unroll
        for (int i = 0; i < 2; ++i) glds16(Btile + (boff[i] + (unsigned)(kt * 32 * ldb)), (unsigned)__builtin_amdgcn_readfirstlane((int)(sa + A_BYTES + i * 4096)));
    };
    const int a_lane = (wr * (16 * WM) + fr) * 64 + 16 * (fq ^ (((fr >> 3) & 1) << 1));
    const int fBl = (fr >> 2) | ((fq & 1) << 2);
    const int b_lane = A_BYTES + (fq * 8 + (fr >> 2)) * 256 + 8 * (fr & 3);
    bf16x8 bfr[4], af[WM];
    auto load_frags = [&](int st) {
        const unsigned char* sb = smem + st * STAGE;
#pragma unroll
        for (int n = 0; n < 4; ++n) {
            const bf16_t* bp = (const bf16_t*)(sb + b_lane + 32 * ((wc * 4 + n) ^ fBl));
            const v4i16_t lo = lds_tr16(bp), hi = lds_tr16(bp + 512);
            bfr[n] = (bf16x8){lo[0], lo[1], lo[2], lo[3], hi[0], hi[1], hi[2], hi[3]};
        }
#pragma unroll
        for (int m = 0; m < WM; ++m) af[m] = *(const bf16x8*)(sb + a_lane + m * 1024);
    };
    auto mfmas = [&]() {
        __builtin_amdgcn_s_setprio(1);
#pragma unroll
        for (int m = 0; m < WM; ++m)
#pragma unroll
            for (int n = 0; n < 4; ++n) acc[m][n] = __builtin_amdgcn_mfma_f32_16x16x32_bf16(bfr[n], af[m], acc[m][n], 0, 0, 0);
        __builtin_amdgcn_s_setprio(0);
    };
    dma(0, 0); dma(1, 1);
    int st = 0, st2 = 2;
#pragma unroll 1
    for (int kt = 0; kt < nk - 1; ++kt) {
        wait_vm<NI>();
        RAW_BARRIER();
        load_frags(st);
        if (kt + 2 < nk) dma(kt + 2, st2);
        mfmas();
        st = (st == 2) ? 0 : st + 1; st2 = (st2 == 2) ? 0 : st2 + 1;
    }
    wait_vm<0>();
    RAW_BARRIER();
    load_frags(st);
    mfmas();
    RAW_BARRIER();
}

__device__ __forceinline__ void conv_some(const Params& p, int l, int maxn, unsigned char* smem);
__device__ __forceinline__ int xcd_max_units(int nMT, int nNT);
__device__ __forceinline__ bool xcd_unit(int it, int nMT, int nNT, int& mt, int& nt, const unsigned char* smem) {
    const volatile int* xinfo = (const volatile int*)(smem + 73728 + 800);
    const int G = gridDim.x, b = obid();
    if (xinfo[0]) {
        const int x = xinfo[1], rank = xinfo[2], cntx = xinfo[3];
        const int start = (x * nMT) >> 3, per = (((x + 1) * nMT) >> 3) - start;
        const int q = rank + it * cntx;
        if (q >= per * nNT) return false;
        mt = start + q % per; nt = q / per;
        return true;
    }
    const int u = b + it * G;
    if (u >= nMT * nNT) return false;
    mt = u / nNT; nt = u % nNT;
    return true;
}

__device__ __forceinline__ void epi_in_row(const f32x4 (&a)[4], int row, int cw, int fq, const float* tab, const f32x4 (&cv)[4], bf16_t* P, float* LF) {
    float v[4][4];
#pragma unroll
    for (int n = 0; n < 4; ++n)
#pragma unroll
        for (int j = 0; j < 4; ++j) v[n][j] = a[n][j];
    if (cw >= OFF_ZF && cw < OFF_HV) {
        const int dir = (cw >= OFF_ZB) ? 1 : 0;
        const int cb = cw - (dir ? OFF_ZB : OFF_ZF);
#pragma unroll
        for (int n = 0; n < 4; ++n) {
            f32x4 o;
#pragma unroll
            for (int j = 0; j < 4; ++j) {
                const float lb = cv[n][j];
                const float sg = sigmoidf_(fmaxf(v[n][j], -80.f));
                o[j] = __logf(lb + (1.f - lb) * sg);
            }
            *(f32x4*)(LF + (size_t)row * LFW + dir * 256 + cb + n * 16 + fq * 4) = o;
        }
        return;
    }
    if (cw < OFF_B) {
#pragma unroll
        for (int n = 0; n < 4; ++n)
#pragma unroll
            for (int j = 0; j < 4; ++j) v[n][j] = gelu_tanh(v[n][j]);
    }
    if ((cw >= 256 && cw < OFF_V)) {
        float ss = 0.f;
#pragma unroll
        for (int n = 0; n < 4; ++n)
#pragma unroll
            for (int j = 0; j < 4; ++j) ss += v[n][j] * v[n][j];
        ss += __shfl_xor(ss, 16); ss += __shfl_xor(ss, 32);
        const float rstd = rsqrtf(ss * (1.f / 64.f) + EPS);
        if (cw < OFF_B) {
#pragma unroll
            for (int n = 0; n < 4; ++n)
#pragma unroll
                for (int j = 0; j < 4; ++j) v[n][j] *= rstd;
        } else {
#pragma unroll
            for (int n = 0; n < 4; ++n)
#pragma unroll
                for (int j = 0; j < 4; ++j) v[n][j] *= rstd * cv[n][j];
            if (row < RL) {
                const int t = row & (T - 1);
#pragma unroll
                for (int ax = 0; ax < 2; ++ax) {
                    const int pos = ax == 0 ? (t >> 6) : (t & 63);
                    const f32x4 cs01 = *(const f32x4*)(tab + TAB_ROPE + (pos * 16 + fq * 4) * 2), cs23 = *(const f32x4*)(tab + TAB_ROPE + (pos * 16 + fq * 4) * 2 + 4);
                    const float csv[4] = {cs01[0], cs01[2], cs23[0], cs23[2]}, snv[4] = {cs01[1], cs01[3], cs23[1], cs23[3]};
#pragma unroll
                    for (int j = 0; j < 4; ++j) {
                        const float cs = csv[j], sn = snv[j];
                        const float x0 = v[2 * ax][j], x1 = v[2 * ax + 1][j];
                        v[2 * ax][j] = x0 * cs - x1 * sn;
                        v[2 * ax + 1][j] = x1 * cs + x0 * sn;
                    }
                }
            }
        }
    }
    if ((cw >= OFF_C && cw < OFF_ZF) || cw >= OFF_G) {
#pragma unroll
        for (int n = 0; n < 4; ++n)
#pragma unroll
            for (int j = 0; j < 4; ++j) v[n][j] = siluf_(v[n][j]);
    }
#pragma unroll
    for (int n = 0; n < 4; ++n) {
        u32x2 pk; pk.x = pk2(v[n][0], v[n][1]); pk.y = pk2(v[n][2], v[n][3]);
        *(u32x2*)(P + (size_t)row * INW + cw + n * 16 + fq * 4) = pk;
    }
}

__device__ void phase_gemm_in(const Params& p, int l, unsigned char* smem) {
    const float* tab = (const float*)(p.ws + WS_TAB);
    const bf16_t* H = (const bf16_t*)(p.ws + WS_H);
    bf16_t* P = (bf16_t*)(p.ws + WS_P);
    float* LF = (float*)(p.ws + WS_LF);
    const bf16_t* W = (const bf16_t*)(p.ws + WS_WIN) + (size_t)l * D * INW;
    const float* qw = p.in[10] + l * 64;
    const float* kw = p.in[11] + l * 64;
    const float* lbt = tab + TAB_LB + l * 512;
    const int tid = otid(), lane = tid & 63, wid = tid >> 6, wr = wid >> 1, wc = wid & 1, fr = lane & 15, fq = lane >> 4;
    constexpr int WM = 6, BMt = 32 * WM;
    const int nMT = R / BMt, nNT = INW / BN;
    int mine = 0;
    for (int it = 0;; ++it, ++mine) {
        int mt, nt;
        if (!xcd_unit(it, nMT, nNT, mt, nt, smem)) break;
        const int row0 = mt * BMt, col0 = nt * BN;
        f32x4 acc[WM][4];
        auto arow = [&](int i) { return (unsigned)((row0 + i) * D); };
        gemm_tile_dma<WM>(H, arow, W + col0, INW, D, smem, acc);
        const int cw = col0 + wc * 64;
        const int rbase = row0 + wr * (16 * WM) + fr;
        f32x4 cv[4];
        {
            const float* csrc = (cw >= OFF_ZF && cw < OFF_HV) ? (lbt + ((cw >= OFF_ZB) ? 256 + cw - OFF_ZB : cw - OFF_ZF)) : ((cw < OFF_KV) ? qw : kw);
#pragma unroll
            for (int n = 0; n < 4; ++n) cv[n] = *(const f32x4*)(csrc + n * 16 + fq * 4);
        }
        epi_in_row(acc[0], rbase, cw, fq, tab, cv, P, LF);
        epi_in_row(acc[1], rbase + 16, cw, fq, tab, cv, P, LF);
        epi_in_row(acc[2], rbase + 32, cw, fq, tab, cv, P, LF);
        epi_in_row(acc[3], rbase + 48, cw, fq, tab, cv, P, LF);
        epi_in_row(acc[4], rbase + 64, cw, fq, tab, cv, P, LF);
        epi_in_row(acc[5], rbase + 80, cw, fq, tab, cv, P, LF);
    }
    { const int idle = xcd_max_units(nMT, nNT) - mine; if (idle > 0) conv_some(p, l, 0 * idle, smem); }
}

__device__ __forceinline__ int next_unit(unsigned* ctr, unsigned char* smem) {
    int* slot = (int*)(smem + 73728 + 512);
    __syncthreads();
    if (otid() == 0) *slot = (int)atomicAdd(ctr, 1u);
    __syncthreads();
    return *slot;
}

constexpr int CONV_ITEMS = 2048, CONV_CHUNKS = NEXP * D * FF / 4 / CONV_ITEMS;
__device__ __forceinline__ void conv_unit(const Params& p, int l, int c) {
    const int tid = otid();
    const size_t lbase = (size_t)l * NEXP * D * FF;
    const float* w1 = p.in[20] + lbase; const float* w3 = p.in[21] + lbase; const float* w2 = p.in[22] + lbase;
    bf16_t* W13 = (bf16_t*)(p.ws + WS_W13) + (size_t)l * NEXP * D * 1024; bf16_t* W2b = (bf16_t*)(p.ws + WS_W2) + lbase;
    const int i0 = c * CONV_ITEMS + tid;
    f32x4 a[8], b[8], d[8];
#pragma unroll
    for (int u = 0; u < 8; ++u) {
        const int i = i0 + u * NTHREADS;
        a[u] = __builtin_nontemporal_load((const f32x4*)(w1 + (size_t)i * 4)); b[u] = __builtin_nontemporal_load((const f32x4*)(w3 + (size_t)i * 4));
        d[u] = __builtin_nontemporal_load((const f32x4*)(w2 + (size_t)i * 4));
    }
#pragma unroll
    for (int u = 0; u < 8; ++u) {
        const int i = i0 + u * NTHREADS;
        const int c4 = (i & 127) * 4, ek = i >> 7;
        const int dc = (c4 >> 6) * 128 + ((c4 >> 5) & 1) * 64 + (c4 & 31);
        u32x2 oa, ob, od; oa.x = pk2(a[u][0], a[u][1]); oa.y = pk2(a[u][2], a[u][3]); ob.x = pk2(b[u][0], b[u][1]); ob.y = pk2(b[u][2], b[u][3]);
        od.x = pk2(d[u][0], d[u][1]); od.y = pk2(d[u][2], d[u][3]);
        *(u32x2*)(W13 + (size_t)ek * 1024 + dc) = oa;
        *(u32x2*)(W13 + (size_t)ek * 1024 + dc + 32) = ob;
        *(u32x2*)(W2b + (size_t)i * 4) = od;
    }
}

__device__ __forceinline__ void conv_some(const Params& p, int l, int maxn, unsigned char* smem) {
    unsigned* ctr = (unsigned*)(p.ws + WS_CTL) + 192 + l;
    for (int n = 0; n < maxn; ++n) {
        const int c = next_unit(ctr, smem);
        if (c >= CONV_CHUNKS) break;
        conv_unit(p, l, c);
    }
}
__device__ __forceinline__ int xcd_max_units(int nMT, int nNT) {
    const int G8 = (gridDim.x >> 3) > 0 ? (gridDim.x >> 3) : 1;
    return (((nMT + 7) >> 3) * nNT + G8 - 1) / G8;
}

constexpr float ATT_C = 0.125f * 1.4426950408889634f;
constexpr int ATT_STAGE = 32768;
constexpr float ATT_THR = 8.0f / ATT_C;
__device__ __forceinline__ void attn_unit(const Params& p, int u, unsigned char* smem) {
    const bf16_t* P = (const bf16_t*)(p.ws + WS_P);
    bf16_t* Y = (bf16_t*)(p.ws + WS_Y);
    const int tid = otid(), lane = tid & 63, wid = tid >> 6, fr = lane & 15, fq = lane >> 4;
    int b, kvh, qrow0, nkt; const bool ctxq = u >= 1024;
    if (!ctxq) { b = u >> 7; kvh = (u >> 6) & 1; qrow0 = b * T + (u & 63) * 32; nkt = 18; }
    else { const int v = u - 1024; b = v >> 4; kvh = (v >> 3) & 1; qrow0 = RL + b * TC + (v & 7) * 32; nkt = 2; }
    const int hh = kvh * 4 + wid;
    bf16x8 qf[2][2];
#pragma unroll
    for (int m = 0; m < 2; ++m)
#pragma unroll
        for (int ks = 0; ks < 2; ++ks) qf[m][ks] = *(const bf16x8*)(P + (size_t)(qrow0 + m * 16 + fr) * INW + OFF_B + hh * 64 + ks * 32 + fq * 8);
    f32x4 o[2][4];
    float mrow[2], lrow[2];
#pragma unroll
    for (int m = 0; m < 2; ++m) { mrow[m] = -1e30f; lrow[m] = 0.f;
#pragma unroll
        for (int n = 0; n < 4; ++n) o[m][n] = (f32x4){0.f, 0.f, 0.f, 0.f}; }
    unsigned koff[4], voff[4];
#pragma unroll
    for (int i = 0; i < 4; ++i) {
        const int r = 8 * (4 * i + wid) + (lane >> 3), cp = lane & 7;
        koff[i] = (unsigned)(r * INW + OFF_KV + kvh * 64 + (cp ^ ((r >> 1) & 7)) * 8);
        voff[i] = (unsigned)(r * INW + OFF_V + kvh * 64 + ((((cp >> 1) ^ ((r >> 1) & 3)) << 1) | (cp & 1)) * 8);
    }
    const unsigned lds0 = (unsigned)(uintptr_t)smem;
    const unsigned wbase = (unsigned)__builtin_amdgcn_readfirstlane((int)(lds0 + (unsigned)wid * 1024u));
    auto dma = [&](int kt, int st) {
        const int base = ctxq ? (RL + b * TC + kt * 128) : (kt < 16 ? (b * T + kt * 128) : (RL + b * TC + (kt - 16) * 128));
        const bf16_t* src = P + (size_t)base * INW;
        const unsigned sa = wbase + (unsigned)(st * ATT_STAGE);
#pragma unroll
        for (int i = 0; i < 4; ++i) {
            glds16(src + koff[i], (unsigned)__builtin_amdgcn_readfirstlane((int)(sa + i * 4096)));
            glds16(src + voff[i], (unsigned)__builtin_amdgcn_readfirstlane((int)(sa + 16384 + i * 4096)));
        }
    };
    const int kq_lane = fr * 128, kq_sw = (fr >> 1) & 7;
    const int hv = ((fq & 1) << 1) | (fr >> 3);
    const int v_lane = (4 * fq + (fr >> 2)) * 128 + 8 * (fr & 3);
    auto compute = [&](int st, int sub) {
        const unsigned char* kb = smem + st * ATT_STAGE + sub * 8192;
        const unsigned char* vb = kb + 16384;
        f32x4 sc[2][4];
        {
            bf16x8 kf[4][2];
#pragma unroll
            for (int n = 0; n < 4; ++n)
#pragma unroll
                for (int ks = 0; ks < 2; ++ks) kf[n][ks] = *(const bf16x8*)(kb + n * 2048 + kq_lane + 16 * ((ks * 4 + fq) ^ kq_sw));
#pragma unroll
            for (int m = 0; m < 2; ++m)
#pragma unroll
                for (int n = 0; n < 4; ++n) {
                    sc[m][n] = (f32x4){0.f, 0.f, 0.f, 0.f};
#pragma unroll
                    for (int ks = 0; ks < 2; ++ks) sc[m][n] = __builtin_amdgcn_mfma_f32_16x16x32_bf16(kf[n][ks], qf[m][ks], sc[m][n], 0, 0, 0);
                }
        }
        bf16x8 vf[4][2];
#pragma unroll
        for (int n = 0; n < 4; ++n)
#pragma unroll
            for (int ks = 0; ks < 2; ++ks) {
                const bf16_t* vp = (const bf16_t*)(vb + ks * 4096 + v_lane + 32 * (n ^ hv));
                const v4i16_t lo = lds_tr16(vp), hi = lds_tr16(vp + 1024);
                vf[n][ks] = (bf16x8){lo[0], lo[1], lo[2], lo[3], hi[0], hi[1], hi[2], hi[3]};
            }
        bf16x8 pf[2][2];
#pragma unroll
        for (int m = 0; m < 2; ++m) {
            float mx = sc[m][0][0];
#pragma unroll
            for (int n = 0; n < 4; ++n)
#pragma unroll
                for (int j = 0; j < 4; ++j) mx = fmaxf(mx, sc[m][n][j]);
            mx = fmaxf(mx, __shfl_xor(mx, 16)); mx = fmaxf(mx, __shfl_xor(mx, 32));
            if (__any(mx - mrow[m] > ATT_THR)) {
                const float mnew = fmaxf(mrow[m], mx);
                const float alpha = __builtin_amdgcn_exp2f((mrow[m] - mnew) * ATT_C);
                mrow[m] = mnew;
                lrow[m] *= alpha;
#pragma unroll
                for (int n = 0; n < 4; ++n) o[m][n] = o[m][n] * alpha;
            }
            const float mc = mrow[m] * ATT_C;
            float ls = 0.f;
#pragma unroll
            for (int n = 0; n < 4; ++n)
#pragma unroll
                for (int j = 0; j < 4; ++j) { sc[m][n][j] = __builtin_amdgcn_exp2f(sc[m][n][j] * ATT_C - mc); ls += sc[m][n][j]; }
            lrow[m] += ls;
#pragma unroll
            for (int ks = 0; ks < 2; ++ks) {
                u32x4 pw;
                pw.x = pk2(sc[m][2 * ks][0], sc[m][2 * ks][1]); pw.y = pk2(sc[m][2 * ks][2], sc[m][2 * ks][3]);
                pw.z = pk2(sc[m][2 * ks + 1][0], sc[m][2 * ks + 1][1]); pw.w = pk2(sc[m][2 * ks + 1][2], sc[m][2 * ks + 1][3]);
                pf[m][ks] = __builtin_bit_cast(bf16x8, pw);
            }
        }
#pragma unroll
        for (int m = 0; m < 2; ++m)
#pragma unroll
            for (int ks = 0; ks < 2; ++ks)
#pragma unroll
                for (int nd = 0; nd < 4; ++nd) o[m][nd] = __builtin_amdgcn_mfma_f32_16x16x32_bf16(vf[nd][ks], pf[m][ks], o[m][nd], 0, 0, 0);
    };
    dma(0, 0);
    wait_vm<0>();
    RAW_BARRIER();
    int st = 0;
#pragma unroll 1
    for (int kt = 0; kt < nkt; ++kt) {
        if (kt + 1 < nkt) dma(kt + 1, st ^ 1);
        compute(st, 0);
        compute(st, 1);
        wait_vm<0>();
        RAW_BARRIER();
        st ^= 1;
    }
#pragma unroll
    for (int m = 0; m < 2; ++m) {
        float lt = lrow[m];
        lt += __shfl_xor(lt, 16); lt += __shfl_xor(lt, 32);
        const float inv = 1.f / lt;
        const size_t row = (size_t)(qrow0 + m * 16 + fr);
#pragma unroll
        for (int nd = 0; nd < 4; ++nd) {
            u32x2 pk; pk.x = pk2(o[m][nd][0] * inv, o[m][nd][1] * inv); pk.y = pk2(o[m][nd][2] * inv, o[m][nd][3] * inv);
            *(u32x2*)(Y + row * D + 256 + hh * 64 + nd * 16 + fq * 4) = pk;
        }
    }
}

constexpr int LDA = 128 + 8;
__device__ __forceinline__ void mixa_unit(const Params& p, int l, int u, unsigned char* smem) {
    const bf16_t* P = (const bf16_t*)(p.ws + WS_P);
    bf16_t* Y = (bf16_t*)(p.ws + WS_Y);
    const int n = u >> 2, h = u & 3;
    const float* W = p.in[8] + ((size_t)l * 4 + h) * 128 * 128;
    const float* bs = p.in[9] + (l * 4 + h) * 128;
    bf16_t* Ws = (bf16_t*)smem;
    bf16_t* Vs = Ws + 128 * LDA;
    const int tid = otid(), lane = tid & 63, wid = tid >> 6, fr = lane & 15, fq = lane >> 4;
#pragma unroll
    for (int i = 0; i < 16; ++i) {
        const int pc = tid + 256 * i, t = pc >> 5, s4 = (pc & 31) * 4;
        const f32x4 w = *(const f32x4*)(W + t * 128 + s4);
        u32x2 o; o.x = pk2(w[0], w[1]); o.y = pk2(w[2], w[3]);
        *(u32x2*)(Ws + t * LDA + s4) = o;
    }
#pragma unroll
    for (int i = 0; i < 2; ++i) {
        const int mb = tid + 256 * i, dg = mb & 15, sg = mb >> 4;
        u32x2 vr[4];
#pragma unroll
        for (int r = 0; r < 4; ++r) vr[r] = *(const u32x2*)(P + (size_t)(n * 128 + 4 * sg + r) * INW + 256 + h * 64 + 4 * dg);
#pragma unroll
        for (int di = 0; di < 4; ++di) {
            const int w = di >> 1;
            u32x2 ov;
            if ((di & 1) == 0) { ov.x = (vr[0][w] & 0xffffu) | (vr[1][w] << 16); ov.y = (vr[2][w] & 0xffffu) | (vr[3][w] << 16); }
            else { ov.x = (vr[0][w] >> 16) | (vr[1][w] & 0xffff0000u); ov.y = (vr[2][w] >> 16) | (vr[3][w] & 0xffff0000u); }
            *(u32x2*)(Vs + (4 * dg + di) * LDA + 4 * sg) = ov;
        }
    }
    __syncthreads();
    f32x4 acc[2][4];
#pragma unroll
    for (int m = 0; m < 2; ++m)
#pragma unroll
        for (int nd = 0; nd < 4; ++nd) acc[m][nd] = (f32x4){0.f, 0.f, 0.f, 0.f};
#pragma unroll
    for (int ks = 0; ks < 4; ++ks) {
        bf16x8 wf[2], vf[4];
#pragma unroll
        for (int m = 0; m < 2; ++m) wf[m] = *(const bf16x8*)(Ws + (32 * wid + 16 * m + fr) * LDA + ks * 32 + fq * 8);
#pragma unroll
        for (int nd = 0; nd < 4; ++nd) vf[nd] = *(const bf16x8*)(Vs + (16 * nd + fr) * LDA + ks * 32 + fq * 8);
#pragma unroll
        for (int m = 0; m < 2; ++m)
#pragma unroll
            for (int nd = 0; nd < 4; ++nd) acc[m][nd] = __builtin_amdgcn_mfma_f32_16x16x32_bf16(vf[nd], wf[m], acc[m][nd], 0, 0, 0);
    }
#pragma unroll
    for (int m = 0; m < 2; ++m) {
        const int t = 32 * wid + 16 * m + fr;
        const size_t row = (size_t)n * 128 + t;
        const float bias = bs[t];
#pragma unroll
        for (int nd = 0; nd < 4; ++nd) {
            const int c = h * 64 + 16 * nd + 4 * fq;
            const u32x2 uu = *(const u32x2*)(P + row * INW + c);
            u32x2 pk;
            pk.x = pk2(bflo(uu.x) * (acc[m][nd][0] + bias), bfhi(uu.x) * (acc[m][nd][1] + bias));
            pk.y = pk2(bflo(uu.y) * (acc[m][nd][2] + bias), bfhi(uu.y) * (acc[m][nd][3] + bias));
            *(u32x2*)(Y + row * D + c) = pk;
        }
    }
}

__device__ __forceinline__ int hg_pos(int I, int ii) { return 32 * (I >> 1) + 4 * (I & 1) + 8 * (ii >> 2) + (ii & 3); }
__device__ __forceinline__ void hgrn_state_unit(const Params& p, int l, int u, unsigned char* smem) {
    const bf16_t* P = (const bf16_t*)(p.ws + WS_P);
    const float* LF = (const float*)(p.ws + WS_LF);
    bf16_t* SST = (bf16_t*)(p.ws + WS_OFB);
    const int b = u >> 3, h = (u >> 1) & 3, dir = u & 1;
    const int tid = otid(), lane = tid & 63, wid = tid >> 6, fr = lane & 15, fq = lane >> 4;
    const int k = lane, I = wid;
    bf16_t* KT = (bf16_t*)smem;
    bf16_t* VT = KT + 64 * LDT;
    float* Tsub = (float*)(VT + 64 * LDT);
    float* Etot = Tsub + 256;
    f32x4 sacc[4];
#pragma unroll
    for (int nk = 0; nk < 4; ++nk) sacc[nk] = (f32x4){0.f, 0.f, 0.f, 0.f};
    float lf[16], vv[16];
    auto mcof = [&](int j) { return dir == 0 ? (j < 4 ? 256 + b * 4 + j : b * 32 + (j - 4)) : (j < 4 ? 256 + b * 4 + (3 - j) : b * 32 + (35 - j)); };
    auto gload = [&](int j) {
        const int mc = mcof(j);
#pragma unroll
        for (int ii = 0; ii < 16; ++ii) {
            const int tau = 16 * I + ii;
            const size_t row = (size_t)mc * 64 + (dir ? 63 - tau : tau);
            lf[ii] = LF[row * LFW + dir * 256 + h * 64 + k];
            vv[ii] = bf2f(P[row * INW + OFF_HV + h * 64 + k]);
        }
    };
    gload(0);
    for (int j = 0; j < 36; ++j) {
        float c[16];
        c[0] = lf[0];
#pragma unroll
        for (int ii = 1; ii < 16; ++ii) c[ii] = c[ii - 1] + lf[ii];
        Tsub[I * 64 + k] = c[15];
        __syncthreads();
        float Rs = 0.f;
#pragma unroll
        for (int M = 1; M < 4; ++M) Rs += (M > I) ? Tsub[M * 64 + k] : 0.f;
        if (I == 0) Etot[k] = __expf(c[15] + Rs);
#pragma unroll
        for (int g = 0; g < 4; ++g) {
            float kh[4];
#pragma unroll
            for (int jj = 0; jj < 4; ++jj) { const int ii = 4 * g + jj; kh[jj] = (1.f - __expf(lf[ii])) * __expf(c[15] - c[ii] + Rs); }
            u32x2 kw; kw.x = pk2(kh[0], kh[1]); kw.y = pk2(kh[2], kh[3]);
            u32x2 vw; vw.x = pk2(vv[4 * g], vv[4 * g + 1]); vw.y = pk2(vv[4 * g + 2], vv[4 * g + 3]);
            const int pos = hg_pos(I, 4 * g);
            *(u32x2*)(KT + k * LDT + pos) = kw;
            *(u32x2*)(VT + k * LDT + pos) = vw;
        }
        const int mc = mcof(j);
        {
            bf16_t* dst = SST + ((size_t)(mc * 4 + h) * 2 + dir) * 4096;
#pragma unroll
            for (int nk = 0; nk < 4; ++nk)
#pragma unroll
                for (int r = 0; r < 4; ++r) dst[(16 * wid + 4 * fq + r) * 64 + 16 * nk + fr] = f2bf(sacc[nk][r]);
        }
        if (j + 1 < 36) gload(j + 1);
        __builtin_amdgcn_sched_barrier(0);
        __syncthreads();
        bf16x8 vf[2];
#pragma unroll
        for (int ks = 0; ks < 2; ++ks) vf[ks] = *(const bf16x8*)(VT + (16 * wid + fr) * LDT + 32 * ks + 8 * fq);
#pragma unroll
        for (int nk = 0; nk < 4; ++nk) {
            const float e = Etot[16 * nk + fr];
            sacc[nk] = sacc[nk] * e;
#pragma unroll
            for (int ks = 0; ks < 2; ++ks) {
                const bf16x8 kf = *(const bf16x8*)(KT + (16 * nk + fr) * LDT + 32 * ks + 8 * fq);
                sacc[nk] = __builtin_amdgcn_mfma_f32_16x16x32_bf16(vf[ks], kf, sacc[nk], 0, 0, 0);
            }
        }
        __syncthreads();
    }
    asm volatile("s_waitcnt vmcnt(0)" ::: "memory");
    __syncthreads();
    if (otid() == 0) {
        __builtin_amdgcn_fence(__ATOMIC_RELEASE, "agent");
        asm volatile("s_waitcnt vmcnt(0)" ::: "memory");
        __hip_atomic_fetch_add((unsigned*)(p.ws + WS_CTL) + 160 + l, 1u, __ATOMIC_RELAXED, __HIP_MEMORY_SCOPE_AGENT);
    }
}


__device__ __forceinline__ void hgrn_out_unit(const Params& p, int l, int u, unsigned char* smem) {
    const bf16_t* P = (const bf16_t*)(p.ws + WS_P);
    const float* LF = (const float*)(p.ws + WS_LF);
    const bf16_t* SST = (const bf16_t*)(p.ws + WS_OFB);
    bf16_t* Y = (bf16_t*)(p.ws + WS_Y);
    const float* hw = p.in[13] + l * 64;
    const int mc = u >> 2, h = u & 3;
    const int tid = otid(), lane = tid & 63, wid = tid >> 6, fr = lane & 15, fq = lane >> 4;
    const int k = lane, I = wid;
    bf16_t* QT0 = (bf16_t*)smem;
    bf16_t* KD = QT0 + 64 * LDT;
    bf16_t* KO = KD + 64 * LDT;
    bf16_t* QS = KO + 64 * LDT;
    bf16_t* QT1 = QS + 64 * LDT;
    bf16_t* QT2 = QT1 + 32 * LDT;
    bf16_t* VT = QT2 + 16 * LDT;
    float* Tsub = (float*)(VT + 64 * LDT);
    float* SSQ = Tsub + 256;
    f32x4 om[4];
#pragma unroll 1
    for (int dd = 0; dd < 2; ++dd) {
        const int dir = 1 - dd;
        float lf[16], c[16];
#pragma unroll
        for (int ii = 0; ii < 16; ++ii) {
            const int tau = 16 * I + ii;
            const size_t row = (size_t)mc * 64 + (dir ? 63 - tau : tau);
            lf[ii] = LF[row * LFW + dir * 256 + h * 64 + k];
        }
        c[0] = lf[0];
#pragma unroll
        for (int ii = 1; ii < 16; ++ii) c[ii] = c[ii - 1] + lf[ii];
        Tsub[I * 64 + k] = c[15];
        __syncthreads();
        const float T0 = Tsub[k], T1 = Tsub[64 + k], T2 = Tsub[128 + k];
        const float pre = (I > 0 ? T0 : 0.f) + (I > 1 ? T1 : 0.f) + (I > 2 ? T2 : 0.f);
        const float epre = __expf(pre);
        const float g1 = __expf(I == 2 ? T1 : T2);
        const float g2 = __expf(T1 + T2);
#pragma unroll
        for (int g = 0; g < 4; ++g) {
            float vq[4];
#pragma unroll
            for (int jj = 0; jj < 4; ++jj) {
                const int ii = 4 * g + jj, tau = 16 * I + ii;
                const size_t row = (size_t)mc * 64 + (dir ? 63 - tau : tau);
                const float q = bf2f(P[row * INW + OFF_C + h * 64 + k]);
                vq[jj] = bf2f(P[row * INW + OFF_HV + h * 64 + k]);
                const float qt = q * __expf(c[ii]);
                const float kk = 1.f - __expf(lf[ii]);
                QT0[tau * LDT + k] = f2bf(qt);
                QS[tau * LDT + k] = f2bf(qt * epre);
                KD[tau * LDT + k] = f2bf(kk * __expf(fminf(-c[ii], 80.f)));
                KO[tau * LDT + k] = f2bf(kk * __expf(c[15] - c[ii]));
                if (I >= 2) QT1[(tau - 32) * LDT + k] = f2bf(qt * g1);
                if (I == 3) QT2[(tau - 48) * LDT + k] = f2bf(qt * g2);
            }
            u32x2 vw; vw.x = pk2(vq[0], vq[1]); vw.y = pk2(vq[2], vq[3]);
            *(u32x2*)(VT + k * LDT + hg_pos(I, 4 * g)) = vw;
        }
        bf16x8 stf[2];
        {
            const bf16_t* src = SST + ((size_t)(mc * 4 + h) * 2 + dir) * 4096 + (16 * wid + fr) * 64 + 8 * fq;
            stf[0] = *(const bf16x8*)(src); stf[1] = *(const bf16x8*)(src + 32);
        }
        __syncthreads();
        bf16x8 vf[2];
#pragma unroll
        for (int ks = 0; ks < 2; ++ks) vf[ks] = *(const bf16x8*)(VT + (16 * wid + fr) * LDT + 32 * ks + 8 * fq);
        f32x4 o[4];
#pragma unroll
        for (int I2 = 0; I2 < 4; ++I2) {
            f32x4 A[4];
#pragma unroll
            for (int J = 0; J < 4; ++J) {
                A[J] = (f32x4){0.f, 0.f, 0.f, 0.f};
                if (J <= I2) {
                    const bf16_t* kbase = (J == I2 ? KD : KO) + (16 * J + fr) * LDT + 8 * fq;
                    const bf16_t* qbase = (I2 - J <= 1) ? (QT0 + (16 * I2 + fr) * LDT) : ((I2 - J == 2) ? (QT1 + (16 * I2 - 32 + fr) * LDT) : (QT2 + fr * LDT));
#pragma unroll
                    for (int ks = 0; ks < 2; ++ks) {
                        const bf16x8 kf = *(const bf16x8*)(kbase + 32 * ks);
                        const bf16x8 qf = *(const bf16x8*)(qbase + 32 * ks + 8 * fq);
                        A[J] = __builtin_amdgcn_mfma_f32_16x16x32_bf16(kf, qf, A[J], 0, 0, 0);
                    }
                    if (J == I2) {
#pragma unroll
                        for (int r = 0; r < 4; ++r) A[J][r] = (4 * fq + r <= fr) ? A[J][r] : 0.f;
                    }
                }
            }
            o[I2] = (f32x4){0.f, 0.f, 0.f, 0.f};
#pragma unroll
            for (int ks = 0; ks < 2; ++ks) {
                if (2 * ks <= I2) {
                    u32x4 pw;
                    pw.x = pk2(A[2 * ks][0], A[2 * ks][1]); pw.y = pk2(A[2 * ks][2], A[2 * ks][3]);
                    pw.z = pk2(A[2 * ks + 1][0], A[2 * ks + 1][1]); pw.w = pk2(A[2 * ks + 1][2], A[2 * ks + 1][3]);
                    o[I2] = __builtin_amdgcn_mfma_f32_16x16x32_bf16(vf[ks], __builtin_bit_cast(bf16x8, pw), o[I2], 0, 0, 0);
                }
                const bf16x8 qsf = *(const bf16x8*)(QS + (16 * I2 + fr) * LDT + 32 * ks + 8 * fq);
                o[I2] = __builtin_amdgcn_mfma_f32_16x16x32_bf16(stf[ks], qsf, o[I2], 0, 0, 0);
            }
        }
        if (dir == 1) {
            const int src = (lane & 48) | (15 - fr);
#pragma unroll
            for (int Im = 0; Im < 4; ++Im)
#pragma unroll
                for (int r = 0; r < 4; ++r) om[Im][r] = __shfl(o[3 - Im][r], src);
        } else {
#pragma unroll
            for (int Im = 0; Im < 4; ++Im) om[Im] = om[Im] + o[Im];
        }
        __syncthreads();
    }
#pragma unroll
    for (int Im = 0; Im < 4; ++Im) {
        float s = om[Im][0] * om[Im][0] + om[Im][1] * om[Im][1] + om[Im][2] * om[Im][2] + om[Im][3] * om[Im][3];
        s += __shfl_xor(s, 16); s += __shfl_xor(s, 32);
        if (fq == 0) SSQ[wid * 64 + 16 * Im + fr] = s;
    }
    __syncthreads();
    const f32x4 wv = *(const f32x4*)(hw + 16 * wid + 4 * fq);
#pragma unroll
    for (int Im = 0; Im < 4; ++Im) {
        const int i = 16 * Im + fr;
        const float tot = SSQ[i] + SSQ[64 + i] + SSQ[128 + i] + SSQ[192 + i];
        const float rstd = rsqrtf(tot * (1.f / 64.f) + EPS);
        const size_t row = (size_t)mc * 64 + i;
        const u32x2 gg = *(const u32x2*)(P + row * INW + OFF_G + h * 64 + 16 * wid + 4 * fq);
        u32x2 pk;
        pk.x = pk2(om[Im][0] * rstd * wv[0] * bflo(gg.x), om[Im][1] * rstd * wv[1] * bfhi(gg.x));
        pk.y = pk2(om[Im][2] * rstd * wv[2] * bflo(gg.y), om[Im][3] * rstd * wv[3] * bfhi(gg.y));
        *(u32x2*)(Y + row * D + 768 + h * 64 + 16 * wid + 4 * fq) = pk;
    }
}

__device__ void phase_mix1(const Params& p, int l, unsigned char* smem, int rep) {
    unsigned* ctr = (unsigned*)(p.ws + WS_CTL) + 128 + l * 2 + rep * 4;
    unsigned* done = (unsigned*)(p.ws + WS_CTL) + 160 + l;
    const int n_attn = (l == 0) ? 1152 : 1024, n_mixa = (l == 0) ? 576 : 512, n_hout = ((l == 0) ? 288 : 256) * 4;
    const int total = 64 + n_attn + n_mixa + n_hout;
    bool acquired = false;
    int* slot = (int*)(smem + 73728 + 512);
    int u = next_unit(ctr, smem);
    while (u < total) {
        int nxt = 0;
        if (u >= 64 && otid() == 0) nxt = (int)atomicAdd(ctr, 1u);
        if (u < 64) { hgrn_state_unit(p, l, u, smem); if (otid() == 0) nxt = (int)atomicAdd(ctr, 1u); }
        else if (u < 64 + n_attn) attn_unit(p, u - 64, smem);
        else if (u < 64 + n_attn + n_mixa) mixa_unit(p, l, u - 64 - n_attn, smem);
        else {
            if (!acquired) {
                if (otid() == 0) {
                    unsigned spins = 0;
                    while (__hip_atomic_load(done, __ATOMIC_RELAXED, __HIP_MEMORY_SCOPE_AGENT) < 64u * (unsigned)(rep + 1)) { __builtin_amdgcn_s_sleep(8); if (++spins > (1u << 24)) break; }
                    __builtin_amdgcn_fence(__ATOMIC_ACQUIRE, "agent");
                    asm volatile("s_waitcnt vmcnt(0)" ::: "memory");
                }
                __syncthreads();
                acquired = true;
            }
            hgrn_out_unit(p, l, u - 64 - n_attn - n_mixa, smem);
        }
        __syncthreads();
        if (otid() == 0) *slot = nxt;
        __syncthreads();
        u = *slot;
    }
}

template <int WM>
__device__ __forceinline__ void phase_out_t(const Params& p, int l, unsigned char* smem) {
    const float* tab = (const float*)(p.ws + WS_TAB);
    const bf16_t* Y = (const bf16_t*)(p.ws + WS_Y);
    float* X1 = (float*)(p.ws + WS_X1);
    const float* X2 = (const float*)(p.ws + WS_X2);
    const bf16_t* W = (const bf16_t*)(p.ws + WS_WOUT) + (size_t)l * D * D;
    const int tid = otid(), lane = tid & 63, wid = tid >> 6, wr = wid >> 1, wc = wid & 1, fr = lane & 15, fq = lane >> 4;
    const int nrows = (l == 0) ? R : RL;
    constexpr int BMt = 32 * WM;
    const int nMT = (nrows + BMt - 1) / BMt, nNT = D / BN;
    int mine = 0;
    for (int it = 0;; ++it, ++mine) {
        int mt, nt;
        if (!xcd_unit(it, nMT, nNT, mt, nt, smem)) break;
        const int row0 = mt * BMt, col0 = nt * BN;
        f32x4 acc[WM][4];
        auto arow = [&](int i) { return (unsigned)((row0 + i) * D); };
        gemm_tile_dma<WM>(Y, arow, W + col0, D, D, smem, acc);
#pragma unroll
        for (int m = 0; m < WM; ++m) {
            const int row = row0 + wr * (16 * WM) + m * 16 + fr;
            const int mr = row_modrow(row);
            const float* g1 = tab + TAB_MOD + (l * 9 + mr) * 6144 + 2 * 1024;
            const float* xin = (l == 0) ? (row < RL ? p.in[0] + (size_t)row * D : p.in[2] + (size_t)(row - RL) * D) : X2 + (size_t)row * D;
#pragma unroll
            for (int n = 0; n < 4; ++n) {
                const int col = col0 + wc * 64 + n * 16 + fq * 4;
                const f32x4 xv = *(const f32x4*)(xin + col), gv = *(const f32x4*)(g1 + col);
                *(f32x4*)(X1 + (size_t)row * D + col) = xv + gv * acc[m][n];
            }
        }
    }
    { const int idle = xcd_max_units(nMT, nNT) - mine; if (idle > 0) conv_some(p, l, 3 * idle, smem); }
}
__device__ void phase_out(const Params& p, int l, unsigned char* smem) {
    if (l == 0) phase_out_t<6>(p, l, smem); else phase_out_t<4>(p, l, smem);
}

__device__ void phase_route(const Params& p, int l, unsigned char* smem) {
    const float* tab = (const float*)(p.ws + WS_TAB);
    bf16_t* H = (bf16_t*)(p.ws + WS_H);
    const float* X1 = (const float*)(p.ws + WS_X1);
    int* rt = (int*)(p.ws + WS_RT);
    unsigned* ctl = (unsigned*)(p.ws + WS_CTL);
    const float* nw = p.in[15] + l * 1024;
    const float* wg = p.in[16] + (size_t)l * 1024 * 4;
    const float* bg = p.in[17] + l * 4;
    const float* we = p.in[18] + (size_t)l * 1024 * 32;
    const float* be = p.in[19] + l * 32;
    const int tid = otid(), lane = tid & 63, wid = tid >> 6, wr = wid >> 1, wc = wid & 1, fr = lane & 15, fq = lane >> 4;
    const int nrows = (l == 0) ? R : RL;
    float* Ls = (float*)smem;
    constexpr int BM = 64;
    for (int u = obid(); u < nrows / BM; u += gridDim.x) {
        const int row0 = u * BM;
        {
            const int mr = row_modrow(row0);
            const float* sh = tab + TAB_MOD + (l * 9 + mr) * 6144 + 3 * 1024;
            const float* scv = sh + 1024;
            f32x4 ma[4], mb[4];
#pragma unroll
            for (int j = 0; j < 4; ++j) {
                const int k = 4 * lane + 256 * j;
                ma[j] = *(const f32x4*)(nw + k) * (1.f + *(const f32x4*)(scv + k)); mb[j] = *(const f32x4*)(sh + k);
            }
#pragma unroll 1
            for (int rb = 0; rb < 4; ++rb) {
                const int rowb = row0 + wid * 16 + rb * 4;
                f32x4 v[4][4];
#pragma unroll
                for (int q = 0; q < 4; ++q)
#pragma unroll
                    for (int j = 0; j < 4; ++j) v[q][j] = *(const f32x4*)(X1 + (size_t)(rowb + q) * D + 4 * lane + 256 * j);
                float ss[4];
#pragma unroll
                for (int q = 0; q < 4; ++q) {
                    ss[q] = 0.f;
#pragma unroll
                    for (int j = 0; j < 4; ++j) ss[q] += (v[q][j].x * v[q][j].x + v[q][j].y * v[q][j].y) + (v[q][j].z * v[q][j].z + v[q][j].w * v[q][j].w);
                }
#pragma unroll
                for (int o = 1; o < 64; o <<= 1) {
#pragma unroll
                    for (int q = 0; q < 4; ++q) ss[q] += __shfl_xor(ss[q], o);
                }
#pragma unroll
                for (int q = 0; q < 4; ++q) {
                    const float rstd = rsqrtf(ss[q] * (1.f / D) + EPS);
#pragma unroll
                    for (int j = 0; j < 4; ++j) {
                        const f32x4 o = v[q][j] * rstd * ma[j] + mb[j];
                        u32x2 pk; pk.x = pk2(o.x, o.y); pk.y = pk2(o.z, o.w);
                        *(u32x2*)(H + (size_t)(rowb + q) * D + 4 * lane + 256 * j) = pk;
                    }
                }
            }
        }
        asm volatile("s_waitcnt vmcnt(0)" ::: "memory");
        __syncthreads();
        {
            const bf16_t* WRl = (const bf16_t*)(p.ws + WS_WR) + (size_t)l * 48 * 1024;
            f32x4 acc[4][3];
#pragma unroll
            for (int m = 0; m < 4; ++m)
#pragma unroll
                for (int n = 0; n < 3; ++n) acc[m][n] = (f32x4){0.f, 0.f, 0.f, 0.f};
            const bf16_t* ap = H + (size_t)(row0 + fr) * D + wid * 256 + fq * 8;
            const bf16_t* bp = WRl + (size_t)fr * 1024 + wid * 256 + fq * 8;
#pragma unroll 1
            for (int kh = 0; kh < 4; ++kh) {
                bf16x8 af[2][4], bf[2][3];
#pragma unroll
                for (int ks = 0; ks < 2; ++ks) {
#pragma unroll
                    for (int m = 0; m < 4; ++m) af[ks][m] = *(const bf16x8*)(ap + (size_t)m * 16 * D + (kh * 2 + ks) * 32);
#pragma unroll
                    for (int n = 0; n < 3; ++n) bf[ks][n] = *(const bf16x8*)(bp + (size_t)n * 16 * 1024 + (kh * 2 + ks) * 32);
                }
#pragma unroll
                for (int ks = 0; ks < 2; ++ks)
#pragma unroll
                    for (int m = 0; m < 4; ++m)
#pragma unroll
                        for (int n = 0; n < 3; ++n) acc[m][n] = __builtin_amdgcn_mfma_f32_16x16x32_bf16(bf[ks][n], af[ks][m], acc[m][n], 0, 0, 0);
            }
            float* Lp = (float*)smem + wid * (64 * 48);
#pragma unroll
            for (int m = 0; m < 4; ++m)
#pragma unroll
                for (int n = 0; n < 3; ++n) *(f32x4*)(Lp + (m * 16 + fr) * 48 + n * 16 + fq * 4) = acc[m][n];
        }
        __syncthreads();
        unsigned* lcnt = (unsigned*)(smem + 49152);
        if (tid < 32) lcnt[tid] = 0u;
        int dec_ea = 0, dec_eb = 0, dec_la = 0, dec_lb = 0; float dec_ga = 0.f, dec_gb = 0.f;
        __syncthreads();
        if (tid < BM) {
            const int row = row0 + tid;
            const float* lp = (const float*)smem + tid * 48;
            float lg[36];
#pragma unroll
            for (int i = 0; i < 36; ++i) lg[i] = (lp[i] + lp[64 * 48 + i]) + (lp[2 * 64 * 48 + i] + lp[3 * 64 * 48 + i]);
            float gl[4];
#pragma unroll
            for (int i = 0; i < 4; ++i) gl[i] = lg[i] + bg[i];
            int grp = 0; float gm = gl[0];
#pragma unroll
            for (int i = 1; i < 4; ++i) if (gl[i] > gm) { gm = gl[i]; grp = i; }
            float gs = 0.f;
#pragma unroll
            for (int i = 0; i < 4; ++i) gs += expf(gl[i] - gm);
            const float pgrp = 1.f / gs;
            float ev[8];
#pragma unroll
            for (int i = 0; i < 8; ++i) {
                float x = lg[4 + i];
#pragma unroll
                for (int g = 1; g < 4; ++g) x = (grp == g) ? lg[4 + g * 8 + i] : x;
                ev[i] = x + be[grp * 8 + i];
            }
            int i0 = 0; float v0 = ev[0];
#pragma unroll
            for (int i = 1; i < 8; ++i) if (ev[i] > v0) { v0 = ev[i]; i0 = i; }
            int i1 = -1; float v1 = -3.0e38f;
#pragma unroll
            for (int i = 0; i < 8; ++i) if (i != i0 && ev[i] > v1) { v1 = ev[i]; i1 = i; }
            const float e1 = expf(v1 - v0);
            const float ga = pgrp / (1.f + e1), gb = pgrp * e1 / (1.f + e1);
            const int ea = grp * 8 + i0, eb = grp * 8 + i1;
            dec_ea = ea; dec_eb = eb; dec_ga = ga; dec_gb = gb;
            dec_la = (int)atomicAdd(&lcnt[ea], 1u);
            dec_lb = (int)atomicAdd(&lcnt[eb], 1u);
        }
        __syncthreads();
        if (tid < 32) { const unsigned c = lcnt[tid]; lcnt[32 + tid] = c ? atomicAdd(&ctl[cur_idx(l, tid)], c) : 0u; }
        __syncthreads();
        if (tid < BM) {
            const int row = row0 + tid;
            const int sa = (int)lcnt[32 + dec_ea] + dec_la, sb = (int)lcnt[32 + dec_eb] + dec_lb;
            rt[row * 2] = dec_ea; rt[row * 2 + 1] = dec_eb;
            rt[2 * R + row * 2] = sa; rt[2 * R + row * 2 + 1] = sb;
            ((float*)rt)[4 * R + row * 2] = dec_ga; ((float*)rt)[4 * R + row * 2 + 1] = dec_gb;
            rt[6 * R + dec_ea * R + sa] = row;
            rt[6 * R + dec_eb * R + sb] = row;
        }
        __syncthreads();
    }
    conv_some(p, l, 1 << 30, smem);
}

constexpr int MOE_WM = 6, MOE_BM = 32 * MOE_WM;
__device__ __forceinline__ void moe_units(const Params& p, int l, int* s_cnt, int* s_base, int* s_tpre) {
    const unsigned* ctl = (const unsigned*)(p.ws + WS_CTL);
    if (otid() == 0) {
        int base = 0, tp = 0;
        for (int e = 0; e < NEXP; ++e) {
            const int c = (int)ctl[cur_idx(l, e)];
            s_cnt[e] = c; s_base[e] = base; s_tpre[e] = tp;
            base += c; tp += (c + MOE_BM - 1) / MOE_BM;
        }
        s_tpre[NEXP] = tp;
    }
    __syncthreads();
}

__device__ void phase_moe1(const Params& p, int l, unsigned char* smem) {
    int* s_cnt = (int*)(smem + 73728);
    int* s_base = s_cnt + 32;
    int* s_tpre = s_base + 32;
    moe_units(p, l, s_cnt, s_base, s_tpre);
    const bf16_t* H = (const bf16_t*)(p.ws + WS_H);
    bf16_t* HM = (bf16_t*)(p.ws + WS_LF);
    const int* list = (const int*)(p.ws + WS_RT) + 6 * R;
    const int tid = otid(), lane = tid & 63, wid = tid >> 6, wr = wid >> 1, wc = wid & 1, fr = lane & 15, fq = lane >> 4;
    const int ntiles = s_tpre[NEXP];
    constexpr int nNT = FF / 64;
    int mine = 0;
    for (int it = 0;; ++it, ++mine) {
        int tg, nt;
        if (!xcd_unit(it, ntiles, nNT, tg, nt, smem)) break;
        int e = 0;
        while (s_tpre[e + 1] <= tg) ++e;
        const int mt = tg - s_tpre[e], cnt = s_cnt[e], base = s_base[e];
        const bf16_t* w13 = (const bf16_t*)(p.ws + WS_W13) + ((size_t)l * NEXP + e) * D * 1024;
        const int* lst = list + (size_t)e * R;
        f32x4 acc[MOE_WM][4];
        auto arow = [&](int i) { int s = mt * MOE_BM + i; s = s < cnt ? s : cnt - 1; return (unsigned)(lst[s] * D); };
        gemm_tile_dma<MOE_WM>(H, arow, w13 + nt * 128, 1024, D, smem, acc);
#pragma unroll
        for (int m = 0; m < MOE_WM; ++m) {
            const int s = mt * MOE_BM + wr * (16 * MOE_WM) + m * 16 + fr;
            if (s < cnt) {
#pragma unroll
                for (int n = 0; n < 2; ++n) {
                    float hv[4];
#pragma unroll
                    for (int j = 0; j < 4; ++j) hv[j] = siluf_(acc[m][n][j]) * acc[m][n + 2][j];
                    u32x2 pk; pk.x = pk2(hv[0], hv[1]); pk.y = pk2(hv[2], hv[3]);
                    *(u32x2*)(HM + (size_t)(base + s) * FF + nt * 64 + wc * 32 + n * 16 + fq * 4) = pk;
                }
            }
        }
    }
    if (l + 1 < 2) { const int idle = xcd_max_units(ntiles, nNT) - mine; if (idle > 0) conv_some(p, l + 1, 3 * idle, smem); }
}

__device__ void phase_moe2(const Params& p, int l, unsigned char* smem) {
    int* s_cnt = (int*)(smem + 73728);
    int* s_base = s_cnt + 32;
    int* s_tpre = s_base + 32;
    moe_units(p, l, s_cnt, s_base, s_tpre);
    const bf16_t* HM = (const bf16_t*)(p.ws + WS_LF);
    bf16_t* OUTM = (bf16_t*)(p.ws + WS_P);
    const int tid = otid(), lane = tid & 63, wid = tid >> 6, wr = wid >> 1, wc = wid & 1, fr = lane & 15, fq = lane >> 4;
    const int ntiles = s_tpre[NEXP];
    constexpr int nNT = D / BN;
    int mine = 0;
    for (int it = 0;; ++it, ++mine) {
        int tg, nt;
        if (!xcd_unit(it, ntiles, nNT, tg, nt, smem)) break;
        int e = 0;
        while (s_tpre[e + 1] <= tg) ++e;
        const int mt = tg - s_tpre[e], cnt = s_cnt[e], base = s_base[e];
        const bf16_t* w2 = (const bf16_t*)(p.ws + WS_W2) + ((size_t)l * NEXP + e) * FF * D;
        f32x4 acc[MOE_WM][4];
        auto arow = [&](int i) { int s = mt * MOE_BM + i; s = s < cnt ? s : cnt - 1; return (unsigned)((base + s) * FF); };
        gemm_tile_dma<MOE_WM>(HM, arow, w2 + nt * BN, D, FF, smem, acc);
#pragma unroll
        for (int m = 0; m < MOE_WM; ++m) {
            const int s = mt * MOE_BM + wr * (16 * MOE_WM) + m * 16 + fr;
            if (s < cnt) {
#pragma unroll
                for (int n = 0; n < 4; ++n) {
                    u32x2 pk; pk.x = pk2(acc[m][n][0], acc[m][n][1]); pk.y = pk2(acc[m][n][2], acc[m][n][3]);
                    *(u32x2*)(OUTM + (size_t)(base + s) * D + nt * BN + wc * 64 + n * 16 + fq * 4) = pk;
                }
            }
        }
    }
    if (l + 1 < 2) { const int idle = xcd_max_units(ntiles, nNT) - mine; if (idle > 0) conv_some(p, l + 1, 3 * idle, smem); }
}

#define XB_TMO      128
#define XB_XCNT(j)  (256  + 64 * (j))
#define XB_XSUB(j)  (1280 + 64 * (j))
#define XB_XGEN(j)  (2304 + 64 * (j))
#define XB_TOP      3328
#define XB_TOPGEN   3392
#define XCD_BAR_WORDS 3456
#define XB_SPIN_CAP (1u << 22)
#define LAS __attribute__((address_space(3)))
__device__ __forceinline__ unsigned xb_ld(unsigned* p)              { return __hip_atomic_load(p, __ATOMIC_RELAXED, __HIP_MEMORY_SCOPE_AGENT); }
__device__ __forceinline__ unsigned xb_add(unsigned* p, unsigned v) { return __hip_atomic_fetch_add(p, v, __ATOMIC_RELAXED, __HIP_MEMORY_SCOPE_AGENT); }
__device__ __forceinline__ unsigned xb_xcc_id() { return (unsigned)__builtin_amdgcn_s_getreg((3 << 11) | 20) & 0xFu; }
#define XB_SPIN(cond, bar) do { unsigned _sp = 0; while (cond) { __builtin_amdgcn_s_sleep(1); \
    if ((++_sp & 255u) == 0u) { if (xb_ld(&(bar)[XB_TMO])) break; if (_sp > XB_SPIN_CAP) { atomicAdd(&(bar)[XB_TMO], 1u); break; } } } } while (0)
struct XcdBarrier { unsigned* bar; unsigned x; volatile unsigned* st; };
__device__ __forceinline__ XcdBarrier xcd_barrier_post(unsigned* bar, volatile unsigned* st, volatile int* xinfo) {
    XcdBarrier b; b.bar = bar; b.x = xb_xcc_id(); b.st = st;
    if (threadIdx.x == 0) { const unsigned r = xb_add(&bar[XB_XCNT(b.x)], 1u); xinfo[0] = 0; xinfo[1] = (int)b.x; xinfo[2] = (int)r; xinfo[3] = 0; }
    return b;
}
__device__ __forceinline__ void xcd_barrier_complete(unsigned* bar, unsigned x, unsigned& nloc, unsigned& nx) {
    const unsigned G = gridDim.x * gridDim.y * gridDim.z;
    unsigned sum, cnt, mine, sp = 0u;
    for (;;) {
        sum = 0u; cnt = 0u; mine = 0u;
#pragma unroll
        for (unsigned j = 0; j < 16; ++j) { const unsigned c = xb_ld(&bar[XB_XCNT(j)]); sum += c; cnt += (c > 0u) ? 1u : 0u; mine = (j == x) ? c : mine; }
        if (sum == G) break;
        __builtin_amdgcn_s_sleep(1);
        if ((++sp & 255u) == 0u) { if (xb_ld(&bar[XB_TMO])) break; if (sp > XB_SPIN_CAP) { atomicAdd(&bar[XB_TMO], 1u); break; } }
    }
    nloc = mine > 0u ? mine : 1u; nx = cnt > 0u ? cnt : 1u;
}
__device__ __forceinline__ void xcd_barrier(const XcdBarrier& b) {
    asm volatile("s_waitcnt vmcnt(0)" ::: "memory");
    __syncthreads();
    if (threadIdx.x == 0) {
        unsigned* bar = b.bar;
        __builtin_amdgcn_s_waitcnt(0);
        unsigned nloc = b.st[0], nx = b.st[1];
        if (nloc == 0u) { xcd_barrier_complete(bar, b.x, nloc, nx); b.st[0] = nloc; b.st[1] = nx; }
        const unsigned old = xb_add(&bar[XB_XSUB(b.x)], 1u);
        const unsigned gen = old / nloc;
        if (old + 1u == (gen + 1u) * nloc) {
            __builtin_amdgcn_fence(__ATOMIC_RELEASE, "agent");
            asm volatile("s_waitcnt vmcnt(0)" ::: "memory");
            const unsigned og = xb_add(&bar[XB_TOP], 1u);
            const unsigned tg = og / nx;
            if (og + 1u == (tg + 1u) * nx) xb_add(&bar[XB_TOPGEN], 1u);
            else XB_SPIN(xb_ld(&bar[XB_TOPGEN]) == tg, bar);
            __builtin_amdgcn_fence(__ATOMIC_ACQUIRE, "agent");
            xb_add(&bar[XB_XGEN(b.x)], 1u);
            asm volatile("s_waitcnt vmcnt(0)" ::: "memory");
        } else {
            XB_SPIN(xb_ld(&bar[XB_XGEN(b.x)]) == gen, bar);
            __builtin_amdgcn_fence(__ATOMIC_ACQUIRE, "agent");
            asm volatile("s_waitcnt vmcnt(0)" ::: "memory");
        }
    }
    __syncthreads();
}

constexpr int NPHASES = 16;
#ifndef PROBE_S
#define PROBE_S -1
#define PROBE_REPS 1
#endif
constexpr int SMEM_BYTES = 4 * 64 * LDT * 2 + 4 * 64 * LDT * 2 + 1024;
__global__ void __launch_bounds__(NTHREADS, 2) mega(Params p) {
    __shared__ __attribute__((aligned(16))) unsigned char smem[SMEM_BYTES];
    cg::grid_group grid = cg::this_grid();
    {
        volatile unsigned* st = (volatile unsigned*)(smem + 73728 + 768);
        if (threadIdx.x < 2) st[threadIdx.x] = 0u;
        __syncthreads();
        volatile int* xinfo = (volatile int*)(smem + 73728 + 800);
        (void)xcd_barrier_post((unsigned*)(p.ws + WS_CTL) + 4096, st, xinfo);
    }
#define GRID_BAR() do { XcdBarrier bar_; bar_.bar = (unsigned*)(p.ws + WS_CTL) + 4096; bar_.x = xb_xcc_id(); bar_.st = (volatile unsigned*)(smem + 73728 + 768); xcd_barrier(bar_); } while (0)
    for (int ph = p.ph_lo; ph < p.ph_hi; ++ph) {
        if (ph == 0) phase_init(p, smem);
        else if (ph == NPHASES - 1) phase_final(p, 1);
        else {
            const int l = (ph - 1) / 7, s = (ph - 1) % 7;
            const int reps = (s == PROBE_S) ? PROBE_REPS : 1;
            for (int rep = 0; rep < reps; ++rep) {
                switch (s) {
                    case 0: phase_prep(p, l); break;
                    case 1: phase_gemm_in(p, l, smem); break;
                    case 2: phase_mix1(p, l, smem, rep); break;
                    case 3: phase_out(p, l, smem); break;
                    case 4: phase_route(p, l, smem); break;
                    case 5: phase_moe1(p, l, smem); break;
                    default: phase_moe2(p, l, smem); break;
                }
                if (rep + 1 < reps) GRID_BAR();
            }
        }
        if (ph + 1 < p.ph_hi) {
            if (ph == 0) {
                if (p.ph_hi < 0) grid.sync();
                GRID_BAR();
                if (threadIdx.x == 0) {
                    unsigned* bw = (unsigned*)(p.ws + WS_CTL) + 4096;
                    volatile int* xi = (volatile int*)(smem + 73728 + 800);
                    const unsigned myx = xb_xcc_id();
                    unsigned sum = 0, ok = 1;
                    for (int j = 0; j < 8; ++j) { const unsigned c = xb_ld(&bw[XB_XCNT(j)]); sum += c; ok &= (c > 0u); }
                    xi[3] = (int)xb_ld(&bw[XB_XCNT(myx & 7u)]);
                    xi[0] = (ok && sum == gridDim.x && myx < 8u) ? 1 : 0;
                }
                __syncthreads();
            } else GRID_BAR();
        }
    }
}

extern "C" void kernel_launch(void* const* d_in, const int* in_sizes, int n_in, void* d_out, int out_size, void* d_ws, size_t ws_size, hipStream_t stream) {
    static int grid_blocks = 0;
    if (grid_blocks == 0) {
        if (n_in != 23 || out_size != RL * D || ws_size < WS_END) { fprintf(stderr, "kernel_launch: unexpected shapes (n_in %d out %d ws %zu need %zu)\n", n_in, out_size, ws_size, (size_t)WS_END); grid_blocks = -1; return; }
        int dev = 0, cus = 0, per_cu = 0;
        hipGetDevice(&dev);
        hipDeviceGetAttribute(&cus, hipDeviceAttributeMultiprocessorCount, dev);
        hipOccupancyMaxActiveBlocksPerMultiprocessor(&per_cu, mega, NTHREADS, 0);
        if (per_cu > 2) per_cu = 2;
        if (per_cu < 1) per_cu = 1;
        grid_blocks = cus * per_cu;
    }
    if (grid_blocks < 0) return;
    hipMemsetAsync((char*)d_ws + WS_CTL, 0, 1 * MiB, stream);
    Params p{};
    for (int i = 0; i < 23; ++i) p.in[i] = (const float*)d_in[i];
    p.out = (float*)d_out; p.ws = (unsigned char*)d_ws; p.ph_lo = 0; p.ph_hi = NPHASES;
    void* args[] = {&p};
    hipError_t e = hipLaunchCooperativeKernel((void*)mega, dim3(grid_blocks), dim3(NTHREADS), args, 0, stream);
    if (e != hipSuccess) fprintf(stderr, "cooperative launch failed: %s (grid %d)\n", hipGetErrorString(e), grid_blocks);
}
```

```cpp
#include <hip/hip_runtime.h>
#include <hip/hip_cooperative_groups.h>
#include <cstdio>
#include <cstdint>
namespace cg = cooperative_groups;

constexpr int D = 1024, NB = 8, T = 2048, TC = 256;
constexpr int RL = NB * T, RC = NB * TC, R = RL + RC;
constexpr int INW = 2560, LFW = 512;
constexpr int OFF_B = 512, OFF_KV = 1024, OFF_V = 1152, OFF_C = 1280, OFF_ZF = 1536, OFF_ZB = 1792, OFF_HV = 2048, OFF_G = 2304;
constexpr int NEXP = 32, FF = 512;
constexpr float EPS = 1e-6f;
constexpr int NTHREADS = 256;

constexpr size_t MiB = 1ull << 20;
constexpr size_t WS_CTL = 0;
constexpr size_t WS_TAB = 1 * MiB;
constexpr size_t WS_H = 2 * MiB;
constexpr size_t WS_P = WS_H + 36 * MiB;
constexpr size_t WS_LF = WS_P + 90 * MiB;
constexpr size_t WS_Y = WS_LF + 36 * MiB;
constexpr size_t WS_X1 = WS_Y + 36 * MiB;
constexpr size_t WS_X2 = WS_X1;
constexpr size_t WS_OFB = WS_X1 + 72 * MiB;
constexpr size_t WS_RT = WS_OFB + 18 * MiB;
constexpr size_t WS_WIN = WS_RT + 4 * MiB;
constexpr size_t WS_WOUT = WS_WIN + 10 * MiB;
constexpr size_t WS_WR = WS_WOUT + 4 * MiB;
constexpr size_t WS_W13 = WS_WR + 1 * MiB;
constexpr size_t WS_W2 = WS_W13 + 128 * MiB;
constexpr size_t WS_END = WS_W2 + 64 * MiB;
constexpr int TAB_ROPE = 0;
constexpr int TAB_LB = 2048;
constexpr int TAB_MOD = 4096;

typedef unsigned short bf16_t;
typedef short bf16x8 __attribute__((ext_vector_type(8)));
typedef float f32x4 __attribute__((ext_vector_type(4)));
typedef float f32x2 __attribute__((ext_vector_type(2)));
typedef unsigned u32x4 __attribute__((ext_vector_type(4)));
typedef unsigned u32x2 __attribute__((ext_vector_type(2)));
typedef __bf16 bf16x2_t __attribute__((ext_vector_type(2)));

struct Params {
    const float* in[23];
    float* out;
    unsigned char* ws;
    int ph_lo, ph_hi;
};

__device__ __forceinline__ unsigned pk2(float lo, float hi) { f32x2 v = {lo, hi}; bf16x2_t b = __builtin_convertvector(v, bf16x2_t); return __builtin_bit_cast(unsigned, b); }
__device__ __forceinline__ bf16_t f2bf(float f) { return (bf16_t)(pk2(f, 0.f) & 0xffffu); }
__device__ __forceinline__ float bf2f(bf16_t u) { return __uint_as_float(((unsigned)u) << 16); }
__device__ __forceinline__ float bflo(unsigned w) { return __uint_as_float(w << 16); }
__device__ __forceinline__ float bfhi(unsigned w) { return __uint_as_float(w & 0xffff0000u); }
__device__ __forceinline__ float wave_sum(float v) {
#pragma unroll
    for (int o = 1; o < 64; o <<= 1) v += __shfl_xor(v, o);
    return v;
}
__device__ __forceinline__ float sigmoidf_(float x) { return __builtin_amdgcn_rcpf(1.f + __expf(-x)); }
__device__ __forceinline__ float siluf_(float x) { return x * sigmoidf_(x); }
__device__ __forceinline__ float gelu_tanh(float x) {
    const float u = 0.7978845608028654f * (x + 0.044715f * x * x * x);
    return x * __builtin_amdgcn_rcpf(1.f + __expf(-2.f * u));
}
__device__ __forceinline__ int otid() { int t = threadIdx.x; asm volatile("" : "+v"(t)); return t; }
__device__ __forceinline__ int obid() { int t = blockIdx.x; asm volatile("" : "+s"(t)); return t; }
__device__ __forceinline__ int cur_idx(int l, int e) { return 8192 + (l * 32 + e) * 64; }
__device__ __forceinline__ int row_modrow(int row) { return row < RL ? (row >> 11) : 8; }

__device__ void phase_init(const Params& p, unsigned char* smem) {
    float* tab = (float*)(p.ws + WS_TAB);
    const float* c = p.in[1];
    const float* c_ctx = p.in[3];
    const float* w_mod = p.in[4];
    const float* b_mod = p.in[5];
    float* sc = (float*)smem;
    const int tid = otid();
    for (int i = tid; i < 9 * 1024; i += NTHREADS) {
        const int b = i >> 10, k = i & 1023;
        const float v = (b < 8) ? c[b * 1024 + k] : c_ctx[k];
        sc[i] = siluf_(v);
    }
    __syncthreads();
    float* red = (float*)(smem + 36864);
    for (int it = obid(); it < 384; it += gridDim.x) {
        const int l = it / 192, j0 = (it % 192) * 32;
        const int jj = tid & 31, kg = tid >> 5;
        const float* w = w_mod + (size_t)l * 1024 * 6144 + (size_t)(kg * 128) * 6144 + j0 + jj;
        float acc[9];
#pragma unroll
        for (int b = 0; b < 9; ++b) acc[b] = 0.f;
        for (int k0 = 0; k0 < 128; k0 += 8) {
            float wv[8];
#pragma unroll
            for (int i = 0; i < 8; ++i) wv[i] = w[(size_t)(k0 + i) * 6144];
#pragma unroll
            for (int i = 0; i < 8; ++i)
#pragma unroll
                for (int b = 0; b < 9; ++b) acc[b] += sc[b * 1024 + kg * 128 + k0 + i] * wv[i];
        }
#pragma unroll
        for (int b = 0; b < 9; ++b) red[(kg * 9 + b) * 32 + jj] = acc[b];
        __syncthreads();
        for (int o = tid; o < 9 * 32; o += NTHREADS) {
            const int b = o >> 5, j2 = o & 31;
            float sum = 0.f;
#pragma unroll
            for (int g = 0; g < 8; ++g) sum += red[(g * 9 + b) * 32 + j2];
            tab[TAB_MOD + (l * 9 + b) * 6144 + j0 + j2] = sum + b_mod[l * 6144 + j0 + j2];
        }
        __syncthreads();
    }
    {
        const int gtid = obid() * NTHREADS + tid, gsize = gridDim.x * NTHREADS;
        const float* w_in = p.in[7]; const float* w_out = p.in[14];
        bf16_t* WIN = (bf16_t*)(p.ws + WS_WIN); bf16_t* WOUT = (bf16_t*)(p.ws + WS_WOUT); bf16_t* WR = (bf16_t*)(p.ws + WS_WR);
        for (int i = gtid; i < 2 * 1024 * INW / 4; i += gsize) { const f32x4 v = *(const f32x4*)(w_in + (size_t)i * 4); u32x2 o; o.x = pk2(v[0], v[1]); o.y = pk2(v[2], v[3]); *(u32x2*)(WIN + (size_t)i * 4) = o; }
        for (int i = gtid; i < 2 * 1024 * D / 4; i += gsize) { const f32x4 v = *(const f32x4*)(w_out + (size_t)i * 4); u32x2 o; o.x = pk2(v[0], v[1]); o.y = pk2(v[2], v[3]); *(u32x2*)(WOUT + (size_t)i * 4) = o; }
        for (int i = gtid; i < 2 * 48 * 1024; i += gsize) {
            const int k = i & 1023, n = (i >> 10) % 48, l = i / (48 * 1024);
            float v = 0.f;
            if (n < 4) v = p.in[16][((size_t)l * 1024 + k) * 4 + n];
            else if (n < 36) v = p.in[18][((size_t)l * 1024 + k) * 32 + (n - 4)];
            WR[i] = f2bf(v);
        }
    }
    if (obid() == gridDim.x - 1) {
        for (int i = tid; i < 64 * 16; i += NTHREADS) {
            const int pos = i >> 4, f = i & 15;
            const float inv = 1.0f / powf(10000.0f, (float)(2 * f) / 32.0f);
            const float ang = (float)pos * inv;
            tab[TAB_ROPE + i * 2] = cosf(ang);
            tab[TAB_ROPE + i * 2 + 1] = sinf(ang);
        }
        const float* lbl = p.in[12];
        for (int i = tid; i < 512; i += NTHREADS) {
            const float a0 = lbl[i], a1 = lbl[512 + i];
            const float m = fmaxf(a0, a1);
            const float e0 = expf(a0 - m), e1 = expf(a1 - m);
            const float s1 = e1 / (e0 + e1);
            tab[TAB_LB + i] = 0.f;
            tab[TAB_LB + 512 + i] = s1;
        }
    }
}

__device__ void phase_prep(const Params& p, int l) {
    const float* tab = (const float*)(p.ws + WS_TAB);
    bf16_t* H = (bf16_t*)(p.ws + WS_H);
    const int lane = otid() & 63;
    const int gw = obid() * (NTHREADS / 64) + (otid() >> 6), NGW = gridDim.x * (NTHREADS / 64);
    const float* nw = p.in[6] + l * 1024;
    const int* rt = (const int*)(p.ws + WS_RT);
    int basev = 0;
    if (l > 0) {
        const unsigned* ctl = (const unsigned*)(p.ws + WS_CTL);
        const int cnt = (lane < NEXP) ? (int)ctl[cur_idx(l - 1, lane & 31)] : 0;
        int incl = cnt;
#pragma unroll
        for (int o = 1; o < 32; o <<= 1) { const int t = __shfl_up(incl, o); if (lane >= o) incl += t; }
        basev = incl - cnt;
    }
    auto load_row = [&](int row, f32x4 (&v)[4]) {
        if (l == 0) {
            const float* src = row < RL ? p.in[0] + (size_t)row * D : p.in[2] + (size_t)(row - RL) * D;
#pragma unroll
            for (int j = 0; j < 4; ++j) v[j] = *(const f32x4*)(src + 4 * lane + 256 * j);
        } else {
            const int mr = row_modrow(row);
            const float* X1 = (const float*)(p.ws + WS_X1) + (size_t)row * D;
            const int e0 = rt[row * 2], e1 = rt[row * 2 + 1];
            const int s0 = rt[2 * R + row * 2], s1 = rt[2 * R + row * 2 + 1];
            const float g0 = ((const float*)rt)[4 * R + row * 2], g1 = ((const float*)rt)[4 * R + row * 2 + 1];
            const int base0 = __shfl(basev, e0), base1 = __shfl(basev, e1);
            const bf16_t* O0 = (const bf16_t*)(p.ws + WS_P) + (size_t)(base0 + s0) * D;
            const bf16_t* O1 = (const bf16_t*)(p.ws + WS_P) + (size_t)(base1 + s1) * D;
            const float* g2 = tab + TAB_MOD + ((l - 1) * 9 + mr) * 6144 + 5 * 1024;
            float* X2 = (float*)(p.ws + WS_X2) + (size_t)row * D;
#pragma unroll
            for (int j = 0; j < 4; ++j) {
                const int k = 4 * lane + 256 * j;
                const f32x4 x1 = *(const f32x4*)(X1 + k);
                const u32x2 a = *(const u32x2*)(O0 + k), b = *(const u32x2*)(O1 + k);
                const f32x4 gg = *(const f32x4*)(g2 + k);
                f32x4 m;
                m.x = g0 * bflo(a.x) + g1 * bflo(b.x); m.y = g0 * bfhi(a.x) + g1 * bfhi(b.x);
                m.z = g0 * bflo(a.y) + g1 * bflo(b.y); m.w = g0 * bfhi(a.y) + g1 * bfhi(b.y);
                v[j] = x1 + gg * m;
                *(f32x4*)(X2 + k) = v[j];
            }
        }
    };
    const int per = (R + NGW - 1) / NGW;
    const int rbeg = gw * per, rend = (rbeg + per < R) ? rbeg + per : R;
    int cur_mr = -1;
    f32x4 ma[4], mb[4];
    auto store_row = [&](int row, const f32x4 (&v)[4], float ss) {
        const float rstd = rsqrtf(ss * (1.f / D) + EPS);
#pragma unroll
        for (int j = 0; j < 4; ++j) {
            const f32x4 o = v[j] * rstd * ma[j] + mb[j];
            u32x2 pk; pk.x = pk2(o.x, o.y); pk.y = pk2(o.z, o.w);
            *(u32x2*)(H + (size_t)row * D + 4 * lane + 256 * j) = pk;
        }
    };
    for (int row = rbeg; row < rend; row += 3) {
        const int r1 = row + 1, r2 = row + 2;
        const bool h1 = r1 < rend, h2 = r2 < rend;
        f32x4 v0[4], v1[4], v2[4];
        load_row(row, v0);
        if (h1) load_row(r1, v1);
        if (h2) load_row(r2, v2);
        float s0 = 0.f, s1 = 0.f, s2 = 0.f;
#pragma unroll
        for (int j = 0; j < 4; ++j) {
            s0 += (v0[j].x * v0[j].x + v0[j].y * v0[j].y) + (v0[j].z * v0[j].z + v0[j].w * v0[j].w);
            if (h1) s1 += (v1[j].x * v1[j].x + v1[j].y * v1[j].y) + (v1[j].z * v1[j].z + v1[j].w * v1[j].w);
            if (h2) s2 += (v2[j].x * v2[j].x + v2[j].y * v2[j].y) + (v2[j].z * v2[j].z + v2[j].w * v2[j].w);
        }
#pragma unroll
        for (int o = 1; o < 64; o <<= 1) { s0 += __shfl_xor(s0, o); s1 += __shfl_xor(s1, o); s2 += __shfl_xor(s2, o); }
        auto mod_for = [&](int r) {
            const int mr = row_modrow(r);
            if (mr != cur_mr) {
                cur_mr = mr;
                const float* sh = tab + TAB_MOD + (l * 9 + mr) * 6144;
#pragma unroll
                for (int j = 0; j < 4; ++j) { const int k = 4 * lane + 256 * j; ma[j] = *(const f32x4*)(nw + k) * (1.f + *(const f32x4*)(sh + 1024 + k)); mb[j] = *(const f32x4*)(sh + k); }
            }
        };
        mod_for(row); store_row(row, v0, s0);
        if (h1) { mod_for(r1); store_row(r1, v1, s1); }
        if (h2) { mod_for(r2); store_row(r2, v2, s2); }
    }
}

__device__ void phase_final(const Params& p, int l) {
    const float* tab = (const float*)(p.ws + WS_TAB);
    const int lane = otid() & 63;
    const int gw = obid() * (NTHREADS / 64) + (otid() >> 6), NGW = gridDim.x * (NTHREADS / 64);
    const int* rt = (const int*)(p.ws + WS_RT);
    const unsigned* ctl = (const unsigned*)(p.ws + WS_CTL);
    int basev;
    {
        const int cnt = (lane < NEXP) ? (int)ctl[cur_idx(l, lane & 31)] : 0;
        int incl = cnt;
#pragma unroll
        for (int o = 1; o < 32; o <<= 1) { const int t = __shfl_up(incl, o); if (lane >= o) incl += t; }
        basev = incl - cnt;
    }
    for (int row0 = gw; row0 < RL; row0 += 2 * NGW) {
        f32x4 x1[2][4], gg[2][4]; u32x2 oa[2][4], ob[2][4]; float g0[2], g1[2];
#pragma unroll
        for (int q = 0; q < 2; ++q) {
            const int row = row0 + q * NGW;
            if (row < RL) {
                const int mr = row >> 11;
                const float* X1 = (const float*)(p.ws + WS_X1) + (size_t)row * D;
                const int e0 = rt[row * 2], e1 = rt[row * 2 + 1];
                const int s0 = rt[2 * R + row * 2], s1 = rt[2 * R + row * 2 + 1];
                g0[q] = ((const float*)rt)[4 * R + row * 2]; g1[q] = ((const float*)rt)[4 * R + row * 2 + 1];
                const int base0 = __shfl(basev, e0), base1 = __shfl(basev, e1);
                const bf16_t* O0 = (const bf16_t*)(p.ws + WS_P) + (size_t)(base0 + s0) * D;
                const bf16_t* O1 = (const bf16_t*)(p.ws + WS_P) + (size_t)(base1 + s1) * D;
                const float* g2 = tab + TAB_MOD + (l * 9 + mr) * 6144 + 5 * 1024;
#pragma unroll
                for (int j = 0; j < 4; ++j) {
                    const int k = 4 * lane + 256 * j;
                    x1[q][j] = *(const f32x4*)(X1 + k); oa[q][j] = *(const u32x2*)(O0 + k); ob[q][j] = *(const u32x2*)(O1 + k); gg[q][j] = *(const f32x4*)(g2 + k);
                }
            }
        }
#pragma unroll
        for (int q = 0; q < 2; ++q) {
            const int row = row0 + q * NGW;
            if (row < RL) {
                float* O = p.out + (size_t)row * D;
#pragma unroll
                for (int j = 0; j < 4; ++j) {
                    const u32x2 a = oa[q][j], b = ob[q][j];
                    f32x4 m;
                    m.x = g0[q] * bflo(a.x) + g1[q] * bflo(b.x); m.y = g0[q] * bfhi(a.x) + g1[q] * bfhi(b.x);
                    m.z = g0[q] * bflo(a.y) + g1[q] * bflo(b.y); m.w = g0[q] * bfhi(a.y) + g1[q] * bfhi(b.y);
                    *(f32x4*)(O + 4 * lane + 256 * j) = x1[q][j] + gg[q][j] * m;
                }
            }
        }
    }
}

constexpr int BN = 128;
constexpr int LDT = 64 + 8;
typedef short v4i16_t __attribute__((ext_vector_type(4)));
typedef __attribute__((address_space(3))) v4i16_t* lds_v4i16_ptr;
__device__ __forceinline__ v4i16_t lds_tr16(const bf16_t* p) { return __builtin_amdgcn_ds_read_tr16_b64_v4i16((lds_v4i16_ptr)(p)); }

template <int N> __device__ __forceinline__ void wait_vm() {
    if constexpr (N == 0) asm volatile("s_waitcnt vmcnt(0)" ::: "memory");
    else if constexpr (N == 3) asm volatile("s_waitcnt vmcnt(3)" ::: "memory");
    else if constexpr (N == 4) asm volatile("s_waitcnt vmcnt(4)" ::: "memory");
    else if constexpr (N == 5) asm volatile("s_waitcnt vmcnt(5)" ::: "memory");
    else if constexpr (N == 6) asm volatile("s_waitcnt vmcnt(6)" ::: "memory");
    else static_assert(N < 0, "wait_vm");
}
#define RAW_BARRIER() do { asm volatile("s_waitcnt lgkmcnt(0)" ::: "memory"); __builtin_amdgcn_s_barrier(); } while (0)
__device__ __forceinline__ void glds16(const void* gsrc, unsigned lds_dst) {
    unsigned keep;
    asm volatile("s_mov_b32 %0, m0\n\ts_mov_b32 m0, %2\n\ts_nop 0\n\tglobal_load_lds_dwordx4 %1, off\n\ts_mov_b32 m0, %0" : "=&s"(keep) : "v"(gsrc), "s"(lds_dst) : "memory");
}
template <int WM, class AF>
__device__ __forceinline__ void gemm_tile_dma(const bf16_t* Abase, const AF& arow, const bf16_t* Btile, int ldb, int K, unsigned char* smem, f32x4 (&acc)[WM][4]) {
    constexpr int A_BYTES = 32 * WM * 64, B_BYTES = 8192, STAGE = A_BYTES + B_BYTES;
    constexpr int AI = WM / 2, NI = AI + 2;
    static_assert(WM % 2 == 0 && 3 * STAGE <= 73728, "gemm_tile_dma");
    const int tid = otid(), lane = tid & 63, wid = tid >> 6, wr = wid >> 1, wc = wid & 1, fr = lane & 15, fq = lane >> 4;
    unsigned aoff[AI], boff[2];
#pragma unroll
    for (int i = 0; i < AI; ++i) {
        const int r = 16 * (i * 4 + wid) + (lane >> 2);
        const int c = (lane & 3) ^ (((r >> 3) & 1) << 1);
        aoff[i] = arow(r) + 8 * c;
    }
#pragma unroll
    for (int i = 0; i < 2; ++i) {
        const int kr = 4 * (i * 4 + wid) + (lane >> 4), jp = lane & 15;
        const int g = (jp >> 1) ^ ((kr & 3) | (((kr >> 3) & 1) << 2));
        boff[i] = (unsigned)(kr * ldb + (g * 2 + (jp & 1)) * 8);
    }
#pragma unroll
    for (int m = 0; m < WM; ++m)
#pragma unroll
        for (int n = 0; n < 4; ++n) acc[m][n] = (f32x4){0.f, 0.f, 0.f, 0.f};
    const int nk = K / 32;
    const unsigned lds0 = (unsigned)(uintptr_t)smem;
    const unsigned wbase = (unsigned)__builtin_amdgcn_readfirstlane((int)(lds0 + (unsigned)wid * 1024u));
    auto dma = [&](int kt, int st) {
        const unsigned sa = wbase + (unsigned)(st * STAGE);
#pragma unroll
        for (int i = 0; i < AI; ++i) glds16(Abase + (aoff[i] + kt * 32), (unsigned)__builtin_amdgcn_readfirstlane((int)(sa + i * 4096)));
#pragma unroll
        for (int i = 0; i < 2; ++i) glds16(Btile + (boff[i] + (unsigned)(kt * 32 * ldb)), (unsigned)__builtin_amdgcn_readfirstlane((int)(sa + A_BYTES + i * 4096)));
    };
    const int a_lane = (wr * (16 * WM) + fr) * 64 + 16 * (fq ^ (((fr >> 3) & 1) << 1));
    const int fBl = (fr >> 2) | ((fq & 1) << 2);
    const int b_lane = A_BYTES + (fq * 8 + (fr >> 2)) * 256 + 8 * (fr & 3);
    bf16x8 bfr[4], af[WM];
    auto load_frags = [&](int st) {
        const unsigned char* sb = smem + st * STAGE;
#pragma unroll
        for (int n = 0; n < 4; ++n) {
            const bf16_t* bp = (const bf16_t*)(sb + b_lane + 32 * ((wc * 4 + n) ^ fBl));
            const v4i16_t lo = lds_tr16(bp), hi = lds_tr16(bp + 512);
            bfr[n] = (bf16x8){lo[0], lo[1], lo[2], lo[3], hi[0], hi[1], hi[2], hi[3]};
        }
#pragma unroll
        for (int m = 0; m < WM; ++m) af[m] = *(const bf16x8*)(sb + a_lane + m * 1024);
    };
    auto mfmas = [&]() {
        __builtin_amdgcn_s_setprio(1);
#pragma unroll
        for (int m = 0; m < WM; ++m)
#pragma unroll
            for (int n = 0; n < 4; ++n) acc[m][n] = __builtin_amdgcn_mfma_f32_16x16x32_bf16(bfr[n], af[m], acc[m][n], 0, 0, 0);
        __builtin_amdgcn_s_setprio(0);
    };
    dma(0, 0); dma(1, 1);
    int st = 0, st2 = 2;
#pragma unroll 1
    for (int kt = 0; kt < nk - 1; ++kt) {
        wait_vm<NI>();
        RAW_BARRIER();
        load_frags(st);
        if (kt + 2 < nk) dma(kt + 2, st2);
        mfmas();
        st = (st == 2) ? 0 : st + 1; st2 = (st2 == 2) ? 0 : st2 + 1;
    }
    wait_vm<0>();
    RAW_BARRIER();
    load_frags(st);
    mfmas();
    RAW_BARRIER();
}

__device__ __forceinline__ void conv_some(const Params& p, int l, int maxn, unsigned char* smem);
__device__ __forceinline__ int xcd_max_units(int nMT, int nNT);
__device__ __forceinline__ bool xcd_unit(int it, int nMT, int nNT, int& mt, int& nt, const unsigned char* smem) {
    const volatile int* xinfo = (const volatile int*)(smem + 73728 + 800);
    const int G = gridDim.x, b = obid();
    if (xinfo[0]) {
        const int x = xinfo[1], rank = xinfo[2], cntx = xinfo[3];
        const int start = (x * nMT) >> 3, per = (((x + 1) * nMT) >> 3) - start;
        const int q = rank + it * cntx;
        if (q >= per * nNT) return false;
        mt = start + q % per; nt = q / per;
        return true;
    }
    const int u = b + it * G;
    if (u >= nMT * nNT) return false;
    mt = u / nNT; nt = u % nNT;
    return true;
}

__device__ __forceinline__ void epi_in_row(const f32x4 (&a)[4], int row, int cw, int fq, const float* tab, const f32x4 (&cv)[4], bf16_t* P, float* LF) {
    float v[4][4];
#pragma unroll
    for (int n = 0; n < 4; ++n)
#pragma unroll
        for (int j = 0; j < 4; ++j) v[n][j] = a[n][j];
    if (cw >= OFF_ZF && cw < OFF_HV) {
        const int dir = (cw >= OFF_ZB) ? 1 : 0;
        const int cb = cw - (dir ? OFF_ZB : OFF_ZF);
#pragma unroll
        for (int n = 0; n < 4; ++n) {
            f32x4 o;
#pragma unroll
            for (int j = 0; j < 4; ++j) {
                const float lb = cv[n][j];
                const float sg = sigmoidf_(fmaxf(v[n][j], -80.f));
                o[j] = __logf(lb + (1.f - lb) * sg);
            }
            *(f32x4*)(LF + (size_t)row * LFW + dir * 256 + cb + n * 16 + fq * 4) = o;
        }
        return;
    }
    if (cw < OFF_B) {
#pragma unroll
        for (int n = 0; n < 4; ++n)
#pragma unroll
            for (int j = 0; j < 4; ++j) v[n][j] = gelu_tanh(v[n][j]);
    }
    if ((cw >= 256 && cw < OFF_V)) {
        float ss = 0.f;
#pragma unroll
        for (int n = 0; n < 4; ++n)
#pragma unroll
            for (int j = 0; j < 4; ++j) ss += v[n][j] * v[n][j];
        ss += __shfl_xor(ss, 16); ss += __shfl_xor(ss, 32);
        const float rstd = rsqrtf(ss * (1.f / 64.f) + EPS);
        if (cw < OFF_B) {
#pragma unroll
            for (int n = 0; n < 4; ++n)
#pragma unroll
                for (int j = 0; j < 4; ++j) v[n][j] *= rstd;
        } else {
#pragma unroll
            for (int n = 0; n < 4; ++n)
#pragma unroll
                for (int j = 0; j < 4; ++j) v[n][j] *= rstd * cv[n][j];
            if (row < RL) {
                const int t = row & (T - 1);
#pragma unroll
                for (int ax = 0; ax < 2; ++ax) {
                    const int pos = ax == 0 ? (t >> 6) : (t & 63);
                    const f32x4 cs01 = *(const f32x4*)(tab + TAB_ROPE + (pos * 16 + fq * 4) * 2), cs23 = *(const f32x4*)(tab + TAB_ROPE + (pos * 16 + fq * 4) * 2 + 4);
                    const float csv[4] = {cs01[0], cs01[2], cs23[0], cs23[2]}, snv[4] = {cs01[1], cs01[3], cs23[1], cs23[3]};
#pragma unroll
                    for (int j = 0; j < 4; ++j) {
                        const float cs = csv[j], sn = snv[j];
                        const float x0 = v[2 * ax][j], x1 = v[2 * ax + 1][j];
                        v[2 * ax][j] = x0 * cs - x1 * sn;
                        v[2 * ax + 1][j] = x1 * cs + x0 * sn;
                    }
                }
            }
        }
    }
    if ((cw >= OFF_C && cw < OFF_ZF) || cw >= OFF_G) {
#pragma unroll
        for (int n = 0; n < 4; ++n)
#pragma unroll
            for (int j = 0; j < 4; ++j) v[n][j] = siluf_(v[n][j]);
    }
#pragma unroll
    for (int n = 0; n < 4; ++n) {
        u32x2 pk; pk.x = pk2(v[n][0], v[n][1]); pk.y = pk2(v[n][2], v[n][3]);
        *(u32x2*)(P + (size_t)row * INW + cw + n * 16 + fq * 4) = pk;
    }
}

__device__ void phase_gemm_in(const Params& p, int l, unsigned char* smem) {
    const float* tab = (const float*)(p.ws + WS_TAB);
    const bf16_t* H = (const bf16_t*)(p.ws + WS_H);
    bf16_t* P = (bf16_t*)(p.ws + WS_P);
    float* LF = (float*)(p.ws + WS_LF);
    const bf16_t* W = (const bf16_t*)(p.ws + WS_WIN) + (size_t)l * D * INW;
    const float* qw = p.in[10] + l * 64;
    const float* kw = p.in[11] + l * 64;
    const float* lbt = tab + TAB_LB + l * 512;
    const int tid = otid(), lane = tid & 63, wid = tid >> 6, wr = wid >> 1, wc = wid & 1, fr = lane & 15, fq = lane >> 4;
    constexpr int WM = 6, BMt = 32 * WM;
    const int nMT = R / BMt, nNT = INW / BN;
    int mine = 0;
    for (int it = 0;; ++it, ++mine) {
        int mt, nt;
        if (!xcd_unit(it, nMT, nNT, mt, nt, smem)) break;
        const int row0 = mt * BMt, col0 = nt * BN;
        f32x4 acc[WM][4];
        auto arow = [&](int i) { return (unsigned)((row0 + i) * D); };
        gemm_tile_dma<WM>(H, arow, W + col0, INW, D, smem, acc);
        const int cw = col0 + wc * 64;
        const int rbase = row0 + wr * (16 * WM) + fr;
        f32x4 cv[4];
        {
            const float* csrc = (cw >= OFF_ZF && cw < OFF_HV) ? (lbt + ((cw >= OFF_ZB) ? 256 + cw - OFF_ZB : cw - OFF_ZF)) : ((cw < OFF_KV) ? qw : kw);
#pragma unroll
            for (int n = 0; n < 4; ++n) cv[n] = *(const f32x4*)(csrc + n * 16 + fq * 4);
        }
        epi_in_row(acc[0], rbase, cw, fq, tab, cv, P, LF);
        epi_in_row(acc[1], rbase + 16, cw, fq, tab, cv, P, LF);
        epi_in_row(acc[2], rbase + 32, cw, fq, tab, cv, P, LF);
        epi_in_row(acc[3], rbase + 48, cw, fq, tab, cv, P, LF);
        epi_in_row(acc[4], rbase + 64, cw, fq, tab, cv, P, LF);
        epi_in_row(acc[5], rbase + 80, cw, fq, tab, cv, P, LF);
    }
    { const int idle = xcd_max_units(nMT, nNT) - mine; if (idle > 0) conv_some(p, l, 0 * idle, smem); }
}

__device__ __forceinline__ int next_unit(unsigned* ctr, unsigned char* smem) {
    int* slot = (int*)(smem + 73728 + 512);
    __syncthreads();
    if (otid() == 0) *slot = (int)atomicAdd(ctr, 1u);
    __syncthreads();
    return *slot;
}

constexpr int CONV_ITEMS = 2048, CONV_CHUNKS = NEXP * D * FF / 4 / CONV_ITEMS;
__device__ __forceinline__ void conv_unit(const Params& p, int l, int c) {
    const int tid = otid();
    const size_t lbase = (size_t)l * NEXP * D * FF;
    const float* w1 = p.in[20] + lbase; const float* w3 = p.in[21] + lbase; const float* w2 = p.in[22] + lbase;
    bf16_t* W13 = (bf16_t*)(p.ws + WS_W13) + (size_t)l * NEXP * D * 1024; bf16_t* W2b = (bf16_t*)(p.ws + WS_W2) + lbase;
    const int i0 = c * CONV_ITEMS + tid;
    f32x4 a[8], b[8], d[8];
#pragma unroll
    for (int u = 0; u < 8; ++u) {
        const int i = i0 + u * NTHREADS;
        a[u] = __builtin_nontemporal_load((const f32x4*)(w1 + (size_t)i * 4)); b[u] = __builtin_nontemporal_load((const f32x4*)(w3 + (size_t)i * 4));
        d[u] = __builtin_nontemporal_load((const f32x4*)(w2 + (size_t)i * 4));
    }
#pragma unroll
    for (int u = 0; u < 8; ++u) {
        const int i = i0 + u * NTHREADS;
        const int c4 = (i & 127) * 4, ek = i >> 7;
        const int dc = (c4 >> 6) * 128 + ((c4 >> 5) & 1) * 64 + (c4 & 31);
        u32x2 oa, ob, od; oa.x = pk2(a[u][0], a[u][1]); oa.y = pk2(a[u][2], a[u][3]); ob.x = pk2(b[u][0], b[u][1]); ob.y = pk2(b[u][2], b[u][3]);
        od.x = pk2(d[u][0], d[u][1]); od.y = pk2(d[u][2], d[u][3]);
        *(u32x2*)(W13 + (size_t)ek * 1024 + dc) = oa;
        *(u32x2*)(W13 + (size_t)ek * 1024 + dc + 32) = ob;
        *(u32x2*)(W2b + (size_t)i * 4) = od;
    }
}

__device__ __forceinline__ void conv_some(const Params& p, int l, int maxn, unsigned char* smem) {
    unsigned* ctr = (unsigned*)(p.ws + WS_CTL) + 192 + l;
    for (int n = 0; n < maxn; ++n) {
        const int c = next_unit(ctr, smem);
        if (c >= CONV_CHUNKS) break;
        conv_unit(p, l, c);
    }
}
__device__ __forceinline__ int xcd_max_units(int nMT, int nNT) {
    const int G8 = (gridDim.x >> 3) > 0 ? (gridDim.x >> 3) : 1;
    return (((nMT + 7) >> 3) * nNT + G8 - 1) / G8;
}

constexpr float ATT_C = 0.125f * 1.4426950408889634f;
constexpr int ATT_STAGE = 32768;
constexpr float ATT_THR = 8.0f / ATT_C;
__device__ __forceinline__ void attn_unit(const Params& p, int u, unsigned char* smem) {
    const bf16_t* P = (const bf16_t*)(p.ws + WS_P);
    bf16_t* Y = (bf16_t*)(p.ws + WS_Y);
    const int tid = otid(), lane = tid & 63, wid = tid >> 6, fr = lane & 15, fq = lane >> 4;
    int b, kvh, qrow0, nkt; const bool ctxq = u >= 1024;
    if (!ctxq) { b = u >> 7; kvh = (u >> 6) & 1; qrow0 = b * T + (u & 63) * 32; nkt = 18; }
    else { const int v = u - 1024; b = v >> 4; kvh = (v >> 3) & 1; qrow0 = RL + b * TC + (v & 7) * 32; nkt = 2; }
    const int hh = kvh * 4 + wid;
    bf16x8 qf[2][2];
#pragma unroll
    for (int m = 0; m < 2; ++m)
#pragma unroll
        for (int ks = 0; ks < 2; ++ks) qf[m][ks] = *(const bf16x8*)(P + (size_t)(qrow0 + m * 16 + fr) * INW + OFF_B + hh * 64 + ks * 32 + fq * 8);
    f32x4 o[2][4];
    float mrow[2], lrow[2];
#pragma unroll
    for (int m = 0; m < 2; ++m) { mrow[m] = -1e30f; lrow[m] = 0.f;
#pragma unroll
        for (int n = 0; n < 4; ++n) o[m][n] = (f32x4){0.f, 0.f, 0.f, 0.f}; }
    unsigned koff[4], voff[4];
#pragma unroll
    for (int i = 0; i < 4; ++i) {
        const int r = 8 * (4 * i + wid) + (lane >> 3), cp = lane & 7;
        koff[i] = (unsigned)(r * INW + OFF_KV + kvh * 64 + (cp ^ ((r >> 1) & 7)) * 8);
        voff[i] = (unsigned)(r * INW + OFF_V + kvh * 64 + ((((cp >> 1) ^ ((r >> 1) & 3)) << 1) | (cp & 1)) * 8);
    }
    const unsigned lds0 = (unsigned)(uintptr_t)smem;
    const unsigned wbase = (unsigned)__builtin_amdgcn_readfirstlane((int)(lds0 + (unsigned)wid * 1024u));
    auto dma = [&](int kt, int st) {
        const int base = ctxq ? (RL + b * TC + kt * 128) : (kt < 16 ? (b * T + kt * 128) : (RL + b * TC + (kt - 16) * 128));
        const bf16_t* src = P + (size_t)base * INW;
        const unsigned sa = wbase + (unsigned)(st * ATT_STAGE);
#pragma unroll
        for (int i = 0; i < 4; ++i) {
            glds16(src + koff[i], (unsigned)__builtin_amdgcn_readfirstlane((int)(sa + i * 4096)));
            glds16(src + voff[i], (unsigned)__builtin_amdgcn_readfirstlane((int)(sa + 16384 + i * 4096)));
        }
    };
    const int kq_lane = fr * 128, kq_sw = (fr >> 1) & 7;
    const int hv = ((fq & 1) << 1) | (fr >> 3);
    const int v_lane = (4 * fq + (fr >> 2)) * 128 + 8 * (fr & 3);
    auto compute = [&](int st, int sub) {
        const unsigned char* kb = smem + st * ATT_STAGE + sub * 8192;
        const unsigned char* vb = kb + 16384;
        f32x4 sc[2][4];
        {
            bf16x8 kf[4][2];
#pragma unroll
            for (int n = 0; n < 4; ++n)
#pragma unroll
                for (int ks = 0; ks < 2; ++ks) kf[n][ks] = *(const bf16x8*)(kb + n * 2048 + kq_lane + 16 * ((ks * 4 + fq) ^ kq_sw));
#pragma unroll
            for (int m = 0; m < 2; ++m)
#pragma unroll
                for (int n = 0; n < 4; ++n) {
                    sc[m][n] = (f32x4){0.f, 0.f, 0.f, 0.f};
#pragma unroll
                    for (int ks = 0; ks < 2; ++ks) sc[m][n] = __builtin_amdgcn_mfma_f32_16x16x32_bf16(kf[n][ks], qf[m][ks], sc[m][n], 0, 0, 0);
                }
        }
        bf16x8 vf[4][2];
#pragma unroll
        for (int n = 0; n < 4; ++n)
#pragma unroll
            for (int ks = 0; ks < 2; ++ks) {
                const bf16_t* vp = (const bf16_t*)(vb + ks * 4096 + v_lane + 32 * (n ^ hv));
                const v4i16_t lo = lds_tr16(vp), hi = lds_tr16(vp + 1024);
                vf[n][ks] = (bf16x8){lo[0], lo[1], lo[2], lo[3], hi[0], hi[1], hi[2], hi[3]};
            }
        bf16x8 pf[2][2];
#pragma unroll
        for (int m = 0; m < 2; ++m) {
            float mx = sc[m][0][0];
#pragma unroll
            for (int n = 0; n < 4; ++n)
#pragma unroll
                for (int j = 0; j < 4; ++j) mx = fmaxf(mx, sc[m][n][j]);
            mx = fmaxf(mx, __shfl_xor(mx, 16)); mx = fmaxf(mx, __shfl_xor(mx, 32));
            if (__any(mx - mrow[m] > ATT_THR)) {
                const float mnew = fmaxf(mrow[m], mx);
                const float alpha = __builtin_amdgcn_exp2f((mrow[m] - mnew) * ATT_C);
                mrow[m] = mnew;
                lrow[m] *= alpha;
#pragma unroll
                for (int n = 0; n < 4; ++n) o[m][n] = o[m][n] * alpha;
            }
            const float mc = mrow[m] * ATT_C;
            float ls = 0.f;
#pragma unroll
            for (int n = 0; n < 4; ++n)
#pragma unroll
                for (int j = 0; j < 4; ++j) { sc[m][n][j] = __builtin_amdgcn_exp2f(sc[m][n][j] * ATT_C - mc); ls += sc[m][n][j]; }
            lrow[m] += ls;
#pragma unroll
            for (int ks = 0; ks < 2; ++ks) {
                u32x4 pw;
                pw.x = pk2(sc[m][2 * ks][0], sc[m][2 * ks][1]); pw.y = pk2(sc[m][2 * ks][2], sc[m][2 * ks][3]);
                pw.z = pk2(sc[m][2 * ks + 1][0], sc[m][2 * ks + 1][1]); pw.w = pk2(sc[m][2 * ks + 1][2], sc[m][2 * ks + 1][3]);
                pf[m][ks] = __builtin_bit_cast(bf16x8, pw);
            }
        }
#pragma unroll
        for (int m = 0; m < 2; ++m)
#pragma unroll
            for (int ks = 0; ks < 2; ++ks)
#pragma unroll
                for (int nd = 0; nd < 4; ++nd) o[m][nd] = __builtin_amdgcn_mfma_f32_16x16x32_bf16(vf[nd][ks], pf[m][ks], o[m][nd], 0, 0, 0);
    };
    dma(0, 0);
    wait_vm<0>();
    RAW_BARRIER();
    int st = 0;
#pragma unroll 1
    for (int kt = 0; kt < nkt; ++kt) {
        if (kt + 1 < nkt) dma(kt + 1, st ^ 1);
        compute(st, 0);
        compute(st, 1);
        wait_vm<0>();
        RAW_BARRIER();
        st ^= 1;
    }
#pragma unroll
    for (int m = 0; m < 2; ++m) {
        float lt = lrow[m];
        lt += __shfl_xor(lt, 16); lt += __shfl_xor(lt, 32);
        const float inv = 1.f / lt;
        const size_t row = (size_t)(qrow0 + m * 16 + fr);
#pragma unroll
        for (int nd = 0; nd < 4; ++nd) {
            u32x2 pk; pk.x = pk2(o[m][nd][0] * inv, o[m][nd][1] * inv); pk.y = pk2(o[m][nd][2] * inv, o[m][nd][3] * inv);
            *(u32x2*)(Y + row * D + 256 + hh * 64 + nd * 16 + fq * 4) = pk;
        }
    }
}

constexpr int LDA = 128 + 8;
__device__ __forceinline__ void mixa_unit(const Params& p, int l, int u, unsigned char* smem) {
    const bf16_t* P = (const bf16_t*)(p.ws + WS_P);
    bf16_t* Y = (bf16_t*)(p.ws + WS_Y);
    const int n = u >> 2, h = u & 3;
    const float* W = p.in[8] + ((size_t)l * 4 + h) * 128 * 128;
    const float* bs = p.in[9] + (l * 4 + h) * 128;
    bf16_t* Ws = (bf16_t*)smem;
    bf16_t* Vs = Ws + 128 * LDA;
    const int tid = otid(), lane = tid & 63, wid = tid >> 6, fr = lane & 15, fq = lane >> 4;
#pragma unroll
    for (int i = 0; i < 16; ++i) {
        const int pc = tid + 256 * i, t = pc >> 5, s4 = (pc & 31) * 4;
        const f32x4 w = *(const f32x4*)(W + t * 128 + s4);
        u32x2 o; o.x = pk2(w[0], w[1]); o.y = pk2(w[2], w[3]);
        *(u32x2*)(Ws + t * LDA + s4) = o;
    }
#pragma unroll
    for (int i = 0; i < 2; ++i) {
        const int mb = tid + 256 * i, dg = mb & 15, sg = mb >> 4;
        u32x2 vr[4];
#pragma unroll
        for (int r = 0; r < 4; ++r) vr[r] = *(const u32x2*)(P + (size_t)(n * 128 + 4 * sg + r) * INW + 256 + h * 64 + 4 * dg);
#pragma unroll
        for (int di = 0; di < 4; ++di) {
            const int w = di >> 1;
            u32x2 ov;
            if ((di & 1) == 0) { ov.x = (vr[0][w] & 0xffffu) | (vr[1][w] << 16); ov.y = (vr[2][w] & 0xffffu) | (vr[3][w] << 16); }
            else { ov.x = (vr[0][w] >> 16) | (vr[1][w] & 0xffff0000u); ov.y = (vr[2][w] >> 16) | (vr[3][w] & 0xffff0000u); }
            *(u32x2*)(Vs + (4 * dg + di) * LDA + 4 * sg) = ov;
        }
    }
    __syncthreads();
    f32x4 acc[2][4];
#pragma unroll
    for (int m = 0; m < 2; ++m)
#pragma unroll
        for (int nd = 0; nd < 4; ++nd) acc[m][nd] = (f32x4){0.f, 0.f, 0.f, 0.f};
#pragma unroll
    for (int ks = 0; ks < 4; ++ks) {
        bf16x8 wf[2], vf[4];
#pragma unroll
        for (int m = 0; m < 2; ++m) wf[m] = *(const bf16x8*)(Ws + (32 * wid + 16 * m + fr) * LDA + ks * 32 + fq * 8);
#pragma unroll
        for (int nd = 0; nd < 4; ++nd) vf[nd] = *(const bf16x8*)(Vs + (16 * nd + fr) * LDA + ks * 32 + fq * 8);
#pragma unroll
        for (int m = 0; m < 2; ++m)
#pragma unroll
            for (int nd = 0; nd < 4; ++nd) acc[m][nd] = __builtin_amdgcn_mfma_f32_16x16x32_bf16(vf[nd], wf[m], acc[m][nd], 0, 0, 0);
    }
#pragma unroll
    for (int m = 0; m < 2; ++m) {
        const int t = 32 * wid + 16 * m + fr;
        const size_t row = (size_t)n * 128 + t;
        const float bias = bs[t];
#pragma unroll
        for (int nd = 0; nd < 4; ++nd) {
            const int c = h * 64 + 16 * nd + 4 * fq;
            const u32x2 uu = *(const u32x2*)(P + row * INW + c);
            u32x2 pk;
            pk.x = pk2(bflo(uu.x) * (acc[m][nd][0] + bias), bfhi(uu.x) * (acc[m][nd][1] + bias));
            pk.y = pk2(bflo(uu.y) * (acc[m][nd][2] + bias), bfhi(uu.y) * (acc[m][nd][3] + bias));
            *(u32x2*)(Y + row * D + c) = pk;
        }
    }
}

__device__ __forceinline__ int hg_pos(int I, int ii) { return 32 * (I >> 1) + 4 * (I & 1) + 8 * (ii >> 2) + (ii & 3); }
__device__ __forceinline__ void hgrn_state_unit(const Params& p, int l, int u, unsigned char* smem) {
    const bf16_t* P = (const bf16_t*)(p.ws + WS_P);
    const float* LF = (const float*)(p.ws + WS_LF);
    bf16_t* SST = (bf16_t*)(p.ws + WS_OFB);
    const int b = u >> 3, h = (u >> 1) & 3, dir = u & 1;
    const int tid = otid(), lane = tid & 63, wid = tid >> 6, fr = lane & 15, fq = lane >> 4;
    const int k = lane, I = wid;
    bf16_t* KT = (bf16_t*)smem;
    bf16_t* VT = KT + 64 * LDT;
    float* Tsub = (float*)(VT + 64 * LDT);
    float* Etot = Tsub + 256;
    f32x4 sacc[4];
#pragma unroll
    for (int nk = 0; nk < 4; ++nk) sacc[nk] = (f32x4){0.f, 0.f, 0.f, 0.f};
    float lf[16], vv[16];
    auto mcof = [&](int j) { return dir == 0 ? (j < 4 ? 256 + b * 4 + j : b * 32 + (j - 4)) : (j < 4 ? 256 + b * 4 + (3 - j) : b * 32 + (35 - j)); };
    auto gload = [&](int j) {
        const int mc = mcof(j);
#pragma unroll
        for (int ii = 0; ii < 16; ++ii) {
            const int tau = 16 * I + ii;
            const size_t row = (size_t)mc * 64 + (dir ? 63 - tau : tau);
            lf[ii] = LF[row * LFW + dir * 256 + h * 64 + k];
            vv[ii] = bf2f(P[row * INW + OFF_HV + h * 64 + k]);
        }
    };
    gload(0);
    for (int j = 0; j < 36; ++j) {
        float c[16];
        c[0] = lf[0];
#pragma unroll
        for (int ii = 1; ii < 16; ++ii) c[ii] = c[ii - 1] + lf[ii];
        Tsub[I * 64 + k] = c[15];
        __syncthreads();
        float Rs = 0.f;
#pragma unroll
        for (int M = 1; M < 4; ++M) Rs += (M > I) ? Tsub[M * 64 + k] : 0.f;
        if (I == 0) Etot[k] = __expf(c[15] + Rs);
#pragma unroll
        for (int g = 0; g < 4; ++g) {
            float kh[4];
#pragma unroll
            for (int jj = 0; jj < 4; ++jj) { const int ii = 4 * g + jj; kh[jj] = (1.f - __expf(lf[ii])) * __expf(c[15] - c[ii] + Rs); }
            u32x2 kw; kw.x = pk2(kh[0], kh[1]); kw.y = pk2(kh[2], kh[3]);
            u32x2 vw; vw.x = pk2(vv[4 * g], vv[4 * g + 1]); vw.y = pk2(vv[4 * g + 2], vv[4 * g + 3]);
            const int pos = hg_pos(I, 4 * g);
            *(u32x2*)(KT + k * LDT + pos) = kw;
            *(u32x2*)(VT + k * LDT + pos) = vw;
        }
        const int mc = mcof(j);
        {
            bf16_t* dst = SST + ((size_t)(mc * 4 + h) * 2 + dir) * 4096;
#pragma unroll
            for (int nk = 0; nk < 4; ++nk)
#pragma unroll
                for (int r = 0; r < 4; ++r) dst[(16 * wid + 4 * fq + r) * 64 + 16 * nk + fr] = f2bf(sacc[nk][r]);
        }
        if (j + 1 < 36) gload(j + 1);
        __builtin_amdgcn_sched_barrier(0);
        __syncthreads();
        bf16x8 vf[2];
#pragma unroll
        for (int ks = 0; ks < 2; ++ks) vf[ks] = *(const bf16x8*)(VT + (16 * wid + fr) * LDT + 32 * ks + 8 * fq);
#pragma unroll
        for (int nk = 0; nk < 4; ++nk) {
            const float e = Etot[16 * nk + fr];
            sacc[nk] = sacc[nk] * e;
#pragma unroll
            for (int ks = 0; ks < 2; ++ks) {
                const bf16x8 kf = *(const bf16x8*)(KT + (16 * nk + fr) * LDT + 32 * ks + 8 * fq);
                sacc[nk] = __builtin_amdgcn_mfma_f32_16x16x32_bf16(vf[ks], kf, sacc[nk], 0, 0, 0);
            }
        }
        __syncthreads();
    }
    asm volatile("s_waitcnt vmcnt(0)" ::: "memory");
    __syncthreads();
    if (otid() == 0) {
        __builtin_amdgcn_fence(__ATOMIC_RELEASE, "agent");
        asm volatile("s_waitcnt vmcnt(0)" ::: "memory");
        __hip_atomic_fetch_add((unsigned*)(p.ws + WS_CTL) + 160 + l, 1u, __ATOMIC_RELAXED, __HIP_MEMORY_SCOPE_AGENT);
    }
}


__device__ __forceinline__ void hgrn_out_unit(const Params& p, int l, int u, unsigned char* smem) {
    const bf16_t* P = (const bf16_t*)(p.ws + WS_P);
    const float* LF = (const float*)(p.ws + WS_LF);
    const bf16_t* SST = (const bf16_t*)(p.ws + WS_OFB);
    bf16_t* Y = (bf16_t*)(p.ws + WS_Y);
    const float* hw = p.in[13] + l * 64;
    const int mc = u >> 2, h = u & 3;
    const int tid = otid(), lane = tid & 63, wid = tid >> 6, fr = lane & 15, fq = lane >> 4;
    const int k = lane, I = wid;
    bf16_t* QT0 = (bf16_t*)smem;
    bf16_t* KD = QT0 + 64 * LDT;
    bf16_t* KO = KD + 64 * LDT;
    bf16_t* QS = KO + 64 * LDT;
    bf16_t* QT1 = QS + 64 * LDT;
    bf16_t* QT2 = QT1 + 32 * LDT;
    bf16_t* VT = QT2 + 16 * LDT;
    float* Tsub = (float*)(VT + 64 * LDT);
    float* SSQ = Tsub + 256;
    f32x4 om[4];
#pragma unroll 1
    for (int dd = 0; dd < 2; ++dd) {
        const int dir = 1 - dd;
        float lf[16], c[16];
#pragma unroll
        for (int ii = 0; ii < 16; ++ii) {
            const int tau = 16 * I + ii;
            const size_t row = (size_t)mc * 64 + (dir ? 63 - tau : tau);
            lf[ii] = LF[row * LFW + dir * 256 + h * 64 + k];
        }
        c[0] = lf[0];
#pragma unroll
        for (int ii = 1; ii < 16; ++ii) c[ii] = c[ii - 1] + lf[ii];
        Tsub[I * 64 + k] = c[15];
        __syncthreads();
        const float T0 = Tsub[k], T1 = Tsub[64 + k], T2 = Tsub[128 + k];
        const float pre = (I > 0 ? T0 : 0.f) + (I > 1 ? T1 : 0.f) + (I > 2 ? T2 : 0.f);
        const float epre = __expf(pre);
        const float g1 = __expf(I == 2 ? T1 : T2);
        const float g2 = __expf(T1 + T2);
#pragma unroll
        for (int g = 0; g < 4; ++g) {
            float vq[4];
#pragma unroll
            for (int jj = 0; jj < 4; ++jj) {
                const int ii = 4 * g + jj, tau = 16 * I + ii;
                const size_t row = (size_t)mc * 64 + (dir ? 63 - tau : tau);
                const float q = bf2f(P[row * INW + OFF_C + h * 64 + k]);
                vq[jj] = bf2f(P[row * INW + OFF_HV + h * 64 + k]);
                const float qt = q * __expf(c[ii]);
                const float kk = 1.f - __expf(lf[ii]);
                QT0[tau * LDT + k] = f2bf(qt);
                QS[tau * LDT + k] = f2bf(qt * epre);
                KD[tau * LDT + k] = f2bf(kk * __expf(fminf(-c[ii], 80.f)));
                KO[tau * LDT + k] = f2bf(kk * __expf(c[15] - c[ii]));
                if (I >= 2) QT1[(tau - 32) * LDT + k] = f2bf(qt * g1);
                if (I == 3) QT2[(tau - 48) * LDT + k] = f2bf(qt * g2);
            }
            u32x2 vw; vw.x = pk2(vq[0], vq[1]); vw.y = pk2(vq[2], vq[3]);
            *(u32x2*)(VT + k * LDT + hg_pos(I, 4 * g)) = vw;
        }
        bf16x8 stf[2];
        {
            const bf16_t* src = SST + ((size_t)(mc * 4 + h) * 2 + dir) * 4096 + (16 * wid + fr) * 64 + 8 * fq;
            stf[0] = *(const bf16x8*)(src); stf[1] = *(const bf16x8*)(src + 32);
        }
        __syncthreads();
        bf16x8 vf[2];
#pragma unroll
        for (int ks = 0; ks < 2; ++ks) vf[ks] = *(const bf16x8*)(VT + (16 * wid + fr) * LDT + 32 * ks + 8 * fq);
        f32x4 o[4];
#pragma unroll
        for (int I2 = 0; I2 < 4; ++I2) {
            f32x4 A[4];
#pragma unroll
            for (int J = 0; J < 4; ++J) {
                A[J] = (f32x4){0.f, 0.f, 0.f, 0.f};
                if (J <= I2) {
                    const bf16_t* kbase = (J == I2 ? KD : KO) + (16 * J + fr) * LDT + 8 * fq;
                    const bf16_t* qbase = (I2 - J <= 1) ? (QT0 + (16 * I2 + fr) * LDT) : ((I2 - J == 2) ? (QT1 + (16 * I2 - 32 + fr) * LDT) : (QT2 + fr * LDT));
#pragma unroll
                    for (int ks = 0; ks < 2; ++ks) {
                        const bf16x8 kf = *(const bf16x8*)(kbase + 32 * ks);
                        const bf16x8 qf = *(const bf16x8*)(qbase + 32 * ks + 8 * fq);
                        A[J] = __builtin_amdgcn_mfma_f32_16x16x32_bf16(kf, qf, A[J], 0, 0, 0);
                    }
                    if (J == I2) {
#pragma unroll
                        for (int r = 0; r < 4; ++r) A[J][r] = (4 * fq + r <= fr) ? A[J][r] : 0.f;
                    }
                }
            }
            o[I2] = (f32x4){0.f, 0.f, 0.f, 0.f};
#pragma unroll
            for (int ks = 0; ks < 2; ++ks) {
                if (2 * ks <= I2) {
                    u32x4 pw;
                    pw.x = pk2(A[2 * ks][0], A[2 * ks][1]); pw.y = pk2(A[2 * ks][2], A[2 * ks][3]);
                    pw.z = pk2(A[2 * ks + 1][0], A[2 * ks + 1][1]); pw.w = pk2(A[2 * ks + 1][2], A[2 * ks + 1][3]);
                    o[I2] = __builtin_amdgcn_mfma_f32_16x16x32_bf16(vf[ks], __builtin_bit_cast(bf16x8, pw), o[I2], 0, 0, 0);
                }
                const bf16x8 qsf = *(const bf16x8*)(QS + (16 * I2 + fr) * LDT + 32 * ks + 8 * fq);
                o[I2] = __builtin_amdgcn_mfma_f32_16x16x32_bf16(stf[ks], qsf, o[I2], 0, 0, 0);
            }
        }
        if (dir == 1) {
            const int src = (lane & 48) | (15 - fr);
#pragma unroll
            for (int Im = 0; Im < 4; ++Im)
#pragma unroll
                for (int r = 0; r < 4; ++r) om[Im][r] = __shfl(o[3 - Im][r], src);
        } else {
#pragma unroll
            for (int Im = 0; Im < 4; ++Im) om[Im] = om[Im] + o[Im];
        }
        __syncthreads();
    }
#pragma unroll
    for (int Im = 0; Im < 4; ++Im) {
        float s = om[Im][0] * om[Im][0] + om[Im][1] * om[Im][1] + om[Im][2] * om[Im][2] + om[Im][3] * om[Im][3];
        s += __shfl_xor(s, 16); s += __shfl_xor(s, 32);
        if (fq == 0) SSQ[wid * 64 + 16 * Im + fr] = s;
    }
    __syncthreads();
    const f32x4 wv = *(const f32x4*)(hw + 16 * wid + 4 * fq);
#pragma unroll
    for (int Im = 0; Im < 4; ++Im) {
        const int i = 16 * Im + fr;
        const float tot = SSQ[i] + SSQ[64 + i] + SSQ[128 + i] + SSQ[192 + i];
        const float rstd = rsqrtf(tot * (1.f / 64.f) + EPS);
        const size_t row = (size_t)mc * 64 + i;
        const u32x2 gg = *(const u32x2*)(P + row * INW + OFF_G + h * 64 + 16 * wid + 4 * fq);
        u32x2 pk;
        pk.x = pk2(om[Im][0] * rstd * wv[0] * bflo(gg.x), om[Im][1] * rstd * wv[1] * bfhi(gg.x));
        pk.y = pk2(om[Im][2] * rstd * wv[2] * bflo(gg.y), om[Im][3] * rstd * wv[3] * bfhi(gg.y));
        *(u32x2*)(Y + row * D + 768 + h * 64 + 16 * wid + 4 * fq) = pk;
    }
}

__device__ void phase_mix1(const Params& p, int l, unsigned char* smem, int rep) {
    unsigned* ctr = (unsigned*)(p.ws + WS_CTL) + 128 + l * 2 + rep * 4;
    unsigned* done = (unsigned*)(p.ws + WS_CTL) + 160 + l;
    const int n_attn = (l == 0) ? 1152 : 1024, n_mixa = (l == 0) ? 576 : 512, n_hout = ((l == 0) ? 288 : 256) * 4;
    const int total = 64 + n_attn + n_mixa + n_hout;
    bool acquired = false;
    int* slot = (int*)(smem + 73728 + 512);
    int u = next_unit(ctr, smem);
    while (u < total) {
        int nxt = 0;
        if (u >= 64 && otid() == 0) nxt = (int)atomicAdd(ctr, 1u);
        if (u < 64) { hgrn_state_unit(p, l, u, smem); if (otid() == 0) nxt = (int)atomicAdd(ctr, 1u); }
        else if (u < 64 + n_attn) attn_unit(p, u - 64, smem);
        else if (u < 64 + n_attn + n_mixa) mixa_unit(p, l, u - 64 - n_attn, smem);
        else {
            if (!acquired) {
                if (otid() == 0) {
                    unsigned spins = 0;
                    while (__hip_atomic_load(done, __ATOMIC_RELAXED, __HIP_MEMORY_SCOPE_AGENT) < 64u * (unsigned)(rep + 1)) { __builtin_amdgcn_s_sleep(8); if (++spins > (1u << 24)) break; }
                    __builtin_amdgcn_fence(__ATOMIC_ACQUIRE, "agent");
                    asm volatile("s_waitcnt vmcnt(0)" ::: "memory");
                }
                __syncthreads();
                acquired = true;
            }
            hgrn_out_unit(p, l, u - 64 - n_attn - n_mixa, smem);
        }
        __syncthreads();
        if (otid() == 0) *slot = nxt;
        __syncthreads();
        u = *slot;
    }
}

template <int WM>
__device__ __forceinline__ void phase_out_t(const Params& p, int l, unsigned char* smem) {
    const float* tab = (const float*)(p.ws + WS_TAB);
    const bf16_t* Y = (const bf16_t*)(p.ws + WS_Y);
    float* X1 = (float*)(p.ws + WS_X1);
    const float* X2 = (const float*)(p.ws + WS_X2);
    const bf16_t* W = (const bf16_t*)(p.ws + WS_WOUT) + (size_t)l * D * D;
    const int tid = otid(), lane = tid & 63, wid = tid >> 6, wr = wid >> 1, wc = wid & 1, fr = lane & 15, fq = lane >> 4;
    const int nrows = (l == 0) ? R : RL;
    constexpr int BMt = 32 * WM;
    const int nMT = (nrows + BMt - 1) / BMt, nNT = D / BN;
    int mine = 0;
    for (int it = 0;; ++it, ++mine) {
        int mt, nt;
        if (!xcd_unit(it, nMT, nNT, mt, nt, smem)) break;
        const int row0 = mt * BMt, col0 = nt * BN;
        f32x4 acc[WM][4];
        auto arow = [&](int i) { return (unsigned)((row0 + i) * D); };
        gemm_tile_dma<WM>(Y, arow, W + col0, D, D, smem, acc);
#pragma unroll
        for (int m = 0; m < WM; ++m) {
            const int row = row0 + wr * (16 * WM) + m * 16 + fr;
            const int mr = row_modrow(row);
            const float* g1 = tab + TAB_MOD + (l * 9 + mr) * 6144 + 2 * 1024;
            const float* xin = (l == 0) ? (row < RL ? p.in[0] + (size_t)row * D : p.in[2] + (size_t)(row - RL) * D) : X2 + (size_t)row * D;
#pragma unroll
            for (int n = 0; n < 4; ++n) {
                const int col = col0 + wc * 64 + n * 16 + fq * 4;
                const f32x4 xv = *(const f32x4*)(xin + col), gv = *(const f32x4*)(g1 + col);
                *(f32x4*)(X1 + (size_t)row * D + col) = xv + gv * acc[m][n];
            }
        }
    }
    { const int idle = xcd_max_units(nMT, nNT) - mine; if (idle > 0) conv_some(p, l, 4 * idle, smem); }
}
__device__ void phase_out(const Params& p, int l, unsigned char* smem) {
    if (l == 0) phase_out_t<6>(p, l, smem); else phase_out_t<4>(p, l, smem);
}

__device__ void phase_route(const Params& p, int l, unsigned char* smem) {
    const float* tab = (const float*)(p.ws + WS_TAB);
    bf16_t* H = (bf16_t*)(p.ws + WS_H);
    const float* X1 = (const float*)(p.ws + WS_X1);
    int* rt = (int*)(p.ws + WS_RT);
    unsigned* ctl = (unsigned*)(p.ws + WS_CTL);
    const float* nw = p.in[15] + l * 1024;
    const float* wg = p.in[16] + (size_t)l * 1024 * 4;
    const float* bg = p.in[17] + l * 4;
    const float* we = p.in[18] + (size_t)l * 1024 * 32;
    const float* be = p.in[19] + l * 32;
    const int tid = otid(), lane = tid & 63, wid = tid >> 6, wr = wid >> 1, wc = wid & 1, fr = lane & 15, fq = lane >> 4;
    const int nrows = (l == 0) ? R : RL;
    float* Ls = (float*)smem;
    constexpr int BM = 64;
    for (int u = obid(); u < nrows / BM; u += gridDim.x) {
        const int row0 = u * BM;
        {
            const int mr = row_modrow(row0);
            const float* sh = tab + TAB_MOD + (l * 9 + mr) * 6144 + 3 * 1024;
            const float* scv = sh + 1024;
            f32x4 ma[4], mb[4];
#pragma unroll
            for (int j = 0; j < 4; ++j) {
                const int k = 4 * lane + 256 * j;
                ma[j] = *(const f32x4*)(nw + k) * (1.f + *(const f32x4*)(scv + k)); mb[j] = *(const f32x4*)(sh + k);
            }
#pragma unroll 1
            for (int rb = 0; rb < 4; ++rb) {
                const int rowb = row0 + wid * 16 + rb * 4;
                f32x4 v[4][4];
#pragma unroll
                for (int q = 0; q < 4; ++q)
#pragma unroll
                    for (int j = 0; j < 4; ++j) v[q][j] = *(const f32x4*)(X1 + (size_t)(rowb + q) * D + 4 * lane + 256 * j);
                float ss[4];
#pragma unroll
                for (int q = 0; q < 4; ++q) {
                    ss[q] = 0.f;
#pragma unroll
                    for (int j = 0; j < 4; ++j) ss[q] += (v[q][j].x * v[q][j].x + v[q][j].y * v[q][j].y) + (v[q][j].z * v[q][j].z + v[q][j].w * v[q][j].w);
                }
#pragma unroll
                for (int o = 1; o < 64; o <<= 1) {
#pragma unroll
                    for (int q = 0; q < 4; ++q) ss[q] += __shfl_xor(ss[q], o);
                }
#pragma unroll
                for (int q = 0; q < 4; ++q) {
                    const float rstd = rsqrtf(ss[q] * (1.f / D) + EPS);
#pragma unroll
                    for (int j = 0; j < 4; ++j) {
                        const f32x4 o = v[q][j] * rstd * ma[j] + mb[j];
                        u32x2 pk; pk.x = pk2(o.x, o.y); pk.y = pk2(o.z, o.w);
                        *(u32x2*)(H + (size_t)(rowb + q) * D + 4 * lane + 256 * j) = pk;
                    }
                }
            }
        }
        asm volatile("s_waitcnt vmcnt(0)" ::: "memory");
        __syncthreads();
        {
            const bf16_t* WRl = (const bf16_t*)(p.ws + WS_WR) + (size_t)l * 48 * 1024;
            f32x4 acc[4][3];
#pragma unroll
            for (int m = 0; m < 4; ++m)
#pragma unroll
                for (int n = 0; n < 3; ++n) acc[m][n] = (f32x4){0.f, 0.f, 0.f, 0.f};
            const bf16_t* ap = H + (size_t)(row0 + fr) * D + wid * 256 + fq * 8;
            const bf16_t* bp = WRl + (size_t)fr * 1024 + wid * 256 + fq * 8;
#pragma unroll 1
            for (int kh = 0; kh < 4; ++kh) {
                bf16x8 af[2][4], bf[2][3];
#pragma unroll
                for (int ks = 0; ks < 2; ++ks) {
#pragma unroll
                    for (int m = 0; m < 4; ++m) af[ks][m] = *(const bf16x8*)(ap + (size_t)m * 16 * D + (kh * 2 + ks) * 32);
#pragma unroll
                    for (int n = 0; n < 3; ++n) bf[ks][n] = *(const bf16x8*)(bp + (size_t)n * 16 * 1024 + (kh * 2 + ks) * 32);
                }
#pragma unroll
                for (int ks = 0; ks < 2; ++ks)
#pragma unroll
                    for (int m = 0; m < 4; ++m)
#pragma unroll
                        for (int n = 0; n < 3; ++n) acc[m][n] = __builtin_amdgcn_mfma_f32_16x16x32_bf16(bf[ks][n], af[ks][m], acc[m][n], 0, 0, 0);
            }
            float* Lp = (float*)smem + wid * (64 * 48);
#pragma unroll
            for (int m = 0; m < 4; ++m)
#pragma unroll
                for (int n = 0; n < 3; ++n) *(f32x4*)(Lp + (m * 16 + fr) * 48 + n * 16 + fq * 4) = acc[m][n];
        }
        __syncthreads();
        unsigned* lcnt = (unsigned*)(smem + 49152);
        if (tid < 32) lcnt[tid] = 0u;
        int dec_ea = 0, dec_eb = 0, dec_la = 0, dec_lb = 0; float dec_ga = 0.f, dec_gb = 0.f;
        __syncthreads();
        if (tid < BM) {
            const int row = row0 + tid;
            const float* lp = (const float*)smem + tid * 48;
            float lg[36];
#pragma unroll
            for (int i = 0; i < 36; ++i) lg[i] = (lp[i] + lp[64 * 48 + i]) + (lp[2 * 64 * 48 + i] + lp[3 * 64 * 48 + i]);
            float gl[4];
#pragma unroll
            for (int i = 0; i < 4; ++i) gl[i] = lg[i] + bg[i];
            int grp = 0; float gm = gl[0];
#pragma unroll
            for (int i = 1; i < 4; ++i) if (gl[i] > gm) { gm = gl[i]; grp = i; }
            float gs = 0.f;
#pragma unroll
            for (int i = 0; i < 4; ++i) gs += expf(gl[i] - gm);
            const float pgrp = 1.f / gs;
            float ev[8];
#pragma unroll
            for (int i = 0; i < 8; ++i) {
                float x = lg[4 + i];
#pragma unroll
                for (int g = 1; g < 4; ++g) x = (grp == g) ? lg[4 + g * 8 + i] : x;
                ev[i] = x + be[grp * 8 + i];
            }
            int i0 = 0; float v0 = ev[0];
#pragma unroll
            for (int i = 1; i < 8; ++i) if (ev[i] > v0) { v0 = ev[i]; i0 = i; }
            int i1 = -1; float v1 = -3.0e38f;
#pragma unroll
            for (int i = 0; i < 8; ++i) if (i != i0 && ev[i] > v1) { v1 = ev[i]; i1 = i; }
            const float e1 = expf(v1 - v0);
            const float ga = pgrp / (1.f + e1), gb = pgrp * e1 / (1.f + e1);
            const int ea = grp * 8 + i0, eb = grp * 8 + i1;
            dec_ea = ea; dec_eb = eb; dec_ga = ga; dec_gb = gb;
            dec_la = (int)atomicAdd(&lcnt[ea], 1u);
            dec_lb = (int)atomicAdd(&lcnt[eb], 1u);
        }
        __syncthreads();
        if (tid < 32) { const unsigned c = lcnt[tid]; lcnt[32 + tid] = c ? atomicAdd(&ctl[cur_idx(l, tid)], c) : 0u; }
        __syncthreads();
        if (tid < BM) {
            const int row = row0 + tid;
            const int sa = (int)lcnt[32 + dec_ea] + dec_la, sb = (int)lcnt[32 + dec_eb] + dec_lb;
            rt[row * 2] = dec_ea; rt[row * 2 + 1] = dec_eb;
            rt[2 * R + row * 2] = sa; rt[2 * R + row * 2 + 1] = sb;
            ((float*)rt)[4 * R + row * 2] = dec_ga; ((float*)rt)[4 * R + row * 2 + 1] = dec_gb;
            rt[6 * R + dec_ea * R + sa] = row;
            rt[6 * R + dec_eb * R + sb] = row;
        }
        __syncthreads();
    }
    conv_some(p, l, 1 << 30, smem);
}

constexpr int MOE_WM = 6, MOE_BM = 32 * MOE_WM;
__device__ __forceinline__ void moe_units(const Params& p, int l, int* s_cnt, int* s_base, int* s_tpre) {
    const unsigned* ctl = (const unsigned*)(p.ws + WS_CTL);
    if (otid() == 0) {
        int base = 0, tp = 0;
        for (int e = 0; e < NEXP; ++e) {
            const int c = (int)ctl[cur_idx(l, e)];
            s_cnt[e] = c; s_base[e] = base; s_tpre[e] = tp;
            base += c; tp += (c + MOE_BM - 1) / MOE_BM;
        }
        s_tpre[NEXP] = tp;
    }
    __syncthreads();
}

__device__ void phase_moe1(const Params& p, int l, unsigned char* smem) {
    int* s_cnt = (int*)(smem + 73728);
    int* s_base = s_cnt + 32;
    int* s_tpre = s_base + 32;
    moe_units(p, l, s_cnt, s_base, s_tpre);
    const bf16_t* H = (const bf16_t*)(p.ws + WS_H);
    bf16_t* HM = (bf16_t*)(p.ws + WS_LF);
    const int* list = (const int*)(p.ws + WS_RT) + 6 * R;
    const int tid = otid(), lane = tid & 63, wid = tid >> 6, wr = wid >> 1, wc = wid & 1, fr = lane & 15, fq = lane >> 4;
    const int ntiles = s_tpre[NEXP];
    constexpr int nNT = FF / 64;
    int mine = 0;
    for (int it = 0;; ++it, ++mine) {
        int tg, nt;
        if (!xcd_unit(it, ntiles, nNT, tg, nt, smem)) break;
        int e = 0;
        while (s_tpre[e + 1] <= tg) ++e;
        const int mt = tg - s_tpre[e], cnt = s_cnt[e], base = s_base[e];
        const bf16_t* w13 = (const bf16_t*)(p.ws + WS_W13) + ((size_t)l * NEXP + e) * D * 1024;
        const int* lst = list + (size_t)e * R;
        f32x4 acc[MOE_WM][4];
        auto arow = [&](int i) { int s = mt * MOE_BM + i; s = s < cnt ? s : cnt - 1; return (unsigned)(lst[s] * D); };
        gemm_tile_dma<MOE_WM>(H, arow, w13 + nt * 128, 1024, D, smem, acc);
#pragma unroll
        for (int m = 0; m < MOE_WM; ++m) {
            const int s = mt * MOE_BM + wr * (16 * MOE_WM) + m * 16 + fr;
            if (s < cnt) {
#pragma unroll
                for (int n = 0; n < 2; ++n) {
                    float hv[4];
#pragma unroll
                    for (int j = 0; j < 4; ++j) hv[j] = siluf_(acc[m][n][j]) * acc[m][n + 2][j];
                    u32x2 pk; pk.x = pk2(hv[0], hv[1]); pk.y = pk2(hv[2], hv[3]);
                    *(u32x2*)(HM + (size_t)(base + s) * FF + nt * 64 + wc * 32 + n * 16 + fq * 4) = pk;
                }
            }
        }
    }
    if (l + 1 < 2) { const int idle = xcd_max_units(ntiles, nNT) - mine; if (idle > 0) conv_some(p, l + 1, 3 * idle, smem); }
}

__device__ void phase_moe2(const Params& p, int l, unsigned char* smem) {
    int* s_cnt = (int*)(smem + 73728);
    int* s_base = s_cnt + 32;
    int* s_tpre = s_base + 32;
    moe_units(p, l, s_cnt, s_base, s_tpre);
    const bf16_t* HM = (const bf16_t*)(p.ws + WS_LF);
    bf16_t* OUTM = (bf16_t*)(p.ws + WS_P);
    const int tid = otid(), lane = tid & 63, wid = tid >> 6, wr = wid >> 1, wc = wid & 1, fr = lane & 15, fq = lane >> 4;
    const int ntiles = s_tpre[NEXP];
    constexpr int nNT = D / BN;
    int mine = 0;
    for (int it = 0;; ++it, ++mine) {
        int tg, nt;
        if (!xcd_unit(it, ntiles, nNT, tg, nt, smem)) break;
        int e = 0;
        while (s_tpre[e + 1] <= tg) ++e;
        const int mt = tg - s_tpre[e], cnt = s_cnt[e], base = s_base[e];
        const bf16_t* w2 = (const bf16_t*)(p.ws + WS_W2) + ((size_t)l * NEXP + e) * FF * D;
        f32x4 acc[MOE_WM][4];
        auto arow = [&](int i) { int s = mt * MOE_BM + i; s = s < cnt ? s : cnt - 1; return (unsigned)((base + s) * FF); };
        gemm_tile_dma<MOE_WM>(HM, arow, w2 + nt * BN, D, FF, smem, acc);
#pragma unroll
        for (int m = 0; m < MOE_WM; ++m) {
            const int s = mt * MOE_BM + wr * (16 * MOE_WM) + m * 16 + fr;
            if (s < cnt) {
#pragma unroll
                for (int n = 0; n < 4; ++n) {
                    u32x2 pk; pk.x = pk2(acc[m][n][0], acc[m][n][1]); pk.y = pk2(acc[m][n][2], acc[m][n][3]);
                    *(u32x2*)(OUTM + (size_t)(base + s) * D + nt * BN + wc * 64 + n * 16 + fq * 4) = pk;
                }
            }
        }
    }
    if (l + 1 < 2) { const int idle = xcd_max_units(ntiles, nNT) - mine; if (idle > 0) conv_some(p, l + 1, 3 * idle, smem); }
}

#define XB_TMO      128
#define XB_XCNT(j)  (256  + 64 * (j))
#define XB_XSUB(j)  (1280 + 64 * (j))
#define XB_XGEN(j)  (2304 + 64 * (j))
#define XB_TOP      3328
#define XB_TOPGEN   3392
#define XCD_BAR_WORDS 3456
#define XB_SPIN_CAP (1u << 22)
#define LAS __attribute__((address_space(3)))
__device__ __forceinline__ unsigned xb_ld(unsigned* p)              { return __hip_atomic_load(p, __ATOMIC_RELAXED, __HIP_MEMORY_SCOPE_AGENT); }
__device__ __forceinline__ unsigned xb_add(unsigned* p, unsigned v) { return __hip_atomic_fetch_add(p, v, __ATOMIC_RELAXED, __HIP_MEMORY_SCOPE_AGENT); }
__device__ __forceinline__ unsigned xb_xcc_id() { return (unsigned)__builtin_amdgcn_s_getreg((3 << 11) | 20) & 0xFu; }
#define XB_SPIN(cond, bar) do { unsigned _sp = 0; while (cond) { __builtin_amdgcn_s_sleep(1); \
    if ((++_sp & 255u) == 0u) { if (xb_ld(&(bar)[XB_TMO])) break; if (_sp > XB_SPIN_CAP) { atomicAdd(&(bar)[XB_TMO], 1u); break; } } } } while (0)
struct XcdBarrier { unsigned* bar; unsigned x; volatile unsigned* st; };
__device__ __forceinline__ XcdBarrier xcd_barrier_post(unsigned* bar, volatile unsigned* st, volatile int* xinfo) {
    XcdBarrier b; b.bar = bar; b.x = xb_xcc_id(); b.st = st;
    if (threadIdx.x == 0) { const unsigned r = xb_add(&bar[XB_XCNT(b.x)], 1u); xinfo[0] = 0; xinfo[1] = (int)b.x; xinfo[2] = (int)r; xinfo[3] = 0; }
    return b;
}
__device__ __forceinline__ void xcd_barrier_complete(unsigned* bar, unsigned x, unsigned& nloc, unsigned& nx) {
    const unsigned G = gridDim.x * gridDim.y * gridDim.z;
    unsigned sum, cnt, mine, sp = 0u;
    for (;;) {
        sum = 0u; cnt = 0u; mine = 0u;
#pragma unroll
        for (unsigned j = 0; j < 16; ++j) { const unsigned c = xb_ld(&bar[XB_XCNT(j)]); sum += c; cnt += (c > 0u) ? 1u : 0u; mine = (j == x) ? c : mine; }
        if (sum == G) break;
        __builtin_amdgcn_s_sleep(1);
        if ((++sp & 255u) == 0u) { if (xb_ld(&bar[XB_TMO])) break; if (sp > XB_SPIN_CAP) { atomicAdd(&bar[XB_TMO], 1u); break; } }
    }
    nloc = mine > 0u ? mine : 1u; nx = cnt > 0u ? cnt : 1u;
}
__device__ __forceinline__ void xcd_barrier(const XcdBarrier& b) {
    asm volatile("s_waitcnt vmcnt(0)" ::: "memory");
    __syncthreads();
    if (threadIdx.x == 0) {
        unsigned* bar = b.bar;
        __builtin_amdgcn_s_waitcnt(0);
        unsigned nloc = b.st[0], nx = b.st[1];
        if (nloc == 0u) { xcd_barrier_complete(bar, b.x, nloc, nx); b.st[0] = nloc; b.st[1] = nx; }
        const unsigned old = xb_add(&bar[XB_XSUB(b.x)], 1u);
        const unsigned gen = old / nloc;
        if (old + 1u == (gen + 1u) * nloc) {
            __builtin_amdgcn_fence(__ATOMIC_RELEASE, "agent");
            asm volatile("s_waitcnt vmcnt(0)" ::: "memory");
            const unsigned og = xb_add(&bar[XB_TOP], 1u);
            const unsigned tg = og / nx;
            if (og + 1u == (tg + 1u) * nx) xb_add(&bar[XB_TOPGEN], 1u);
            else XB_SPIN(xb_ld(&bar[XB_TOPGEN]) == tg, bar);
            __builtin_amdgcn_fence(__ATOMIC_ACQUIRE, "agent");
            xb_add(&bar[XB_XGEN(b.x)], 1u);
            asm volatile("s_waitcnt vmcnt(0)" ::: "memory");
        } else {
            XB_SPIN(xb_ld(&bar[XB_XGEN(b.x)]) == gen, bar);
            __builtin_amdgcn_fence(__ATOMIC_ACQUIRE, "agent");
            asm volatile("s_waitcnt vmcnt(0)" ::: "memory");
        }
    }
    __syncthreads();
}

constexpr int NPHASES = 16;
#ifndef PROBE_S
#define PROBE_S -1
#define PROBE_REPS 1
#endif
constexpr int SMEM_BYTES = 4 * 64 * LDT * 2 + 4 * 64 * LDT * 2 + 1024;
__global__ void __launch_bounds__(NTHREADS, 2) mega(Params p) {
    __shared__ __attribute__((aligned(16))) unsigned char smem[SMEM_BYTES];
    cg::grid_group grid = cg::this_grid();
    {
        volatile unsigned* st = (volatile unsigned*)(smem + 73728 + 768);
        if (threadIdx.x < 2) st[threadIdx.x] = 0u;
        __syncthreads();
        volatile int* xinfo = (volatile int*)(smem + 73728 + 800);
        (void)xcd_barrier_post((unsigned*)(p.ws + WS_CTL) + 4096, st, xinfo);
    }
#define GRID_BAR() do { XcdBarrier bar_; bar_.bar = (unsigned*)(p.ws + WS_CTL) + 4096; bar_.x = xb_xcc_id(); bar_.st = (volatile unsigned*)(smem + 73728 + 768); xcd_barrier(bar_); } while (0)
    for (int ph = p.ph_lo; ph < p.ph_hi; ++ph) {
        if (ph == 0) phase_init(p, smem);
        else if (ph == NPHASES - 1) phase_final(p, 1);
        else {
            const int l = (ph - 1) / 7, s = (ph - 1) % 7;
            const int reps = (s == PROBE_S) ? PROBE_REPS : 1;
            for (int rep = 0; rep < reps; ++rep) {
                switch (s) {
                    case 0: phase_prep(p, l); break;
                    case 1: phase_gemm_in(p, l, smem); break;
                    case 2: phase_mix1(p, l, smem, rep); break;
                    case 3: phase_out(p, l, smem); break;
                    case 4: phase_route(p, l, smem); break;
                    case 5: phase_moe1(p, l, smem); break;
                    default: phase_moe2(p, l, smem); break;
                }
                if (rep + 1 < reps) GRID_BAR();
            }
        }
        if (ph + 1 < p.ph_hi) {
            if (ph == 0) {
                if (p.ph_hi < 0) grid.sync();
                GRID_BAR();
                if (threadIdx.x == 0) {
                    unsigned* bw = (unsigned*)(p.ws + WS_CTL) + 4096;
                    volatile int* xi = (volatile int*)(smem + 73728 + 800);
                    const unsigned myx = xb_xcc_id();
                    unsigned sum = 0, ok = 1;
                    for (int j = 0; j < 8; ++j) { const unsigned c = xb_ld(&bw[XB_XCNT(j)]); sum += c; ok &= (c > 0u); }
                    xi[3] = (int)xb_ld(&bw[XB_XCNT(myx & 7u)]);
                    xi[0] = (ok && sum == gridDim.x && myx < 8u) ? 1 : 0;
                }
                __syncthreads();
            } else GRID_BAR();
        }
    }
}

extern "C" void kernel_launch(void* const* d_in, const int* in_sizes, int n_in, void* d_out, int out_size, void* d_ws, size_t ws_size, hipStream_t stream) {
    static int grid_blocks = 0;
    if (grid_blocks == 0) {
        if (n_in != 23 || out_size != RL * D || ws_size < WS_END) { fprintf(stderr, "kernel_launch: unexpected shapes (n_in %d out %d ws %zu need %zu)\n", n_in, out_size, ws_size, (size_t)WS_END); grid_blocks = -1; return; }
        int dev = 0, cus = 0, per_cu = 0;
        hipGetDevice(&dev);
        hipDeviceGetAttribute(&cus, hipDeviceAttributeMultiprocessorCount, dev);
        hipOccupancyMaxActiveBlocksPerMultiprocessor(&per_cu, mega, NTHREADS, 0);
        if (per_cu > 2) per_cu = 2;
        if (per_cu < 1) per_cu = 1;
        grid_blocks = cus * per_cu;
    }
    if (grid_blocks < 0) return;
    hipMemsetAsync((char*)d_ws + WS_CTL, 0, 1 * MiB, stream);
    Params p{};
    for (int i = 0; i < 23; ++i) p.in[i] = (const float*)d_in[i];
    p.out = (float*)d_out; p.ws = (unsigned char*)d_ws; p.ph_lo = 0; p.ph_hi = NPHASES;
    void* args[] = {&p};
    hipError_t e = hipLaunchCooperativeKernel((void*)mega, dim3(grid_blocks), dim3(NTHREADS), args, 0, stream);
    if (e != hipSuccess) fprintf(stderr, "cooperative launch failed: %s (grid %d)\n", hipGetErrorString(e), grid_blocks);
}
```
